# Optimizing an MI355X kernel written in HIP

```python
import math
import jax
import jax.numpy as jnp
from jax import lax
import numpy as np

D_MODEL = 1024
BATCH = 2
SEQ = 8192
DEPTH = 2
DEC_BATCH = 8
DEC_SEQ = 64
PAST_LEN = 4096

CHUNK = 64
EPS = 1e-6
D_PLE = 256
D_FF = 3072
FFN_CONV = 3
D_LRU = 512
LRU_HEADS = 8
LRU_HEAD_DIM = D_LRU // LRU_HEADS
LRU_CONV = 4
LRU_C = 8.0
GLA_HEADS = 4
GLA_DK = 64
GLA_DV = 128
GLA_KEY = GLA_HEADS * GLA_DK
GLA_VAL = GLA_HEADS * GLA_DV
GLA_RANK = 16
GLA_TAU = 16.0
SSD_HEADS = 8
SSD_HEAD_DIM = 64
SSD_INNER = SSD_HEADS * SSD_HEAD_DIM
SSD_GROUPS = 2
SSD_STATE = 128
SSD_CONV = 4
SSD_XBC = SSD_INNER + 2 * SSD_GROUPS * SSD_STATE
D_MIX = D_LRU + GLA_VAL + SSD_INNER
IN_WIDTHS = (D_LRU, D_LRU, GLA_KEY, GLA_KEY, GLA_VAL, GLA_VAL, GLA_RANK, SSD_INNER, SSD_XBC, SSD_HEADS)
D_IN = D_LRU * 2 + GLA_KEY * 2 + GLA_VAL * 2 + GLA_RANK + SSD_INNER + SSD_XBC + SSD_HEADS

kernel_name = "hybrid_streaming_encoder_step"


def rmsnorm(x, g):
    xf = x.astype(jnp.float32)
    y = xf * lax.rsqrt(jnp.mean(xf * xf, axis=-1, keepdims=True) + EPS)
    return (y * g.astype(jnp.float32)).astype(x.dtype)


def causal_dwconv(x, buf, w, b):
    T = x.shape[1]
    width = w.shape[0]
    xp = jnp.concatenate([buf.astype(x.dtype), x], axis=1)
    y = b
    for j in range(width):
        y = y + xp[:, j:j + T] * w[j]
    return y, xp[:, T:].astype(buf.dtype)


def _linear_combine(left, right):
    a1, b1 = left
    a2, b2 = right
    return a1 * a2, a2 * b1 + b2


def rglru_mixer(xb, gb, conv_buf, h0, conv_w, conv_b, w_r, b_r, w_i, b_i, lam):
    B, T, _ = xb.shape
    f32 = jnp.float32
    xc, new_buf = causal_dwconv(xb, conv_buf, conv_w, conv_b)
    xh = xc.reshape(B, T, LRU_HEADS, LRU_HEAD_DIM)
    r = jax.nn.sigmoid((jnp.einsum('bthi,hij->bthj', xh, w_r).reshape(B, T, D_LRU) + b_r).astype(f32))
    i_g = jax.nn.sigmoid((jnp.einsum('bthi,hij->bthj', xh, w_i).reshape(B, T, D_LRU) + b_i).astype(f32))
    log_a = -LRU_C * jax.nn.softplus(-lam.astype(f32)) * r
    a = jnp.exp(log_a)
    u = jnp.sqrt(-jnp.expm1(2.0 * log_a)) * (i_g * xc.astype(f32))
    u = u.at[:, 0].add(a[:, 0] * h0.astype(f32))
    _, h = lax.associative_scan(_linear_combine, (a, u), axis=1)
    y = h * jax.nn.gelu(gb.astype(f32), approximate=True)
    return y.astype(xb.dtype), new_buf, h[:, -1].astype(h0.dtype)


def gla_mixer(q, k, v, g, lr, S0, w_lr, b_lr, norm_g):
    B, T, _ = q.shape
    L = min(CHUNK, T)
    N = T // L
    f32 = jnp.float32
    log_alpha = jax.nn.log_sigmoid((lr @ w_lr + b_lr).astype(f32)) / GLA_TAU
    shp_k = (B, N, L, GLA_HEADS, GLA_DK)
    qc = q.astype(f32).reshape(shp_k) * (GLA_DK ** -0.5)
    kc = k.astype(f32).reshape(shp_k)
    vc = v.astype(f32).reshape(B, N, L, GLA_HEADS, GLA_DV)
    cum = jnp.cumsum(log_alpha.reshape(shp_k), axis=2)
    last = cum[:, :, -1]
    q_dec = qc * jnp.exp(cum)
    k_inv = kc * jnp.exp(-cum)
    k_end = kc * jnp.exp(last[:, :, None] - cum)
    mask = jnp.tril(jnp.ones((L, L), dtype=bool))
    scores = jnp.where(mask, jnp.einsum('bnihd,bnjhd->bnhij', q_dec, k_inv), 0.0)
    o_intra = jnp.einsum('bnhij,bnjhe->bnihe', scores, vc)
    dS = jnp.einsum('bnjhd,bnjhe->bnhde', k_end, vc)

    def step(S, inp):
        dec, ds = inp
        return dec[..., None] * S + ds, S

    S_last, S_prev = lax.scan(step, S0.astype(f32), (jnp.moveaxis(jnp.exp(last), 1, 0), jnp.moveaxis(dS, 1, 0)))
    S_prev = jnp.moveaxis(S_prev, 0, 1)
    o = o_intra + jnp.einsum('bnihd,bnhde->bnihe', q_dec, S_prev)
    o = o * lax.rsqrt(jnp.mean(o * o, axis=-1, keepdims=True) + EPS)
    o = o.reshape(B, T, GLA_VAL) * norm_g.astype(f32)
    o = o * jax.nn.silu(g.astype(f32))
    return o.astype(q.dtype), S_last.astype(S0.dtype)


def ssd_mixer(z, xbc, dt_raw, conv_buf, S0, conv_w, conv_b, dt_bias, a_log, d_skip, norm_g):
    B, T, _ = z.shape
    L = min(CHUNK, T)
    N = T // L
    f32 = jnp.float32
    xbc_c, new_buf = causal_dwconv(xbc, conv_buf, conv_w, conv_b)
    xbc_c = jax.nn.silu(xbc_c.astype(f32))
    xs, Bm, Cm = jnp.split(xbc_c, [SSD_INNER, SSD_INNER + SSD_GROUPS * SSD_STATE], axis=-1)
    rep = SSD_HEADS // SSD_GROUPS
    xh = xs.reshape(B, N, L, SSD_HEADS, SSD_HEAD_DIM)
    Bh = jnp.repeat(Bm.reshape(B, T, SSD_GROUPS, SSD_STATE), rep, axis=2).reshape(B, N, L, SSD_HEADS, SSD_STATE)
    Ch = jnp.repeat(Cm.reshape(B, T, SSD_GROUPS, SSD_STATE), rep, axis=2).reshape(B, N, L, SSD_HEADS, SSD_STATE)
    dt = jax.nn.softplus(dt_raw.astype(f32) + dt_bias.astype(f32)).reshape(B, N, L, SSD_HEADS)
    dA = dt * -jnp.exp(a_log.astype(f32))
    cum = jnp.cumsum(dA, axis=2)
    last = cum[:, :, -1]
    cum_h = jnp.moveaxis(cum, 2, 3)
    seg = cum_h[..., :, None] - cum_h[..., None, :]
    mask = jnp.tril(jnp.ones((L, L), dtype=bool))
    decay = jnp.where(mask, jnp.exp(jnp.where(mask, seg, 0.0)), 0.0)
    scores = jnp.einsum('bnihs,bnjhs->bnhij', Ch, Bh) * decay * jnp.moveaxis(dt, 2, 3)[..., None, :]
    y = jnp.einsum('bnhij,bnjhp->bnihp', scores, xh)
    w_end = jnp.exp(last[:, :, None] - cum) * dt
    dS = jnp.einsum('bnjh,bnjhs,bnjhp->bnhps', w_end, Bh, xh)

    def step(S, inp):
        dec, ds = inp
        return dec[..., None, None] * S + ds, S

    S_last, S_prev = lax.scan(step, S0.astype(f32), (jnp.moveaxis(jnp.exp(last), 1, 0), jnp.moveaxis(dS, 1, 0)))
    S_prev = jnp.moveaxis(S_prev, 0, 1)
    y = y + jnp.einsum('bnihs,bnhps->bnihp', Ch, S_prev) * jnp.exp(cum)[..., None]
    y = y + d_skip.astype(f32)[:, None] * xh
    y = y.reshape(B, T, SSD_INNER) * jax.nn.silu(z.astype(f32))
    y = rmsnorm(y, norm_g)
    return y.astype(z.dtype), new_buf, S_last.astype(S0.dtype)


def conv_ffn(xn, buf, w_gate, w_up, conv_w, conv_b, w_down):
    g, new_buf = causal_dwconv(xn @ w_gate, buf, conv_w, conv_b)
    return (jax.nn.gelu(g, approximate=True) * (xn @ w_up)) @ w_down, new_buf


def run_trunk(x, p, lru_conv, lru_h, gla_S, ssd_conv, ssd_S, ffn_conv, weights):
    (norm_mix, w_in, lru_conv_w, lru_conv_b, lru_w_r, lru_b_r, lru_w_i, lru_b_i, lru_lambda,
     gla_w_lr, gla_b_lr, gla_norm, ssd_conv_w, ssd_conv_b, ssd_dt_bias, ssd_a_log, ssd_d, ssd_norm,
     w_out, norm_ffn, ffn_w_gate, ffn_w_up, ffn_conv_w, ffn_conv_b, ffn_w_down,
     norm_ple, ple_w_gate, ple_w_proj, norm_final) = weights
    offsets = np.cumsum(IN_WIDTHS)[:-1].tolist()
    n_lc, n_lh, n_gs, n_sc, n_ss, n_fc = [], [], [], [], [], []
    for i in range(DEPTH):
        xn = rmsnorm(x, norm_mix[i])
        (a_x, a_g, b_q, b_k, b_v, b_g, b_lr, c_z, c_xbc, c_dt) = jnp.split(xn @ w_in[i], offsets, axis=-1)
        ya, nbuf_a, nh_a = rglru_mixer(a_x, a_g, lru_conv[i], lru_h[i], lru_conv_w[i], lru_conv_b[i],
                                       lru_w_r[i], lru_b_r[i], lru_w_i[i], lru_b_i[i], lru_lambda[i])
        yb, nS_b = gla_mixer(b_q, b_k, b_v, b_g, b_lr, gla_S[i], gla_w_lr[i], gla_b_lr[i], gla_norm[i])
        yc, nbuf_c, nS_c = ssd_mixer(c_z, c_xbc, c_dt, ssd_conv[i], ssd_S[i], ssd_conv_w[i], ssd_conv_b[i],
                                     ssd_dt_bias[i], ssd_a_log[i], ssd_d[i], ssd_norm[i])
        x = x + jnp.concatenate([ya, yb, yc], axis=-1) @ w_out[i]
        f, nbuf_f = conv_ffn(rmsnorm(x, norm_ffn[i]), ffn_conv[i], ffn_w_gate[i], ffn_w_up[i],
                             ffn_conv_w[i], ffn_conv_b[i], ffn_w_down[i])
        x = x + f
        gate = jax.nn.sigmoid(rmsnorm(x, norm_ple[i]) @ ple_w_gate[i])
        x = x + gate * (p[i] @ ple_w_proj[i])
        n_lc.append(nbuf_a)
        n_lh.append(nh_a)
        n_gs.append(nS_b)
        n_sc.append(nbuf_c)
        n_ss.append(nS_c)
        n_fc.append(nbuf_f)
    y = rmsnorm(x, norm_final)
    return (y, jnp.stack(n_lc), jnp.stack(n_lh), jnp.stack(n_gs), jnp.stack(n_sc), jnp.stack(n_ss), jnp.stack(n_fc))


def setup_inputs(seed: int = 0) -> dict:
    key = jax.random.key(seed)
    keys = jax.random.split(key, 48)
    counter = [0]

    def nk():
        counter[0] += 1
        return keys[counter[0] - 1]

    def normal(shape, scale):
        return jax.random.normal(nk(), shape, jnp.float32) * scale

    def gain(shape):
        return 1.0 + normal(shape, 0.02)

    a_pow = jax.random.uniform(nk(), (DEPTH, D_LRU), jnp.float32, 0.9, 0.999)
    sig = a_pow ** (1.0 / LRU_C)
    dt0 = jnp.exp(jax.random.uniform(nk(), (DEPTH, SSD_HEADS), jnp.float32, math.log(1e-3), math.log(1e-1)))
    return {
        "x_prompt": normal((BATCH, SEQ, D_MODEL), 1.0),
        "x_sample": normal((DEC_BATCH, DEC_SEQ, D_MODEL), 1.0),
        "state_lru_conv": normal((DEPTH, DEC_BATCH, LRU_CONV - 1, D_LRU), 1.0),
        "state_lru_h": normal((DEPTH, DEC_BATCH, D_LRU), 0.5),
        "state_gla": normal((DEPTH, DEC_BATCH, GLA_HEADS, GLA_DK, GLA_DV), 0.1),
        "state_ssd_conv": normal((DEPTH, DEC_BATCH, SSD_CONV - 1, SSD_XBC), 1.0),
        "state_ssd": normal((DEPTH, DEC_BATCH, SSD_HEADS, SSD_HEAD_DIM, SSD_STATE), 0.1),
        "state_ffn_conv": normal((DEPTH, DEC_BATCH, FFN_CONV - 1, D_FF), 1.0),
        "p_prompt": normal((DEPTH, BATCH, SEQ, D_PLE), 1.0),
        "p_sample": normal((DEPTH, DEC_BATCH, DEC_SEQ, D_PLE), 1.0),
        "norm_mix": gain((DEPTH, D_MODEL)),
        "w_in": normal((DEPTH, D_MODEL, D_IN), D_MODEL ** -0.5),
        "lru_conv_w": normal((DEPTH, LRU_CONV, D_LRU), LRU_CONV ** -0.5),
        "lru_conv_b": normal((DEPTH, D_LRU), 0.01),
        "lru_w_r": normal((DEPTH, LRU_HEADS, LRU_HEAD_DIM, LRU_HEAD_DIM), LRU_HEAD_DIM ** -0.5),
        "lru_b_r": normal((DEPTH, D_LRU), 0.01),
        "lru_w_i": normal((DEPTH, LRU_HEADS, LRU_HEAD_DIM, LRU_HEAD_DIM), LRU_HEAD_DIM ** -0.5),
        "lru_b_i": normal((DEPTH, D_LRU), 0.01),
        "lru_lambda": jnp.log(sig) - jnp.log1p(-sig),
        "gla_w_lr": normal((DEPTH, GLA_RANK, GLA_KEY), GLA_RANK ** -0.5),
        "gla_b_lr": normal((DEPTH, GLA_KEY), 0.1),
        "gla_norm": gain((DEPTH, GLA_VAL)),
        "ssd_conv_w": normal((DEPTH, SSD_CONV, SSD_XBC), SSD_CONV ** -0.5),
        "ssd_conv_b": normal((DEPTH, SSD_XBC), 0.01),
        "ssd_dt_bias": dt0 + jnp.log(-jnp.expm1(-dt0)),
        "ssd_a_log": jnp.log(jax.random.uniform(nk(), (DEPTH, SSD_HEADS), jnp.float32, 1.0, 16.0)),
        "ssd_d": gain((DEPTH, SSD_HEADS)),
        "ssd_norm": gain((DEPTH, SSD_INNER)),
        "w_out": normal((DEPTH, D_MIX, D_MODEL), D_MIX ** -0.5),
        "norm_ffn": gain((DEPTH, D_MODEL)),
        "ffn_w_gate": normal((DEPTH, D_MODEL, D_FF), D_MODEL ** -0.5),
        "ffn_w_up": normal((DEPTH, D_MODEL, D_FF), D_MODEL ** -0.5),
        "ffn_conv_w": normal((DEPTH, FFN_CONV, D_FF), FFN_CONV ** -0.5),
        "ffn_conv_b": normal((DEPTH, D_FF), 0.01),
        "ffn_w_down": normal((DEPTH, D_FF, D_MODEL), D_FF ** -0.5),
        "norm_ple": gain((DEPTH, D_MODEL)),
        "ple_w_gate": normal((DEPTH, D_MODEL, D_MODEL), D_MODEL ** -0.5),
        "ple_w_proj": normal((DEPTH, D_PLE, D_MODEL), D_PLE ** -0.5),
        "norm_final": gain((D_MODEL,)),
    }


def reference(x_prompt, x_sample, state_lru_conv, state_lru_h, state_gla, state_ssd_conv, state_ssd, state_ffn_conv,
              p_prompt, p_sample, norm_mix, w_in, lru_conv_w, lru_conv_b, lru_w_r, lru_b_r, lru_w_i, lru_b_i,
              lru_lambda, gla_w_lr, gla_b_lr, gla_norm, ssd_conv_w, ssd_conv_b, ssd_dt_bias, ssd_a_log, ssd_d,
              ssd_norm, w_out, norm_ffn, ffn_w_gate, ffn_w_up, ffn_conv_w, ffn_conv_b, ffn_w_down, norm_ple,
              ple_w_gate, ple_w_proj, norm_final):
    weights = (norm_mix, w_in, lru_conv_w, lru_conv_b, lru_w_r, lru_b_r, lru_w_i, lru_b_i, lru_lambda,
               gla_w_lr, gla_b_lr, gla_norm, ssd_conv_w, ssd_conv_b, ssd_dt_bias, ssd_a_log, ssd_d, ssd_norm,
               w_out, norm_ffn, ffn_w_gate, ffn_w_up, ffn_conv_w, ffn_conv_b, ffn_w_down,
               norm_ple, ple_w_gate, ple_w_proj, norm_final)
    bp = x_prompt.shape[0]
    dt = x_prompt.dtype
    (y_prompt, p_lru_conv, p_lru_h, p_gla, p_ssd_conv, p_ssd, p_ffn_conv) = run_trunk(
        x_prompt, p_prompt,
        jnp.zeros((DEPTH, bp, LRU_CONV - 1, D_LRU), dt),
        jnp.zeros((DEPTH, bp, D_LRU), dt),
        jnp.zeros((DEPTH, bp, GLA_HEADS, GLA_DK, GLA_DV), dt),
        jnp.zeros((DEPTH, bp, SSD_CONV - 1, SSD_XBC), dt),
        jnp.zeros((DEPTH, bp, SSD_HEADS, SSD_HEAD_DIM, SSD_STATE), dt),
        jnp.zeros((DEPTH, bp, FFN_CONV - 1, D_FF), dt),
        weights)
    (y_sample, s_lru_conv, s_lru_h, s_gla, s_ssd_conv, s_ssd, s_ffn_conv) = run_trunk(
        x_sample, p_sample, state_lru_conv, state_lru_h, state_gla, state_ssd_conv, state_ssd, state_ffn_conv,
        weights)
    return (y_prompt, y_sample, p_lru_conv, p_lru_h, p_gla, p_ssd_conv, p_ssd, p_ffn_conv,
            s_lru_conv, s_lru_h, s_gla, s_ssd_conv, s_ssd, s_ffn_conv)
```

```cpp
#include <hip/hip_runtime.h>
#include <cstdio>
#include <cstdint>

#define DI __device__ __forceinline__
#define LAS __attribute__((address_space(3)))
typedef unsigned short bf16_t;
typedef short bf16x8 __attribute__((ext_vector_type(8)));
typedef short s16x4 __attribute__((ext_vector_type(4)));
typedef float f32x4 __attribute__((ext_vector_type(4)));
typedef float f32x2 __attribute__((ext_vector_type(2)));
typedef unsigned u32x4 __attribute__((ext_vector_type(4)));
typedef unsigned u32x2 __attribute__((ext_vector_type(2)));

#ifndef MK_PER_PHASE
#define MK_PER_PHASE 1
#endif

constexpr int DEPTH = 2, D = 1024, MP = 16384, MS = 512, M = MP + MS;
constexpr int DIN = 4120, DINP = 4352, DFF = 3072, DMIX = 1536, DPLE = 256;
constexpr int NCH = M / 64;
constexpr float EPS = 1e-6f;
constexpr int PC_AX = 0, PC_BQ = 512, PC_BK = 768, PC_BV = 1024, PC_BLR = 1536, PC_XBC = 1552, PC_DT = 2576, PC_PAD = 2584, PC_Y = 2816, PC_AG = 2816, PC_BG = 3328, PC_CZ = 3840;

enum { I_XP = 0, I_XS, I_SLC, I_SLH, I_SG, I_SSC, I_SS, I_SFC, I_PP, I_PS, I_NMIX, I_WIN, I_LCW, I_LCB, I_LWR, I_LBR, I_LWI, I_LBI, I_LAM, I_GWLR, I_GBLR, I_GNORM,
       I_SCW, I_SCB, I_SDTB, I_SALOG, I_SD, I_SNORM, I_WOUT, I_NFFN, I_WG, I_WU, I_FCW, I_FCB, I_WD, I_NPLE, I_PWG, I_PWP, I_NFIN, N_IN };
constexpr size_t O_Y = 0;
constexpr size_t O_PLC = (size_t)M * D;
constexpr size_t O_PLH = O_PLC + 2 * 2 * 3 * 512;
constexpr size_t O_PG = O_PLH + 2 * 2 * 512;
constexpr size_t O_PSC = O_PG + 2 * 2 * 4 * 64 * 128;
constexpr size_t O_PS = O_PSC + 2 * 2 * 3 * 1024;
constexpr size_t O_PFC = O_PS + 2 * 2 * 8 * 64 * 128;
constexpr size_t O_SLC = O_PFC + 2 * 2 * 2 * 3072;
constexpr size_t O_SLH = O_SLC + 2 * 8 * 3 * 512;
constexpr size_t O_SG = O_SLH + 2 * 8 * 512;
constexpr size_t O_SSC = O_SG + 2 * 8 * 4 * 64 * 128;
constexpr size_t O_SS = O_SSC + 2 * 8 * 3 * 1024;
constexpr size_t O_SFC = O_SS + 2 * 8 * 8 * 64 * 128;
constexpr size_t O_END = O_SFC + 2 * 8 * 2 * 3072;

constexpr size_t MiB = 1u << 20;
constexpr size_t al4k(size_t x) { return (x + 4095) & ~(size_t)4095; }
constexpr int XB_PAD = 256;
constexpr int XB_ROWS = XB_PAD + M + 128;
constexpr size_t WS_CTL = 0, CTL_ZERO_BYTES = 64 * 1024;
constexpr size_t WS_WIN = al4k(WS_CTL + CTL_ZERO_BYTES);
constexpr size_t WS_WOUT = al4k(WS_WIN + (size_t)DINP * D * 2);
constexpr size_t WS_WGU = al4k(WS_WOUT + (size_t)D * DMIX * 2);
constexpr size_t WS_WD = al4k(WS_WGU + (size_t)2 * DFF * D * 2);
constexpr size_t WS_WPG = al4k(WS_WD + (size_t)D * DFF * 2);
constexpr size_t WS_WPP = al4k(WS_WPG + (size_t)D * D * 2);
constexpr size_t WS_LRUW = al4k(WS_WPP + (size_t)D * DPLE * 2);
constexpr size_t WS_RSS = al4k(WS_LRUW + (size_t)DEPTH * 2 * 8 * 4096 * 2);
constexpr size_t WS_RSSN = al4k(WS_RSS + (size_t)XB_ROWS * 64);
constexpr size_t WS_PSS = al4k(WS_RSSN + (size_t)XB_ROWS * 64);
constexpr size_t WS_LRUS = al4k(WS_PSS + (size_t)M * 64);
constexpr size_t WS_DEC = al4k(WS_LRUS + (size_t)3 * NCH * 512 * 4);
constexpr size_t WS_PB = al4k(WS_DEC + (size_t)(64 * 4 * 64 + 64 * 8) * 4);
constexpr size_t WS_XB = al4k(WS_PB + (size_t)M * DPLE * 2);
constexpr size_t WS_DS = al4k(WS_XB + (size_t)XB_ROWS * D * 2);
constexpr size_t WS_XBN = WS_DS;
constexpr size_t WS_R = al4k(WS_DS + (size_t)M * D * 2);
constexpr size_t WS_PPO = WS_R + 100 * MiB;
constexpr size_t WS_END = WS_R + (size_t)M * DINP * 2;
static_assert(WS_END <= 256 * MiB, "workspace");
static_assert((size_t)64 * 12 * 8192 * 4 <= (size_t)M * D * 2, "DS fits the XBN slot");
static_assert((size_t)M * DFF * 2 <= 100 * MiB && WS_PPO + (size_t)M * D * 2 <= WS_END, "overlay");

DI float bf2f(bf16_t b) { return __uint_as_float(((unsigned)b) << 16); }
DI unsigned f2bf(float f) { unsigned u = __float_as_uint(f); return (u + 0x7fffu + ((u >> 16) & 1u)) >> 16; }
DI unsigned pk2(float lo, float hi) { return f2bf(lo) | (f2bf(hi) << 16); }
DI float sigm(float x) { return __builtin_amdgcn_rcpf(1.f + __expf(-x)); }
DI float silu_f(float x) { return x * __builtin_amdgcn_rcpf(1.f + __expf(-x)); }
DI float gelu_t(float x) { const float u = 1.5957691216f * (x + 0.044715f * x * x * x); return x * __builtin_amdgcn_rcpf(1.f + __expf(-u)); }
DI float softplus_f(float x) { return fmaxf(x, 0.f) + log1pf(__expf(-fabsf(x))); }
DI float logsig_f(float x) { return fminf(x, 0.f) - log1pf(__expf(-fabsf(x))); }
DI void unpack8(const u32x4 v, float (&o)[8]) {
#pragma unroll
    for (int i = 0; i < 4; ++i) { o[2 * i] = __uint_as_float(v[i] << 16); o[2 * i + 1] = __uint_as_float(v[i] & 0xffff0000u); }
}
DI u32x4 pack8(const float (&o)[8]) { u32x4 r; r.x = pk2(o[0], o[1]); r.y = pk2(o[2], o[3]); r.z = pk2(o[4], o[5]); r.w = pk2(o[6], o[7]); return r; }
DI int lane_id() { int l; asm volatile("v_mbcnt_lo_u32_b32 %0, -1, 0\n\tv_mbcnt_hi_u32_b32 %0, -1, %0" : "=v"(l)); return l; }
#define LDS_WAIT() asm volatile("s_waitcnt lgkmcnt(0)" ::: "memory")
#define VM_WAIT() asm volatile("s_waitcnt vmcnt(0)" ::: "memory")

namespace pg8 {
constexpr int BM = 256, BK = 64, HALF = 128, HTB = HALF * BK * 2, STAGE_BYTES = 8 * HTB, NXCD = 8, WGM = 8;
__host__ __device__ __forceinline__ int lds_byte(int r, int c) { const int st = (r >> 4) * 2 + (c >> 5), rr = r & 15, cc = c & 31, ob = rr * 64 + cc * 2; return st * 1024 + (ob ^ (((ob >> 9) & 1) << 5)); }
__host__ __device__ __forceinline__ void stage_rc(int b, int& R, int& C) { const int st = b / 1024, sb = b % 1024, swz = sb ^ (((sb >> 9) & 1) << 5); R = (st >> 1) * 16 + swz / 64; C = (st & 1) * 32 + (swz % 64) / 2; }
__host__ __device__ __forceinline__ int perm32(int rho) { const int n = rho >> 4, i = rho & 15; return 8 * (i >> 2) + 4 * n + (i & 3); }

struct Unit { int pm, pn, arow; };
struct Gemm { const bf16_t* A; const bf16_t* Bt; int lda, ldb, K; };

struct StaticOrder {
    int nM, nN, nwg, G, c, shifted;
    __device__ void init(int nM_, int nN_, int G_, int c_, int shifted_) { nM = nM_; nN = nN_; nwg = nM * nN; G = G_; c = c_; shifted = shifted_; }
    __device__ bool next(int i, Unit& u) const {
        const long L = (long)i * G + c; if (L >= nwg) return false;
        int wgid = (int)L; { const int q = nwg / NXCD, r = nwg % NXCD, xcd = wgid % NXCD, off = wgid / NXCD; wgid = (xcd < r ? xcd * (q + 1) : r * (q + 1) + (xcd - r) * q) + off; }
        const int nig = WGM * nN, gid = wgid / nig, fm = gid * WGM, gsz = (nM - fm) < WGM ? (nM - fm) : WGM;
        u.pm = fm + ((wgid % nig) % gsz); u.pn = (wgid % nig) / gsz; u.arow = shifted ? 254 * u.pm - 2 : 256 * u.pm; return true;
    }
};
DI unsigned cvt_pk_bf16(float lo, float hi) { unsigned r; asm volatile("v_cvt_pk_bf16_f32 %0, %1, %2" : "=v"(r) : "v"(lo), "v"(hi)); return r; }

template <class Epi, class Sched>
DI void gemm_phase(LAS unsigned char* lds, const Gemm g, const Sched& S, const Epi& E, int wid) {
    const int lane = lane_id(), tid = wid * 64 + lane, wr = wid >> 2, wc = wid & 3, fr = lane & 15, fq = lane >> 4;
    const int K = g.K, nt = K / BK;
    unsigned voffA[2], voffB[2];
#pragma unroll
    for (int i = 0; i < 2; ++i) { int R, C; stage_rc(tid * 16 + i * 8192, R, C); const int Rb = Epi::PERM ? ((R & ~31) + perm32(R & 31)) : R;
        voffA[i] = (unsigned)(R * g.lda + C) * 2u; voffB[i] = (unsigned)(Rb * g.ldb + C) * 2u; }
    const size_t kstep = (size_t)(BK * 2);
    const size_t hstepA = (size_t)HALF * g.lda * 2, hstepB = (size_t)HALF * g.ldb * 2;
    const unsigned ldsw = (unsigned)wid * 1024u;
    const int aoff = lds_byte(wr * 64 + fr, fq * 8), boff = lds_byte(wc * 32 + fr, fq * 8);
#define PG8_SA(b, h) (((b) * 2 + (h)) * HTB)
#define PG8_SB(b, h) ((4 + (b) * 2 + (h)) * HTB)
#define PG8_STAGE(bufoff, gbase, voff) do { _Pragma("unroll") for (int _i = 0; _i < 2; ++_i) \
        __builtin_amdgcn_global_load_lds((const unsigned*)((const char*)(gbase) + (voff)[_i]), (LAS unsigned*)(lds + (bufoff) + ldsw + _i * 8192), 16, 0, 0); } while (0)
#define PG8_LDA(dst, b, h) do { _Pragma("unroll") for (int m = 0; m < 4; ++m) _Pragma("unroll") for (int k = 0; k < 2; ++k) dst[m][k] = *(const LAS bf16x8*)(lds + PG8_SA(b, h) + aoff + m * 2048 + k * 1024); } while (0)
#define PG8_LDB(dst, b, h) do { _Pragma("unroll") for (int n = 0; n < 2; ++n) _Pragma("unroll") for (int k = 0; k < 2; ++k) dst[n][k] = *(const LAS bf16x8*)(lds + PG8_SB(b, h) + boff + n * 2048 + k * 1024); } while (0)
#define PG8_MMA(ai, bj, At, Bt) do { __builtin_amdgcn_s_setprio(1); _Pragma("unroll") for (int m = 0; m < 4; ++m) _Pragma("unroll") for (int n = 0; n < 2; ++n) _Pragma("unroll") for (int k = 0; k < 2; ++k) \
        acc[ai][bj][m][n] = __builtin_amdgcn_mfma_f32_16x16x32_bf16(Bt[n][k], At[m][k], acc[ai][bj][m][n], 0, 0, 0); __builtin_amdgcn_s_setprio(0); } while (0)
#define PG8_WAIT_V(n) asm volatile("s_waitcnt vmcnt(" #n ")" ::: "memory")
#define PG8_WAIT_L(n) asm volatile("s_waitcnt lgkmcnt(" #n ")" ::: "memory")
#define PG8_BAR __builtin_amdgcn_s_barrier()
#define PG8_SCHED __builtin_amdgcn_sched_barrier(0)
    Unit cur, nxt; int ui = 0;
    if (!S.next(0, cur)) return;
    f32x4 acc[2][2][4][2];
#pragma unroll
    for (int a = 0; a < 2; ++a)
#pragma unroll
        for (int b = 0; b < 2; ++b)
#pragma unroll
            for (int m = 0; m < 4; ++m)
#pragma unroll
                for (int n = 0; n < 2; ++n) acc[a][b][m][n] = (f32x4){0.f, 0.f, 0.f, 0.f};
    bf16x8 At[4][2], B0[2][2], B1[2][2];
    const char* cA = (const char*)g.A + (long)cur.arow * g.lda * 2; const char* cB = (const char*)g.Bt + (size_t)cur.pn * 256 * g.ldb * 2;
    PG8_STAGE(PG8_SB(0, 0), cB, voffB); PG8_STAGE(PG8_SB(0, 1), cB + hstepB, voffB); PG8_STAGE(PG8_SA(0, 0), cA, voffA); PG8_STAGE(PG8_SA(0, 1), cA + hstepA, voffA);
    if (wr == 1) PG8_BAR;
    PG8_WAIT_V(2); PG8_BAR;
    PG8_STAGE(PG8_SB(1, 0), cB + kstep, voffB); PG8_STAGE(PG8_SA(1, 0), cA + kstep, voffA); PG8_STAGE(PG8_SB(1, 1), cB + hstepB + kstep, voffB);
    PG8_WAIT_V(6); PG8_BAR;
    for (;;) {
        const bool has_next = S.next(ui + 1, nxt);
        const char* nA = has_next ? (const char*)g.A + (long)nxt.arow * g.lda * 2 : cA; const char* nB = has_next ? (const char*)g.Bt + (size_t)nxt.pn * 256 * g.ldb * 2 : cB;
#pragma unroll 1
        for (int t = 0; t < nt; t += 2) {
            const bool last = (t == nt - 2);
            const char* a1 = cA + (size_t)(t + 1) * kstep;
            const char* a2 = last ? nA : cA + (size_t)(t + 2) * kstep; const char* b2 = last ? nB : cB + (size_t)(t + 2) * kstep;
            const char* a3 = a2 + kstep; const char* b3 = b2 + kstep;
            PG8_LDB(B0, 0, 0); PG8_LDB(B1, 0, 1); PG8_SCHED; PG8_LDA(At, 0, 0); PG8_STAGE(PG8_SA(1, 1), a1 + hstepA, voffA);
            PG8_WAIT_V(8); PG8_WAIT_L(0); PG8_BAR; PG8_MMA(0, 0, At, B0); PG8_MMA(0, 1, At, B1); PG8_BAR; PG8_SCHED;
            PG8_LDA(At, 0, 1); PG8_STAGE(PG8_SB(0, 0), b2, voffB); PG8_STAGE(PG8_SB(0, 1), b2 + hstepB, voffB); PG8_STAGE(PG8_SA(0, 0), a2, voffA);
            PG8_WAIT_V(8); PG8_WAIT_L(0); PG8_BAR; PG8_MMA(1, 0, At, B0); PG8_MMA(1, 1, At, B1); PG8_BAR; PG8_SCHED;
            PG8_LDB(B0, 1, 0); PG8_LDB(B1, 1, 1); PG8_SCHED; PG8_LDA(At, 1, 0); PG8_STAGE(PG8_SA(0, 1), a2 + hstepA, voffA);
            PG8_WAIT_V(8); PG8_WAIT_L(0); PG8_BAR; PG8_MMA(0, 0, At, B0); PG8_MMA(0, 1, At, B1); PG8_BAR; PG8_SCHED;
            PG8_LDA(At, 1, 1); PG8_STAGE(PG8_SB(1, 0), b3, voffB); PG8_STAGE(PG8_SB(1, 1), b3 + hstepB, voffB); PG8_STAGE(PG8_SA(1, 0), a3, voffA);
            PG8_WAIT_V(8); PG8_WAIT_L(0); PG8_BAR; PG8_MMA(1, 0, At, B0); PG8_MMA(1, 1, At, B1); PG8_BAR; PG8_SCHED;
        }
        if (wr == 0) PG8_BAR;
        { const int l2 = lane_id(); E(acc, cur, wr, wc, l2 & 15, l2 >> 4, lds); }
        if (!has_next) break;
#pragma unroll
        for (int a = 0; a < 2; ++a)
#pragma unroll
            for (int b = 0; b < 2; ++b)
#pragma unroll
                for (int m = 0; m < 4; ++m)
#pragma unroll
                    for (int n = 0; n < 2; ++n) acc[a][b][m][n] = (f32x4){0.f, 0.f, 0.f, 0.f};
        cur = nxt; cA = nA; cB = nB; ++ui;
        if (wr == 1) PG8_BAR;
    }
    PG8_WAIT_V(0);
    PG8_BAR;
#undef PG8_SA
#undef PG8_SB
#undef PG8_STAGE
#undef PG8_LDA
#undef PG8_LDB
#undef PG8_MMA
#undef PG8_WAIT_V
#undef PG8_WAIT_L
#undef PG8_BAR
#undef PG8_SCHED
}
}

#define XB_TMO      128
#define XB_XCNT(j)  (256  + 64 * (j))
#define XB_XSUB(j)  (1280 + 64 * (j))
#define XB_XGEN(j)  (2304 + 64 * (j))
#define XB_TOP      3328
#define XB_TOPGEN   3392
#define XCD_BAR_WORDS 3456
#define XB_SPIN_CAP (1u << 18)
DI unsigned xb_ld(unsigned* p)              { return __hip_atomic_load(p, __ATOMIC_RELAXED, __HIP_MEMORY_SCOPE_AGENT); }
DI unsigned xb_add(unsigned* p, unsigned v) { return __hip_atomic_fetch_add(p, v, __ATOMIC_RELAXED, __HIP_MEMORY_SCOPE_AGENT); }
DI unsigned xb_xcc_id() { return (unsigned)__builtin_amdgcn_s_getreg((3 << 11) | 20) & 0xFu; }
#define XB_SPIN(cond, bar) do { unsigned _sp = 0; while (cond) { __builtin_amdgcn_s_sleep(1); \
    if ((++_sp & 255u) == 0u) { if (xb_ld(&(bar)[XB_TMO])) break; if (_sp > XB_SPIN_CAP) { atomicAdd(&(bar)[XB_TMO], 1u); break; } } } } while (0)
struct XcdBarrier { unsigned* bar; unsigned x; volatile LAS unsigned* st; };
DI XcdBarrier xcd_barrier_post(unsigned* bar, volatile LAS unsigned* st, bool t0) {
    XcdBarrier b; b.bar = bar; b.x = xb_xcc_id(); b.st = st;
    if (t0) (void)xb_add(&bar[XB_XCNT(b.x)], 1u);
    return b;
}
DI void xcd_barrier_complete(unsigned* bar, unsigned x, unsigned& nloc, unsigned& nx) {
    const unsigned G = gridDim.x * gridDim.y * gridDim.z;
    unsigned sum, cnt, mine, sp = 0u;
    for (;;) {
        sum = 0u; cnt = 0u; mine = 0u;
#pragma unroll
        for (unsigned j = 0; j < 16; ++j) { const unsigned c = xb_ld(&bar[XB_XCNT(j)]); sum += c; cnt += (c > 0u) ? 1u : 0u; mine = (j == x) ? c : mine; }
        if (sum == G) break;
        __builtin_amdgcn_s_sleep(1);
        if ((++sp & 255u) == 0u) { if (xb_ld(&bar[XB_TMO])) break; if (sp > XB_SPIN_CAP) { atomicAdd(&bar[XB_TMO], 1u); break; } }
    }
    nloc = mine > 0u ? mine : 1u; nx = cnt > 0u ? cnt : 1u;
}
DI void xcd_barrier(const XcdBarrier& b, bool t0) {
    asm volatile("s_waitcnt vmcnt(0)" ::: "memory");
    __syncthreads();
    if (t0) {
        unsigned* bar = b.bar;
        __builtin_amdgcn_s_waitcnt(0);
        unsigned nloc = b.st[0], nx = b.st[1];
        if (nloc == 0u) { xcd_barrier_complete(bar, b.x, nloc, nx); b.st[0] = nloc; b.st[1] = nx; }
        const unsigned old = xb_add(&bar[XB_XSUB(b.x)], 1u);
        const unsigned gen = old / nloc;
        if (old + 1u == (gen + 1u) * nloc) {
            __builtin_amdgcn_fence(__ATOMIC_RELEASE, "agent");
            asm volatile("s_waitcnt vmcnt(0)" ::: "memory");
            const unsigned og = xb_add(&bar[XB_TOP], 1u);
            const unsigned tg = og / nx;
            if (og + 1u == (tg + 1u) * nx) xb_add(&bar[XB_TOPGEN], 1u);
            else XB_SPIN(xb_ld(&bar[XB_TOPGEN]) == tg, bar);
            __builtin_amdgcn_fence(__ATOMIC_ACQUIRE, "agent");
            xb_add(&bar[XB_XGEN(b.x)], 1u);
            asm volatile("s_waitcnt vmcnt(0)" ::: "memory");
        } else {
            XB_SPIN(xb_ld(&bar[XB_XGEN(b.x)]) == gen, bar);
            __builtin_amdgcn_fence(__ATOMIC_ACQUIRE, "agent");
            asm volatile("s_waitcnt vmcnt(0)" ::: "memory");
        }
    }
    __syncthreads();
}

constexpr int NWAVES = 8;
constexpr int RING_BYTES = 131072;
constexpr int XG_OFF = RING_BYTES;
constexpr int MISC_OFF = RING_BYTES + 8192;
constexpr int LDS_BYTES = 147456;

struct Args { const float* in[N_IN]; float* out; unsigned char* ws; int ph_lo, ph_hi, use_bar, pad; };

struct Ctx {
    LAS unsigned char* lds;
    const float* const* in; float* out; unsigned char* ws;
    int tid, lane, wave, G, vcu;
};
#define OPAQUE_CTX(C) do { asm volatile("" : "+v"((C).tid), "+v"((C).lane)); asm volatile("" : "+s"((C).wave), "+s"((C).vcu)); } while (0)
DI bf16_t* wsb(const Ctx& F, size_t off) { return (bf16_t*)(F.ws + off); }
DI float* wsf(const Ctx& F, size_t off) { return (float*)(F.ws + off); }

DI bool chunk_first(int c) { return c == 0 || c == 128 || c >= 256; }
DI bool chunk_last(int c) { return c == 127 || c >= 255; }
DI int chunk_seq(int c) { return c < 128 ? 0 : (c < 256 ? 1 : c - 254); }
DI float* st_out(const Ctx& F, size_t offp, size_t offs, int layer, int seq, int per) {
    return seq < 2 ? F.out + offp + (size_t)(layer * 2 + seq) * per : F.out + offs + (size_t)(layer * 8 + (seq - 2)) * per;
}

DI float wave_sum(float v) {
#pragma unroll
    for (int o = 1; o < 64; o <<= 1) v += __shfl_xor(v, o);
    return v;
}
DI int win_dst(int n) {
    if (n < 512) return PC_AX + n;
    if (n < 1024) return PC_AG + (n - 512);
    if (n < 1280) return PC_BQ + (n - 1024);
    if (n < 1536) return PC_BK + (n - 1280);
    if (n < 2048) return PC_BV + (n - 1536);
    if (n < 2560) return PC_BG + (n - 2048);
    if (n < 2576) return PC_BLR + (n - 2560);
    if (n < 3088) return PC_CZ + (n - 2576);
    if (n < 4112) return PC_XBC + (n - 3088);
    return PC_DT + (n - 4112);
}
DI int map_row(int mode, int n) {
    if (mode == 1) return win_dst(n);
    if (mode == 2) return 256 * (n >> 7) + (n & 127);
    if (mode == 3) return 256 * (n >> 7) + 128 + (n & 127);
    return n;
}
DI void tr_item(const float* W, int K, int N, bf16_t* WT, int mode, const float* g, LAS float* scr, int item, int lane) {
    const int nblk = (N + 31) / 32, kb = item / nblk, nb = item % nblk, k0 = 64 * kb, n0 = 32 * nb;
#pragma unroll 8
    for (int i = 0; i < 32; ++i) { const int kk = 2 * i + (lane >> 5), n = n0 + (lane & 31); float v = n < N ? W[(size_t)(k0 + kk) * N + n] : 0.f; if (g) v *= g[k0 + kk]; scr[kk * 33 + (lane & 31)] = v; }
    LDS_WAIT();
    const int c = lane & 7;
#pragma unroll
    for (int j = 0; j < 4; ++j) { const int n = (lane >> 3) + 8 * j; const LAS float* s = scr + (8 * c) * 33 + n;
        u32x4 o; o.x = pk2(s[0 * 33], s[1 * 33]); o.y = pk2(s[2 * 33], s[3 * 33]); o.z = pk2(s[4 * 33], s[5 * 33]); o.w = pk2(s[6 * 33], s[7 * 33]);
        if (n0 + n < N) *(u32x4*)(WT + (size_t)map_row(mode, n0 + n) * K + k0 + 8 * c) = o; }
    LDS_WAIT();
}
DI void convert_set(const Ctx& F, int layer, int which) {
    LAS float* scr = (LAS float*)(F.lds + F.wave * 16384);
    const int gw = F.vcu * NWAVES + F.wave, NGW = F.G * NWAVES;
    int base = 0;
#define CONV_MAT(cond, Wp, K_, N_, WTp, mode_, gp) if (cond) { const int ni = ((K_) / 64) * (((N_) + 31) / 32); \
        for (int it = gw - base; it < ni; it += NGW) { if (it >= 0) tr_item(Wp, K_, N_, WTp, mode_, gp, scr, it, F.lane); } base = (base + ni) % NGW; }
    CONV_MAT(which & 1, F.in[I_WIN] + (size_t)layer * D * DIN, D, DIN, wsb(F, WS_WIN), 1, F.in[I_NMIX] + layer * D)
    CONV_MAT(which & 2, F.in[I_WOUT] + (size_t)layer * DMIX * D, DMIX, D, wsb(F, WS_WOUT), 0, (const float*)nullptr)
    CONV_MAT(which & 4, F.in[I_WG] + (size_t)layer * D * DFF, D, DFF, wsb(F, WS_WGU), 2, F.in[I_NFFN] + layer * D)
    CONV_MAT(which & 4, F.in[I_WU] + (size_t)layer * D * DFF, D, DFF, wsb(F, WS_WGU), 3, F.in[I_NFFN] + layer * D)
    CONV_MAT(which & 8, F.in[I_WD] + (size_t)layer * DFF * D, DFF, D, wsb(F, WS_WD), 0, (const float*)nullptr)
    CONV_MAT(which & 16, F.in[I_PWG] + (size_t)layer * D * D, D, D, wsb(F, WS_WPG), 0, F.in[I_NPLE] + layer * D)
    CONV_MAT(which & 32, F.in[I_PWP] + (size_t)layer * DPLE * D, DPLE, D, wsb(F, WS_WPP), 0, (const float*)nullptr)
    if (which & 128) {
        for (int it = gw; it < DEPTH * 2 * 8 * 2; it += NGW) { const int mat = it >> 1, sub = it & 1, l = mat >> 4, ri = (mat >> 3) & 1, h = mat & 7;
            tr_item(F.in[ri ? I_LWI : I_LWR] + (size_t)(l * 8 + h) * 4096, 64, 64, wsb(F, WS_LRUW) + (size_t)((l * 2 + ri) * 8 + h) * 4096, 0, nullptr, scr, sub, F.lane); }
    }
#undef CONV_MAT
    if (which & 1) {
        u32x4* z = (u32x4*)(wsb(F, WS_WIN) + (size_t)PC_PAD * D); const int n16 = (PC_Y - PC_PAD) * D * 2 / 16;
        u32x4 zv = (u32x4){0u, 0u, 0u, 0u}; asm volatile("" : "+v"(zv));
        for (int i = blockIdx.x * 512 + F.tid; i < n16; i += F.G * 512) z[i] = zv;
    }
    if (which & 64) {
        const float* pp = F.in[I_PP] + (size_t)layer * MP * DPLE; const float* ps = F.in[I_PS] + (size_t)layer * MS * DPLE; bf16_t* pb = wsb(F, WS_PB);
        const int n8 = M * DPLE / 8;
        for (int i = blockIdx.x * 512 + F.tid; i < n8; i += F.G * 512) { const size_t e = (size_t)i * 8; const float* src = e < (size_t)MP * DPLE ? pp + e : ps + (e - (size_t)MP * DPLE);
            const f32x4 a = *(const f32x4*)src, b = *(const f32x4*)(src + 4); u32x4 o; o.x = pk2(a.x, a.y); o.y = pk2(a.z, a.w); o.z = pk2(b.x, b.y); o.w = pk2(b.z, b.w); *(u32x4*)(pb + e) = o; }
    }
}
DI void p0_rows(const Ctx& F) {
    const int gw = F.vcu * NWAVES + F.wave, NGW = F.G * NWAVES;
    bf16_t* xb = wsb(F, WS_XBN); float* rss = wsf(F, WS_RSSN) + (size_t)XB_PAD * 16;
    for (int m = gw; m < M; m += NGW) {
        const float* xr = m < MP ? F.in[I_XP] + (size_t)m * D : F.in[I_XS] + (size_t)(m - MP) * D;
        const f32x4* x4 = (const f32x4*)xr + F.lane; f32x4 v[4]; float s = 0.f;
#pragma unroll
        for (int j = 0; j < 4; ++j) { v[j] = x4[64 * j]; s += (v[j].x * v[j].x + v[j].y * v[j].y) + (v[j].z * v[j].z + v[j].w * v[j].w); }
        s = wave_sum(s);
        u32x2* o8 = (u32x2*)(xb + (size_t)m * D) + F.lane;
#pragma unroll
        for (int j = 0; j < 4; ++j) { u32x2 w; w.x = pk2(v[j].x, v[j].y); w.y = pk2(v[j].z, v[j].w); o8[64 * j] = w; }
        if (F.lane < 16) rss[(size_t)m * 16 + F.lane] = F.lane == 0 ? s : 0.f;
    }
}

DI float row_rstd(const float* rss, long row) {
    const f32x4* p = (const f32x4*)(rss + row * 16); const f32x4 a = p[0], b = p[1], c = p[2], d = p[3];
    const float s = ((a.x + a.y) + (a.z + a.w)) + ((b.x + b.y) + (b.z + b.w)) + ((c.x + c.y) + (c.z + c.w)) + ((d.x + d.y) + (d.z + d.w));
    return rsqrtf(fmaxf(s, 0.f) * (1.f / D) + EPS);
}
DI float row_rstd_q(const float* rss, long row, int fq) {
    const f32x4 a = *(const f32x4*)(rss + row * 16 + 4 * fq); float s = (a.x + a.y) + (a.z + a.w);
    s += __shfl_xor(s, 16); s += __shfl_xor(s, 32);
    return rsqrtf(fmaxf(s, 0.f) * (1.f / D) + EPS);
}
struct EpiProj {
    static constexpr bool PERM = true;
    bf16_t* O; const float* rss;
    DI void operator()(const f32x4 (&acc)[2][2][4][2], const pg8::Unit& u, int wr, int wc, int fr_, int fq_, LAS unsigned char*) const {
        int fr = fr_, fq = fq_; asm volatile("" : "+v"(fr), "+v"(fq));
        const int row0 = u.arow + wr * 64 + fr, col0 = u.pn * 256 + wc * 32 + 8 * fq;
#pragma unroll
        for (int ai = 0; ai < 2; ++ai)
#pragma unroll
            for (int m = 0; m < 4; ++m) { const int r = row0 + ai * 128 + m * 16; const float rs = row_rstd_q(rss, r, fq); bf16_t* rowp = O + (size_t)r * DINP + col0;
#pragma unroll
                for (int bj = 0; bj < 2; ++bj) { const f32x4 v0 = acc[ai][bj][m][0] * rs, v1 = acc[ai][bj][m][1] * rs;
                    u32x4 w; w.x = pg8::cvt_pk_bf16(v0[0], v0[1]); w.y = pg8::cvt_pk_bf16(v0[2], v0[3]); w.z = pg8::cvt_pk_bf16(v1[0], v1[1]); w.w = pg8::cvt_pk_bf16(v1[2], v1[3]);
                    *(u32x4*)(rowp + bj * 128) = w; } }
    }
};
struct EpiRes {
    static constexpr bool PERM = false;
    const float* xin_p; const float* xin_s; float* xout; bf16_t* xb; float* rss;
    DI void operator()(const f32x4 (&acc)[2][2][4][2], const pg8::Unit& u, int wr, int wc, int fr_, int fq_, LAS unsigned char*) const {
        int fr = fr_, fq = fq_; asm volatile("" : "+v"(fr), "+v"(fq));
        const int row0 = u.arow + wr * 64 + fr, col0 = u.pn * 256 + wc * 32 + 4 * fq;
#pragma unroll
        for (int ai = 0; ai < 2; ++ai)
#pragma unroll
            for (int m = 0; m < 4; ++m) { const int r = row0 + ai * 128 + m * 16; const size_t off = (size_t)r * D + col0;
                const float* xi = r < MP ? xin_p + off : xin_s + (off - (size_t)MP * D);
                float ss = 0.f;
#pragma unroll
                for (int bj = 0; bj < 2; ++bj)
#pragma unroll
                    for (int n = 0; n < 2; ++n) { const int co = bj * 128 + n * 16;
                        const f32x4 xn = *(const f32x4*)(xi + co) + acc[ai][bj][m][n]; *(f32x4*)(xout + off + co) = xn;
                        u32x2 w; w.x = pg8::cvt_pk_bf16(xn[0], xn[1]); w.y = pg8::cvt_pk_bf16(xn[2], xn[3]); *(u32x2*)(xb + off + co) = w;
                        ss += (xn[0] * xn[0] + xn[1] * xn[1]) + (xn[2] * xn[2] + xn[3] * xn[3]); }
                ss += __shfl_xor(ss, 16); ss += __shfl_xor(ss, 32);
                if (fq == 0) rss[(size_t)r * 16 + u.pn * 4 + wc] = ss;
                asm volatile("" ::: "memory"); }
    }
};
struct EpiPle {
    static constexpr bool PERM = false;
    const float* xin; float* xout; bf16_t* xb; const float* rss_in; float* rss_out; const bf16_t* pp;
    DI void operator()(const f32x4 (&acc)[2][2][4][2], const pg8::Unit& u, int wr, int wc, int fr_, int fq_, LAS unsigned char*) const {
        int fr = fr_, fq = fq_; asm volatile("" : "+v"(fr), "+v"(fq));
        const int row0 = u.arow + wr * 64 + fr, col0 = u.pn * 256 + wc * 32 + 4 * fq;
#pragma unroll
        for (int ai = 0; ai < 2; ++ai)
#pragma unroll
            for (int m = 0; m < 4; ++m) { const int r = row0 + ai * 128 + m * 16; const size_t off = (size_t)r * D + col0;
                const float rs = row_rstd_q(rss_in, r, fq); float ss = 0.f;
#pragma unroll
                for (int bj = 0; bj < 2; ++bj)
#pragma unroll
                    for (int n = 0; n < 2; ++n) { const int co = bj * 128 + n * 16; f32x4 f = acc[ai][bj][m][n];
                        const u32x2 pw = *(const u32x2*)(pp + off + co);
                        f[0] = sigm(f[0] * rs) * __uint_as_float(pw.x << 16); f[1] = sigm(f[1] * rs) * __uint_as_float(pw.x & 0xffff0000u);
                        f[2] = sigm(f[2] * rs) * __uint_as_float(pw.y << 16); f[3] = sigm(f[3] * rs) * __uint_as_float(pw.y & 0xffff0000u);
                        const f32x4 xn = *(const f32x4*)(xin + off + co) + f; *(f32x4*)(xout + off + co) = xn;
                        u32x2 w; w.x = pg8::cvt_pk_bf16(xn[0], xn[1]); w.y = pg8::cvt_pk_bf16(xn[2], xn[3]); *(u32x2*)(xb + off + co) = w;
                        ss += (xn[0] * xn[0] + xn[1] * xn[1]) + (xn[2] * xn[2] + xn[3] * xn[3]); }
                ss += __shfl_xor(ss, 16); ss += __shfl_xor(ss, 32);
                if (fq == 0) rss_out[(size_t)r * 16 + u.pn * 4 + wc] = ss;
                asm volatile("" ::: "memory"); }
    }
};
struct EpiPP {
    static constexpr bool PERM = false;
    bf16_t* pp;
    DI void operator()(const f32x4 (&acc)[2][2][4][2], const pg8::Unit& u, int wr, int wc, int fr_, int fq_, LAS unsigned char*) const {
        int fr = fr_, fq = fq_; asm volatile("" : "+v"(fr), "+v"(fq));
        const int row0 = u.arow + wr * 64 + fr, col0 = u.pn * 256 + wc * 32 + 4 * fq;
#pragma unroll
        for (int ai = 0; ai < 2; ++ai)
#pragma unroll
            for (int m = 0; m < 4; ++m) { const size_t off = (size_t)(row0 + ai * 128 + m * 16) * D + col0;
#pragma unroll
                for (int bj = 0; bj < 2; ++bj)
#pragma unroll
                    for (int n = 0; n < 2; ++n) { const f32x4 f = acc[ai][bj][m][n]; u32x2 w; w.x = pg8::cvt_pk_bf16(f[0], f[1]); w.y = pg8::cvt_pk_bf16(f[2], f[3]); *(u32x2*)(pp + off + bj * 128 + n * 16) = w; } }
    }
};
struct EpiFfn {
    static constexpr bool PERM = true;
    bf16_t* H; const float* rss; const float* cw; const float* cb; const float* st_in; float* st_p; float* st_s;
    DI void operator()(f32x4 (&acc)[2][2][4][2], const pg8::Unit& u, int wr, int wc, int fr_, int fq_, LAS unsigned char* lds) const {
        int fr = fr_, fq = fq_; asm volatile("" : "+v"(fr), "+v"(fq));
        const int lane = fr + 16 * fq;
        const int gc0 = u.pn * 128 + wc * 32 + 8 * fq;
        LAS float* XG = (LAS float*)(lds + XG_OFF);
#pragma unroll
        for (int ai = 0; ai < 2; ++ai)
#pragma unroll
            for (int m = 0; m < 4; ++m) { const float rs = row_rstd_q(rss, (long)u.arow + ai * 128 + wr * 64 + m * 16 + fr, fq);
#pragma unroll
                for (int bj = 0; bj < 2; ++bj)
#pragma unroll
                    for (int n = 0; n < 2; ++n) acc[ai][bj][m][n] *= rs;
                asm volatile("" : "+v"(acc[ai][0][m][0]), "+v"(acc[ai][0][m][1]), "+v"(acc[ai][1][m][0]), "+v"(acc[ai][1][m][1]) :: "memory"); }
        if (fr >= 14) {
#pragma unroll
            for (int ai = 0; ai < 2; ++ai)
#pragma unroll
                for (int n = 0; n < 2; ++n) *(LAS f32x4*)(XG + ((2 * ai + wr) * 2 + (fr - 14)) * 128 + wc * 32 + 8 * fq + 4 * n) = acc[ai][0][3][n];
        }
        LDS_WAIT(); __builtin_amdgcn_s_barrier(); asm volatile("" ::: "memory");
        const int src1 = (lane & 48) | ((fr + 15) & 15), src2 = (lane & 48) | ((fr + 14) & 15);
#pragma unroll
        for (int n = 0; n < 2; ++n) {
            const int gc = gc0 + 4 * n;
            const f32x4 w0 = *(const f32x4*)(cw + gc), w1 = *(const f32x4*)(cw + DFF + gc), w2 = *(const f32x4*)(cw + 2 * DFF + gc), bb = *(const f32x4*)(cb + gc);
#pragma unroll
            for (int ai = 0; ai < 2; ++ai) {
                f32x4 pr1, pr2;
                const int pb = 2 * ai + wr - 1;
                if (pb >= 0) { pr1 = *(const LAS f32x4*)(XG + (pb * 2 + 1) * 128 + wc * 32 + 8 * fq + 4 * n);
                               pr2 = *(const LAS f32x4*)(XG + (pb * 2 + (fr & 1)) * 128 + wc * 32 + 8 * fq + 4 * n); }
                else { pr1 = (f32x4){0.f, 0.f, 0.f, 0.f}; pr2 = pr1; }
#pragma unroll
                for (int m = 0; m < 4; ++m) {
                    const int j = ai * 128 + wr * 64 + m * 16 + fr; const long r = (long)u.arow + j;
                    int t, seq; if (r < MP) { t = (int)r & 8191; seq = (int)(r >> 13); } else { t = (int)(r - MP) & 63; seq = 2 + (int)((r - MP) >> 6); }
                    const int T = r < MP ? 8192 : 64;
                    const bool valid = j >= 2 && r < M;
                    const f32x4 cur = acc[ai][0][m][n]; f32x4 r1, r2;
#pragma unroll
                    for (int i = 0; i < 4; ++i) { r1[i] = __shfl(cur[i], src1); r2[i] = __shfl(cur[i], src2); }
                    f32x4 p1 = fr >= 1 ? r1 : pr1, p2 = fr >= 2 ? r2 : pr2;
                    pr1 = r1; pr2 = r2;
                    if (valid && t < 2) {
                        const f32x4 z = (f32x4){0.f, 0.f, 0.f, 0.f}; f32x4 s0 = z, s1 = z;
                        if (seq >= 2) { const float* sp = st_in + (size_t)(seq - 2) * 2 * DFF + gc; s0 = *(const f32x4*)sp; s1 = *(const f32x4*)(sp + DFF); }
                        if (t == 0) { p1 = s1; p2 = s0; } else { p2 = s1; }
                    }
                    const f32x4 gpre = bb + w0 * p2 + w1 * p1 + w2 * cur; const f32x4 up = acc[ai][1][m][n];
                    const float h0 = gelu_t(gpre[0]) * up[0], h1 = gelu_t(gpre[1]) * up[1], h2 = gelu_t(gpre[2]) * up[2], h3 = gelu_t(gpre[3]) * up[3];
                    if (valid) { u32x2 hw; hw.x = pg8::cvt_pk_bf16(h0, h1); hw.y = pg8::cvt_pk_bf16(h2, h3); *(u32x2*)(H + (size_t)r * DFF + gc) = hw;
                        if (t >= T - 2) { float* so = (seq < 2 ? st_p + (size_t)seq * 2 * DFF : st_s + (size_t)(seq - 2) * 2 * DFF) + (size_t)(t - (T - 2)) * DFF + gc; *(f32x4*)so = cur; } }
                    asm volatile("" ::: "memory");
                }
            }
        }
    }
};

DI bf16x8 frag_row(const LAS unsigned char* img, int pitch, int row0, int k0, int lane) {
    return *(const LAS bf16x8*)(img + (row0 + (lane & 15)) * pitch + (k0 + 8 * (lane >> 4)) * 2);
}
DI bf16x8 frag_tr(const LAS unsigned char* img, int pitch, int k0, int n0, int lane) {
    const int g = lane >> 4, i = lane & 15, q = i >> 2, p = i & 3;
    const LAS unsigned char* a = img + (k0 + 8 * g + q) * pitch + (n0 + 4 * p) * 2;
    const s16x4 lo = __builtin_amdgcn_ds_read_tr16_b64_v4i16((LAS s16x4*)a);
    const s16x4 hi = __builtin_amdgcn_ds_read_tr16_b64_v4i16((LAS s16x4*)(a + 4 * pitch));
    return __builtin_shufflevector(lo, hi, 0, 1, 2, 3, 4, 5, 6, 7);
}
#define MFMA16(a, b, c) __builtin_amdgcn_mfma_f32_16x16x32_bf16((a), (b), (c), 0, 0, 0)
DI void st_bf16(LAS unsigned char* img, int pitch, int row, int col, float v) { *(LAS bf16_t*)(img + row * pitch + col * 2) = (bf16_t)f2bf(v); }
DI float ld_bf16(const LAS unsigned char* img, int pitch, int row, int col) { return bf2f(*(const LAS bf16_t*)(img + row * pitch + col * 2)); }

template <bool SSD> struct LAT {
    static constexpr int DA = SSD ? 128 : 64, DB = SSD ? 64 : 128;
    static constexpr int PA = (DA + 8) * 2, PV = (DB + 8) * 2, PPI = 144, PS = (DB + 8) * 2;
    static constexpr int O_QD = 0, O_KI = O_QD + 64 * PA, O_KE = O_KI + 64 * PA, O_VV = O_KE + 64 * PA, O_P = O_VV + 64 * PV, O_SB = O_P + 64 * PPI, O_TAB = O_SB + DA * PS;
    static constexpr int NT_O = DB / 32;
};
template <bool SSD> DI void la_mt_nt(int T, int& mt, int& nt) { if (SSD) { mt = T >> 2; nt = T & 3; } else { mt = T >> 3; nt = T & 7; } }

template <bool SSD> DI void la_state_update(LAS unsigned char* lds, f32x4 (&S)[4], int w, int lane) {
    typedef LAT<SSD> L; const LAS float* tab = (const LAS float*)(lds + L::O_TAB); const int q = lane >> 4;
#pragma unroll
    for (int x = 0; x < 4; ++x) { int mt, nt; la_mt_nt<SSD>(4 * w + x, mt, nt);
        if (SSD) { const float d = tab[256]; S[x] *= d; }
        else {
#pragma unroll
            for (int r = 0; r < 4; ++r) S[x][r] *= tab[1536 + 16 * mt + 4 * q + r]; }
#pragma unroll
        for (int ks = 0; ks < 2; ++ks) { const bf16x8 a = frag_tr(lds + L::O_KE, L::PA, 32 * ks, 16 * mt, lane); const bf16x8 b = frag_tr(lds + L::O_VV, L::PV, 32 * ks, 16 * nt, lane); S[x] = MFMA16(a, b, S[x]); }
    }
}
template <bool SSD> DI void la_write_sb(LAS unsigned char* lds, const f32x4 (&S)[4], int w, int lane) {
    typedef LAT<SSD> L; const int q = lane >> 4, c = lane & 15;
#pragma unroll
    for (int x = 0; x < 4; ++x) { int mt, nt; la_mt_nt<SSD>(4 * w + x, mt, nt);
#pragma unroll
        for (int r = 0; r < 4; ++r) st_bf16(lds + L::O_SB, L::PS, 16 * mt + 4 * q + r, 16 * nt + c, S[x][r]); }
}
template <bool SSD> DI void la_compute_p(LAS unsigned char* lds, int w, int lane) {
    typedef LAT<SSD> L; const LAS float* tab = (const LAS float*)(lds + L::O_TAB); const int q = lane >> 4, c = lane & 15, mt = w >> 1;
#pragma unroll
    for (int x = 0; x < 2; ++x) { const int nt = (w & 1) * 2 + x; f32x4 acc = {0.f, 0.f, 0.f, 0.f};
#pragma unroll
        for (int ks = 0; ks < L::DA / 32; ++ks) { const bf16x8 a = frag_row(lds + L::O_QD, L::PA, 16 * mt, 32 * ks, lane); const bf16x8 b = frag_row(lds + L::O_KI, L::PA, 16 * nt, 32 * ks, lane); acc = MFMA16(a, b, acc); }
        const int j = 16 * nt + c;
#pragma unroll
        for (int r = 0; r < 4; ++r) { const int i = 16 * mt + 4 * q + r; float v = acc[r];
            if (SSD) v *= __expf(tab[64 + i] - tab[64 + j]) * tab[j];
            v = (j > i) ? 0.f : v; st_bf16(lds + L::O_P, L::PPI, i, j, v); }
    }
}
template <bool SSD> DI void la_compute_out(LAS unsigned char* lds, f32x4 (&o1)[LAT<SSD>::NT_O], f32x4 (&o2)[LAT<SSD>::NT_O], int w, int lane) {
    typedef LAT<SSD> L; const int mt = w >> 1;
#pragma unroll
    for (int x = 0; x < L::NT_O; ++x) { const int nt = (w & 1) * L::NT_O + x; f32x4 a1 = {0.f, 0.f, 0.f, 0.f}, a2 = {0.f, 0.f, 0.f, 0.f};
#pragma unroll
        for (int ks = 0; ks < 2; ++ks) { const bf16x8 a = frag_row(lds + L::O_P, L::PPI, 16 * mt, 32 * ks, lane); const bf16x8 b = frag_tr(lds + L::O_VV, L::PV, 32 * ks, 16 * nt, lane); a1 = MFMA16(a, b, a1); }
#pragma unroll
        for (int ks = 0; ks < L::DA / 32; ++ks) { const bf16x8 a = frag_row(lds + L::O_QD, L::PA, 16 * mt, 32 * ks, lane); const bf16x8 b = frag_tr(lds + L::O_SB, L::PS, 32 * ks, 16 * nt, lane); a2 = MFMA16(a, b, a2); }
        o1[x] = a1; o2[x] = a2; }
}
DI void la_store_ds(float* ds, const f32x4 (&S)[4], int w, int lane) {
#pragma unroll
    for (int x = 0; x < 4; ++x)
#pragma unroll
        for (int r = 0; r < 4; ++r) ds[((4 * w + x) * 4 + r) * 64 + lane] = S[x][r];
}
DI void la_load_ds(const float* ds, f32x4 (&S)[4], int w, int lane) {
#pragma unroll
    for (int x = 0; x < 4; ++x)
#pragma unroll
        for (int r = 0; r < 4; ++r) S[x][r] = ds[((4 * w + x) * 4 + r) * 64 + lane];
}

struct GlaCoef { float wlr[16]; float blr; };
DI float gla_stage(const Ctx& F, int layer, int h, int chunk, const GlaCoef& cf) {
    typedef LAT<false> L; LAS unsigned char* lds = F.lds; LAS float* tab = (LAS float*)(lds + L::O_TAB);
    const bf16_t* proj = wsb(F, WS_R); const int row0 = 64 * chunk, d = F.lane, w = F.wave;
    if (F.tid < 128) { const int t = F.tid >> 1, half = F.tid & 1; const u32x4 v = *(const u32x4*)(proj + (size_t)(row0 + t) * DINP + PC_BLR + 8 * half); float f[8]; unpack8(v, f);
#pragma unroll
        for (int i = 0; i < 8; ++i) tab[t * 16 + 8 * half + i] = f[i]; }
#pragma unroll
    for (int i = 0; i < 2; ++i) { const int idx = F.tid + 512 * i, t = idx >> 4, c16 = idx & 15;
        *(LAS u32x4*)(lds + L::O_VV + t * L::PV + c16 * 16) = *(const u32x4*)(proj + (size_t)(row0 + t) * DINP + PC_BV + 128 * h + 8 * c16); }
    float qv[8], kv[8];
#pragma unroll
    for (int i = 0; i < 8; ++i) { const size_t ro = (size_t)(row0 + 8 * w + i) * DINP; qv[i] = bf2f(proj[ro + PC_BQ + 64 * h + d]); kv[i] = bf2f(proj[ro + PC_BK + 64 * h + d]); }
    __syncthreads();
    float pre[8]; float run = 0.f;
#pragma unroll
    for (int i = 0; i < 8; ++i) { const int t = 8 * w + i; float z = cf.blr;
#pragma unroll
        for (int r = 0; r < 16; ++r) z += tab[t * 16 + r] * cf.wlr[r];
        run += logsig_f(z) * (1.f / 16.f); pre[i] = run; }
    tab[1024 + w * 64 + d] = run;
    __syncthreads();
    float off = 0.f, last = 0.f;
#pragma unroll
    for (int ww = 0; ww < 8; ++ww) { const float tv = tab[1024 + ww * 64 + d]; last += tv; if (ww < w) off += tv; }
#pragma unroll
    for (int i = 0; i < 8; ++i) { const int t = 8 * w + i; const float cum = off + pre[i];
        st_bf16(lds + L::O_QD, L::PA, t, d, qv[i] * 0.125f * __expf(cum)); st_bf16(lds + L::O_KI, L::PA, t, d, kv[i] * __expf(-cum)); st_bf16(lds + L::O_KE, L::PA, t, d, kv[i] * __expf(last - cum)); }
    if (w == 0) tab[1536 + d] = __expf(last);
    __syncthreads();
    return last;
}
DI float ssd_stage(const Ctx& F, int layer, int h, int chunk) {
    typedef LAT<true> L; LAS unsigned char* lds = F.lds; LAS float* tab = (LAS float*)(lds + L::O_TAB);
    const bf16_t* proj = wsb(F, WS_R); const int row0 = 64 * chunk, g = h >> 2; const bool first = chunk_first(chunk);
    float xr[11][8]; int cidx = 0, rg = 0, ch = 0;
    if (F.tid < 320) { cidx = F.tid % 40; rg = F.tid / 40;
        ch = cidx < 8 ? 64 * h + 8 * cidx : (cidx < 24 ? 512 + 128 * g + 8 * (cidx - 8) : 768 + 128 * g + 8 * (cidx - 24));
#pragma unroll
        for (int i = 0; i < 11; ++i) { const int tt = 8 * rg - 3 + i;
            if (tt >= 0 || !first) { const u32x4 v = *(const u32x4*)(proj + (size_t)(row0 + tt) * DINP + PC_XBC + ch); unpack8(v, xr[i]); }
            else if (chunk >= 256) { const float* sp = F.in[I_SSC] + ((size_t)(layer * 8 + (chunk - 256)) * 3 + (tt + 3)) * 1024 + ch; const f32x4 a = *(const f32x4*)sp, b = *(const f32x4*)(sp + 4);
                xr[i][0] = a.x; xr[i][1] = a.y; xr[i][2] = a.z; xr[i][3] = a.w; xr[i][4] = b.x; xr[i][5] = b.y; xr[i][6] = b.z; xr[i][7] = b.w; }
            else {
#pragma unroll
                for (int e = 0; e < 8; ++e) xr[i][e] = 0.f; }
        }
    }
    float last = 0.f;
    if (F.wave == 0) { const int t = F.lane; const float dtraw = bf2f(proj[(size_t)(row0 + t) * DINP + PC_DT + h]);
        const float dt = softplus_f(dtraw + F.in[I_SDTB][layer * 8 + h]); float cum = -dt * __expf(F.in[I_SALOG][layer * 8 + h]);
#pragma unroll
        for (int o = 1; o < 64; o <<= 1) { const float v = __shfl_up(cum, o); if (t >= o) cum += v; }
        last = __shfl(cum, 63);
        tab[t] = dt; tab[64 + t] = cum; tab[128 + t] = __expf(last - cum) * dt; tab[192 + t] = __expf(cum); if (t == 0) tab[256] = __expf(last); }
    __syncthreads();
    if (F.tid < 320) {
        const float* cwp = F.in[I_SCW] + (size_t)layer * 4 * 1024 + ch; const float* cbp = F.in[I_SCB] + layer * 1024 + ch;
        float wv[4][8], bv[8];
#pragma unroll
        for (int j = 0; j < 4; ++j) { const f32x4 a = *(const f32x4*)(cwp + j * 1024), b = *(const f32x4*)(cwp + j * 1024 + 4); wv[j][0] = a.x; wv[j][1] = a.y; wv[j][2] = a.z; wv[j][3] = a.w; wv[j][4] = b.x; wv[j][5] = b.y; wv[j][6] = b.z; wv[j][7] = b.w; }
        { const f32x4 a = *(const f32x4*)cbp, b = *(const f32x4*)(cbp + 4); bv[0] = a.x; bv[1] = a.y; bv[2] = a.z; bv[3] = a.w; bv[4] = b.x; bv[5] = b.y; bv[6] = b.z; bv[7] = b.w; }
#pragma unroll
        for (int r = 0; r < 8; ++r) { const int t = 8 * rg + r; float o[8];
#pragma unroll
            for (int e = 0; e < 8; ++e) { float v = bv[e];
#pragma unroll
                for (int j = 0; j < 4; ++j) v += wv[j][e] * xr[r + j][e];
                o[e] = silu_f(v); }
            if (cidx < 8) *(LAS u32x4*)(lds + L::O_VV + t * L::PV + cidx * 16) = pack8(o);
            else if (cidx < 24) { *(LAS u32x4*)(lds + L::O_KI + t * L::PA + (cidx - 8) * 16) = pack8(o); const float we = tab[128 + t];
#pragma unroll
                for (int e = 0; e < 8; ++e) o[e] *= we;
                *(LAS u32x4*)(lds + L::O_KE + t * L::PA + (cidx - 8) * 16) = pack8(o); }
            else *(LAS u32x4*)(lds + L::O_QD + t * L::PA + (cidx - 24) * 16) = pack8(o);
        }
    }
    __syncthreads();
    return last;
}

template <bool SSD> DI void la_pass_a(const Ctx& F0, int layer, int panel, int h) {
    Ctx F = F0; OPAQUE_CTX(F);
    LAS unsigned char* lds = F.lds; const int w = F.wave, lane = F.lane;
    f32x4 S[4];
#pragma unroll
    for (int x = 0; x < 4; ++x) S[x] = (f32x4){0.f, 0.f, 0.f, 0.f};
    GlaCoef cf; if (!SSD) {
#pragma unroll
        for (int r = 0; r < 16; ++r) cf.wlr[r] = F.in[I_GWLR][(size_t)(layer * 16 + r) * 256 + 64 * h + lane];
        cf.blr = F.in[I_GBLR][layer * 256 + 64 * h + lane]; }
    float lastsum = 0.f;
    const Ctx Fp = F;
#pragma unroll 1
    for (int cc = 0; cc < 4; ++cc) { const int chunk = 4 * panel + cc;
        Ctx F = Fp; { unsigned z_ = 0; asm volatile("" : "+s"(z_)); F.lds = Fp.lds + z_; } LAS unsigned char* lds = F.lds;
        float last; if (SSD) last = ssd_stage(F, layer, h, chunk); else last = gla_stage(F, layer, h, chunk, cf);
        lastsum += last;
        la_state_update<SSD>(lds, S, w, lane);
        __syncthreads();
    }
    const int hh = SSD ? 4 + h : h;
    la_store_ds(wsf(F, WS_DS) + ((size_t)panel * 12 + hh) * 8192, S, w, lane);
    float* dec = wsf(F, WS_DEC);
    if (w == 0) { if (SSD) { if (lane == 0) dec[64 * 4 * 64 + panel * 8 + h] = __expf(lastsum); } else dec[(panel * 4 + h) * 64 + lane] = __expf(lastsum); }
}

template <bool SSD> DI void la_pass_c(const Ctx& F0, int layer, int c0, int nc, int h) {
    Ctx F = F0; OPAQUE_CTX(F);
    typedef LAT<SSD> L; LAS unsigned char* lds = F.lds; LAS float* tab = (LAS float*)(lds + L::O_TAB); const int w = F.wave, lane = F.lane, q = lane >> 4, c = lane & 15, mt = w >> 1;
    bf16_t* proj = wsb(F, WS_R);
    f32x4 S[4];
    GlaCoef cf; if (!SSD) {
#pragma unroll
        for (int r = 0; r < 16; ++r) cf.wlr[r] = F.in[I_GWLR][(size_t)(layer * 16 + r) * 256 + 64 * h + lane];
        cf.blr = F.in[I_GBLR][layer * 256 + 64 * h + lane]; }
    const int hh = SSD ? 4 + h : h;
    const Ctx Fp = F;
#pragma unroll 1
    for (int cc = 0; cc < nc; ++cc) { const int chunk = c0 + cc, row0 = 64 * chunk;
        Ctx F = Fp; { unsigned z_ = 0; asm volatile("" : "+s"(z_)); F.lds = Fp.lds + z_; } LAS unsigned char* lds = F.lds; LAS float* tab = (LAS float*)(lds + L::O_TAB);
        if (cc == 0 || chunk_first(chunk)) {
            if (chunk < 256) la_load_ds(wsf(F, WS_DS) + ((size_t)(chunk >> 2) * 12 + hh) * 8192, S, w, lane);
            else { const int b = chunk - 256;
#pragma unroll
                for (int x = 0; x < 4; ++x) { int smt, snt; la_mt_nt<SSD>(4 * w + x, smt, snt);
                    if (SSD) { const float* sp = F.in[I_SS] + ((size_t)((layer * 8 + b) * 8 + h) * 64 + 16 * snt + c) * 128 + 16 * smt + 4 * q; S[x] = *(const f32x4*)sp; }
                    else { const float* sp = F.in[I_SG] + ((size_t)((layer * 8 + b) * 4 + h) * 64 + 16 * smt + 4 * q) * 128 + 16 * snt + c;
#pragma unroll
                        for (int r = 0; r < 4; ++r) S[x][r] = sp[r * 128]; } } }
            la_write_sb<SSD>(lds, S, w, lane);
        }
        if (SSD) ssd_stage(F, layer, h, chunk); else gla_stage(F, layer, h, chunk, cf);
        la_compute_p<SSD>(lds, w, lane);
        __syncthreads();
        f32x4 o1[L::NT_O], o2[L::NT_O];
        la_compute_out<SSD>(lds, o1, o2, w, lane);
        la_state_update<SSD>(lds, S, w, lane);
        if (SSD) {
            const float Dh = F.in[I_SD][layer * 8 + h]; float ss[4] = {0.f, 0.f, 0.f, 0.f};
#pragma unroll
            for (int x = 0; x < L::NT_O; ++x) { const int p = 16 * ((w & 1) * L::NT_O + x) + c;
#pragma unroll
                for (int r = 0; r < 4; ++r) { const int i = 16 * mt + 4 * q + r; const float y = o1[x][r] + tab[192 + i] * o2[x][r] + Dh * ld_bf16(lds + L::O_VV, L::PV, i, p);
                    bf16_t* zp = proj + (size_t)(row0 + i) * DINP + PC_CZ + 64 * h + p; const float yg = y * silu_f(bf2f(*zp)); *zp = (bf16_t)f2bf(yg); ss[r] += yg * yg; } }
#pragma unroll
            for (int r = 0; r < 4; ++r) { float s = ss[r]; s += __shfl_xor(s, 1); s += __shfl_xor(s, 2); s += __shfl_xor(s, 4); s += __shfl_xor(s, 8);
                if (c == 0) wsf(F, WS_PSS)[(size_t)(row0 + 16 * mt + 4 * q + r) * 16 + 2 * h + (w & 1)] = s; }
            __syncthreads();
        } else {
            float ss[4] = {0.f, 0.f, 0.f, 0.f};
#pragma unroll
            for (int x = 0; x < L::NT_O; ++x) { o1[x] += o2[x];
#pragma unroll
                for (int r = 0; r < 4; ++r) ss[r] += o1[x][r] * o1[x][r]; }
#pragma unroll
            for (int r = 0; r < 4; ++r) { float s = ss[r]; s += __shfl_xor(s, 1); s += __shfl_xor(s, 2); s += __shfl_xor(s, 4); s += __shfl_xor(s, 8);
                if (c == 0) tab[1600 + (16 * mt + 4 * q + r) * 2 + (w & 1)] = s; }
            __syncthreads();
#pragma unroll
            for (int r = 0; r < 4; ++r) { const int i = 16 * mt + 4 * q + r; const float rstd = rsqrtf((tab[1600 + 2 * i] + tab[1600 + 2 * i + 1]) * (1.f / 128.f) + EPS);
#pragma unroll
                for (int x = 0; x < L::NT_O; ++x) { const int e = 16 * ((w & 1) * L::NT_O + x) + c; bf16_t* gp = proj + (size_t)(row0 + i) * DINP + PC_BG + 128 * h + e;
                    const float y = o1[x][r] * rstd * F.in[I_GNORM][layer * 512 + 128 * h + e] * silu_f(bf2f(*gp)); *gp = (bf16_t)f2bf(y); } }
        }
        if (chunk_last(chunk)) { const int seq = chunk_seq(chunk);
            if (SSD) { float* so = st_out(F, O_PS, O_SS, layer, seq, 8 * 64 * 128) + (size_t)h * 64 * 128;
#pragma unroll
                for (int x = 0; x < 4; ++x) { int smt, snt; la_mt_nt<SSD>(4 * w + x, smt, snt); *(f32x4*)(so + (size_t)(16 * snt + c) * 128 + 16 * smt + 4 * q) = S[x]; } }
            else { float* so = st_out(F, O_PG, O_SG, layer, seq, 4 * 64 * 128) + (size_t)h * 64 * 128;
#pragma unroll
                for (int x = 0; x < 4; ++x) { int smt, snt; la_mt_nt<SSD>(4 * w + x, smt, snt);
#pragma unroll
                    for (int r = 0; r < 4; ++r) so[(size_t)(16 * smt + 4 * q + r) * 128 + 16 * snt + c] = S[x][r]; } }
        } else if (cc + 1 < nc) la_write_sb<SSD>(lds, S, w, lane);
        __syncthreads();
    }
}

template <bool PASS_C> DI void lru_chunk(const Ctx& F0, int layer, int chunk) {
    Ctx F = F0; OPAQUE_CTX(F);
    const int h = F.wave, lane = F.lane, q = lane >> 4, c = lane & 15, row0 = 64 * chunk; const bool first = chunk_first(chunk);
    LAS unsigned char* T = F.lds + h * 9216; constexpr int TP = 144;
    bf16_t* proj = wsb(F, WS_R);
    {
        const int cc = lane & 7, rg = lane >> 3, ch = 64 * h + 8 * cc; float xr[11][8];
#pragma unroll
        for (int i = 0; i < 11; ++i) { const int tt = 8 * rg - 3 + i;
            if (tt >= 0 || !first) { const u32x4 v = *(const u32x4*)(proj + (size_t)(row0 + tt) * DINP + PC_AX + ch); unpack8(v, xr[i]); }
            else if (chunk >= 256) { const float* sp = F.in[I_SLC] + ((size_t)(layer * 8 + (chunk - 256)) * 3 + (tt + 3)) * 512 + ch; const f32x4 a = *(const f32x4*)sp, b = *(const f32x4*)(sp + 4);
                xr[i][0] = a.x; xr[i][1] = a.y; xr[i][2] = a.z; xr[i][3] = a.w; xr[i][4] = b.x; xr[i][5] = b.y; xr[i][6] = b.z; xr[i][7] = b.w; }
            else {
#pragma unroll
                for (int e = 0; e < 8; ++e) xr[i][e] = 0.f; }
        }
        const float* cwp = F.in[I_LCW] + (size_t)layer * 4 * 512 + ch; const float* cbp = F.in[I_LCB] + layer * 512 + ch;
        float wv[4][8], bv[8];
#pragma unroll
        for (int j = 0; j < 4; ++j) { const f32x4 a = *(const f32x4*)(cwp + j * 512), b = *(const f32x4*)(cwp + j * 512 + 4); wv[j][0] = a.x; wv[j][1] = a.y; wv[j][2] = a.z; wv[j][3] = a.w; wv[j][4] = b.x; wv[j][5] = b.y; wv[j][6] = b.z; wv[j][7] = b.w; }
        { const f32x4 a = *(const f32x4*)cbp, b = *(const f32x4*)(cbp + 4); bv[0] = a.x; bv[1] = a.y; bv[2] = a.z; bv[3] = a.w; bv[4] = b.x; bv[5] = b.y; bv[6] = b.z; bv[7] = b.w; }
#pragma unroll
        for (int r = 0; r < 8; ++r) { float o[8];
#pragma unroll
            for (int e = 0; e < 8; ++e) { float v = bv[e];
#pragma unroll
                for (int j = 0; j < 4; ++j) v += wv[j][e] * xr[r + j][e];
                o[e] = v; }
            *(LAS u32x4*)(T + (8 * rg + r) * TP + cc * 16) = pack8(o); }
    }
    LDS_WAIT();
    bf16x8 af[4][2];
#pragma unroll
    for (int mt = 0; mt < 4; ++mt)
#pragma unroll
        for (int ks = 0; ks < 2; ++ks) af[mt][ks] = frag_row(T, TP, 16 * mt, 32 * ks, lane);
    const bf16_t* wr_t = wsb(F, WS_LRUW) + (size_t)((layer * 2 + 0) * 8 + h) * 4096; const bf16_t* wi_t = wsb(F, WS_LRUW) + (size_t)((layer * 2 + 1) * 8 + h) * 4096;
#pragma unroll 1
    for (int nt = 0; nt < 4; ++nt) {
        bf16x8 br[2], bi[2];
#pragma unroll
        for (int ks = 0; ks < 2; ++ks) { const int o = (16 * nt + c) * 64 + 32 * ks + 8 * q; br[ks] = *(const bf16x8*)(wr_t + o); bi[ks] = *(const bf16x8*)(wi_t + o); }
        f32x4 ar[4], ai[4];
#pragma unroll
        for (int mt = 0; mt < 4; ++mt) { ar[mt] = (f32x4){0.f, 0.f, 0.f, 0.f}; ai[mt] = ar[mt];
#pragma unroll
            for (int ks = 0; ks < 2; ++ks) { ar[mt] = MFMA16(af[mt][ks], br[ks], ar[mt]); ai[mt] = MFMA16(af[mt][ks], bi[ks], ai[mt]); } }
        const int col = 64 * h + 16 * nt + c;
        const float b_r = F.in[I_LBR][layer * 512 + col], b_i = F.in[I_LBI][layer * 512 + col], c8 = -8.f * softplus_f(-F.in[I_LAM][layer * 512 + col]);
        float hc = 0.f, pc = 1.f;
        if (PASS_C) hc = chunk >= 256 ? F.in[I_SLH][(size_t)(layer * 8 + (chunk - 256)) * 512 + col] : wsf(F, WS_LRUS)[(size_t)(2 * NCH + chunk) * 512 + col];
#pragma unroll
        for (int mt = 0; mt < 4; ++mt) {
            float a[4], uu[4];
#pragma unroll
            for (int r = 0; r < 4; ++r) { const int t = 16 * mt + 4 * q + r; const float rg_ = sigm(ar[mt][r] + b_r), ig = sigm(ai[mt][r] + b_i), la = c8 * rg_;
                a[r] = __expf(la); uu[r] = sqrtf(fmaxf(-expm1f(2.f * la), 0.f)) * ig * ld_bf16(T, TP, t, 16 * nt + c); }
            const float P = (a[0] * a[1]) * (a[2] * a[3]); const float Hl = ((uu[0] * a[1] + uu[1]) * a[2] + uu[2]) * a[3] + uu[3];
            float hrun = hc, my_in = 0.f;
#pragma unroll
            for (int qq = 0; qq < 4; ++qq) { const float Pq = __shfl(P, c + 16 * qq), Hq = __shfl(Hl, c + 16 * qq); if (qq == q) my_in = hrun; hrun = Pq * hrun + Hq; pc *= Pq; }
            hc = hrun;
            if (PASS_C) { float hh = my_in;
#pragma unroll
                for (int r = 0; r < 4; ++r) { hh = a[r] * hh + uu[r]; st_bf16(T, TP, 16 * mt + 4 * q + r, 16 * nt + c, hh); } }
        }
        if (!PASS_C) { if (q == 0) { wsf(F, WS_LRUS)[(size_t)chunk * 512 + col] = pc; wsf(F, WS_LRUS)[(size_t)(NCH + chunk) * 512 + col] = hc; } }
        else if (chunk_last(chunk) && q == 0) st_out(F, O_PLH, O_SLH, layer, chunk_seq(chunk), 512)[col] = hc;
    }
    if (PASS_C) {
        LDS_WAIT();
        const int cc = lane & 7, rg = lane >> 3;
#pragma unroll
        for (int i = 0; i < 8; ++i) { const int t = rg + 8 * i; u32x4* gp = (u32x4*)(proj + (size_t)(row0 + t) * DINP + PC_AG + 64 * h + 8 * cc);
            float hv[8], gv[8]; unpack8(*(const LAS u32x4*)(T + t * TP + cc * 16), hv); unpack8(*gp, gv);
#pragma unroll
            for (int e = 0; e < 8; ++e) hv[e] *= gelu_t(gv[e]);
            *gp = pack8(hv); }
        if (chunk_last(chunk)) { float* so = st_out(F, O_PLC, O_SLC, layer, chunk_seq(chunk), 3 * 512);
#pragma unroll
            for (int i = 0; i < 3; ++i) so[i * 512 + 64 * h + lane] = bf2f(proj[(size_t)(row0 + 61 + i) * DINP + PC_AX + 64 * h + lane]); }
    }
    LDS_WAIT();
}

DI void phase_mixer_a(const Ctx& F, int layer) {
    for (int it = blockIdx.x; it < 1034; it += F.G) {
        if (it < 256) la_pass_a<false>(F, layer, it >> 2, it & 3);
        else if (it < 768) la_pass_a<true>(F, layer, (it - 256) >> 3, (it - 256) & 7);
        else if (it < 1024) lru_chunk<false>(F, layer, it - 768);
        else { const int seq = it - 1024, lastrow = seq < 2 ? 8192 * (seq + 1) - 1 : MP + 64 * (seq - 1) - 1;
            float* so = st_out(F, O_PSC, O_SSC, layer, seq, 3 * 1024); const bf16_t* proj = wsb(F, WS_R);
            for (int e = F.tid; e < 3 * 1024; e += 512) so[e] = bf2f(proj[(size_t)(lastrow - 2 + (e >> 10)) * DINP + PC_XBC + (e & 1023)]); }
        __syncthreads();
    }
}
DI void phase_mixer_b(const Ctx& F, int layer) {
    float* ds = wsf(F, WS_DS); const float* dec = wsf(F, WS_DEC);
    for (int e = blockIdx.x * 512 + F.tid; e < 2 * 12 * 8192; e += F.G * 512) {
        const int idx = e & 8191, hh = (e >> 13) % 12, b = e / (12 * 8192);
        const int ln = idx & 63, r = (idx >> 6) & 3, Tt = idx >> 8; const int a = 16 * (Tt >> 3) + 4 * (ln >> 4) + r;
        float v[32];
#pragma unroll
        for (int p = 0; p < 32; ++p) v[p] = ds[((size_t)(32 * b + p) * 12 + hh) * 8192 + idx];
        float S = 0.f;
#pragma unroll
        for (int p = 0; p < 32; ++p) { const int panel = 32 * b + p; const float dc = hh < 4 ? dec[(panel * 4 + hh) * 64 + a] : dec[64 * 4 * 64 + panel * 8 + (hh - 4)];
            ds[((size_t)panel * 12 + hh) * 8192 + idx] = S; S = dc * S + v[p]; }
    }
    {
        const int gw = blockIdx.x * NWAVES + F.wave; float* ls = wsf(F, WS_LRUS);
        if (gw < 1024) { const int b = gw >> 9, ch = gw & 511, l = F.lane; const int c0 = 128 * b + 2 * l;
            const float A0 = ls[(size_t)c0 * 512 + ch], H0 = ls[(size_t)(NCH + c0) * 512 + ch], A1 = ls[(size_t)(c0 + 1) * 512 + ch], H1 = ls[(size_t)(NCH + c0 + 1) * 512 + ch];
            float A = A1 * A0, H = A1 * H0 + H1;
#pragma unroll
            for (int o = 1; o < 64; o <<= 1) { const float Ap = __shfl_up(A, o), Hp = __shfl_up(H, o); if (l >= o) { H = A * Hp + H; A = A * Ap; } }
            float E = __shfl_up(H, 1); if (l == 0) E = 0.f;
            ls[(size_t)(2 * NCH + c0) * 512 + ch] = E; ls[(size_t)(2 * NCH + c0 + 1) * 512 + ch] = A0 * E + H0; }
    }
}
#ifndef MIX_MASK
#define MIX_MASK 7
#endif
DI void phase_mixer_c(const Ctx& F, int layer) {
    for (int it = blockIdx.x; it < 1128; it += F.G) {
        if (it < 512) { if (MIX_MASK & 1) la_pass_c<true>(F, layer, 4 * (it >> 3), 4, it & 7); }
        else if (it < 768) { if (MIX_MASK & 2) la_pass_c<false>(F, layer, 4 * ((it - 512) >> 2), 4, (it - 512) & 3); }
        else if (it < 1032) { if (MIX_MASK & 4) lru_chunk<true>(F, layer, it - 768); }
        else if (it < 1096) { if (MIX_MASK & 1) la_pass_c<true>(F, layer, 256 + ((it - 1032) >> 3), 1, (it - 1032) & 7); }
        else { if (MIX_MASK & 2) la_pass_c<false>(F, layer, 256 + ((it - 1096) >> 2), 1, (it - 1096) & 3); }
        __syncthreads();
    }
}
DI void phase_ssd_norm(const Ctx& F, int layer) {
    const int gw = F.vcu * NWAVES + F.wave, NGW = F.G * NWAVES; bf16_t* proj = wsb(F, WS_R); const float* pss = wsf(F, WS_PSS);
    float gn[8]; { const float* gp = F.in[I_SNORM] + layer * 512 + 8 * F.lane; const f32x4 a = *(const f32x4*)gp, b = *(const f32x4*)(gp + 4); gn[0] = a.x; gn[1] = a.y; gn[2] = a.z; gn[3] = a.w; gn[4] = b.x; gn[5] = b.y; gn[6] = b.z; gn[7] = b.w; }
    for (int m = gw; m < M; m += NGW) {
        const f32x4* p = (const f32x4*)(pss + (size_t)m * 16); const f32x4 a = p[0], b = p[1], c = p[2], d = p[3];
        const float s = ((a.x + a.y) + (a.z + a.w)) + ((b.x + b.y) + (b.z + b.w)) + ((c.x + c.y) + (c.z + c.w)) + ((d.x + d.y) + (d.z + d.w));
        const float rstd = rsqrtf(s * (1.f / 512.f) + EPS);
        u32x4* yp = (u32x4*)(proj + (size_t)m * DINP + PC_CZ + 8 * F.lane); float v[8]; unpack8(*yp, v);
#pragma unroll
        for (int e = 0; e < 8; ++e) v[e] *= rstd * gn[e];
        *yp = pack8(v);
    }
}
DI void phase_final(const Ctx& F) {
    const int gw = F.vcu * NWAVES + F.wave, NGW = F.G * NWAVES; const float* rss = wsf(F, WS_RSSN) + (size_t)XB_PAD * 16; const float* gf = F.in[I_NFIN];
    for (int m = gw; m < M; m += NGW) { const float rs = row_rstd(rss, m); f32x4* x4 = (f32x4*)(F.out + (size_t)m * D) + F.lane;
#pragma unroll
        for (int j = 0; j < 4; ++j) { const f32x4 g = *((const f32x4*)gf + F.lane + 64 * j); x4[64 * j] = x4[64 * j] * rs * g; } }
}

constexpr int PH_PER_LAYER = 9, N_PHASES = 1 + DEPTH * PH_PER_LAYER + 1;
__global__ void __launch_bounds__(NWAVES * 64, 2) mk_fwd(Args args) {
    extern __shared__ __attribute__((aligned(16))) unsigned char lds_raw[];
    Ctx F; F.lds = (LAS unsigned char*)lds_raw; F.in = args.in; F.out = args.out; F.ws = args.ws;
    F.wave = __builtin_amdgcn_readfirstlane((int)threadIdx.x >> 6); F.lane = 0; F.tid = 0;
#define T0() (F.wave == 0 && lane_id() == 0)
    F.G = gridDim.x; { const int bx = blockIdx.x; F.vcu = (F.G % 8 == 0) ? (bx % 8) * (F.G / 8) + bx / 8 : bx; }
    volatile LAS unsigned* MISC = (volatile LAS unsigned*)(F.lds + MISC_OFF);
    if (F.wave == 0) MISC[lane_id()] = 0u;
    __syncthreads();
    XcdBarrier bar; bar.bar = (unsigned*)(args.ws + WS_CTL); bar.x = 0; bar.st = nullptr;
    if (args.use_bar) bar = xcd_barrier_post((unsigned*)(args.ws + WS_CTL), MISC + 8, T0());
    const int lo = args.ph_lo, hi = args.ph_hi;
#ifndef PH_MASK
#define PH_MASK 0xFFFFu
#endif
#define IN(k) (lo <= (k) && (k) < hi)
#define ON(b) ((PH_MASK >> (b)) & 1u)
#define SEAM(k) do { if (IN(k) && IN((k) + 1)) xcd_barrier(bar, T0()); } while (0)
#define GP float* X = C.out; bf16_t* XB = wsb(C, WS_XB) + (size_t)XB_PAD * D; float* RSS = wsf(C, WS_RSS) + (size_t)XB_PAD * 16; bf16_t* XBN = wsb(C, WS_XBN); float* RSSN = wsf(C, WS_RSSN) + (size_t)XB_PAD * 16; \
    (void)X; (void)XB; (void)RSS; (void)XBN; (void)RSSN
#define PHC Ctx C = F; C.lane = lane_id(); C.tid = C.wave * 64 + C.lane; OPAQUE_CTX(C); { size_t zz_ = 0; asm volatile("" : "+s"(zz_)); C.ws = F.ws + zz_; C.out = (float*)((char*)F.out + zz_); }
    if (IN(0) && ON(0)) { PHC; convert_set(C, 0, 1 | 2 | 4 | 8 | 16 | 32 | 64 | 128); p0_rows(C); }
    SEAM(0);
    for (int layer = 0; layer < DEPTH; ++layer) {
        const int pb = 1 + layer * PH_PER_LAYER;
        if (IN(pb + 0) && ON(1)) { PHC; GP;
            pg8::Gemm g{XBN, wsb(C, WS_WIN), D, D, D}; pg8::StaticOrder S; S.init(M / 256, DINP / 256, C.G, (int)blockIdx.x, 0);
            EpiProj E{wsb(C, WS_R), RSSN}; pg8::gemm_phase<EpiProj, pg8::StaticOrder>(C.lds, g, S, E, C.wave);
        }
        SEAM(pb + 0);
        if (IN(pb + 1) && ON(2)) { PHC; phase_mixer_a(C, layer); }
        SEAM(pb + 1);
        if (IN(pb + 2) && ON(3)) { PHC; phase_mixer_b(C, layer);
            if (layer + 1 < DEPTH) convert_set(C, layer + 1, 1);
            if (layer >= 1) convert_set(C, layer, 2 | 4 | 8 | 16 | 32 | 64); }
        SEAM(pb + 2);
        if (IN(pb + 3) && ON(4)) { PHC; phase_mixer_c(C, layer); }
        SEAM(pb + 3);
        if (IN(pb + 4) && ON(5)) { PHC; phase_ssd_norm(C, layer); }
        SEAM(pb + 4);
        if (IN(pb + 5) && ON(6)) { PHC; GP;
            pg8::Gemm g{wsb(C, WS_R) + PC_Y, wsb(C, WS_WOUT), DINP, DMIX, DMIX}; pg8::StaticOrder S; S.init(M / 256, D / 256, C.G, (int)blockIdx.x, 0);
            EpiRes E{layer == 0 ? C.in[I_XP] : X, layer == 0 ? C.in[I_XS] : X + (size_t)MP * D, X, XB, RSS};
            pg8::gemm_phase<EpiRes, pg8::StaticOrder>(C.lds, g, S, E, C.wave);
        }
        SEAM(pb + 5);
        if (IN(pb + 6) && ON(7)) { PHC; GP;
            pg8::Gemm g{XB, wsb(C, WS_WGU), D, D, D}; pg8::StaticOrder S; S.init(67, 2 * DFF / 256, C.G, (int)blockIdx.x, 1);
            EpiFfn E{wsb(C, WS_R), RSS, C.in[I_FCW] + (size_t)layer * 3 * DFF, C.in[I_FCB] + layer * DFF, C.in[I_SFC] + (size_t)layer * 8 * 2 * DFF,
                     C.out + O_PFC + (size_t)layer * 2 * 2 * DFF, C.out + O_SFC + (size_t)layer * 8 * 2 * DFF};
            pg8::gemm_phase<EpiFfn, pg8::StaticOrder>(C.lds, g, S, E, C.wave);
        }
        SEAM(pb + 6);
        if (IN(pb + 7) && ON(8)) { PHC; GP;
            pg8::Gemm g{wsb(C, WS_R), wsb(C, WS_WD), DFF, DFF, DFF}; pg8::StaticOrder S; S.init(M / 256, D / 256, C.G, (int)blockIdx.x, 0);
            EpiRes E{X, X + (size_t)MP * D, X, XB, RSS}; pg8::gemm_phase<EpiRes, pg8::StaticOrder>(C.lds, g, S, E, C.wave);
        }
        SEAM(pb + 7);
        if (IN(pb + 8) && ON(9)) {
            { PHC; pg8::Gemm g{wsb(C, WS_PB), wsb(C, WS_WPP), DPLE, DPLE, DPLE}; pg8::StaticOrder S; S.init(M / 256, D / 256, C.G, (int)blockIdx.x, 0);
              EpiPP E{wsb(C, WS_PPO)}; pg8::gemm_phase<EpiPP, pg8::StaticOrder>(C.lds, g, S, E, C.wave); }
            VM_WAIT(); __syncthreads();
            { PHC; GP; pg8::Gemm g{XB, wsb(C, WS_WPG), D, D, D}; pg8::StaticOrder S; S.init(M / 256, D / 256, C.G, (int)blockIdx.x, 0);
              EpiPle E{X, X, XBN, RSS, RSSN, wsb(C, WS_PPO)}; pg8::gemm_phase<EpiPle, pg8::StaticOrder>(C.lds, g, S, E, C.wave); }
        }
        SEAM(pb + 8);
    }
    if (IN(N_PHASES - 1) && ON(10)) { PHC; phase_final(C); }
#undef IN
#undef ON
#undef SEAM
}

extern "C" void kernel_launch(void* const* d_in, const int* in_sizes, int n_in, void* d_out, int out_size, void* d_ws, size_t ws_size, hipStream_t stream) {
    static int grid = 0;
    if (grid == 0) {
        if (n_in != N_IN || (size_t)out_size != O_END || ws_size < WS_END) { fprintf(stderr, "kernel_launch: unexpected shapes: n_in %d out %d ws %zu (need %d, %zu, %zu)\n", n_in, out_size, ws_size, (int)N_IN, (size_t)O_END, (size_t)WS_END); grid = -1; return; }
        int dev = 0, cus = 0, per_cu = 0;
        if (hipGetDevice(&dev) != hipSuccess || hipDeviceGetAttribute(&cus, hipDeviceAttributeMultiprocessorCount, dev) != hipSuccess) { grid = -1; return; }
        if (hipFuncSetAttribute((const void*)mk_fwd, hipFuncAttributeMaxDynamicSharedMemorySize, LDS_BYTES) != hipSuccess) { fprintf(stderr, "kernel_launch: hipFuncSetAttribute failed\n"); grid = -1; return; }
        if (hipOccupancyMaxActiveBlocksPerMultiprocessor(&per_cu, (const void*)mk_fwd, NWAVES * 64, LDS_BYTES) != hipSuccess || per_cu < 1) { fprintf(stderr, "kernel_launch: occupancy query says %d\n", per_cu); per_cu = 1; }
        (void)hipGetLastError();
        grid = cus;
    }
    if (grid < 0) return;
    (void)hipMemsetAsync((char*)d_ws + WS_CTL, 0, CTL_ZERO_BYTES, stream);
    Args a{};
    for (int i = 0; i < N_IN; ++i) a.in[i] = (const float*)d_in[i];
    a.out = (float*)d_out; a.ws = (unsigned char*)d_ws;
#if MK_PER_PHASE
    for (int p = 0; p < N_PHASES; ++p) { a.ph_lo = p; a.ph_hi = p + 1; a.use_bar = 0; hipLaunchKernelGGL(mk_fwd, dim3(grid), dim3(NWAVES * 64), LDS_BYTES, stream, a); }
#else
    a.ph_lo = 0; a.ph_hi = N_PHASES; a.use_bar = 1;
    void* kargs[] = {&a};
    hipError_t e = hipLaunchCooperativeKernel((const void*)mk_fwd, dim3(grid), dim3(NWAVES * 64), kargs, LDS_BYTES, stream);
    if (e != hipSuccess) fprintf(stderr, "kernel_launch: cooperative launch failed: %s\n", hipGetErrorString(e));
#endif
}
```

```cpp
#include <hip/hip_runtime.h>
#include <cstdio>
#include <cstdint>

#define DI __device__ __forceinline__
#define LAS __attribute__((address_space(3)))
typedef unsigned short bf16_t;
typedef short bf16x8 __attribute__((ext_vector_type(8)));
typedef short s16x4 __attribute__((ext_vector_type(4)));
typedef float f32x4 __attribute__((ext_vector_type(4)));
typedef float f32x2 __attribute__((ext_vector_type(2)));
typedef unsigned u32x4 __attribute__((ext_vector_type(4)));
typedef unsigned u32x2 __attribute__((ext_vector_type(2)));

#ifndef MK_PER_PHASE
#define MK_PER_PHASE 0
#endif

constexpr int DEPTH = 2, D = 1024, MP = 16384, MS = 512, M = MP + MS;
constexpr int DIN = 4120, DINP = 4352, DFF = 3072, DMIX = 1536, DPLE = 256;
constexpr int NCH = M / 64;
constexpr float EPS = 1e-6f;
constexpr int PC_AX = 0, PC_BQ = 512, PC_BK = 768, PC_BV = 1024, PC_BLR = 1536, PC_XBC = 1552, PC_DT = 2576, PC_PAD = 2584, PC_Y = 2816, PC_AG = 2816, PC_BG = 3328, PC_CZ = 3840;

enum { I_XP = 0, I_XS, I_SLC, I_SLH, I_SG, I_SSC, I_SS, I_SFC, I_PP, I_PS, I_NMIX, I_WIN, I_LCW, I_LCB, I_LWR, I_LBR, I_LWI, I_LBI, I_LAM, I_GWLR, I_GBLR, I_GNORM,
       I_SCW, I_SCB, I_SDTB, I_SALOG, I_SD, I_SNORM, I_WOUT, I_NFFN, I_WG, I_WU, I_FCW, I_FCB, I_WD, I_NPLE, I_PWG, I_PWP, I_NFIN, N_IN };
constexpr size_t O_Y = 0;
constexpr size_t O_PLC = (size_t)M * D;
constexpr size_t O_PLH = O_PLC + 2 * 2 * 3 * 512;
constexpr size_t O_PG = O_PLH + 2 * 2 * 512;
constexpr size_t O_PSC = O_PG + 2 * 2 * 4 * 64 * 128;
constexpr size_t O_PS = O_PSC + 2 * 2 * 3 * 1024;
constexpr size_t O_PFC = O_PS + 2 * 2 * 8 * 64 * 128;
constexpr size_t O_SLC = O_PFC + 2 * 2 * 2 * 3072;
constexpr size_t O_SLH = O_SLC + 2 * 8 * 3 * 512;
constexpr size_t O_SG = O_SLH + 2 * 8 * 512;
constexpr size_t O_SSC = O_SG + 2 * 8 * 4 * 64 * 128;
constexpr size_t O_SS = O_SSC + 2 * 8 * 3 * 1024;
constexpr size_t O_SFC = O_SS + 2 * 8 * 8 * 64 * 128;
constexpr size_t O_END = O_SFC + 2 * 8 * 2 * 3072;

constexpr size_t MiB = 1u << 20;
constexpr size_t al4k(size_t x) { return (x + 4095) & ~(size_t)4095; }
constexpr int XB_PAD = 256;
constexpr int XB_ROWS = XB_PAD + M + 128;
constexpr size_t WS_CTL = 0, CTL_ZERO_BYTES = 64 * 1024;
constexpr size_t WS_WIN = al4k(WS_CTL + CTL_ZERO_BYTES);
constexpr size_t WS_WOUT = al4k(WS_WIN + (size_t)DINP * D * 2);
constexpr size_t WS_WGU = al4k(WS_WOUT + (size_t)D * DMIX * 2);
constexpr size_t WS_WD = al4k(WS_WGU + (size_t)2 * DFF * D * 2);
constexpr size_t WS_WPG = al4k(WS_WD + (size_t)D * DFF * 2);
constexpr size_t WS_WPP = al4k(WS_WPG + (size_t)D * D * 2);
constexpr size_t WS_LRUW = al4k(WS_WPP + (size_t)D * DPLE * 2);
constexpr size_t WS_RSS = al4k(WS_LRUW + (size_t)DEPTH * 2 * 8 * 4096 * 2);
constexpr size_t WS_RSSN = al4k(WS_RSS + (size_t)XB_ROWS * 64);
constexpr size_t WS_PSS = al4k(WS_RSSN + (size_t)XB_ROWS * 64);
constexpr size_t WS_LRUS = al4k(WS_PSS + (size_t)M * 64);
constexpr size_t WS_DEC = al4k(WS_LRUS + (size_t)3 * NCH * 512 * 4);
constexpr size_t WS_PB = al4k(WS_DEC + (size_t)(64 * 4 * 64 + 64 * 8) * 4);
constexpr size_t WS_XB = al4k(WS_PB + (size_t)M * DPLE * 2);
constexpr size_t WS_DS = al4k(WS_XB + (size_t)XB_ROWS * D * 2);
constexpr size_t WS_XBN = WS_DS;
constexpr size_t WS_R = al4k(WS_DS + (size_t)M * D * 2);
constexpr size_t WS_PPO = WS_R + 100 * MiB;
constexpr size_t WS_END = WS_R + (size_t)M * DINP * 2;
static_assert(WS_END <= 256 * MiB, "workspace");
static_assert((size_t)64 * 12 * 8192 * 4 <= (size_t)M * D * 2, "DS fits the XBN slot");
static_assert((size_t)M * DFF * 2 <= 100 * MiB && WS_PPO + (size_t)M * D * 2 <= WS_END, "overlay");

DI float bf2f(bf16_t b) { return __uint_as_float(((unsigned)b) << 16); }
DI unsigned f2bf(float f) { unsigned u = __float_as_uint(f); return (u + 0x7fffu + ((u >> 16) & 1u)) >> 16; }
DI unsigned pk2(float lo, float hi) { return f2bf(lo) | (f2bf(hi) << 16); }
DI float sigm(float x) { return __builtin_amdgcn_rcpf(1.f + __expf(-x)); }
DI float silu_f(float x) { return x * __builtin_amdgcn_rcpf(1.f + __expf(-x)); }
DI float gelu_t(float x) { const float u = 1.5957691216f * (x + 0.044715f * x * x * x); return x * __builtin_amdgcn_rcpf(1.f + __expf(-u)); }
DI float softplus_f(float x) { return fmaxf(x, 0.f) + log1pf(__expf(-fabsf(x))); }
DI float logsig_f(float x) { return fminf(x, 0.f) - log1pf(__expf(-fabsf(x))); }
DI void unpack8(const u32x4 v, float (&o)[8]) {
#pragma unroll
    for (int i = 0; i < 4; ++i) { o[2 * i] = __uint_as_float(v[i] << 16); o[2 * i + 1] = __uint_as_float(v[i] & 0xffff0000u); }
}
DI u32x4 pack8(const float (&o)[8]) { u32x4 r; r.x = pk2(o[0], o[1]); r.y = pk2(o[2], o[3]); r.z = pk2(o[4], o[5]); r.w = pk2(o[6], o[7]); return r; }
DI int lane_id() { int l; asm volatile("v_mbcnt_lo_u32_b32 %0, -1, 0\n\tv_mbcnt_hi_u32_b32 %0, -1, %0" : "=v"(l)); return l; }
#define LDS_WAIT() asm volatile("s_waitcnt lgkmcnt(0)" ::: "memory")
#define VM_WAIT() asm volatile("s_waitcnt vmcnt(0)" ::: "memory")

namespace pg8 {
constexpr int BM = 256, BK = 64, HALF = 128, HTB = HALF * BK * 2, STAGE_BYTES = 8 * HTB, NXCD = 8, WGM = 8;
__host__ __device__ __forceinline__ int lds_byte(int r, int c) { const int st = (r >> 4) * 2 + (c >> 5), rr = r & 15, cc = c & 31, ob = rr * 64 + cc * 2; return st * 1024 + (ob ^ (((ob >> 9) & 1) << 5)); }
__host__ __device__ __forceinline__ void stage_rc(int b, int& R, int& C) { const int st = b / 1024, sb = b % 1024, swz = sb ^ (((sb >> 9) & 1) << 5); R = (st >> 1) * 16 + swz / 64; C = (st & 1) * 32 + (swz % 64) / 2; }
__host__ __device__ __forceinline__ int perm32(int rho) { const int n = rho >> 4, i = rho & 15; return 8 * (i >> 2) + 4 * n + (i & 3); }

struct Unit { int pm, pn, arow; };
struct Gemm { const bf16_t* A; const bf16_t* Bt; int lda, ldb, K; };

struct StaticOrder {
    int nM, nN, nwg, G, c, shifted;
    __device__ void init(int nM_, int nN_, int G_, int c_, int shifted_) { nM = nM_; nN = nN_; nwg = nM * nN; G = G_; c = c_; shifted = shifted_; }
    __device__ bool next(int i, Unit& u) const {
        const long L = (long)i * G + c; if (L >= nwg) return false;
        int wgid = (int)L; { const int q = nwg / NXCD, r = nwg % NXCD, xcd = wgid % NXCD, off = wgid / NXCD; wgid = (xcd < r ? xcd * (q + 1) : r * (q + 1) + (xcd - r) * q) + off; }
        const int nig = WGM * nN, gid = wgid / nig, fm = gid * WGM, gsz = (nM - fm) < WGM ? (nM - fm) : WGM;
        u.pm = fm + ((wgid % nig) % gsz); u.pn = (wgid % nig) / gsz; u.arow = shifted ? 254 * u.pm - 2 : 256 * u.pm; return true;
    }
};
DI unsigned cvt_pk_bf16(float lo, float hi) { unsigned r; asm volatile("v_cvt_pk_bf16_f32 %0, %1, %2" : "=v"(r) : "v"(lo), "v"(hi)); return r; }

template <class Epi, class Sched>
DI void gemm_phase(LAS unsigned char* lds, const Gemm g, const Sched& S, const Epi& E, int wid) {
    const int lane = lane_id(), tid = wid * 64 + lane, wr = wid >> 2, wc = wid & 3, fr = lane & 15, fq = lane >> 4;
    const int K = g.K, nt = K / BK;
    unsigned voffA[2], voffB[2];
#pragma unroll
    for (int i = 0; i < 2; ++i) { int R, C; stage_rc(tid * 16 + i * 8192, R, C); const int Rb = Epi::PERM ? ((R & ~31) + perm32(R & 31)) : R;
        voffA[i] = (unsigned)(R * g.lda + C) * 2u; voffB[i] = (unsigned)(Rb * g.ldb + C) * 2u; }
    const size_t kstep = (size_t)(BK * 2);
    const size_t hstepA = (size_t)HALF * g.lda * 2, hstepB = (size_t)HALF * g.ldb * 2;
    const unsigned ldsw = (unsigned)wid * 1024u;
    const int aoff = lds_byte(wr * 64 + fr, fq * 8), boff = lds_byte(wc * 32 + fr, fq * 8);
#define PG8_SA(b, h) (((b) * 2 + (h)) * HTB)
#define PG8_SB(b, h) ((4 + (b) * 2 + (h)) * HTB)
#define PG8_STAGE(bufoff, gbase, voff) do { _Pragma("unroll") for (int _i = 0; _i < 2; ++_i) \
        __builtin_amdgcn_global_load_lds((const unsigned*)((const char*)(gbase) + (voff)[_i]), (LAS unsigned*)(lds + (bufoff) + ldsw + _i * 8192), 16, 0, 0); } while (0)
#define PG8_LDA(dst, b, h) do { _Pragma("unroll") for (int m = 0; m < 4; ++m) _Pragma("unroll") for (int k = 0; k < 2; ++k) dst[m][k] = *(const LAS bf16x8*)(lds + PG8_SA(b, h) + aoff + m * 2048 + k * 1024); } while (0)
#define PG8_LDB(dst, b, h) do { _Pragma("unroll") for (int n = 0; n < 2; ++n) _Pragma("unroll") for (int k = 0; k < 2; ++k) dst[n][k] = *(const LAS bf16x8*)(lds + PG8_SB(b, h) + boff + n * 2048 + k * 1024); } while (0)
#define PG8_MMA(ai, bj, At, Bt) do { __builtin_amdgcn_s_setprio(1); _Pragma("unroll") for (int m = 0; m < 4; ++m) _Pragma("unroll") for (int n = 0; n < 2; ++n) _Pragma("unroll") for (int k = 0; k < 2; ++k) \
        acc[ai][bj][m][n] = __builtin_amdgcn_mfma_f32_16x16x32_bf16(Bt[n][k], At[m][k], acc[ai][bj][m][n], 0, 0, 0); __builtin_amdgcn_s_setprio(0); } while (0)
#define PG8_WAIT_V(n) asm volatile("s_waitcnt vmcnt(" #n ")" ::: "memory")
#define PG8_WAIT_L(n) asm volatile("s_waitcnt lgkmcnt(" #n ")" ::: "memory")
#define PG8_BAR __builtin_amdgcn_s_barrier()
#define PG8_SCHED __builtin_amdgcn_sched_barrier(0)
    Unit cur, nxt; int ui = 0;
    if (!S.next(0, cur)) return;
    f32x4 acc[2][2][4][2];
#pragma unroll
    for (int a = 0; a < 2; ++a)
#pragma unroll
        for (int b = 0; b < 2; ++b)
#pragma unroll
            for (int m = 0; m < 4; ++m)
#pragma unroll
                for (int n = 0; n < 2; ++n) acc[a][b][m][n] = (f32x4){0.f, 0.f, 0.f, 0.f};
    bf16x8 At[4][2], B0[2][2], B1[2][2];
    const char* cA = (const char*)g.A + (long)cur.arow * g.lda * 2; const char* cB = (const char*)g.Bt + (size_t)cur.pn * 256 * g.ldb * 2;
    PG8_STAGE(PG8_SB(0, 0), cB, voffB); PG8_STAGE(PG8_SB(0, 1), cB + hstepB, voffB); PG8_STAGE(PG8_SA(0, 0), cA, voffA); PG8_STAGE(PG8_SA(0, 1), cA + hstepA, voffA);
    if (wr == 1) PG8_BAR;
    PG8_WAIT_V(2); PG8_BAR;
    PG8_STAGE(PG8_SB(1, 0), cB + kstep, voffB); PG8_STAGE(PG8_SA(1, 0), cA + kstep, voffA); PG8_STAGE(PG8_SB(1, 1), cB + hstepB + kstep, voffB);
    PG8_WAIT_V(6); PG8_BAR;
    for (;;) {
        const bool has_next = S.next(ui + 1, nxt);
        const char* nA = has_next ? (const char*)g.A + (long)nxt.arow * g.lda * 2 : cA; const char* nB = has_next ? (const char*)g.Bt + (size_t)nxt.pn * 256 * g.ldb * 2 : cB;
#pragma unroll 1
        for (int t = 0; t < nt; t += 2) {
            const bool last = (t == nt - 2);
            const char* a1 = cA + (size_t)(t + 1) * kstep;
            const char* a2 = last ? nA : cA + (size_t)(t + 2) * kstep; const char* b2 = last ? nB : cB + (size_t)(t + 2) * kstep;
            const char* a3 = a2 + kstep; const char* b3 = b2 + kstep;
            PG8_LDB(B0, 0, 0); PG8_LDB(B1, 0, 1); PG8_SCHED; PG8_LDA(At, 0, 0); PG8_STAGE(PG8_SA(1, 1), a1 + hstepA, voffA);
            PG8_WAIT_V(8); PG8_WAIT_L(0); PG8_BAR; PG8_MMA(0, 0, At, B0); PG8_MMA(0, 1, At, B1); PG8_BAR; PG8_SCHED;
            PG8_LDA(At, 0, 1); PG8_STAGE(PG8_SB(0, 0), b2, voffB); PG8_STAGE(PG8_SB(0, 1), b2 + hstepB, voffB); PG8_STAGE(PG8_SA(0, 0), a2, voffA);
            PG8_WAIT_V(8); PG8_WAIT_L(0); PG8_BAR; PG8_MMA(1, 0, At, B0); PG8_MMA(1, 1, At, B1); PG8_BAR; PG8_SCHED;
            PG8_LDB(B0, 1, 0); PG8_LDB(B1, 1, 1); PG8_SCHED; PG8_LDA(At, 1, 0); PG8_STAGE(PG8_SA(0, 1), a2 + hstepA, voffA);
            PG8_WAIT_V(8); PG8_WAIT_L(0); PG8_BAR; PG8_MMA(0, 0, At, B0); PG8_MMA(0, 1, At, B1); PG8_BAR; PG8_SCHED;
            PG8_LDA(At, 1, 1); PG8_STAGE(PG8_SB(1, 0), b3, voffB); PG8_STAGE(PG8_SB(1, 1), b3 + hstepB, voffB); PG8_STAGE(PG8_SA(1, 0), a3, voffA);
            PG8_WAIT_V(8); PG8_WAIT_L(0); PG8_BAR; PG8_MMA(1, 0, At, B0); PG8_MMA(1, 1, At, B1); PG8_BAR; PG8_SCHED;
        }
        if (wr == 0) PG8_BAR;
        { const int l2 = lane_id(); E(acc, cur, wr, wc, l2 & 15, l2 >> 4, lds); }
        if (!has_next) break;
#pragma unroll
        for (int a = 0; a < 2; ++a)
#pragma unroll
            for (int b = 0; b < 2; ++b)
#pragma unroll
                for (int m = 0; m < 4; ++m)
#pragma unroll
                    for (int n = 0; n < 2; ++n) acc[a][b][m][n] = (f32x4){0.f, 0.f, 0.f, 0.f};
        cur = nxt; cA = nA; cB = nB; ++ui;
        if (wr == 1) PG8_BAR;
    }
    PG8_WAIT_V(0);
    PG8_BAR;
#undef PG8_SA
#undef PG8_SB
#undef PG8_STAGE
#undef PG8_LDA
#undef PG8_LDB
#undef PG8_MMA
#undef PG8_WAIT_V
#undef PG8_WAIT_L
#undef PG8_BAR
#undef PG8_SCHED
}
}

#define XB_TMO      128
#define XB_XCNT(j)  (256  + 64 * (j))
#define XB_XSUB(j)  (1280 + 64 * (j))
#define XB_XGEN(j)  (2304 + 64 * (j))
#define XB_TOP      3328
#define XB_TOPGEN   3392
#define XCD_BAR_WORDS 3456
#define XB_SPIN_CAP (1u << 18)
DI unsigned xb_ld(unsigned* p)              { return __hip_atomic_load(p, __ATOMIC_RELAXED, __HIP_MEMORY_SCOPE_AGENT); }
DI unsigned xb_add(unsigned* p, unsigned v) { return __hip_atomic_fetch_add(p, v, __ATOMIC_RELAXED, __HIP_MEMORY_SCOPE_AGENT); }
DI unsigned xb_xcc_id() { return (unsigned)__builtin_amdgcn_s_getreg((3 << 11) | 20) & 0xFu; }
#define XB_SPIN(cond, bar) do { unsigned _sp = 0; while (cond) { __builtin_amdgcn_s_sleep(1); \
    if ((++_sp & 255u) == 0u) { if (xb_ld(&(bar)[XB_TMO])) break; if (_sp > XB_SPIN_CAP) { atomicAdd(&(bar)[XB_TMO], 1u); break; } } } } while (0)
struct XcdBarrier { unsigned* bar; unsigned x; volatile LAS unsigned* st; };
DI XcdBarrier xcd_barrier_post(unsigned* bar, volatile LAS unsigned* st, bool t0) {
    XcdBarrier b; b.bar = bar; b.x = xb_xcc_id(); b.st = st;
    if (t0) (void)xb_add(&bar[XB_XCNT(b.x)], 1u);
    return b;
}
DI void xcd_barrier_complete(unsigned* bar, unsigned x, unsigned& nloc, unsigned& nx) {
    const unsigned G = gridDim.x * gridDim.y * gridDim.z;
    unsigned sum, cnt, mine, sp = 0u;
    for (;;) {
        sum = 0u; cnt = 0u; mine = 0u;
#pragma unroll
        for (unsigned j = 0; j < 16; ++j) { const unsigned c = xb_ld(&bar[XB_XCNT(j)]); sum += c; cnt += (c > 0u) ? 1u : 0u; mine = (j == x) ? c : mine; }
        if (sum == G) break;
        __builtin_amdgcn_s_sleep(1);
        if ((++sp & 255u) == 0u) { if (xb_ld(&bar[XB_TMO])) break; if (sp > XB_SPIN_CAP) { atomicAdd(&bar[XB_TMO], 1u); break; } }
    }
    nloc = mine > 0u ? mine : 1u; nx = cnt > 0u ? cnt : 1u;
}
DI void xcd_barrier(const XcdBarrier& b, bool t0) {
    asm volatile("s_waitcnt vmcnt(0)" ::: "memory");
    __syncthreads();
    if (t0) {
        unsigned* bar = b.bar;
        __builtin_amdgcn_s_waitcnt(0);
        unsigned nloc = b.st[0], nx = b.st[1];
        if (nloc == 0u) { xcd_barrier_complete(bar, b.x, nloc, nx); b.st[0] = nloc; b.st[1] = nx; }
        const unsigned old = xb_add(&bar[XB_XSUB(b.x)], 1u);
        const unsigned gen = old / nloc;
        if (old + 1u == (gen + 1u) * nloc) {
            __builtin_amdgcn_fence(__ATOMIC_RELEASE, "agent");
            asm volatile("s_waitcnt vmcnt(0)" ::: "memory");
            const unsigned og = xb_add(&bar[XB_TOP], 1u);
            const unsigned tg = og / nx;
            if (og + 1u == (tg + 1u) * nx) xb_add(&bar[XB_TOPGEN], 1u);
            else XB_SPIN(xb_ld(&bar[XB_TOPGEN]) == tg, bar);
            __builtin_amdgcn_fence(__ATOMIC_ACQUIRE, "agent");
            xb_add(&bar[XB_XGEN(b.x)], 1u);
            asm volatile("s_waitcnt vmcnt(0)" ::: "memory");
        } else {
            XB_SPIN(xb_ld(&bar[XB_XGEN(b.x)]) == gen, bar);
            __builtin_amdgcn_fence(__ATOMIC_ACQUIRE, "agent");
            asm volatile("s_waitcnt vmcnt(0)" ::: "memory");
        }
    }
    __syncthreads();
}

constexpr int NWAVES = 8;
constexpr int RING_BYTES = 131072;
constexpr int XG_OFF = RING_BYTES;
constexpr int MISC_OFF = RING_BYTES + 8192;
constexpr int LDS_BYTES = 147456;

struct Args { const float* in[N_IN]; float* out; unsigned char* ws; int ph_lo, ph_hi, use_bar, pad; };

struct Ctx {
    LAS unsigned char* lds;
    const float* const* in; float* out; unsigned char* ws;
    int tid, lane, wave, G, vcu;
};
#define OPAQUE_CTX(C) do { asm volatile("" : "+v"((C).tid), "+v"((C).lane)); asm volatile("" : "+s"((C).wave), "+s"((C).vcu)); } while (0)
DI bf16_t* wsb(const Ctx& F, size_t off) { return (bf16_t*)(F.ws + off); }
DI float* wsf(const Ctx& F, size_t off) { return (float*)(F.ws + off); }

DI bool chunk_first(int c) { return c == 0 || c == 128 || c >= 256; }
DI bool chunk_last(int c) { return c == 127 || c >= 255; }
DI int chunk_seq(int c) { return c < 128 ? 0 : (c < 256 ? 1 : c - 254); }
DI float* st_out(const Ctx& F, size_t offp, size_t offs, int layer, int seq, int per) {
    return seq < 2 ? F.out + offp + (size_t)(layer * 2 + seq) * per : F.out + offs + (size_t)(layer * 8 + (seq - 2)) * per;
}

DI float wave_sum(float v) {
#pragma unroll
    for (int o = 1; o < 64; o <<= 1) v += __shfl_xor(v, o);
    return v;
}
DI int win_dst(int n) {
    if (n < 512) return PC_AX + n;
    if (n < 1024) return PC_AG + (n - 512);
    if (n < 1280) return PC_BQ + (n - 1024);
    if (n < 1536) return PC_BK + (n - 1280);
    if (n < 2048) return PC_BV + (n - 1536);
    if (n < 2560) return PC_BG + (n - 2048);
    if (n < 2576) return PC_BLR + (n - 2560);
    if (n < 3088) return PC_CZ + (n - 2576);
    if (n < 4112) return PC_XBC + (n - 3088);
    return PC_DT + (n - 4112);
}
DI int map_row(int mode, int n) {
    if (mode == 1) return win_dst(n);
    if (mode == 2) return 256 * (n >> 7) + (n & 127);
    if (mode == 3) return 256 * (n >> 7) + 128 + (n & 127);
    return n;
}
DI void tr_item(const float* W, int K, int N, bf16_t* WT, int mode, const float* g, LAS float* scr, int item, int lane) {
    const int nblk = (N + 31) / 32, kb = item / nblk, nb = item % nblk, k0 = 64 * kb, n0 = 32 * nb;
#pragma unroll 8
    for (int i = 0; i < 32; ++i) { const int kk = 2 * i + (lane >> 5), n = n0 + (lane & 31); float v = n < N ? W[(size_t)(k0 + kk) * N + n] : 0.f; if (g) v *= g[k0 + kk]; scr[kk * 33 + (lane & 31)] = v; }
    LDS_WAIT();
    const int c = lane & 7;
#pragma unroll
    for (int j = 0; j < 4; ++j) { const int n = (lane >> 3) + 8 * j; const LAS float* s = scr + (8 * c) * 33 + n;
        u32x4 o; o.x = pk2(s[0 * 33], s[1 * 33]); o.y = pk2(s[2 * 33], s[3 * 33]); o.z = pk2(s[4 * 33], s[5 * 33]); o.w = pk2(s[6 * 33], s[7 * 33]);
        if (n0 + n < N) *(u32x4*)(WT + (size_t)map_row(mode, n0 + n) * K + k0 + 8 * c) = o; }
    LDS_WAIT();
}
DI void convert_set(const Ctx& F, int layer, int which) {
    LAS float* scr = (LAS float*)(F.lds + F.wave * 16384);
    const int gw = F.vcu * NWAVES + F.wave, NGW = F.G * NWAVES;
    int base = 0;
#define CONV_MAT(cond, Wp, K_, N_, WTp, mode_, gp) if (cond) { const int ni = ((K_) / 64) * (((N_) + 31) / 32); \
        for (int it = gw - base; it < ni; it += NGW) { if (it >= 0) tr_item(Wp, K_, N_, WTp, mode_, gp, scr, it, F.lane); } base = (base + ni) % NGW; }
    CONV_MAT(which & 1, F.in[I_WIN] + (size_t)layer * D * DIN, D, DIN, wsb(F, WS_WIN), 1, F.in[I_NMIX] + layer * D)
    CONV_MAT(which & 2, F.in[I_WOUT] + (size_t)layer * DMIX * D, DMIX, D, wsb(F, WS_WOUT), 0, (const float*)nullptr)
    CONV_MAT(which & 4, F.in[I_WG] + (size_t)layer * D * DFF, D, DFF, wsb(F, WS_WGU), 2, F.in[I_NFFN] + layer * D)
    CONV_MAT(which & 4, F.in[I_WU] + (size_t)layer * D * DFF, D, DFF, wsb(F, WS_WGU), 3, F.in[I_NFFN] + layer * D)
    CONV_MAT(which & 8, F.in[I_WD] + (size_t)layer * DFF * D, DFF, D, wsb(F, WS_WD), 0, (const float*)nullptr)
    CONV_MAT(which & 16, F.in[I_PWG] + (size_t)layer * D * D, D, D, wsb(F, WS_WPG), 0, F.in[I_NPLE] + layer * D)
    CONV_MAT(which & 32, F.in[I_PWP] + (size_t)layer * DPLE * D, DPLE, D, wsb(F, WS_WPP), 0, (const float*)nullptr)
    if (which & 128) {
        for (int it = gw; it < DEPTH * 2 * 8 * 2; it += NGW) { const int mat = it >> 1, sub = it & 1, l = mat >> 4, ri = (mat >> 3) & 1, h = mat & 7;
            tr_item(F.in[ri ? I_LWI : I_LWR] + (size_t)(l * 8 + h) * 4096, 64, 64, wsb(F, WS_LRUW) + (size_t)((l * 2 + ri) * 8 + h) * 4096, 0, nullptr, scr, sub, F.lane); }
    }
#undef CONV_MAT
    if (which & 1) {
        u32x4* z = (u32x4*)(wsb(F, WS_WIN) + (size_t)PC_PAD * D); const int n16 = (PC_Y - PC_PAD) * D * 2 / 16;
        u32x4 zv = (u32x4){0u, 0u, 0u, 0u}; asm volatile("" : "+v"(zv));
        for (int i = blockIdx.x * 512 + F.tid; i < n16; i += F.G * 512) z[i] = zv;
    }
    if (which & 64) {
        const float* pp = F.in[I_PP] + (size_t)layer * MP * DPLE; const float* ps = F.in[I_PS] + (size_t)layer * MS * DPLE; bf16_t* pb = wsb(F, WS_PB);
        const int n8 = M * DPLE / 8;
        for (int i = blockIdx.x * 512 + F.tid; i < n8; i += F.G * 512) { const size_t e = (size_t)i * 8; const float* src = e < (size_t)MP * DPLE ? pp + e : ps + (e - (size_t)MP * DPLE);
            const f32x4 a = *(const f32x4*)src, b = *(const f32x4*)(src + 4); u32x4 o; o.x = pk2(a.x, a.y); o.y = pk2(a.z, a.w); o.z = pk2(b.x, b.y); o.w = pk2(b.z, b.w); *(u32x4*)(pb + e) = o; }
    }
}
DI void p0_rows(const Ctx& F) {
    const int gw = F.vcu * NWAVES + F.wave, NGW = F.G * NWAVES;
    bf16_t* xb = wsb(F, WS_XBN); float* rss = wsf(F, WS_RSSN) + (size_t)XB_PAD * 16;
    for (int m = gw; m < M; m += NGW) {
        const float* xr = m < MP ? F.in[I_XP] + (size_t)m * D : F.in[I_XS] + (size_t)(m - MP) * D;
        const f32x4* x4 = (const f32x4*)xr + F.lane; f32x4 v[4]; float s = 0.f;
#pragma unroll
        for (int j = 0; j < 4; ++j) { v[j] = x4[64 * j]; s += (v[j].x * v[j].x + v[j].y * v[j].y) + (v[j].z * v[j].z + v[j].w * v[j].w); }
        s = wave_sum(s);
        u32x2* o8 = (u32x2*)(xb + (size_t)m * D) + F.lane;
#pragma unroll
        for (int j = 0; j < 4; ++j) { u32x2 w; w.x = pk2(v[j].x, v[j].y); w.y = pk2(v[j].z, v[j].w); o8[64 * j] = w; }
        if (F.lane < 16) rss[(size_t)m * 16 + F.lane] = F.lane == 0 ? s : 0.f;
    }
}

DI float row_rstd(const float* rss, long row) {
    const f32x4* p = (const f32x4*)(rss + row * 16); const f32x4 a = p[0], b = p[1], c = p[2], d = p[3];
    const float s = ((a.x + a.y) + (a.z + a.w)) + ((b.x + b.y) + (b.z + b.w)) + ((c.x + c.y) + (c.z + c.w)) + ((d.x + d.y) + (d.z + d.w));
    return rsqrtf(fmaxf(s, 0.f) * (1.f / D) + EPS);
}
DI float row_rstd_q(const float* rss, long row, int fq) {
    const f32x4 a = *(const f32x4*)(rss + row * 16 + 4 * fq); float s = (a.x + a.y) + (a.z + a.w);
    s += __shfl_xor(s, 16); s += __shfl_xor(s, 32);
    return rsqrtf(fmaxf(s, 0.f) * (1.f / D) + EPS);
}
struct EpiProj {
    static constexpr bool PERM = true;
    bf16_t* O; const float* rss;
    DI void operator()(const f32x4 (&acc)[2][2][4][2], const pg8::Unit& u, int wr, int wc, int fr_, int fq_, LAS unsigned char*) const {
        int fr = fr_, fq = fq_; asm volatile("" : "+v"(fr), "+v"(fq));
        const int row0 = u.arow + wr * 64 + fr, col0 = u.pn * 256 + wc * 32 + 8 * fq;
#pragma unroll
        for (int ai = 0; ai < 2; ++ai)
#pragma unroll
            for (int m = 0; m < 4; ++m) { const int r = row0 + ai * 128 + m * 16; const float rs = row_rstd_q(rss, r, fq); bf16_t* rowp = O + (size_t)r * DINP + col0;
#pragma unroll
                for (int bj = 0; bj < 2; ++bj) { const f32x4 v0 = acc[ai][bj][m][0] * rs, v1 = acc[ai][bj][m][1] * rs;
                    u32x4 w; w.x = pg8::cvt_pk_bf16(v0[0], v0[1]); w.y = pg8::cvt_pk_bf16(v0[2], v0[3]); w.z = pg8::cvt_pk_bf16(v1[0], v1[1]); w.w = pg8::cvt_pk_bf16(v1[2], v1[3]);
                    *(u32x4*)(rowp + bj * 128) = w; } }
    }
};
struct EpiRes {
    static constexpr bool PERM = false;
    const float* xin_p; const float* xin_s; float* xout; bf16_t* xb; float* rss;
    DI void operator()(const f32x4 (&acc)[2][2][4][2], const pg8::Unit& u, int wr, int wc, int fr_, int fq_, LAS unsigned char*) const {
        int fr = fr_, fq = fq_; asm volatile("" : "+v"(fr), "+v"(fq));
        const int row0 = u.arow + wr * 64 + fr, col0 = u.pn * 256 + wc * 32 + 4 * fq;
#pragma unroll
        for (int ai = 0; ai < 2; ++ai)
#pragma unroll
            for (int m = 0; m < 4; ++m) { const int r = row0 + ai * 128 + m * 16; const size_t off = (size_t)r * D + col0;
                const float* xi = r < MP ? xin_p + off : xin_s + (off - (size_t)MP * D);
                float ss = 0.f;
#pragma unroll
                for (int bj = 0; bj < 2; ++bj)
#pragma unroll
                    for (int n = 0; n < 2; ++n) { const int co = bj * 128 + n * 16;
                        const f32x4 xn = *(const f32x4*)(xi + co) + acc[ai][bj][m][n]; *(f32x4*)(xout + off + co) = xn;
                        u32x2 w; w.x = pg8::cvt_pk_bf16(xn[0], xn[1]); w.y = pg8::cvt_pk_bf16(xn[2], xn[3]); *(u32x2*)(xb + off + co) = w;
                        ss += (xn[0] * xn[0] + xn[1] * xn[1]) + (xn[2] * xn[2] + xn[3] * xn[3]); }
                ss += __shfl_xor(ss, 16); ss += __shfl_xor(ss, 32);
                if (fq == 0) rss[(size_t)r * 16 + u.pn * 4 + wc] = ss;
                asm volatile("" ::: "memory"); }
    }
};
struct EpiPle {
    static constexpr bool PERM = false;
    const float* xin; float* xout; bf16_t* xb; const float* rss_in; float* rss_out; const bf16_t* pp;
    DI void operator()(const f32x4 (&acc)[2][2][4][2], const pg8::Unit& u, int wr, int wc, int fr_, int fq_, LAS unsigned char*) const {
        int fr = fr_, fq = fq_; asm volatile("" : "+v"(fr), "+v"(fq));
        const int row0 = u.arow + wr * 64 + fr, col0 = u.pn * 256 + wc * 32 + 4 * fq;
#pragma unroll
        for (int ai = 0; ai < 2; ++ai)
#pragma unroll
            for (int m = 0; m < 4; ++m) { const int r = row0 + ai * 128 + m * 16; const size_t off = (size_t)r * D + col0;
                const float rs = row_rstd_q(rss_in, r, fq); float ss = 0.f;
#pragma unroll
                for (int bj = 0; bj < 2; ++bj)
#pragma unroll
                    for (int n = 0; n < 2; ++n) { const int co = bj * 128 + n * 16; f32x4 f = acc[ai][bj][m][n];
                        const u32x2 pw = *(const u32x2*)(pp + off + co);
                        f[0] = sigm(f[0] * rs) * __uint_as_float(pw.x << 16); f[1] = sigm(f[1] * rs) * __uint_as_float(pw.x & 0xffff0000u);
                        f[2] = sigm(f[2] * rs) * __uint_as_float(pw.y << 16); f[3] = sigm(f[3] * rs) * __uint_as_float(pw.y & 0xffff0000u);
                        const f32x4 xn = *(const f32x4*)(xin + off + co) + f; *(f32x4*)(xout + off + co) = xn;
                        u32x2 w; w.x = pg8::cvt_pk_bf16(xn[0], xn[1]); w.y = pg8::cvt_pk_bf16(xn[2], xn[3]); *(u32x2*)(xb + off + co) = w;
                        ss += (xn[0] * xn[0] + xn[1] * xn[1]) + (xn[2] * xn[2] + xn[3] * xn[3]); }
                ss += __shfl_xor(ss, 16); ss += __shfl_xor(ss, 32);
                if (fq == 0) rss_out[(size_t)r * 16 + u.pn * 4 + wc] = ss;
                asm volatile("" ::: "memory"); }
    }
};
struct EpiPP {
    static constexpr bool PERM = false;
    bf16_t* pp;
    DI void operator()(const f32x4 (&acc)[2][2][4][2], const pg8::Unit& u, int wr, int wc, int fr_, int fq_, LAS unsigned char*) const {
        int fr = fr_, fq = fq_; asm volatile("" : "+v"(fr), "+v"(fq));
        const int row0 = u.arow + wr * 64 + fr, col0 = u.pn * 256 + wc * 32 + 4 * fq;
#pragma unroll
        for (int ai = 0; ai < 2; ++ai)
#pragma unroll
            for (int m = 0; m < 4; ++m) { const size_t off = (size_t)(row0 + ai * 128 + m * 16) * D + col0;
#pragma unroll
                for (int bj = 0; bj < 2; ++bj)
#pragma unroll
                    for (int n = 0; n < 2; ++n) { const f32x4 f = acc[ai][bj][m][n]; u32x2 w; w.x = pg8::cvt_pk_bf16(f[0], f[1]); w.y = pg8::cvt_pk_bf16(f[2], f[3]); *(u32x2*)(pp + off + bj * 128 + n * 16) = w; } }
    }
};
struct EpiFfn {
    static constexpr bool PERM = true;
    bf16_t* H; const float* rss; const float* cw; const float* cb; const float* st_in; float* st_p; float* st_s;
    DI void operator()(f32x4 (&acc)[2][2][4][2], const pg8::Unit& u, int wr, int wc, int fr_, int fq_, LAS unsigned char* lds) const {
        int fr = fr_, fq = fq_; asm volatile("" : "+v"(fr), "+v"(fq));
        const int lane = fr + 16 * fq;
        const int gc0 = u.pn * 128 + wc * 32 + 8 * fq;
        LAS float* XG = (LAS float*)(lds + XG_OFF);
#pragma unroll
        for (int ai = 0; ai < 2; ++ai)
#pragma unroll
            for (int m = 0; m < 4; ++m) { const float rs = row_rstd_q(rss, (long)u.arow + ai * 128 + wr * 64 + m * 16 + fr, fq);
#pragma unroll
                for (int bj = 0; bj < 2; ++bj)
#pragma unroll
                    for (int n = 0; n < 2; ++n) acc[ai][bj][m][n] *= rs;
                asm volatile("" : "+v"(acc[ai][0][m][0]), "+v"(acc[ai][0][m][1]), "+v"(acc[ai][1][m][0]), "+v"(acc[ai][1][m][1]) :: "memory"); }
        if (fr >= 14) {
#pragma unroll
            for (int ai = 0; ai < 2; ++ai)
#pragma unroll
                for (int n = 0; n < 2; ++n) *(LAS f32x4*)(XG + ((2 * ai + wr) * 2 + (fr - 14)) * 128 + wc * 32 + 8 * fq + 4 * n) = acc[ai][0][3][n];
        }
        LDS_WAIT(); __builtin_amdgcn_s_barrier(); asm volatile("" ::: "memory");
        const int src1 = (lane & 48) | ((fr + 15) & 15), src2 = (lane & 48) | ((fr + 14) & 15);
#pragma unroll
        for (int n = 0; n < 2; ++n) {
            const int gc = gc0 + 4 * n;
            const f32x4 w0 = *(const f32x4*)(cw + gc), w1 = *(const f32x4*)(cw + DFF + gc), w2 = *(const f32x4*)(cw + 2 * DFF + gc), bb = *(const f32x4*)(cb + gc);
#pragma unroll
            for (int ai = 0; ai < 2; ++ai) {
                f32x4 pr1, pr2;
                const int pb = 2 * ai + wr - 1;
                if (pb >= 0) { pr1 = *(const LAS f32x4*)(XG + (pb * 2 + 1) * 128 + wc * 32 + 8 * fq + 4 * n);
                               pr2 = *(const LAS f32x4*)(XG + (pb * 2 + (fr & 1)) * 128 + wc * 32 + 8 * fq + 4 * n); }
                else { pr1 = (f32x4){0.f, 0.f, 0.f, 0.f}; pr2 = pr1; }
#pragma unroll
                for (int m = 0; m < 4; ++m) {
                    const int j = ai * 128 + wr * 64 + m * 16 + fr; const long r = (long)u.arow + j;
                    int t, seq; if (r < MP) { t = (int)r & 8191; seq = (int)(r >> 13); } else { t = (int)(r - MP) & 63; seq = 2 + (int)((r - MP) >> 6); }
                    const int T = r < MP ? 8192 : 64;
                    const bool valid = j >= 2 && r < M;
                    const f32x4 cur = acc[ai][0][m][n]; f32x4 r1, r2;
#pragma unroll
                    for (int i = 0; i < 4; ++i) { r1[i] = __shfl(cur[i], src1); r2[i] = __shfl(cur[i], src2); }
                    f32x4 p1 = fr >= 1 ? r1 : pr1, p2 = fr >= 2 ? r2 : pr2;
                    pr1 = r1; pr2 = r2;
                    if (valid && t < 2) {
                        const f32x4 z = (f32x4){0.f, 0.f, 0.f, 0.f}; f32x4 s0 = z, s1 = z;
                        if (seq >= 2) { const float* sp = st_in + (size_t)(seq - 2) * 2 * DFF + gc; s0 = *(const f32x4*)sp; s1 = *(const f32x4*)(sp + DFF); }
                        if (t == 0) { p1 = s1; p2 = s0; } else { p2 = s1; }
                    }
                    const f32x4 gpre = bb + w0 * p2 + w1 * p1 + w2 * cur; const f32x4 up = acc[ai][1][m][n];
                    const float h0 = gelu_t(gpre[0]) * up[0], h1 = gelu_t(gpre[1]) * up[1], h2 = gelu_t(gpre[2]) * up[2], h3 = gelu_t(gpre[3]) * up[3];
                    if (valid) { u32x2 hw; hw.x = pg8::cvt_pk_bf16(h0, h1); hw.y = pg8::cvt_pk_bf16(h2, h3); *(u32x2*)(H + (size_t)r * DFF + gc) = hw;
                        if (t >= T - 2) { float* so = (seq < 2 ? st_p + (size_t)seq * 2 * DFF : st_s + (size_t)(seq - 2) * 2 * DFF) + (size_t)(t - (T - 2)) * DFF + gc; *(f32x4*)so = cur; } }
                    asm volatile("" ::: "memory");
                }
            }
        }
    }
};

DI bf16x8 frag_row(const LAS unsigned char* img, int pitch, int row0, int k0, int lane) {
    return *(const LAS bf16x8*)(img + (row0 + (lane & 15)) * pitch + (k0 + 8 * (lane >> 4)) * 2);
}
DI bf16x8 frag_tr(const LAS unsigned char* img, int pitch, int k0, int n0, int lane) {
    const int g = lane >> 4, i = lane & 15, q = i >> 2, p = i & 3;
    const LAS unsigned char* a = img + (k0 + 8 * g + q) * pitch + (n0 + 4 * p) * 2;
    const s16x4 lo = __builtin_amdgcn_ds_read_tr16_b64_v4i16((LAS s16x4*)a);
    const s16x4 hi = __builtin_amdgcn_ds_read_tr16_b64_v4i16((LAS s16x4*)(a + 4 * pitch));
    return __builtin_shufflevector(lo, hi, 0, 1, 2, 3, 4, 5, 6, 7);
}
#define MFMA16(a, b, c) __builtin_amdgcn_mfma_f32_16x16x32_bf16((a), (b), (c), 0, 0, 0)
DI void st_bf16(LAS unsigned char* img, int pitch, int row, int col, float v) { *(LAS bf16_t*)(img + row * pitch + col * 2) = (bf16_t)f2bf(v); }
DI float ld_bf16(const LAS unsigned char* img, int pitch, int row, int col) { return bf2f(*(const LAS bf16_t*)(img + row * pitch + col * 2)); }

template <bool SSD> struct LAT {
    static constexpr int DA = SSD ? 128 : 64, DB = SSD ? 64 : 128;
    static constexpr int PA = (DA + 8) * 2, PV = (DB + 8) * 2, PPI = 144, PS = (DB + 8) * 2;
    static constexpr int O_QD = 0, O_KI = O_QD + 64 * PA, O_KE = O_KI + 64 * PA, O_VV = O_KE + 64 * PA, O_P = O_VV + 64 * PV, O_SB = O_P + 64 * PPI, O_TAB = O_SB + DA * PS;
    static constexpr int NT_O = DB / 32;
};
template <bool SSD> DI void la_mt_nt(int T, int& mt, int& nt) { if (SSD) { mt = T >> 2; nt = T & 3; } else { mt = T >> 3; nt = T & 7; } }

template <bool SSD> DI void la_state_update(LAS unsigned char* lds, f32x4 (&S)[4], int w, int lane) {
    typedef LAT<SSD> L; const LAS float* tab = (const LAS float*)(lds + L::O_TAB); const int q = lane >> 4;
#pragma unroll
    for (int x = 0; x < 4; ++x) { int mt, nt; la_mt_nt<SSD>(4 * w + x, mt, nt);
        if (SSD) { const float d = tab[256]; S[x] *= d; }
        else {
#pragma unroll
            for (int r = 0; r < 4; ++r) S[x][r] *= tab[1536 + 16 * mt + 4 * q + r]; }
#pragma unroll
        for (int ks = 0; ks < 2; ++ks) { const bf16x8 a = frag_tr(lds + L::O_KE, L::PA, 32 * ks, 16 * mt, lane); const bf16x8 b = frag_tr(lds + L::O_VV, L::PV, 32 * ks, 16 * nt, lane); S[x] = MFMA16(a, b, S[x]); }
    }
}
template <bool SSD> DI void la_write_sb(LAS unsigned char* lds, const f32x4 (&S)[4], int w, int lane) {
    typedef LAT<SSD> L; const int q = lane >> 4, c = lane & 15;
#pragma unroll
    for (int x = 0; x < 4; ++x) { int mt, nt; la_mt_nt<SSD>(4 * w + x, mt, nt);
#pragma unroll
        for (int r = 0; r < 4; ++r) st_bf16(lds + L::O_SB, L::PS, 16 * mt + 4 * q + r, 16 * nt + c, S[x][r]); }
}
template <bool SSD> DI void la_compute_p(LAS unsigned char* lds, int w, int lane) {
    typedef LAT<SSD> L; const LAS float* tab = (const LAS float*)(lds + L::O_TAB); const int q = lane >> 4, c = lane & 15, mt = w >> 1;
#pragma unroll
    for (int x = 0; x < 2; ++x) { const int nt = (w & 1) * 2 + x; f32x4 acc = {0.f, 0.f, 0.f, 0.f};
#pragma unroll
        for (int ks = 0; ks < L::DA / 32; ++ks) { const bf16x8 a = frag_row(lds + L::O_QD, L::PA, 16 * mt, 32 * ks, lane); const bf16x8 b = frag_row(lds + L::O_KI, L::PA, 16 * nt, 32 * ks, lane); acc = MFMA16(a, b, acc); }
        const int j = 16 * nt + c;
#pragma unroll
        for (int r = 0; r < 4; ++r) { const int i = 16 * mt + 4 * q + r; float v = acc[r];
            if (SSD) v *= __expf(tab[64 + i] - tab[64 + j]) * tab[j];
            v = (j > i) ? 0.f : v; st_bf16(lds + L::O_P, L::PPI, i, j, v); }
    }
}
template <bool SSD> DI void la_compute_out(LAS unsigned char* lds, f32x4 (&o1)[LAT<SSD>::NT_O], f32x4 (&o2)[LAT<SSD>::NT_O], int w, int lane) {
    typedef LAT<SSD> L; const int mt = w >> 1;
#pragma unroll
    for (int x = 0; x < L::NT_O; ++x) { const int nt = (w & 1) * L::NT_O + x; f32x4 a1 = {0.f, 0.f, 0.f, 0.f}, a2 = {0.f, 0.f, 0.f, 0.f};
#pragma unroll
        for (int ks = 0; ks < 2; ++ks) { const bf16x8 a = frag_row(lds + L::O_P, L::PPI, 16 * mt, 32 * ks, lane); const bf16x8 b = frag_tr(lds + L::O_VV, L::PV, 32 * ks, 16 * nt, lane); a1 = MFMA16(a, b, a1); }
#pragma unroll
        for (int ks = 0; ks < L::DA / 32; ++ks) { const bf16x8 a = frag_row(lds + L::O_QD, L::PA, 16 * mt, 32 * ks, lane); const bf16x8 b = frag_tr(lds + L::O_SB, L::PS, 32 * ks, 16 * nt, lane); a2 = MFMA16(a, b, a2); }
        o1[x] = a1; o2[x] = a2; }
}
DI void la_store_ds(float* ds, const f32x4 (&S)[4], int w, int lane) {
#pragma unroll
    for (int x = 0; x < 4; ++x)
#pragma unroll
        for (int r = 0; r < 4; ++r) ds[((4 * w + x) * 4 + r) * 64 + lane] = S[x][r];
}
DI void la_load_ds(const float* ds, f32x4 (&S)[4], int w, int lane) {
#pragma unroll
    for (int x = 0; x < 4; ++x)
#pragma unroll
        for (int r = 0; r < 4; ++r) S[x][r] = ds[((4 * w + x) * 4 + r) * 64 + lane];
}

struct GlaCoef { float wlr[16]; float blr; };
DI float gla_stage(const Ctx& F, int layer, int h, int chunk, const GlaCoef& cf) {
    typedef LAT<false> L; LAS unsigned char* lds = F.lds; LAS float* tab = (LAS float*)(lds + L::O_TAB);
    const bf16_t* proj = wsb(F, WS_R); const int row0 = 64 * chunk, d = F.lane, w = F.wave;
    if (F.tid < 128) { const int t = F.tid >> 1, half = F.tid & 1; const u32x4 v = *(const u32x4*)(proj + (size_t)(row0 + t) * DINP + PC_BLR + 8 * half); float f[8]; unpack8(v, f);
#pragma unroll
        for (int i = 0; i < 8; ++i) tab[t * 16 + 8 * half + i] = f[i]; }
#pragma unroll
    for (int i = 0; i < 2; ++i) { const int idx = F.tid + 512 * i, t = idx >> 4, c16 = idx & 15;
        *(LAS u32x4*)(lds + L::O_VV + t * L::PV + c16 * 16) = *(const u32x4*)(proj + (size_t)(row0 + t) * DINP + PC_BV + 128 * h + 8 * c16); }
    float qv[8], kv[8];
#pragma unroll
    for (int i = 0; i < 8; ++i) { const size_t ro = (size_t)(row0 + 8 * w + i) * DINP; qv[i] = bf2f(proj[ro + PC_BQ + 64 * h + d]); kv[i] = bf2f(proj[ro + PC_BK + 64 * h + d]); }
    __syncthreads();
    float pre[8]; float run = 0.f;
#pragma unroll
    for (int i = 0; i < 8; ++i) { const int t = 8 * w + i; float z = cf.blr;
#pragma unroll
        for (int r = 0; r < 16; ++r) z += tab[t * 16 + r] * cf.wlr[r];
        run += logsig_f(z) * (1.f / 16.f); pre[i] = run; }
    tab[1024 + w * 64 + d] = run;
    __syncthreads();
    float off = 0.f, last = 0.f;
#pragma unroll
    for (int ww = 0; ww < 8; ++ww) { const float tv = tab[1024 + ww * 64 + d]; last += tv; if (ww < w) off += tv; }
#pragma unroll
    for (int i = 0; i < 8; ++i) { const int t = 8 * w + i; const float cum = off + pre[i];
        st_bf16(lds + L::O_QD, L::PA, t, d, qv[i] * 0.125f * __expf(cum)); st_bf16(lds + L::O_KI, L::PA, t, d, kv[i] * __expf(-cum)); st_bf16(lds + L::O_KE, L::PA, t, d, kv[i] * __expf(last - cum)); }
    if (w == 0) tab[1536 + d] = __expf(last);
    __syncthreads();
    return last;
}
DI float ssd_stage(const Ctx& F, int layer, int h, int chunk) {
    typedef LAT<true> L; LAS unsigned char* lds = F.lds; LAS float* tab = (LAS float*)(lds + L::O_TAB);
    const bf16_t* proj = wsb(F, WS_R); const int row0 = 64 * chunk, g = h >> 2; const bool first = chunk_first(chunk);
    float xr[11][8]; int cidx = 0, rg = 0, ch = 0;
    if (F.tid < 320) { cidx = F.tid % 40; rg = F.tid / 40;
        ch = cidx < 8 ? 64 * h + 8 * cidx : (cidx < 24 ? 512 + 128 * g + 8 * (cidx - 8) : 768 + 128 * g + 8 * (cidx - 24));
#pragma unroll
        for (int i = 0; i < 11; ++i) { const int tt = 8 * rg - 3 + i;
            if (tt >= 0 || !first) { const u32x4 v = *(const u32x4*)(proj + (size_t)(row0 + tt) * DINP + PC_XBC + ch); unpack8(v, xr[i]); }
            else if (chunk >= 256) { const float* sp = F.in[I_SSC] + ((size_t)(layer * 8 + (chunk - 256)) * 3 + (tt + 3)) * 1024 + ch; const f32x4 a = *(const f32x4*)sp, b = *(const f32x4*)(sp + 4);
                xr[i][0] = a.x; xr[i][1] = a.y; xr[i][2] = a.z; xr[i][3] = a.w; xr[i][4] = b.x; xr[i][5] = b.y; xr[i][6] = b.z; xr[i][7] = b.w; }
            else {
#pragma unroll
                for (int e = 0; e < 8; ++e) xr[i][e] = 0.f; }
        }
    }
    float last = 0.f;
    if (F.wave == 0) { const int t = F.lane; const float dtraw = bf2f(proj[(size_t)(row0 + t) * DINP + PC_DT + h]);
        const float dt = softplus_f(dtraw + F.in[I_SDTB][layer * 8 + h]); float cum = -dt * __expf(F.in[I_SALOG][layer * 8 + h]);
#pragma unroll
        for (int o = 1; o < 64; o <<= 1) { const float v = __shfl_up(cum, o); if (t >= o) cum += v; }
        last = __shfl(cum, 63);
        tab[t] = dt; tab[64 + t] = cum; tab[128 + t] = __expf(last - cum) * dt; tab[192 + t] = __expf(cum); if (t == 0) tab[256] = __expf(last); }
    __syncthreads();
    if (F.tid < 320) {
        const float* cwp = F.in[I_SCW] + (size_t)layer * 4 * 1024 + ch; const float* cbp = F.in[I_SCB] + layer * 1024 + ch;
        float wv[4][8], bv[8];
#pragma unroll
        for (int j = 0; j < 4; ++j) { const f32x4 a = *(const f32x4*)(cwp + j * 1024), b = *(const f32x4*)(cwp + j * 1024 + 4); wv[j][0] = a.x; wv[j][1] = a.y; wv[j][2] = a.z; wv[j][3] = a.w; wv[j][4] = b.x; wv[j][5] = b.y; wv[j][6] = b.z; wv[j][7] = b.w; }
        { const f32x4 a = *(const f32x4*)cbp, b = *(const f32x4*)(cbp + 4); bv[0] = a.x; bv[1] = a.y; bv[2] = a.z; bv[3] = a.w; bv[4] = b.x; bv[5] = b.y; bv[6] = b.z; bv[7] = b.w; }
#pragma unroll
        for (int r = 0; r < 8; ++r) { const int t = 8 * rg + r; float o[8];
#pragma unroll
            for (int e = 0; e < 8; ++e) { float v = bv[e];
#pragma unroll
                for (int j = 0; j < 4; ++j) v += wv[j][e] * xr[r + j][e];
                o[e] = silu_f(v); }
            if (cidx < 8) *(LAS u32x4*)(lds + L::O_VV + t * L::PV + cidx * 16) = pack8(o);
            else if (cidx < 24) { *(LAS u32x4*)(lds + L::O_KI + t * L::PA + (cidx - 8) * 16) = pack8(o); const float we = tab[128 + t];
#pragma unroll
                for (int e = 0; e < 8; ++e) o[e] *= we;
                *(LAS u32x4*)(lds + L::O_KE + t * L::PA + (cidx - 8) * 16) = pack8(o); }
            else *(LAS u32x4*)(lds + L::O_QD + t * L::PA + (cidx - 24) * 16) = pack8(o);
        }
    }
    __syncthreads();
    return last;
}

template <bool SSD> DI void la_pass_a(const Ctx& F0, int layer, int panel, int h) {
    Ctx F = F0; OPAQUE_CTX(F);
    LAS unsigned char* lds = F.lds; const int w = F.wave, lane = F.lane;
    f32x4 S[4];
#pragma unroll
    for (int x = 0; x < 4; ++x) S[x] = (f32x4){0.f, 0.f, 0.f, 0.f};
    GlaCoef cf; if (!SSD) {
#pragma unroll
        for (int r = 0; r < 16; ++r) cf.wlr[r] = F.in[I_GWLR][(size_t)(layer * 16 + r) * 256 + 64 * h + lane];
        cf.blr = F.in[I_GBLR][layer * 256 + 64 * h + lane]; }
    float lastsum = 0.f;
    const Ctx Fp = F;
#pragma unroll 1
    for (int cc = 0; cc < 4; ++cc) { const int chunk = 4 * panel + cc;
        Ctx F = Fp; { unsigned z_ = 0; asm volatile("" : "+s"(z_)); F.lds = Fp.lds + z_; } LAS unsigned char* lds = F.lds;
        float last; if (SSD) last = ssd_stage(F, layer, h, chunk); else last = gla_stage(F, layer, h, chunk, cf);
        lastsum += last;
        la_state_update<SSD>(lds, S, w, lane);
        __syncthreads();
    }
    const int hh = SSD ? 4 + h : h;
    la_store_ds(wsf(F, WS_DS) + ((size_t)panel * 12 + hh) * 8192, S, w, lane);
    float* dec = wsf(F, WS_DEC);
    if (w == 0) { if (SSD) { if (lane == 0) dec[64 * 4 * 64 + panel * 8 + h] = __expf(lastsum); } else dec[(panel * 4 + h) * 64 + lane] = __expf(lastsum); }
}

template <bool SSD> DI void la_pass_c(const Ctx& F0, int layer, int c0, int nc, int h) {
    Ctx F = F0; OPAQUE_CTX(F);
    typedef LAT<SSD> L; LAS unsigned char* lds = F.lds; LAS float* tab = (LAS float*)(lds + L::O_TAB); const int w = F.wave, lane = F.lane, q = lane >> 4, c = lane & 15, mt = w >> 1;
    bf16_t* proj = wsb(F, WS_R);
    f32x4 S[4];
    GlaCoef cf; if (!SSD) {
#pragma unroll
        for (int r = 0; r < 16; ++r) cf.wlr[r] = F.in[I_GWLR][(size_t)(layer * 16 + r) * 256 + 64 * h + lane];
        cf.blr = F.in[I_GBLR][layer * 256 + 64 * h + lane]; }
    const int hh = SSD ? 4 + h : h;
    const Ctx Fp = F;
#pragma unroll 1
    for (int cc = 0; cc < nc; ++cc) { const int chunk = c0 + cc, row0 = 64 * chunk;
        Ctx F = Fp; { unsigned z_ = 0; asm volatile("" : "+s"(z_)); F.lds = Fp.lds + z_; } LAS unsigned char* lds = F.lds; LAS float* tab = (LAS float*)(lds + L::O_TAB);
        if (cc == 0 || chunk_first(chunk)) {
            if (chunk < 256) la_load_ds(wsf(F, WS_DS) + ((size_t)(chunk >> 2) * 12 + hh) * 8192, S, w, lane);
            else { const int b = chunk - 256;
#pragma unroll
                for (int x = 0; x < 4; ++x) { int smt, snt; la_mt_nt<SSD>(4 * w + x, smt, snt);
                    if (SSD) { const float* sp = F.in[I_SS] + ((size_t)((layer * 8 + b) * 8 + h) * 64 + 16 * snt + c) * 128 + 16 * smt + 4 * q; S[x] = *(const f32x4*)sp; }
                    else { const float* sp = F.in[I_SG] + ((size_t)((layer * 8 + b) * 4 + h) * 64 + 16 * smt + 4 * q) * 128 + 16 * snt + c;
#pragma unroll
                        for (int r = 0; r < 4; ++r) S[x][r] = sp[r * 128]; } } }
            la_write_sb<SSD>(lds, S, w, lane);
        }
        if (SSD) ssd_stage(F, layer, h, chunk); else gla_stage(F, layer, h, chunk, cf);
        la_compute_p<SSD>(lds, w, lane);
        __syncthreads();
        f32x4 o1[L::NT_O], o2[L::NT_O];
        la_compute_out<SSD>(lds, o1, o2, w, lane);
        la_state_update<SSD>(lds, S, w, lane);
        if (SSD) {
            const float Dh = F.in[I_SD][layer * 8 + h]; float ss[4] = {0.f, 0.f, 0.f, 0.f};
#pragma unroll
            for (int x = 0; x < L::NT_O; ++x) { const int p = 16 * ((w & 1) * L::NT_O + x) + c;
#pragma unroll
                for (int r = 0; r < 4; ++r) { const int i = 16 * mt + 4 * q + r; const float y = o1[x][r] + tab[192 + i] * o2[x][r] + Dh * ld_bf16(lds + L::O_VV, L::PV, i, p);
                    bf16_t* zp = proj + (size_t)(row0 + i) * DINP + PC_CZ + 64 * h + p; const float yg = y * silu_f(bf2f(*zp)); *zp = (bf16_t)f2bf(yg); ss[r] += yg * yg; } }
#pragma unroll
            for (int r = 0; r < 4; ++r) { float s = ss[r]; s += __shfl_xor(s, 1); s += __shfl_xor(s, 2); s += __shfl_xor(s, 4); s += __shfl_xor(s, 8);
                if (c == 0) wsf(F, WS_PSS)[(size_t)(row0 + 16 * mt + 4 * q + r) * 16 + 2 * h + (w & 1)] = s; }
            __syncthreads();
        } else {
            float ss[4] = {0.f, 0.f, 0.f, 0.f};
#pragma unroll
            for (int x = 0; x < L::NT_O; ++x) { o1[x] += o2[x];
#pragma unroll
                for (int r = 0; r < 4; ++r) ss[r] += o1[x][r] * o1[x][r]; }
#pragma unroll
            for (int r = 0; r < 4; ++r) { float s = ss[r]; s += __shfl_xor(s, 1); s += __shfl_xor(s, 2); s += __shfl_xor(s, 4); s += __shfl_xor(s, 8);
                if (c == 0) tab[1600 + (16 * mt + 4 * q + r) * 2 + (w & 1)] = s; }
            __syncthreads();
#pragma unroll
            for (int r = 0; r < 4; ++r) { const int i = 16 * mt + 4 * q + r; const float rstd = rsqrtf((tab[1600 + 2 * i] + tab[1600 + 2 * i + 1]) * (1.f / 128.f) + EPS);
#pragma unroll
                for (int x = 0; x < L::NT_O; ++x) { const int e = 16 * ((w & 1) * L::NT_O + x) + c; bf16_t* gp = proj + (size_t)(row0 + i) * DINP + PC_BG + 128 * h + e;
                    const float y = o1[x][r] * rstd * F.in[I_GNORM][layer * 512 + 128 * h + e] * silu_f(bf2f(*gp)); *gp = (bf16_t)f2bf(y); } }
        }
        if (chunk_last(chunk)) { const int seq = chunk_seq(chunk);
            if (SSD) { float* so = st_out(F, O_PS, O_SS, layer, seq, 8 * 64 * 128) + (size_t)h * 64 * 128;
#pragma unroll
                for (int x = 0; x < 4; ++x) { int smt, snt; la_mt_nt<SSD>(4 * w + x, smt, snt); *(f32x4*)(so + (size_t)(16 * snt + c) * 128 + 16 * smt + 4 * q) = S[x]; } }
            else { float* so = st_out(F, O_PG, O_SG, layer, seq, 4 * 64 * 128) + (size_t)h * 64 * 128;
#pragma unroll
                for (int x = 0; x < 4; ++x) { int smt, snt; la_mt_nt<SSD>(4 * w + x, smt, snt);
#pragma unroll
                    for (int r = 0; r < 4; ++r) so[(size_t)(16 * smt + 4 * q + r) * 128 + 16 * snt + c] = S[x][r]; } }
        } else if (cc + 1 < nc) la_write_sb<SSD>(lds, S, w, lane);
        __syncthreads();
    }
}

template <bool PASS_C> DI void lru_chunk(const Ctx& F0, int layer, int chunk) {
    Ctx F = F0; OPAQUE_CTX(F);
    const int h = F.wave, lane = F.lane, q = lane >> 4, c = lane & 15, row0 = 64 * chunk; const bool first = chunk_first(chunk);
    LAS unsigned char* T = F.lds + h * 9216; constexpr int TP = 144;
    bf16_t* proj = wsb(F, WS_R);
    {
        const int cc = lane & 7, rg = lane >> 3, ch = 64 * h + 8 * cc; float xr[11][8];
#pragma unroll
        for (int i = 0; i < 11; ++i) { const int tt = 8 * rg - 3 + i;
            if (tt >= 0 || !first) { const u32x4 v = *(const u32x4*)(proj + (size_t)(row0 + tt) * DINP + PC_AX + ch); unpack8(v, xr[i]); }
            else if (chunk >= 256) { const float* sp = F.in[I_SLC] + ((size_t)(layer * 8 + (chunk - 256)) * 3 + (tt + 3)) * 512 + ch; const f32x4 a = *(const f32x4*)sp, b = *(const f32x4*)(sp + 4);
                xr[i][0] = a.x; xr[i][1] = a.y; xr[i][2] = a.z; xr[i][3] = a.w; xr[i][4] = b.x; xr[i][5] = b.y; xr[i][6] = b.z; xr[i][7] = b.w; }
            else {
#pragma unroll
                for (int e = 0; e < 8; ++e) xr[i][e] = 0.f; }
        }
        const float* cwp = F.in[I_LCW] + (size_t)layer * 4 * 512 + ch; const float* cbp = F.in[I_LCB] + layer * 512 + ch;
        float wv[4][8], bv[8];
#pragma unroll
        for (int j = 0; j < 4; ++j) { const f32x4 a = *(const f32x4*)(cwp + j * 512), b = *(const f32x4*)(cwp + j * 512 + 4); wv[j][0] = a.x; wv[j][1] = a.y; wv[j][2] = a.z; wv[j][3] = a.w; wv[j][4] = b.x; wv[j][5] = b.y; wv[j][6] = b.z; wv[j][7] = b.w; }
        { const f32x4 a = *(const f32x4*)cbp, b = *(const f32x4*)(cbp + 4); bv[0] = a.x; bv[1] = a.y; bv[2] = a.z; bv[3] = a.w; bv[4] = b.x; bv[5] = b.y; bv[6] = b.z; bv[7] = b.w; }
#pragma unroll
        for (int r = 0; r < 8; ++r) { float o[8];
#pragma unroll
            for (int e = 0; e < 8; ++e) { float v = bv[e];
#pragma unroll
                for (int j = 0; j < 4; ++j) v += wv[j][e] * xr[r + j][e];
                o[e] = v; }
            *(LAS u32x4*)(T + (8 * rg + r) * TP + cc * 16) = pack8(o); }
    }
    LDS_WAIT();
    bf16x8 af[4][2];
#pragma unroll
    for (int mt = 0; mt < 4; ++mt)
#pragma unroll
        for (int ks = 0; ks < 2; ++ks) af[mt][ks] = frag_row(T, TP, 16 * mt, 32 * ks, lane);
    const bf16_t* wr_t = wsb(F, WS_LRUW) + (size_t)((layer * 2 + 0) * 8 + h) * 4096; const bf16_t* wi_t = wsb(F, WS_LRUW) + (size_t)((layer * 2 + 1) * 8 + h) * 4096;
#pragma unroll 1
    for (int nt = 0; nt < 4; ++nt) {
        bf16x8 br[2], bi[2];
#pragma unroll
        for (int ks = 0; ks < 2; ++ks) { const int o = (16 * nt + c) * 64 + 32 * ks + 8 * q; br[ks] = *(const bf16x8*)(wr_t + o); bi[ks] = *(const bf16x8*)(wi_t + o); }
        f32x4 ar[4], ai[4];
#pragma unroll
        for (int mt = 0; mt < 4; ++mt) { ar[mt] = (f32x4){0.f, 0.f, 0.f, 0.f}; ai[mt] = ar[mt];
#pragma unroll
            for (int ks = 0; ks < 2; ++ks) { ar[mt] = MFMA16(af[mt][ks], br[ks], ar[mt]); ai[mt] = MFMA16(af[mt][ks], bi[ks], ai[mt]); } }
        const int col = 64 * h + 16 * nt + c;
        const float b_r = F.in[I_LBR][layer * 512 + col], b_i = F.in[I_LBI][layer * 512 + col], c8 = -8.f * softplus_f(-F.in[I_LAM][layer * 512 + col]);
        float hc = 0.f, pc = 1.f;
        if (PASS_C) hc = chunk >= 256 ? F.in[I_SLH][(size_t)(layer * 8 + (chunk - 256)) * 512 + col] : wsf(F, WS_LRUS)[(size_t)(2 * NCH + chunk) * 512 + col];
#pragma unroll
        for (int mt = 0; mt < 4; ++mt) {
            float a[4], uu[4];
#pragma unroll
            for (int r = 0; r < 4; ++r) { const int t = 16 * mt + 4 * q + r; const float rg_ = sigm(ar[mt][r] + b_r), ig = sigm(ai[mt][r] + b_i), la = c8 * rg_;
                a[r] = __expf(la); uu[r] = sqrtf(fmaxf(-expm1f(2.f * la), 0.f)) * ig * ld_bf16(T, TP, t, 16 * nt + c); }
            const float P = (a[0] * a[1]) * (a[2] * a[3]); const float Hl = ((uu[0] * a[1] + uu[1]) * a[2] + uu[2]) * a[3] + uu[3];
            float hrun = hc, my_in = 0.f;
#pragma unroll
            for (int qq = 0; qq < 4; ++qq) { const float Pq = __shfl(P, c + 16 * qq), Hq = __shfl(Hl, c + 16 * qq); if (qq == q) my_in = hrun; hrun = Pq * hrun + Hq; pc *= Pq; }
            hc = hrun;
            if (PASS_C) { float hh = my_in;
#pragma unroll
                for (int r = 0; r < 4; ++r) { hh = a[r] * hh + uu[r]; st_bf16(T, TP, 16 * mt + 4 * q + r, 16 * nt + c, hh); } }
        }
        if (!PASS_C) { if (q == 0) { wsf(F, WS_LRUS)[(size_t)chunk * 512 + col] = pc; wsf(F, WS_LRUS)[(size_t)(NCH + chunk) * 512 + col] = hc; } }
        else if (chunk_last(chunk) && q == 0) st_out(F, O_PLH, O_SLH, layer, chunk_seq(chunk), 512)[col] = hc;
    }
    if (PASS_C) {
        LDS_WAIT();
        const int cc = lane & 7, rg = lane >> 3;
#pragma unroll
        for (int i = 0; i < 8; ++i) { const int t = rg + 8 * i; u32x4* gp = (u32x4*)(proj + (size_t)(row0 + t) * DINP + PC_AG + 64 * h + 8 * cc);
            float hv[8], gv[8]; unpack8(*(const LAS u32x4*)(T + t * TP + cc * 16), hv); unpack8(*gp, gv);
#pragma unroll
            for (int e = 0; e < 8; ++e) hv[e] *= gelu_t(gv[e]);
            *gp = pack8(hv); }
        if (chunk_last(chunk)) { float* so = st_out(F, O_PLC, O_SLC, layer, chunk_seq(chunk), 3 * 512);
#pragma unroll
            for (int i = 0; i < 3; ++i) so[i * 512 + 64 * h + lane] = bf2f(proj[(size_t)(row0 + 61 + i) * DINP + PC_AX + 64 * h + lane]); }
    }
    LDS_WAIT();
}

DI void phase_mixer_a(const Ctx& F, int layer) {
    for (int it = blockIdx.x; it < 1034; it += F.G) {
        if (it < 256) la_pass_a<false>(F, layer, it >> 2, it & 3);
        else if (it < 768) la_pass_a<true>(F, layer, (it - 256) >> 3, (it - 256) & 7);
        else if (it < 1024) lru_chunk<false>(F, layer, it - 768);
        else { const int seq = it - 1024, lastrow = seq < 2 ? 8192 * (seq + 1) - 1 : MP + 64 * (seq - 1) - 1;
            float* so = st_out(F, O_PSC, O_SSC, layer, seq, 3 * 1024); const bf16_t* proj = wsb(F, WS_R);
            for (int e = F.tid; e < 3 * 1024; e += 512) so[e] = bf2f(proj[(size_t)(lastrow - 2 + (e >> 10)) * DINP + PC_XBC + (e & 1023)]); }
        __syncthreads();
    }
}
DI void phase_mixer_b(const Ctx& F, int layer) {
    float* ds = wsf(F, WS_DS); const float* dec = wsf(F, WS_DEC);
    for (int e = blockIdx.x * 512 + F.tid; e < 2 * 12 * 8192; e += F.G * 512) {
        const int idx = e & 8191, hh = (e >> 13) % 12, b = e / (12 * 8192);
        const int ln = idx & 63, r = (idx >> 6) & 3, Tt = idx >> 8; const int a = 16 * (Tt >> 3) + 4 * (ln >> 4) + r;
        float v[32];
#pragma unroll
        for (int p = 0; p < 32; ++p) v[p] = ds[((size_t)(32 * b + p) * 12 + hh) * 8192 + idx];
        float S = 0.f;
#pragma unroll
        for (int p = 0; p < 32; ++p) { const int panel = 32 * b + p; const float dc = hh < 4 ? dec[(panel * 4 + hh) * 64 + a] : dec[64 * 4 * 64 + panel * 8 + (hh - 4)];
            ds[((size_t)panel * 12 + hh) * 8192 + idx] = S; S = dc * S + v[p]; }
    }
    {
        const int gw = blockIdx.x * NWAVES + F.wave; float* ls = wsf(F, WS_LRUS);
        if (gw < 1024) { const int b = gw >> 9, ch = gw & 511, l = F.lane; const int c0 = 128 * b + 2 * l;
            const float A0 = ls[(size_t)c0 * 512 + ch], H0 = ls[(size_t)(NCH + c0) * 512 + ch], A1 = ls[(size_t)(c0 + 1) * 512 + ch], H1 = ls[(size_t)(NCH + c0 + 1) * 512 + ch];
            float A = A1 * A0, H = A1 * H0 + H1;
#pragma unroll
            for (int o = 1; o < 64; o <<= 1) { const float Ap = __shfl_up(A, o), Hp = __shfl_up(H, o); if (l >= o) { H = A * Hp + H; A = A * Ap; } }
            float E = __shfl_up(H, 1); if (l == 0) E = 0.f;
            ls[(size_t)(2 * NCH + c0) * 512 + ch] = E; ls[(size_t)(2 * NCH + c0 + 1) * 512 + ch] = A0 * E + H0; }
    }
}
#ifndef MIX_MASK
#define MIX_MASK 7
#endif
DI void phase_mixer_c(const Ctx& F, int layer) {
    for (int it = blockIdx.x; it < 1128; it += F.G) {
        if (it < 512) { if (MIX_MASK & 1) la_pass_c<true>(F, layer, 4 * (it >> 3), 4, it & 7); }
        else if (it < 768) { if (MIX_MASK & 2) la_pass_c<false>(F, layer, 4 * ((it - 512) >> 2), 4, (it - 512) & 3); }
        else if (it < 1032) { if (MIX_MASK & 4) lru_chunk<true>(F, layer, it - 768); }
        else if (it < 1096) { if (MIX_MASK & 1) la_pass_c<true>(F, layer, 256 + ((it - 1032) >> 3), 1, (it - 1032) & 7); }
        else { if (MIX_MASK & 2) la_pass_c<false>(F, layer, 256 + ((it - 1096) >> 2), 1, (it - 1096) & 3); }
        __syncthreads();
    }
}
DI void phase_ssd_norm(const Ctx& F, int layer) {
    const int gw = F.vcu * NWAVES + F.wave, NGW = F.G * NWAVES; bf16_t* proj = wsb(F, WS_R); const float* pss = wsf(F, WS_PSS);
    float gn[8]; { const float* gp = F.in[I_SNORM] + layer * 512 + 8 * F.lane; const f32x4 a = *(const f32x4*)gp, b = *(const f32x4*)(gp + 4); gn[0] = a.x; gn[1] = a.y; gn[2] = a.z; gn[3] = a.w; gn[4] = b.x; gn[5] = b.y; gn[6] = b.z; gn[7] = b.w; }
    for (int m = gw; m < M; m += NGW) {
        const f32x4* p = (const f32x4*)(pss + (size_t)m * 16); const f32x4 a = p[0], b = p[1], c = p[2], d = p[3];
        const float s = ((a.x + a.y) + (a.z + a.w)) + ((b.x + b.y) + (b.z + b.w)) + ((c.x + c.y) + (c.z + c.w)) + ((d.x + d.y) + (d.z + d.w));
        const float rstd = rsqrtf(s * (1.f / 512.f) + EPS);
        u32x4* yp = (u32x4*)(proj + (size_t)m * DINP + PC_CZ + 8 * F.lane); float v[8]; unpack8(*yp, v);
#pragma unroll
        for (int e = 0; e < 8; ++e) v[e] *= rstd * gn[e];
        *yp = pack8(v);
    }
}
DI void phase_final(const Ctx& F) {
    const int gw = F.vcu * NWAVES + F.wave, NGW = F.G * NWAVES; const float* rss = wsf(F, WS_RSSN) + (size_t)XB_PAD * 16; const float* gf = F.in[I_NFIN];
    for (int m = gw; m < M; m += NGW) { const float rs = row_rstd(rss, m); f32x4* x4 = (f32x4*)(F.out + (size_t)m * D) + F.lane;
#pragma unroll
        for (int j = 0; j < 4; ++j) { const f32x4 g = *((const f32x4*)gf + F.lane + 64 * j); x4[64 * j] = x4[64 * j] * rs * g; } }
}

constexpr int PH_PER_LAYER = 9, N_PHASES = 1 + DEPTH * PH_PER_LAYER + 1;
__global__ void __launch_bounds__(NWAVES * 64, 2) mk_fwd(Args args) {
    extern __shared__ __attribute__((aligned(16))) unsigned char lds_raw[];
    Ctx F; F.lds = (LAS unsigned char*)lds_raw; F.in = args.in; F.out = args.out; F.ws = args.ws;
    F.wave = __builtin_amdgcn_readfirstlane((int)threadIdx.x >> 6); F.lane = 0; F.tid = 0;
#define T0() (F.wave == 0 && lane_id() == 0)
    F.G = gridDim.x; { const int bx = blockIdx.x; F.vcu = (F.G % 8 == 0) ? (bx % 8) * (F.G / 8) + bx / 8 : bx; }
    volatile LAS unsigned* MISC = (volatile LAS unsigned*)(F.lds + MISC_OFF);
    if (F.wave == 0) MISC[lane_id()] = 0u;
    __syncthreads();
    XcdBarrier bar; bar.bar = (unsigned*)(args.ws + WS_CTL); bar.x = 0; bar.st = nullptr;
    if (args.use_bar) bar = xcd_barrier_post((unsigned*)(args.ws + WS_CTL), MISC + 8, T0());
    const int lo = args.ph_lo, hi = args.ph_hi;
#ifndef PH_MASK
#define PH_MASK 0xFFFFu
#endif
#define IN(k) (lo <= (k) && (k) < hi)
#define ON(b) ((PH_MASK >> (b)) & 1u)
#define SEAM(k) do { if (IN(k) && IN((k) + 1)) xcd_barrier(bar, T0()); } while (0)
#define GP float* X = C.out; bf16_t* XB = wsb(C, WS_XB) + (size_t)XB_PAD * D; float* RSS = wsf(C, WS_RSS) + (size_t)XB_PAD * 16; bf16_t* XBN = wsb(C, WS_XBN); float* RSSN = wsf(C, WS_RSSN) + (size_t)XB_PAD * 16; \
    (void)X; (void)XB; (void)RSS; (void)XBN; (void)RSSN
#define PHC Ctx C = F; C.lane = lane_id(); C.tid = C.wave * 64 + C.lane; OPAQUE_CTX(C); { size_t zz_ = 0; asm volatile("" : "+s"(zz_)); C.ws = F.ws + zz_; C.out = (float*)((char*)F.out + zz_); }
    if (IN(0) && ON(0)) { PHC; convert_set(C, 0, 1 | 2 | 4 | 8 | 16 | 32 | 64 | 128); p0_rows(C); }
    SEAM(0);
    for (int layer = 0; layer < DEPTH; ++layer) {
        const int pb = 1 + layer * PH_PER_LAYER;
        if (IN(pb + 0) && ON(1)) { PHC; GP;
            pg8::Gemm g{XBN, wsb(C, WS_WIN), D, D, D}; pg8::StaticOrder S; S.init(M / 256, DINP / 256, C.G, (int)blockIdx.x, 0);
            EpiProj E{wsb(C, WS_R), RSSN}; pg8::gemm_phase<EpiProj, pg8::StaticOrder>(C.lds, g, S, E, C.wave);
        }
        SEAM(pb + 0);
        if (IN(pb + 1) && ON(2)) { PHC; phase_mixer_a(C, layer); }
        SEAM(pb + 1);
        if (IN(pb + 2) && ON(3)) { PHC; phase_mixer_b(C, layer);
            if (layer + 1 < DEPTH) convert_set(C, layer + 1, 1);
            if (layer >= 1) convert_set(C, layer, 2 | 4 | 8 | 16 | 32 | 64); }
        SEAM(pb + 2);
        if (IN(pb + 3) && ON(4)) { PHC; phase_mixer_c(C, layer); }
        SEAM(pb + 3);
        if (IN(pb + 4) && ON(5)) { PHC; phase_ssd_norm(C, layer); }
        SEAM(pb + 4);
        if (IN(pb + 5) && ON(6)) { PHC; GP;
            pg8::Gemm g{wsb(C, WS_R) + PC_Y, wsb(C, WS_WOUT), DINP, DMIX, DMIX}; pg8::StaticOrder S; S.init(M / 256, D / 256, C.G, (int)blockIdx.x, 0);
            EpiRes E{layer == 0 ? C.in[I_XP] : X, layer == 0 ? C.in[I_XS] : X + (size_t)MP * D, X, XB, RSS};
            pg8::gemm_phase<EpiRes, pg8::StaticOrder>(C.lds, g, S, E, C.wave);
        }
        SEAM(pb + 5);
        if (IN(pb + 6) && ON(7)) { PHC; GP;
            pg8::Gemm g{XB, wsb(C, WS_WGU), D, D, D}; pg8::StaticOrder S; S.init(67, 2 * DFF / 256, C.G, (int)blockIdx.x, 1);
            EpiFfn E{wsb(C, WS_R), RSS, C.in[I_FCW] + (size_t)layer * 3 * DFF, C.in[I_FCB] + layer * DFF, C.in[I_SFC] + (size_t)layer * 8 * 2 * DFF,
                     C.out + O_PFC + (size_t)layer * 2 * 2 * DFF, C.out + O_SFC + (size_t)layer * 8 * 2 * DFF};
            pg8::gemm_phase<EpiFfn, pg8::StaticOrder>(C.lds, g, S, E, C.wave);
        }
        SEAM(pb + 6);
        if (IN(pb + 7) && ON(8)) { PHC; GP;
            pg8::Gemm g{wsb(C, WS_R), wsb(C, WS_WD), DFF, DFF, DFF}; pg8::StaticOrder S; S.init(M / 256, D / 256, C.G, (int)blockIdx.x, 0);
            EpiRes E{X, X + (size_t)MP * D, X, XB, RSS}; pg8::gemm_phase<EpiRes, pg8::StaticOrder>(C.lds, g, S, E, C.wave);
        }
        SEAM(pb + 7);
        if (IN(pb + 8) && ON(9)) {
            { PHC; pg8::Gemm g{wsb(C, WS_PB), wsb(C, WS_WPP), DPLE, DPLE, DPLE}; pg8::StaticOrder S; S.init(M / 256, D / 256, C.G, (int)blockIdx.x, 0);
              EpiPP E{wsb(C, WS_PPO)}; pg8::gemm_phase<EpiPP, pg8::StaticOrder>(C.lds, g, S, E, C.wave); }
            VM_WAIT(); __syncthreads();
            { PHC; GP; pg8::Gemm g{XB, wsb(C, WS_WPG), D, D, D}; pg8::StaticOrder S; S.init(M / 256, D / 256, C.G, (int)blockIdx.x, 0);
              EpiPle E{X, X, XBN, RSS, RSSN, wsb(C, WS_PPO)}; pg8::gemm_phase<EpiPle, pg8::StaticOrder>(C.lds, g, S, E, C.wave); }
        }
        SEAM(pb + 8);
    }
    if (IN(N_PHASES - 1) && ON(10)) { PHC; phase_final(C); }
#undef IN
#undef ON
#undef SEAM
}

extern "C" void kernel_launch(void* const* d_in, const int* in_sizes, int n_in, void* d_out, int out_size, void* d_ws, size_t ws_size, hipStream_t stream) {
    static int grid = 0;
    if (grid == 0) {
        if (n_in != N_IN || (size_t)out_size != O_END || ws_size < WS_END) { fprintf(stderr, "kernel_launch: unexpected shapes: n_in %d out %d ws %zu (need %d, %zu, %zu)\n", n_in, out_size, ws_size, (int)N_IN, (size_t)O_END, (size_t)WS_END); grid = -1; return; }
        int dev = 0, cus = 0, per_cu = 0;
        if (hipGetDevice(&dev) != hipSuccess || hipDeviceGetAttribute(&cus, hipDeviceAttributeMultiprocessorCount, dev) != hipSuccess) { grid = -1; return; }
        if (hipFuncSetAttribute((const void*)mk_fwd, hipFuncAttributeMaxDynamicSharedMemorySize, LDS_BYTES) != hipSuccess) { fprintf(stderr, "kernel_launch: hipFuncSetAttribute failed\n"); grid = -1; return; }
        if (hipOccupancyMaxActiveBlocksPerMultiprocessor(&per_cu, (const void*)mk_fwd, NWAVES * 64, LDS_BYTES) != hipSuccess || per_cu < 1) { fprintf(stderr, "kernel_launch: occupancy query says %d\n", per_cu); per_cu = 1; }
        (void)hipGetLastError();
        grid = cus;
    }
    if (grid < 0) return;
    (void)hipMemsetAsync((char*)d_ws + WS_CTL, 0, CTL_ZERO_BYTES, stream);
    Args a{};
    for (int i = 0; i < N_IN; ++i) a.in[i] = (const float*)d_in[i];
    a.out = (float*)d_out; a.ws = (unsigned char*)d_ws;
#if MK_PER_PHASE
    for (int p = 0; p < N_PHASES; ++p) { a.ph_lo = p; a.ph_hi = p + 1; a.use_bar = 0; hipLaunchKernelGGL(mk_fwd, dim3(grid), dim3(NWAVES * 64), LDS_BYTES, stream, a); }
#else
    a.ph_lo = 0; a.ph_hi = N_PHASES; a.use_bar = 1;
    void* kargs[] = {&a};
    hipError_t e = hipLaunchCooperativeKernel((const void*)mk_fwd, dim3(grid), dim3(NWAVES * 64), kargs, LDS_BYTES, stream);
    if (e != hipSuccess) fprintf(stderr, "kernel_launch: cooperative launch failed: %s\n", hipGetErrorString(e));
#endif
}
```

```cpp
#include <hip/hip_runtime.h>
#include <cstdio>
#include <cstdint>

#define DI __device__ __forceinline__
#define LAS __attribute__((address_space(3)))
typedef unsigned short bf16_t;
typedef short bf16x8 __attribute__((ext_vector_type(8)));
typedef short s16x4 __attribute__((ext_vector_type(4)));
typedef float f32x4 __attribute__((ext_vector_type(4)));
typedef float f32x2 __attribute__((ext_vector_type(2)));
typedef unsigned u32x4 __attribute__((ext_vector_type(4)));
typedef unsigned u32x2 __attribute__((ext_vector_type(2)));

#ifndef MK_PER_PHASE
#define MK_PER_PHASE 0
#endif

constexpr int DEPTH = 2, D = 1024, MP = 16384, MS = 512, M = MP + MS;
constexpr int DIN = 4120, DINP = 4352, DFF = 3072, DMIX = 1536, DPLE = 256;
constexpr int NCH = M / 64;
constexpr float EPS = 1e-6f;
constexpr int PC_AX = 0, PC_BQ = 512, PC_BK = 768, PC_BV = 1024, PC_BLR = 1536, PC_XBC = 1552, PC_DT = 2576, PC_PAD = 2584, PC_Y = 2816, PC_AG = 2816, PC_BG = 3328, PC_CZ = 3840;

enum { I_XP = 0, I_XS, I_SLC, I_SLH, I_SG, I_SSC, I_SS, I_SFC, I_PP, I_PS, I_NMIX, I_WIN, I_LCW, I_LCB, I_LWR, I_LBR, I_LWI, I_LBI, I_LAM, I_GWLR, I_GBLR, I_GNORM,
       I_SCW, I_SCB, I_SDTB, I_SALOG, I_SD, I_SNORM, I_WOUT, I_NFFN, I_WG, I_WU, I_FCW, I_FCB, I_WD, I_NPLE, I_PWG, I_PWP, I_NFIN, N_IN };
constexpr size_t O_Y = 0;
constexpr size_t O_PLC = (size_t)M * D;
constexpr size_t O_PLH = O_PLC + 2 * 2 * 3 * 512;
constexpr size_t O_PG = O_PLH + 2 * 2 * 512;
constexpr size_t O_PSC = O_PG + 2 * 2 * 4 * 64 * 128;
constexpr size_t O_PS = O_PSC + 2 * 2 * 3 * 1024;
constexpr size_t O_PFC = O_PS + 2 * 2 * 8 * 64 * 128;
constexpr size_t O_SLC = O_PFC + 2 * 2 * 2 * 3072;
constexpr size_t O_SLH = O_SLC + 2 * 8 * 3 * 512;
constexpr size_t O_SG = O_SLH + 2 * 8 * 512;
constexpr size_t O_SSC = O_SG + 2 * 8 * 4 * 64 * 128;
constexpr size_t O_SS = O_SSC + 2 * 8 * 3 * 1024;
constexpr size_t O_SFC = O_SS + 2 * 8 * 8 * 64 * 128;
constexpr size_t O_END = O_SFC + 2 * 8 * 2 * 3072;

constexpr size_t MiB = 1u << 20;
constexpr size_t al4k(size_t x) { return (x + 4095) & ~(size_t)4095; }
constexpr int XB_PAD = 256;
constexpr int XB_ROWS = XB_PAD + M + 128;
constexpr size_t WS_CTL = 0, CTL_ZERO_BYTES = 64 * 1024;
constexpr size_t WS_WIN = al4k(WS_CTL + CTL_ZERO_BYTES);
constexpr size_t WS_WOUT = al4k(WS_WIN + (size_t)DINP * D * 2);
constexpr size_t WS_WGU = al4k(WS_WOUT + (size_t)D * DMIX * 2);
constexpr size_t WS_WD = al4k(WS_WGU + (size_t)2 * DFF * D * 2);
constexpr size_t WS_WPG = al4k(WS_WD + (size_t)D * DFF * 2);
constexpr size_t WS_WPP = al4k(WS_WPG + (size_t)D * D * 2);
constexpr size_t WS_LRUW = al4k(WS_WPP + (size_t)D * DPLE * 2);
constexpr size_t WS_RSS = al4k(WS_LRUW + (size_t)DEPTH * 2 * 8 * 4096 * 2);
constexpr size_t WS_RSSN = al4k(WS_RSS + (size_t)XB_ROWS * 64);
constexpr size_t WS_PSS = al4k(WS_RSSN + (size_t)XB_ROWS * 64);
constexpr size_t WS_LRUS = al4k(WS_PSS + (size_t)M * 64);
constexpr size_t WS_DEC = al4k(WS_LRUS + (size_t)3 * NCH * 512 * 4);
constexpr size_t WS_PB = al4k(WS_DEC + (size_t)(64 * 4 * 64 + 64 * 8) * 4);
constexpr size_t WS_XB = al4k(WS_PB + (size_t)M * DPLE * 2);
constexpr size_t WS_DS = al4k(WS_XB + (size_t)XB_ROWS * D * 2);
constexpr size_t WS_XBN = WS_DS;
constexpr size_t WS_R = al4k(WS_DS + (size_t)M * D * 2);
constexpr size_t WS_PPO = WS_R + 100 * MiB;
constexpr size_t WS_END = WS_R + (size_t)M * DINP * 2;
static_assert(WS_END <= 256 * MiB, "workspace");
static_assert((size_t)64 * 12 * 8192 * 4 <= (size_t)M * D * 2, "DS fits the XBN slot");
static_assert((size_t)M * DFF * 2 <= 100 * MiB && WS_PPO + (size_t)M * D * 2 <= WS_END, "overlay");

DI float bf2f(bf16_t b) { return __uint_as_float(((unsigned)b) << 16); }
DI unsigned f2bf(float f) { unsigned u = __float_as_uint(f); return (u + 0x7fffu + ((u >> 16) & 1u)) >> 16; }
DI unsigned pk2(float lo, float hi) { return f2bf(lo) | (f2bf(hi) << 16); }
DI float sigm(float x) { return __builtin_amdgcn_rcpf(1.f + __expf(-x)); }
DI float silu_f(float x) { return x * __builtin_amdgcn_rcpf(1.f + __expf(-x)); }
DI float gelu_t(float x) { const float u = 1.5957691216f * (x + 0.044715f * x * x * x); return x * __builtin_amdgcn_rcpf(1.f + __expf(-u)); }
DI float softplus_f(float x) { return fmaxf(x, 0.f) + log1pf(__expf(-fabsf(x))); }
DI float logsig_f(float x) { return fminf(x, 0.f) - log1pf(__expf(-fabsf(x))); }
template <int CTRL> DI float dpp_ror(float x) { return __builtin_bit_cast(float, __builtin_amdgcn_update_dpp(0, __builtin_bit_cast(int, x), CTRL, 0xf, 0xf, false)); }
DI void unpack8(const u32x4 v, float (&o)[8]) {
#pragma unroll
    for (int i = 0; i < 4; ++i) { o[2 * i] = __uint_as_float(v[i] << 16); o[2 * i + 1] = __uint_as_float(v[i] & 0xffff0000u); }
}
DI u32x4 pack8(const float (&o)[8]) { u32x4 r; r.x = pk2(o[0], o[1]); r.y = pk2(o[2], o[3]); r.z = pk2(o[4], o[5]); r.w = pk2(o[6], o[7]); return r; }
DI int lane_id() { int l; asm volatile("v_mbcnt_lo_u32_b32 %0, -1, 0\n\tv_mbcnt_hi_u32_b32 %0, -1, %0" : "=v"(l)); return l; }
#define LDS_WAIT() asm volatile("s_waitcnt lgkmcnt(0)" ::: "memory")
#define VM_WAIT() asm volatile("s_waitcnt vmcnt(0)" ::: "memory")

namespace pg8 {
constexpr int BM = 256, BK = 64, HALF = 128, HTB = HALF * BK * 2, STAGE_BYTES = 8 * HTB, NXCD = 8, WGM = 8;
__host__ __device__ __forceinline__ int lds_byte(int r, int c) { const int st = (r >> 4) * 2 + (c >> 5), rr = r & 15, cc = c & 31, ob = rr * 64 + cc * 2; return st * 1024 + (ob ^ (((ob >> 9) & 1) << 5)); }
__host__ __device__ __forceinline__ void stage_rc(int b, int& R, int& C) { const int st = b / 1024, sb = b % 1024, swz = sb ^ (((sb >> 9) & 1) << 5); R = (st >> 1) * 16 + swz / 64; C = (st & 1) * 32 + (swz % 64) / 2; }
__host__ __device__ __forceinline__ int perm32(int rho) { const int n = rho >> 4, i = rho & 15; return 8 * (i >> 2) + 4 * n + (i & 3); }

struct Unit { int pm, pn, arow; };
struct Gemm { const bf16_t* A; const bf16_t* Bt; int lda, ldb, K; };

struct StaticOrder {
    int nM, nN, nwg, G, c, shifted;
    __device__ void init(int nM_, int nN_, int G_, int c_, int shifted_) { nM = nM_; nN = nN_; nwg = nM * nN; G = G_; c = c_; shifted = shifted_; }
    __device__ bool next(int i, Unit& u) const {
        const long L = (long)i * G + c; if (L >= nwg) return false;
        int wgid = (int)L; { const int q = nwg / NXCD, r = nwg % NXCD, xcd = wgid % NXCD, off = wgid / NXCD; wgid = (xcd < r ? xcd * (q + 1) : r * (q + 1) + (xcd - r) * q) + off; }
        const int nig = WGM * nN, gid = wgid / nig, fm = gid * WGM, gsz = (nM - fm) < WGM ? (nM - fm) : WGM;
        u.pm = fm + ((wgid % nig) % gsz); u.pn = (wgid % nig) / gsz; u.arow = shifted ? 254 * u.pm - 2 : 256 * u.pm; return true;
    }
};
DI unsigned cvt_pk_bf16(float lo, float hi) { unsigned r; asm volatile("v_cvt_pk_bf16_f32 %0, %1, %2" : "=v"(r) : "v"(lo), "v"(hi)); return r; }

template <class Epi, class Sched>
DI void gemm_phase(LAS unsigned char* lds, const Gemm g, const Sched& S, const Epi& E, int wid) {
    const int lane = lane_id(), tid = wid * 64 + lane, wr = wid >> 2, wc = wid & 3, fr = lane & 15, fq = lane >> 4;
    const int K = g.K, nt = K / BK;
    unsigned voffA[2], voffB[2];
#pragma unroll
    for (int i = 0; i < 2; ++i) { int R, C; stage_rc(tid * 16 + i * 8192, R, C); const int Rb = Epi::PERM ? ((R & ~31) + perm32(R & 31)) : R;
        voffA[i] = (unsigned)(R * g.lda + C) * 2u; voffB[i] = (unsigned)(Rb * g.ldb + C) * 2u; }
    const size_t kstep = (size_t)(BK * 2);
    const size_t hstepA = (size_t)HALF * g.lda * 2, hstepB = (size_t)HALF * g.ldb * 2;
    const unsigned ldsw = (unsigned)wid * 1024u;
    const int aoff = lds_byte(wr * 64 + fr, fq * 8), boff = lds_byte(wc * 32 + fr, fq * 8);
#define PG8_SA(b, h) (((b) * 2 + (h)) * HTB)
#define PG8_SB(b, h) ((4 + (b) * 2 + (h)) * HTB)
#define PG8_STAGE(bufoff, gbase, voff) do { _Pragma("unroll") for (int _i = 0; _i < 2; ++_i) \
        __builtin_amdgcn_global_load_lds((const unsigned*)((const char*)(gbase) + (voff)[_i]), (LAS unsigned*)(lds + (bufoff) + ldsw + _i * 8192), 16, 0, 0); } while (0)
#define PG8_LDA(dst, b, h) do { _Pragma("unroll") for (int m = 0; m < 4; ++m) _Pragma("unroll") for (int k = 0; k < 2; ++k) dst[m][k] = *(const LAS bf16x8*)(lds + PG8_SA(b, h) + aoff + m * 2048 + k * 1024); } while (0)
#define PG8_LDB(dst, b, h) do { _Pragma("unroll") for (int n = 0; n < 2; ++n) _Pragma("unroll") for (int k = 0; k < 2; ++k) dst[n][k] = *(const LAS bf16x8*)(lds + PG8_SB(b, h) + boff + n * 2048 + k * 1024); } while (0)
#define PG8_MMA(ai, bj, At, Bt) do { __builtin_amdgcn_s_setprio(1); _Pragma("unroll") for (int m = 0; m < 4; ++m) _Pragma("unroll") for (int n = 0; n < 2; ++n) _Pragma("unroll") for (int k = 0; k < 2; ++k) \
        acc[ai][bj][m][n] = __builtin_amdgcn_mfma_f32_16x16x32_bf16(Bt[n][k], At[m][k], acc[ai][bj][m][n], 0, 0, 0); __builtin_amdgcn_s_setprio(0); } while (0)
#define PG8_WAIT_V(n) asm volatile("s_waitcnt vmcnt(" #n ")" ::: "memory")
#define PG8_WAIT_L(n) asm volatile("s_waitcnt lgkmcnt(" #n ")" ::: "memory")
#define PG8_BAR __builtin_amdgcn_s_barrier()
#define PG8_SCHED __builtin_amdgcn_sched_barrier(0)
    Unit cur, nxt; int ui = 0;
    if (!S.next(0, cur)) return;
    f32x4 acc[2][2][4][2];
#pragma unroll
    for (int a = 0; a < 2; ++a)
#pragma unroll
        for (int b = 0; b < 2; ++b)
#pragma unroll
            for (int m = 0; m < 4; ++m)
#pragma unroll
                for (int n = 0; n < 2; ++n) acc[a][b][m][n] = (f32x4){0.f, 0.f, 0.f, 0.f};
    bf16x8 At[4][2], B0[2][2], B1[2][2];
    const char* cA = (const char*)g.A + (long)cur.arow * g.lda * 2; const char* cB = (const char*)g.Bt + (size_t)cur.pn * 256 * g.ldb * 2;
    PG8_STAGE(PG8_SB(0, 0), cB, voffB); PG8_STAGE(PG8_SB(0, 1), cB + hstepB, voffB); PG8_STAGE(PG8_SA(0, 0), cA, voffA); PG8_STAGE(PG8_SA(0, 1), cA + hstepA, voffA);
    if (wr == 1) PG8_BAR;
    PG8_WAIT_V(2); PG8_BAR;
    PG8_STAGE(PG8_SB(1, 0), cB + kstep, voffB); PG8_STAGE(PG8_SA(1, 0), cA + kstep, voffA); PG8_STAGE(PG8_SB(1, 1), cB + hstepB + kstep, voffB);
    PG8_WAIT_V(6); PG8_BAR;
    for (;;) {
        const bool has_next = S.next(ui + 1, nxt);
        const char* nA = has_next ? (const char*)g.A + (long)nxt.arow * g.lda * 2 : cA; const char* nB = has_next ? (const char*)g.Bt + (size_t)nxt.pn * 256 * g.ldb * 2 : cB;
#pragma unroll 1
        for (int t = 0; t < nt; t += 2) {
            const bool last = (t == nt - 2);
            const char* a1 = cA + (size_t)(t + 1) * kstep;
            const char* a2 = last ? nA : cA + (size_t)(t + 2) * kstep; const char* b2 = last ? nB : cB + (size_t)(t + 2) * kstep;
            const char* a3 = a2 + kstep; const char* b3 = b2 + kstep;
            PG8_LDB(B0, 0, 0); PG8_LDB(B1, 0, 1); PG8_SCHED; PG8_LDA(At, 0, 0); PG8_STAGE(PG8_SA(1, 1), a1 + hstepA, voffA);
            PG8_WAIT_V(8); PG8_WAIT_L(0); PG8_BAR; PG8_MMA(0, 0, At, B0); PG8_MMA(0, 1, At, B1); PG8_BAR; PG8_SCHED;
            PG8_LDA(At, 0, 1); PG8_STAGE(PG8_SB(0, 0), b2, voffB); PG8_STAGE(PG8_SB(0, 1), b2 + hstepB, voffB); PG8_STAGE(PG8_SA(0, 0), a2, voffA);
            PG8_WAIT_V(8); PG8_WAIT_L(0); PG8_BAR; PG8_MMA(1, 0, At, B0); PG8_MMA(1, 1, At, B1); PG8_BAR; PG8_SCHED;
            PG8_LDB(B0, 1, 0); PG8_LDB(B1, 1, 1); PG8_SCHED; PG8_LDA(At, 1, 0); PG8_STAGE(PG8_SA(0, 1), a2 + hstepA, voffA);
            PG8_WAIT_V(8); PG8_WAIT_L(0); PG8_BAR; PG8_MMA(0, 0, At, B0); PG8_MMA(0, 1, At, B1); PG8_BAR; PG8_SCHED;
            PG8_LDA(At, 1, 1); PG8_STAGE(PG8_SB(1, 0), b3, voffB); PG8_STAGE(PG8_SB(1, 1), b3 + hstepB, voffB); PG8_STAGE(PG8_SA(1, 0), a3, voffA);
            PG8_WAIT_V(8); PG8_WAIT_L(0); PG8_BAR; PG8_MMA(1, 0, At, B0); PG8_MMA(1, 1, At, B1); PG8_BAR; PG8_SCHED;
        }
        if (wr == 0) PG8_BAR;
        { const int l2 = lane_id(); E(acc, cur, wr, wc, l2 & 15, l2 >> 4, lds); }
        if (!has_next) break;
#pragma unroll
        for (int a = 0; a < 2; ++a)
#pragma unroll
            for (int b = 0; b < 2; ++b)
#pragma unroll
                for (int m = 0; m < 4; ++m)
#pragma unroll
                    for (int n = 0; n < 2; ++n) acc[a][b][m][n] = (f32x4){0.f, 0.f, 0.f, 0.f};
        cur = nxt; cA = nA; cB = nB; ++ui;
        if (wr == 1) PG8_BAR;
    }
    PG8_WAIT_V(0);
    PG8_BAR;
#undef PG8_SA
#undef PG8_SB
#undef PG8_STAGE
#undef PG8_LDA
#undef PG8_LDB
#undef PG8_MMA
#undef PG8_WAIT_V
#undef PG8_WAIT_L
#undef PG8_BAR
#undef PG8_SCHED
}
}

#define XB_TMO      128
#define XB_XCNT(j)  (256  + 64 * (j))
#define XB_XSUB(j)  (1280 + 64 * (j))
#define XB_XGEN(j)  (2304 + 64 * (j))
#define XB_TOP      3328
#define XB_TOPGEN   3392
#define XCD_BAR_WORDS 3456
#define XB_SPIN_CAP (1u << 18)
DI unsigned xb_ld(unsigned* p)              { return __hip_atomic_load(p, __ATOMIC_RELAXED, __HIP_MEMORY_SCOPE_AGENT); }
DI unsigned xb_add(unsigned* p, unsigned v) { return __hip_atomic_fetch_add(p, v, __ATOMIC_RELAXED, __HIP_MEMORY_SCOPE_AGENT); }
DI unsigned xb_xcc_id() { return (unsigned)__builtin_amdgcn_s_getreg((3 << 11) | 20) & 0xFu; }
#define XB_SPIN(cond, bar) do { unsigned _sp = 0; while (cond) { __builtin_amdgcn_s_sleep(1); \
    if ((++_sp & 255u) == 0u) { if (xb_ld(&(bar)[XB_TMO])) break; if (_sp > XB_SPIN_CAP) { atomicAdd(&(bar)[XB_TMO], 1u); break; } } } } while (0)
struct XcdBarrier { unsigned* bar; unsigned x; volatile LAS unsigned* st; };
DI XcdBarrier xcd_barrier_post(unsigned* bar, volatile LAS unsigned* st, bool t0) {
    XcdBarrier b; b.bar = bar; b.x = xb_xcc_id(); b.st = st;
    if (t0) (void)xb_add(&bar[XB_XCNT(b.x)], 1u);
    return b;
}
DI void xcd_barrier_complete(unsigned* bar, unsigned x, unsigned& nloc, unsigned& nx) {
    const unsigned G = gridDim.x * gridDim.y * gridDim.z;
    unsigned sum, cnt, mine, sp = 0u;
    for (;;) {
        sum = 0u; cnt = 0u; mine = 0u;
#pragma unroll
        for (unsigned j = 0; j < 16; ++j) { const unsigned c = xb_ld(&bar[XB_XCNT(j)]); sum += c; cnt += (c > 0u) ? 1u : 0u; mine = (j == x) ? c : mine; }
        if (sum == G) break;
        __builtin_amdgcn_s_sleep(1);
        if ((++sp & 255u) == 0u) { if (xb_ld(&bar[XB_TMO])) break; if (sp > XB_SPIN_CAP) { atomicAdd(&bar[XB_TMO], 1u); break; } }
    }
    nloc = mine > 0u ? mine : 1u; nx = cnt > 0u ? cnt : 1u;
}
DI void xcd_barrier(const XcdBarrier& b, bool t0) {
    asm volatile("s_waitcnt vmcnt(0)" ::: "memory");
    __syncthreads();
    if (t0) {
        unsigned* bar = b.bar;
        __builtin_amdgcn_s_waitcnt(0);
        unsigned nloc = b.st[0], nx = b.st[1];
        if (nloc == 0u) { xcd_barrier_complete(bar, b.x, nloc, nx); b.st[0] = nloc; b.st[1] = nx; }
        const unsigned old = xb_add(&bar[XB_XSUB(b.x)], 1u);
        const unsigned gen = old / nloc;
        if (old + 1u == (gen + 1u) * nloc) {
            __builtin_amdgcn_fence(__ATOMIC_RELEASE, "agent");
            asm volatile("s_waitcnt vmcnt(0)" ::: "memory");
            const unsigned og = xb_add(&bar[XB_TOP], 1u);
            const unsigned tg = og / nx;
            if (og + 1u == (tg + 1u) * nx) xb_add(&bar[XB_TOPGEN], 1u);
            else XB_SPIN(xb_ld(&bar[XB_TOPGEN]) == tg, bar);
            __builtin_amdgcn_fence(__ATOMIC_ACQUIRE, "agent");
            xb_add(&bar[XB_XGEN(b.x)], 1u);
            asm volatile("s_waitcnt vmcnt(0)" ::: "memory");
        } else {
            XB_SPIN(xb_ld(&bar[XB_XGEN(b.x)]) == gen, bar);
            __builtin_amdgcn_fence(__ATOMIC_ACQUIRE, "agent");
            asm volatile("s_waitcnt vmcnt(0)" ::: "memory");
        }
    }
    __syncthreads();
}

constexpr int NWAVES = 8;
constexpr int RING_BYTES = 131072;
constexpr int XG_OFF = RING_BYTES;
constexpr int MISC_OFF = RING_BYTES + 8192;
constexpr int LDS_BYTES = 147456;

struct Args { const float* in[N_IN]; float* out; unsigned char* ws; int ph_lo, ph_hi, use_bar, pad; };

struct Ctx {
    LAS unsigned char* lds;
    const float* const* in; float* out; unsigned char* ws;
    int tid, lane, wave, G, vcu;
};
#define OPAQUE_CTX(C) do { asm volatile("" : "+v"((C).tid), "+v"((C).lane)); asm volatile("" : "+s"((C).wave), "+s"((C).vcu)); } while (0)
DI bf16_t* wsb(const Ctx& F, size_t off) { return (bf16_t*)(F.ws + off); }
DI float* wsf(const Ctx& F, size_t off) { return (float*)(F.ws + off); }

DI bool chunk_first(int c) { return c == 0 || c == 128 || c >= 256; }
DI bool chunk_last(int c) { return c == 127 || c >= 255; }
DI int chunk_seq(int c) { return c < 128 ? 0 : (c < 256 ? 1 : c - 254); }
DI float* st_out(const Ctx& F, size_t offp, size_t offs, int layer, int seq, int per) {
    return seq < 2 ? F.out + offp + (size_t)(layer * 2 + seq) * per : F.out + offs + (size_t)(layer * 8 + (seq - 2)) * per;
}

DI float wave_sum(float v) {
#pragma unroll
    for (int o = 1; o < 64; o <<= 1) v += __shfl_xor(v, o);
    return v;
}
DI int win_dst(int n) {
    if (n < 512) return PC_AX + n;
    if (n < 1024) return PC_AG + (n - 512);
    if (n < 1280) return PC_BQ + (n - 1024);
    if (n < 1536) return PC_BK + (n - 1280);
    if (n < 2048) return PC_BV + (n - 1536);
    if (n < 2560) return PC_BG + (n - 2048);
    if (n < 2576) return PC_BLR + (n - 2560);
    if (n < 3088) return PC_CZ + (n - 2576);
    if (n < 4112) return PC_XBC + (n - 3088);
    return PC_DT + (n - 4112);
}
DI int map_row(int mode, int n) {
    if (mode == 1) return win_dst(n);
    if (mode == 2) return 256 * (n >> 7) + (n & 127);
    if (mode == 3) return 256 * (n >> 7) + 128 + (n & 127);
    return n;
}
DI void tr_item(const float* W, int K, int N, bf16_t* WT, int mode, const float* g, LAS float* scr, int item, int lane) {
    const int nblk = (N + 31) / 32, kb = item / nblk, nb = item % nblk, k0 = 64 * kb, n0 = 32 * nb;
#pragma unroll 8
    for (int i = 0; i < 32; ++i) { const int kk = 2 * i + (lane >> 5), n = n0 + (lane & 31); float v = n < N ? W[(size_t)(k0 + kk) * N + n] : 0.f; if (g) v *= g[k0 + kk]; scr[kk * 33 + (lane & 31)] = v; }
    LDS_WAIT();
    const int c = lane & 7;
#pragma unroll
    for (int j = 0; j < 4; ++j) { const int n = (lane >> 3) + 8 * j; const LAS float* s = scr + (8 * c) * 33 + n;
        u32x4 o; o.x = pk2(s[0 * 33], s[1 * 33]); o.y = pk2(s[2 * 33], s[3 * 33]); o.z = pk2(s[4 * 33], s[5 * 33]); o.w = pk2(s[6 * 33], s[7 * 33]);
        if (n0 + n < N) *(u32x4*)(WT + (size_t)map_row(mode, n0 + n) * K + k0 + 8 * c) = o; }
    LDS_WAIT();
}
DI void convert_set(const Ctx& F, int layer, int which, int wgi, int nwg) {
    LAS float* scr = (LAS float*)(F.lds + F.wave * 16384);
    const int gw = wgi * NWAVES + F.wave, NGW = nwg * NWAVES;
    int base = 0;
#define CONV_MAT(cond, Wp, K_, N_, WTp, mode_, gp) if (cond) { const int ni = ((K_) / 64) * (((N_) + 31) / 32); \
        for (int it = gw - base; it < ni; it += NGW) { if (it >= 0) tr_item(Wp, K_, N_, WTp, mode_, gp, scr, it, F.lane); } base = (base + ni) % NGW; }
    CONV_MAT(which & 1, F.in[I_WIN] + (size_t)layer * D * DIN, D, DIN, wsb(F, WS_WIN), 1, F.in[I_NMIX] + layer * D)
    CONV_MAT(which & 2, F.in[I_WOUT] + (size_t)layer * DMIX * D, DMIX, D, wsb(F, WS_WOUT), 0, (const float*)nullptr)
    CONV_MAT(which & 4, F.in[I_WG] + (size_t)layer * D * DFF, D, DFF, wsb(F, WS_WGU), 2, F.in[I_NFFN] + layer * D)
    CONV_MAT(which & 4, F.in[I_WU] + (size_t)layer * D * DFF, D, DFF, wsb(F, WS_WGU), 3, F.in[I_NFFN] + layer * D)
    CONV_MAT(which & 8, F.in[I_WD] + (size_t)layer * DFF * D, DFF, D, wsb(F, WS_WD), 0, (const float*)nullptr)
    CONV_MAT(which & 16, F.in[I_PWG] + (size_t)layer * D * D, D, D, wsb(F, WS_WPG), 0, F.in[I_NPLE] + layer * D)
    CONV_MAT(which & 32, F.in[I_PWP] + (size_t)layer * DPLE * D, DPLE, D, wsb(F, WS_WPP), 0, (const float*)nullptr)
    if (which & 128) {
        for (int it = gw; it < DEPTH * 2 * 8 * 2; it += NGW) { const int mat = it >> 1, sub = it & 1, l = mat >> 4, ri = (mat >> 3) & 1, h = mat & 7;
            tr_item(F.in[ri ? I_LWI : I_LWR] + (size_t)(l * 8 + h) * 4096, 64, 64, wsb(F, WS_LRUW) + (size_t)((l * 2 + ri) * 8 + h) * 4096, 0, nullptr, scr, sub, F.lane); }
    }
#undef CONV_MAT
    if (which & 1) {
        u32x4* z = (u32x4*)(wsb(F, WS_WIN) + (size_t)PC_PAD * D); const int n16 = (PC_Y - PC_PAD) * D * 2 / 16;
        u32x4 zv = (u32x4){0u, 0u, 0u, 0u}; asm volatile("" : "+v"(zv));
        for (int i = wgi * 512 + F.tid; i < n16; i += nwg * 512) z[i] = zv;
    }
    if (which & 64) {
        const float* pp = F.in[I_PP] + (size_t)layer * MP * DPLE; const float* ps = F.in[I_PS] + (size_t)layer * MS * DPLE; bf16_t* pb = wsb(F, WS_PB);
        const int n8 = M * DPLE / 8;
        for (int i = wgi * 512 + F.tid; i < n8; i += nwg * 512) { const size_t e = (size_t)i * 8; const float* src = e < (size_t)MP * DPLE ? pp + e : ps + (e - (size_t)MP * DPLE);
            const f32x4 a = *(const f32x4*)src, b = *(const f32x4*)(src + 4); u32x4 o; o.x = pk2(a.x, a.y); o.y = pk2(a.z, a.w); o.z = pk2(b.x, b.y); o.w = pk2(b.z, b.w); *(u32x4*)(pb + e) = o; }
    }
}
DI void p0_rows(const Ctx& F) {
    const int gw = F.vcu * NWAVES + F.wave, NGW = F.G * NWAVES;
    bf16_t* xb = wsb(F, WS_XBN); float* rss = wsf(F, WS_RSSN) + (size_t)XB_PAD * 16;
    for (int m = gw; m < M; m += NGW) {
        const float* xr = m < MP ? F.in[I_XP] + (size_t)m * D : F.in[I_XS] + (size_t)(m - MP) * D;
        const f32x4* x4 = (const f32x4*)xr + F.lane; f32x4 v[4]; float s = 0.f;
#pragma unroll
        for (int j = 0; j < 4; ++j) { v[j] = x4[64 * j]; s += (v[j].x * v[j].x + v[j].y * v[j].y) + (v[j].z * v[j].z + v[j].w * v[j].w); }
        s = wave_sum(s);
        u32x2* o8 = (u32x2*)(xb + (size_t)m * D) + F.lane;
#pragma unroll
        for (int j = 0; j < 4; ++j) { u32x2 w; w.x = pk2(v[j].x, v[j].y); w.y = pk2(v[j].z, v[j].w); o8[64 * j] = w; }
        if (F.lane < 16) rss[(size_t)m * 16 + F.lane] = F.lane == 0 ? s : 0.f;
    }
}

DI float row_rstd(const float* rss, long row) {
    const f32x4* p = (const f32x4*)(rss + row * 16); const f32x4 a = p[0], b = p[1], c = p[2], d = p[3];
    const float s = ((a.x + a.y) + (a.z + a.w)) + ((b.x + b.y) + (b.z + b.w)) + ((c.x + c.y) + (c.z + c.w)) + ((d.x + d.y) + (d.z + d.w));
    return rsqrtf(fmaxf(s, 0.f) * (1.f / D) + EPS);
}
DI float row_rstd_q(const float* rss, long row, int fq) {
    const f32x4 a = *(const f32x4*)(rss + row * 16 + 4 * fq); float s = (a.x + a.y) + (a.z + a.w);
    s += __shfl_xor(s, 16); s += __shfl_xor(s, 32);
    return rsqrtf(fmaxf(s, 0.f) * (1.f / D) + EPS);
}
struct EpiProj {
    static constexpr bool PERM = true;
    bf16_t* O; const float* rss;
    DI void operator()(const f32x4 (&acc)[2][2][4][2], const pg8::Unit& u, int wr, int wc, int fr_, int fq_, LAS unsigned char*) const {
        int fr = fr_, fq = fq_; asm volatile("" : "+v"(fr), "+v"(fq));
        const int row0 = u.arow + wr * 64 + fr, col0 = u.pn * 256 + wc * 32 + 8 * fq;
#pragma unroll
        for (int ai = 0; ai < 2; ++ai)
#pragma unroll
            for (int m = 0; m < 4; ++m) { const int r = row0 + ai * 128 + m * 16; const float rs = row_rstd_q(rss, r, fq); bf16_t* rowp = O + (size_t)r * DINP + col0;
#pragma unroll
                for (int bj = 0; bj < 2; ++bj) { const f32x4 v0 = acc[ai][bj][m][0] * rs, v1 = acc[ai][bj][m][1] * rs;
                    u32x4 w; w.x = pg8::cvt_pk_bf16(v0[0], v0[1]); w.y = pg8::cvt_pk_bf16(v0[2], v0[3]); w.z = pg8::cvt_pk_bf16(v1[0], v1[1]); w.w = pg8::cvt_pk_bf16(v1[2], v1[3]);
                    *(u32x4*)(rowp + bj * 128) = w; } }
    }
};
struct EpiRes {
    static constexpr bool PERM = false;
    const float* xin_p; const float* xin_s; float* xout; bf16_t* xb; float* rss; bool dry;
    DI void operator()(const f32x4 (&acc)[2][2][4][2], const pg8::Unit& u, int wr, int wc, int fr_, int fq_, LAS unsigned char*) const {
        int fr = fr_, fq = fq_; asm volatile("" : "+v"(fr), "+v"(fq));
        const int row0 = u.arow + wr * 64 + fr, col0 = u.pn * 256 + wc * 32 + 4 * fq;
#pragma unroll
        for (int ai = 0; ai < 2; ++ai)
#pragma unroll
            for (int m = 0; m < 4; ++m) { const int r = row0 + ai * 128 + m * 16; const size_t off = (size_t)r * D + col0;
                const float* xi = r < MP ? xin_p + off : xin_s + (off - (size_t)MP * D);
                float ss = 0.f;
#pragma unroll
                for (int bj = 0; bj < 2; ++bj)
#pragma unroll
                    for (int n = 0; n < 2; ++n) { const int co = bj * 128 + n * 16;
                        const f32x4 xn = *(const f32x4*)(xi + co) + acc[ai][bj][m][n]; if (!dry) *(f32x4*)(xout + off + co) = xn;
                        u32x2 w; w.x = pg8::cvt_pk_bf16(xn[0], xn[1]); w.y = pg8::cvt_pk_bf16(xn[2], xn[3]); if (!dry) *(u32x2*)(xb + off + co) = w;
                        ss += (xn[0] * xn[0] + xn[1] * xn[1]) + (xn[2] * xn[2] + xn[3] * xn[3]); }
                ss += __shfl_xor(ss, 16); ss += __shfl_xor(ss, 32);
                if (fq == 0 && !dry) rss[(size_t)r * 16 + u.pn * 4 + wc] = ss;
                asm volatile("" ::: "memory"); }
    }
};
struct EpiPle {
    static constexpr bool PERM = false;
    const float* xin; float* xout; bf16_t* xb; const float* rss_in; float* rss_out; const bf16_t* pp; bool dry;
    DI void operator()(const f32x4 (&acc)[2][2][4][2], const pg8::Unit& u, int wr, int wc, int fr_, int fq_, LAS unsigned char*) const {
        int fr = fr_, fq = fq_; asm volatile("" : "+v"(fr), "+v"(fq));
        const int row0 = u.arow + wr * 64 + fr, col0 = u.pn * 256 + wc * 32 + 4 * fq;
#pragma unroll
        for (int ai = 0; ai < 2; ++ai)
#pragma unroll
            for (int m = 0; m < 4; ++m) { const int r = row0 + ai * 128 + m * 16; const size_t off = (size_t)r * D + col0;
                const float rs = row_rstd_q(rss_in, r, fq); float ss = 0.f;
#pragma unroll
                for (int bj = 0; bj < 2; ++bj)
#pragma unroll
                    for (int n = 0; n < 2; ++n) { const int co = bj * 128 + n * 16; f32x4 f = acc[ai][bj][m][n];
                        const u32x2 pw = *(const u32x2*)(pp + off + co);
                        f[0] = sigm(f[0] * rs) * __uint_as_float(pw.x << 16); f[1] = sigm(f[1] * rs) * __uint_as_float(pw.x & 0xffff0000u);
                        f[2] = sigm(f[2] * rs) * __uint_as_float(pw.y << 16); f[3] = sigm(f[3] * rs) * __uint_as_float(pw.y & 0xffff0000u);
                        const f32x4 xn = *(const f32x4*)(xin + off + co) + f; if (!dry) *(f32x4*)(xout + off + co) = xn;
                        u32x2 w; w.x = pg8::cvt_pk_bf16(xn[0], xn[1]); w.y = pg8::cvt_pk_bf16(xn[2], xn[3]); if (!dry) *(u32x2*)(xb + off + co) = w;
                        ss += (xn[0] * xn[0] + xn[1] * xn[1]) + (xn[2] * xn[2] + xn[3] * xn[3]); }
                ss += __shfl_xor(ss, 16); ss += __shfl_xor(ss, 32);
                if (fq == 0 && !dry) rss_out[(size_t)r * 16 + u.pn * 4 + wc] = ss;
                asm volatile("" ::: "memory"); }
    }
};
struct EpiPP {
    static constexpr bool PERM = false;
    bf16_t* pp;
    DI void operator()(const f32x4 (&acc)[2][2][4][2], const pg8::Unit& u, int wr, int wc, int fr_, int fq_, LAS unsigned char*) const {
        int fr = fr_, fq = fq_; asm volatile("" : "+v"(fr), "+v"(fq));
        const int row0 = u.arow + wr * 64 + fr, col0 = u.pn * 256 + wc * 32 + 4 * fq;
#pragma unroll
        for (int ai = 0; ai < 2; ++ai)
#pragma unroll
            for (int m = 0; m < 4; ++m) { const size_t off = (size_t)(row0 + ai * 128 + m * 16) * D + col0;
#pragma unroll
                for (int bj = 0; bj < 2; ++bj)
#pragma unroll
                    for (int n = 0; n < 2; ++n) { const f32x4 f = acc[ai][bj][m][n]; u32x2 w; w.x = pg8::cvt_pk_bf16(f[0], f[1]); w.y = pg8::cvt_pk_bf16(f[2], f[3]); *(u32x2*)(pp + off + bj * 128 + n * 16) = w; } }
    }
};
struct EpiFfn {
    static constexpr bool PERM = true;
    bf16_t* H; const float* rss; const float* cw; const float* cb; const float* st_in; float* st_p; float* st_s;
    DI void operator()(f32x4 (&acc)[2][2][4][2], const pg8::Unit& u, int wr, int wc, int fr_, int fq_, LAS unsigned char* lds) const {
        int fr = fr_, fq = fq_; asm volatile("" : "+v"(fr), "+v"(fq));
        const int lane = fr + 16 * fq;
        const int gc0 = u.pn * 128 + wc * 32 + 8 * fq;
        LAS float* XG = (LAS float*)(lds + XG_OFF);
#pragma unroll
        for (int ai = 0; ai < 2; ++ai)
#pragma unroll
            for (int m = 0; m < 4; ++m) { const float rs = row_rstd_q(rss, (long)u.arow + ai * 128 + wr * 64 + m * 16 + fr, fq);
#pragma unroll
                for (int bj = 0; bj < 2; ++bj)
#pragma unroll
                    for (int n = 0; n < 2; ++n) acc[ai][bj][m][n] *= rs;
                asm volatile("" : "+v"(acc[ai][0][m][0]), "+v"(acc[ai][0][m][1]), "+v"(acc[ai][1][m][0]), "+v"(acc[ai][1][m][1]) :: "memory"); }
        if (fr >= 14) {
#pragma unroll
            for (int ai = 0; ai < 2; ++ai)
#pragma unroll
                for (int n = 0; n < 2; ++n) *(LAS f32x4*)(XG + ((2 * ai + wr) * 2 + (fr - 14)) * 128 + wc * 32 + 8 * fq + 4 * n) = acc[ai][0][3][n];
        }
        LDS_WAIT(); __builtin_amdgcn_s_barrier(); asm volatile("" ::: "memory");
#pragma unroll
        for (int n = 0; n < 2; ++n) {
            const int gc = gc0 + 4 * n;
            const f32x4 w0 = *(const f32x4*)(cw + gc), w1 = *(const f32x4*)(cw + DFF + gc), w2 = *(const f32x4*)(cw + 2 * DFF + gc), bb = *(const f32x4*)(cb + gc);
#pragma unroll
            for (int ai = 0; ai < 2; ++ai) {
                f32x4 pr1, pr2;
                const int pb = 2 * ai + wr - 1;
                if (pb >= 0) { pr1 = *(const LAS f32x4*)(XG + (pb * 2 + 1) * 128 + wc * 32 + 8 * fq + 4 * n);
                               pr2 = *(const LAS f32x4*)(XG + (pb * 2 + (fr & 1)) * 128 + wc * 32 + 8 * fq + 4 * n); }
                else { pr1 = (f32x4){0.f, 0.f, 0.f, 0.f}; pr2 = pr1; }
#pragma unroll
                for (int m = 0; m < 4; ++m) {
                    const int j = ai * 128 + wr * 64 + m * 16 + fr; const long r = (long)u.arow + j;
                    int t, seq; if (r < MP) { t = (int)r & 8191; seq = (int)(r >> 13); } else { t = (int)(r - MP) & 63; seq = 2 + (int)((r - MP) >> 6); }
                    const int T = r < MP ? 8192 : 64;
                    const bool valid = j >= 2 && r < M;
                    const f32x4 cur = acc[ai][0][m][n]; f32x4 r1, r2;
#pragma unroll
                    for (int i = 0; i < 4; ++i) { r1[i] = dpp_ror<0x121>(cur[i]); r2[i] = dpp_ror<0x122>(cur[i]); }
                    f32x4 p1 = fr >= 1 ? r1 : pr1, p2 = fr >= 2 ? r2 : pr2;
                    pr1 = r1; pr2 = r2;
                    if (valid && t < 2) {
                        const f32x4 z = (f32x4){0.f, 0.f, 0.f, 0.f}; f32x4 s0 = z, s1 = z;
                        if (seq >= 2) { const float* sp = st_in + (size_t)(seq - 2) * 2 * DFF + gc; s0 = *(const f32x4*)sp; s1 = *(const f32x4*)(sp + DFF); }
                        if (t == 0) { p1 = s1; p2 = s0; } else { p2 = s1; }
                    }
                    const f32x4 gpre = bb + w0 * p2 + w1 * p1 + w2 * cur; const f32x4 up = acc[ai][1][m][n];
                    const float h0 = gelu_t(gpre[0]) * up[0], h1 = gelu_t(gpre[1]) * up[1], h2 = gelu_t(gpre[2]) * up[2], h3 = gelu_t(gpre[3]) * up[3];
                    if (valid) { u32x2 hw; hw.x = pg8::cvt_pk_bf16(h0, h1); hw.y = pg8::cvt_pk_bf16(h2, h3); *(u32x2*)(H + (size_t)r * DFF + gc) = hw;
                        if (t >= T - 2) { float* so = (seq < 2 ? st_p + (size_t)seq * 2 * DFF : st_s + (size_t)(seq - 2) * 2 * DFF) + (size_t)(t - (T - 2)) * DFF + gc; *(f32x4*)so = cur; } }
                    asm volatile("" ::: "memory");
                }
            }
        }
    }
};

DI bf16x8 frag_row(const LAS unsigned char* img, int pitch, int row0, int k0, int lane) {
    return *(const LAS bf16x8*)(img + (row0 + (lane & 15)) * pitch + (k0 + 8 * (lane >> 4)) * 2);
}
DI bf16x8 frag_tr(const LAS unsigned char* img, int pitch, int k0, int n0, int lane) {
    const int g = lane >> 4, i = lane & 15, q = i >> 2, p = i & 3;
    const LAS unsigned char* a = img + (k0 + 8 * g + q) * pitch + (n0 + 4 * p) * 2;
    const s16x4 lo = __builtin_amdgcn_ds_read_tr16_b64_v4i16((LAS s16x4*)a);
    const s16x4 hi = __builtin_amdgcn_ds_read_tr16_b64_v4i16((LAS s16x4*)(a + 4 * pitch));
    return __builtin_shufflevector(lo, hi, 0, 1, 2, 3, 4, 5, 6, 7);
}
#define MFMA16(a, b, c) __builtin_amdgcn_mfma_f32_16x16x32_bf16((a), (b), (c), 0, 0, 0)
DI void st_bf16(LAS unsigned char* img, int pitch, int row, int col, float v) { *(LAS bf16_t*)(img + row * pitch + col * 2) = (bf16_t)f2bf(v); }
DI float ld_bf16(const LAS unsigned char* img, int pitch, int row, int col) { return bf2f(*(const LAS bf16_t*)(img + row * pitch + col * 2)); }

template <bool SSD> struct LAT {
    static constexpr int DA = SSD ? 128 : 64, DB = SSD ? 64 : 128;
    static constexpr int PA = (DA + 8) * 2, PV = (DB + 8) * 2, PPI = 144, PS = (DB + 8) * 2;
    static constexpr int O_QD = 0, O_KI = O_QD + 64 * PA, O_KE = O_KI + 64 * PA, O_VV = O_KE + 64 * PA, O_P = O_VV + 64 * PV, O_SB = O_P + 64 * PPI, O_TAB = O_SB + DA * PS;
    static constexpr int NT_O = DB / 32;
};
template <bool SSD> DI void la_mt_nt(int T, int& mt, int& nt) { if (SSD) { mt = T >> 2; nt = T & 3; } else { mt = T >> 3; nt = T & 7; } }

template <bool SSD> DI void la_state_update(LAS unsigned char* lds, f32x4 (&S)[4], int w, int lane) {
    typedef LAT<SSD> L; const LAS float* tab = (const LAS float*)(lds + L::O_TAB); const int q = lane >> 4;
#pragma unroll
    for (int x = 0; x < 4; ++x) { int mt, nt; la_mt_nt<SSD>(4 * w + x, mt, nt);
        if (SSD) { const float d = tab[256]; S[x] *= d; }
        else {
#pragma unroll
            for (int r = 0; r < 4; ++r) S[x][r] *= tab[1536 + 16 * mt + 4 * q + r]; }
#pragma unroll
        for (int ks = 0; ks < 2; ++ks) { const bf16x8 a = frag_tr(lds + L::O_KE, L::PA, 32 * ks, 16 * mt, lane); const bf16x8 b = frag_tr(lds + L::O_VV, L::PV, 32 * ks, 16 * nt, lane); S[x] = MFMA16(a, b, S[x]); }
    }
}
template <bool SSD> DI void la_write_sb(LAS unsigned char* lds, const f32x4 (&S)[4], int w, int lane) {
    typedef LAT<SSD> L; const int q = lane >> 4, c = lane & 15;
#pragma unroll
    for (int x = 0; x < 4; ++x) { int mt, nt; la_mt_nt<SSD>(4 * w + x, mt, nt);
#pragma unroll
        for (int r = 0; r < 4; ++r) st_bf16(lds + L::O_SB, L::PS, 16 * mt + 4 * q + r, 16 * nt + c, S[x][r]); }
}
template <bool SSD> DI void la_compute_p(LAS unsigned char* lds, int w, int lane) {
    typedef LAT<SSD> L; const LAS float* tab = (const LAS float*)(lds + L::O_TAB); const int q = lane >> 4, c = lane & 15, mt = w >> 1;
#pragma unroll
    for (int x = 0; x < 2; ++x) { const int nt = (w & 1) * 2 + x; f32x4 acc = {0.f, 0.f, 0.f, 0.f};
#pragma unroll
        for (int ks = 0; ks < L::DA / 32; ++ks) { const bf16x8 a = frag_row(lds + L::O_QD, L::PA, 16 * mt, 32 * ks, lane); const bf16x8 b = frag_row(lds + L::O_KI, L::PA, 16 * nt, 32 * ks, lane); acc = MFMA16(a, b, acc); }
        const int j = 16 * nt + c;
#pragma unroll
        for (int r = 0; r < 4; ++r) { const int i = 16 * mt + 4 * q + r; float v = acc[r];
            if (SSD) v *= __expf(tab[64 + i] - tab[64 + j]) * tab[j];
            v = (j > i) ? 0.f : v; st_bf16(lds + L::O_P, L::PPI, i, j, v); }
    }
}
template <bool SSD> DI void la_compute_out(LAS unsigned char* lds, f32x4 (&o1)[LAT<SSD>::NT_O], f32x4 (&o2)[LAT<SSD>::NT_O], int w, int lane) {
    typedef LAT<SSD> L; const int mt = w >> 1;
#pragma unroll
    for (int x = 0; x < L::NT_O; ++x) { const int nt = (w & 1) * L::NT_O + x; f32x4 a1 = {0.f, 0.f, 0.f, 0.f}, a2 = {0.f, 0.f, 0.f, 0.f};
#pragma unroll
        for (int ks = 0; ks < 2; ++ks) { const bf16x8 a = frag_row(lds + L::O_P, L::PPI, 16 * mt, 32 * ks, lane); const bf16x8 b = frag_tr(lds + L::O_VV, L::PV, 32 * ks, 16 * nt, lane); a1 = MFMA16(a, b, a1); }
#pragma unroll
        for (int ks = 0; ks < L::DA / 32; ++ks) { const bf16x8 a = frag_row(lds + L::O_QD, L::PA, 16 * mt, 32 * ks, lane); const bf16x8 b = frag_tr(lds + L::O_SB, L::PS, 32 * ks, 16 * nt, lane); a2 = MFMA16(a, b, a2); }
        o1[x] = a1; o2[x] = a2; }
}
DI void la_store_ds(float* ds, const f32x4 (&S)[4], int w, int lane) {
#pragma unroll
    for (int x = 0; x < 4; ++x)
#pragma unroll
        for (int r = 0; r < 4; ++r) ds[((4 * w + x) * 4 + r) * 64 + lane] = S[x][r];
}
DI void la_load_ds(const float* ds, f32x4 (&S)[4], int w, int lane) {
#pragma unroll
    for (int x = 0; x < 4; ++x)
#pragma unroll
        for (int r = 0; r < 4; ++r) S[x][r] = ds[((4 * w + x) * 4 + r) * 64 + lane];
}

struct GlaCoef { float wlr[16]; float blr; };
DI float gla_stage(const Ctx& F, int layer, int h, int chunk, const GlaCoef& cf) {
    typedef LAT<false> L; LAS unsigned char* lds = F.lds; LAS float* tab = (LAS float*)(lds + L::O_TAB);
    const bf16_t* proj = wsb(F, WS_R); const int row0 = 64 * chunk, d = F.lane, w = F.wave;
    if (F.tid < 128) { const int t = F.tid >> 1, half = F.tid & 1; const u32x4 v = *(const u32x4*)(proj + (size_t)(row0 + t) * DINP + PC_BLR + 8 * half); float f[8]; unpack8(v, f);
#pragma unroll
        for (int i = 0; i < 8; ++i) tab[t * 16 + 8 * half + i] = f[i]; }
#pragma unroll
    for (int i = 0; i < 2; ++i) { const int idx = F.tid + 512 * i, t = idx >> 4, c16 = idx & 15;
        *(LAS u32x4*)(lds + L::O_VV + t * L::PV + c16 * 16) = *(const u32x4*)(proj + (size_t)(row0 + t) * DINP + PC_BV + 128 * h + 8 * c16); }
    float qv[8], kv[8];
#pragma unroll
    for (int i = 0; i < 8; ++i) { const size_t ro = (size_t)(row0 + 8 * w + i) * DINP; qv[i] = bf2f(proj[ro + PC_BQ + 64 * h + d]); kv[i] = bf2f(proj[ro + PC_BK + 64 * h + d]); }
    __syncthreads();
    float pre[8]; float run = 0.f;
#pragma unroll
    for (int i = 0; i < 8; ++i) { const int t = 8 * w + i; float z = cf.blr;
#pragma unroll
        for (int r = 0; r < 16; ++r) z += tab[t * 16 + r] * cf.wlr[r];
        run += logsig_f(z) * (1.f / 16.f); pre[i] = run; }
    tab[1024 + w * 64 + d] = run;
    __syncthreads();
    float off = 0.f, last = 0.f;
#pragma unroll
    for (int ww = 0; ww < 8; ++ww) { const float tv = tab[1024 + ww * 64 + d]; last += tv; if (ww < w) off += tv; }
#pragma unroll
    for (int i = 0; i < 8; ++i) { const int t = 8 * w + i; const float cum = off + pre[i];
        st_bf16(lds + L::O_QD, L::PA, t, d, qv[i] * 0.125f * __expf(cum)); st_bf16(lds + L::O_KI, L::PA, t, d, kv[i] * __expf(-cum)); st_bf16(lds + L::O_KE, L::PA, t, d, kv[i] * __expf(last - cum)); }
    if (w == 0) tab[1536 + d] = __expf(last);
    __syncthreads();
    return last;
}
DI float ssd_stage(const Ctx& F, int layer, int h, int chunk) {
    typedef LAT<true> L; LAS unsigned char* lds = F.lds; LAS float* tab = (LAS float*)(lds + L::O_TAB);
    const bf16_t* proj = wsb(F, WS_R); const int row0 = 64 * chunk, g = h >> 2; const bool first = chunk_first(chunk);
    float xr[11][8]; int cidx = 0, rg = 0, ch = 0;
    if (F.tid < 320) { cidx = F.tid % 40; rg = F.tid / 40;
        ch = cidx < 8 ? 64 * h + 8 * cidx : (cidx < 24 ? 512 + 128 * g + 8 * (cidx - 8) : 768 + 128 * g + 8 * (cidx - 24));
#pragma unroll
        for (int i = 0; i < 11; ++i) { const int tt = 8 * rg - 3 + i;
            if (tt >= 0 || !first) { const u32x4 v = *(const u32x4*)(proj + (size_t)(row0 + tt) * DINP + PC_XBC + ch); unpack8(v, xr[i]); }
            else if (chunk >= 256) { const float* sp = F.in[I_SSC] + ((size_t)(layer * 8 + (chunk - 256)) * 3 + (tt + 3)) * 1024 + ch; const f32x4 a = *(const f32x4*)sp, b = *(const f32x4*)(sp + 4);
                xr[i][0] = a.x; xr[i][1] = a.y; xr[i][2] = a.z; xr[i][3] = a.w; xr[i][4] = b.x; xr[i][5] = b.y; xr[i][6] = b.z; xr[i][7] = b.w; }
            else {
#pragma unroll
                for (int e = 0; e < 8; ++e) xr[i][e] = 0.f; }
        }
    }
    float last = 0.f;
    if (F.wave == 0) { const int t = F.lane; const float dtraw = bf2f(proj[(size_t)(row0 + t) * DINP + PC_DT + h]);
        const float dt = softplus_f(dtraw + F.in[I_SDTB][layer * 8 + h]); float cum = -dt * __expf(F.in[I_SALOG][layer * 8 + h]);
#pragma unroll
        for (int o = 1; o < 64; o <<= 1) { const float v = __shfl_up(cum, o); if (t >= o) cum += v; }
        last = __shfl(cum, 63);
        tab[t] = dt; tab[64 + t] = cum; tab[128 + t] = __expf(last - cum) * dt; tab[192 + t] = __expf(cum); if (t == 0) tab[256] = __expf(last); }
    __syncthreads();
    if (F.tid < 320) {
        const float* cwp = F.in[I_SCW] + (size_t)layer * 4 * 1024 + ch; const float* cbp = F.in[I_SCB] + layer * 1024 + ch;
        float wv[4][8], bv[8];
#pragma unroll
        for (int j = 0; j < 4; ++j) { const f32x4 a = *(const f32x4*)(cwp + j * 1024), b = *(const f32x4*)(cwp + j * 1024 + 4); wv[j][0] = a.x; wv[j][1] = a.y; wv[j][2] = a.z; wv[j][3] = a.w; wv[j][4] = b.x; wv[j][5] = b.y; wv[j][6] = b.z; wv[j][7] = b.w; }
        { const f32x4 a = *(const f32x4*)cbp, b = *(const f32x4*)(cbp + 4); bv[0] = a.x; bv[1] = a.y; bv[2] = a.z; bv[3] = a.w; bv[4] = b.x; bv[5] = b.y; bv[6] = b.z; bv[7] = b.w; }
#pragma unroll
        for (int r = 0; r < 8; ++r) { const int t = 8 * rg + r; float o[8];
#pragma unroll
            for (int e = 0; e < 8; ++e) { float v = bv[e];
#pragma unroll
                for (int j = 0; j < 4; ++j) v += wv[j][e] * xr[r + j][e];
                o[e] = silu_f(v); }
            if (cidx < 8) *(LAS u32x4*)(lds + L::O_VV + t * L::PV + cidx * 16) = pack8(o);
            else if (cidx < 24) { *(LAS u32x4*)(lds + L::O_KI + t * L::PA + (cidx - 8) * 16) = pack8(o); const float we = tab[128 + t];
#pragma unroll
                for (int e = 0; e < 8; ++e) o[e] *= we;
                *(LAS u32x4*)(lds + L::O_KE + t * L::PA + (cidx - 8) * 16) = pack8(o); }
            else *(LAS u32x4*)(lds + L::O_QD + t * L::PA + (cidx - 24) * 16) = pack8(o);
        }
    }
    __syncthreads();
    return last;
}

template <bool SSD> DI void la_pass_a(const Ctx& F0, int layer, int panel, int h) {
    Ctx F = F0; OPAQUE_CTX(F);
    LAS unsigned char* lds = F.lds; const int w = F.wave, lane = F.lane;
    f32x4 S[4];
#pragma unroll
    for (int x = 0; x < 4; ++x) S[x] = (f32x4){0.f, 0.f, 0.f, 0.f};
    GlaCoef cf; if (!SSD) {
#pragma unroll
        for (int r = 0; r < 16; ++r) cf.wlr[r] = F.in[I_GWLR][(size_t)(layer * 16 + r) * 256 + 64 * h + lane];
        cf.blr = F.in[I_GBLR][layer * 256 + 64 * h + lane]; }
    float lastsum = 0.f;
    const Ctx Fp = F;
#pragma unroll 1
    for (int cc = 0; cc < 4; ++cc) { const int chunk = 4 * panel + cc;
        Ctx F = Fp; { unsigned z_ = 0; asm volatile("" : "+s"(z_)); F.lds = Fp.lds + z_; } LAS unsigned char* lds = F.lds;
        float last; if (SSD) last = ssd_stage(F, layer, h, chunk); else last = gla_stage(F, layer, h, chunk, cf);
        lastsum += last;
        la_state_update<SSD>(lds, S, w, lane);
        __syncthreads();
    }
    const int hh = SSD ? 4 + h : h;
    la_store_ds(wsf(F, WS_DS) + ((size_t)panel * 12 + hh) * 8192, S, w, lane);
    float* dec = wsf(F, WS_DEC);
    if (w == 0) { if (SSD) { if (lane == 0) dec[64 * 4 * 64 + panel * 8 + h] = __expf(lastsum); } else dec[(panel * 4 + h) * 64 + lane] = __expf(lastsum); }
}

template <bool SSD> DI void la_pass_c(const Ctx& F0, int layer, int c0, int nc, int h, bool dry) {
    Ctx F = F0; OPAQUE_CTX(F);
    typedef LAT<SSD> L; LAS unsigned char* lds = F.lds; LAS float* tab = (LAS float*)(lds + L::O_TAB); const int w = F.wave, lane = F.lane, q = lane >> 4, c = lane & 15, mt = w >> 1;
    bf16_t* proj = wsb(F, WS_R);
    f32x4 S[4];
    GlaCoef cf; if (!SSD) {
#pragma unroll
        for (int r = 0; r < 16; ++r) cf.wlr[r] = F.in[I_GWLR][(size_t)(layer * 16 + r) * 256 + 64 * h + lane];
        cf.blr = F.in[I_GBLR][layer * 256 + 64 * h + lane]; }
    const int hh = SSD ? 4 + h : h;
    const Ctx Fp = F;
#pragma unroll 1
    for (int cc = 0; cc < nc; ++cc) { const int chunk = c0 + cc, row0 = 64 * chunk;
        Ctx F = Fp; { unsigned z_ = 0; asm volatile("" : "+s"(z_)); F.lds = Fp.lds + z_; } LAS unsigned char* lds = F.lds; LAS float* tab = (LAS float*)(lds + L::O_TAB);
        if (cc == 0 || chunk_first(chunk)) {
            if (chunk < 256) la_load_ds(wsf(F, WS_DS) + ((size_t)(chunk >> 2) * 12 + hh) * 8192, S, w, lane);
            else { const int b = chunk - 256;
#pragma unroll
                for (int x = 0; x < 4; ++x) { int smt, snt; la_mt_nt<SSD>(4 * w + x, smt, snt);
                    if (SSD) { const float* sp = F.in[I_SS] + ((size_t)((layer * 8 + b) * 8 + h) * 64 + 16 * snt + c) * 128 + 16 * smt + 4 * q; S[x] = *(const f32x4*)sp; }
                    else { const float* sp = F.in[I_SG] + ((size_t)((layer * 8 + b) * 4 + h) * 64 + 16 * smt + 4 * q) * 128 + 16 * snt + c;
#pragma unroll
                        for (int r = 0; r < 4; ++r) S[x][r] = sp[r * 128]; } } }
            la_write_sb<SSD>(lds, S, w, lane);
        }
        if (SSD) ssd_stage(F, layer, h, chunk); else gla_stage(F, layer, h, chunk, cf);
        la_compute_p<SSD>(lds, w, lane);
        __syncthreads();
        f32x4 o1[L::NT_O], o2[L::NT_O];
        la_compute_out<SSD>(lds, o1, o2, w, lane);
        la_state_update<SSD>(lds, S, w, lane);
        if (SSD) {
            const float Dh = F.in[I_SD][layer * 8 + h]; float ss[4] = {0.f, 0.f, 0.f, 0.f};
#pragma unroll
            for (int x = 0; x < L::NT_O; ++x) { const int p = 16 * ((w & 1) * L::NT_O + x) + c;
#pragma unroll
                for (int r = 0; r < 4; ++r) { const int i = 16 * mt + 4 * q + r; const float y = o1[x][r] + tab[192 + i] * o2[x][r] + Dh * ld_bf16(lds + L::O_VV, L::PV, i, p);
                    bf16_t* zp = proj + (size_t)(row0 + i) * DINP + PC_CZ + 64 * h + p; const float yg = y * silu_f(bf2f(*zp)); if (!dry) *zp = (bf16_t)f2bf(yg); ss[r] += yg * yg; } }
#pragma unroll
            for (int r = 0; r < 4; ++r) { float s = ss[r]; s += __shfl_xor(s, 1); s += __shfl_xor(s, 2); s += __shfl_xor(s, 4); s += __shfl_xor(s, 8);
                if (c == 0 && !dry) wsf(F, WS_PSS)[(size_t)(row0 + 16 * mt + 4 * q + r) * 16 + 2 * h + (w & 1)] = s; }
            __syncthreads();
        } else {
            float ss[4] = {0.f, 0.f, 0.f, 0.f};
#pragma unroll
            for (int x = 0; x < L::NT_O; ++x) { o1[x] += o2[x];
#pragma unroll
                for (int r = 0; r < 4; ++r) ss[r] += o1[x][r] * o1[x][r]; }
#pragma unroll
            for (int r = 0; r < 4; ++r) { float s = ss[r]; s += __shfl_xor(s, 1); s += __shfl_xor(s, 2); s += __shfl_xor(s, 4); s += __shfl_xor(s, 8);
                if (c == 0) tab[1600 + (16 * mt + 4 * q + r) * 2 + (w & 1)] = s; }
            __syncthreads();
#pragma unroll
            for (int r = 0; r < 4; ++r) { const int i = 16 * mt + 4 * q + r; const float rstd = rsqrtf((tab[1600 + 2 * i] + tab[1600 + 2 * i + 1]) * (1.f / 128.f) + EPS);
#pragma unroll
                for (int x = 0; x < L::NT_O; ++x) { const int e = 16 * ((w & 1) * L::NT_O + x) + c; bf16_t* gp = proj + (size_t)(row0 + i) * DINP + PC_BG + 128 * h + e;
                    const float y = o1[x][r] * rstd * F.in[I_GNORM][layer * 512 + 128 * h + e] * silu_f(bf2f(*gp)); if (!dry) *gp = (bf16_t)f2bf(y); } }
        }
        if (chunk_last(chunk) && !dry) { const int seq = chunk_seq(chunk);
            if (SSD) { float* so = st_out(F, O_PS, O_SS, layer, seq, 8 * 64 * 128) + (size_t)h * 64 * 128;
#pragma unroll
                for (int x = 0; x < 4; ++x) { int smt, snt; la_mt_nt<SSD>(4 * w + x, smt, snt); *(f32x4*)(so + (size_t)(16 * snt + c) * 128 + 16 * smt + 4 * q) = S[x]; } }
            else { float* so = st_out(F, O_PG, O_SG, layer, seq, 4 * 64 * 128) + (size_t)h * 64 * 128;
#pragma unroll
                for (int x = 0; x < 4; ++x) { int smt, snt; la_mt_nt<SSD>(4 * w + x, smt, snt);
#pragma unroll
                    for (int r = 0; r < 4; ++r) so[(size_t)(16 * smt + 4 * q + r) * 128 + 16 * snt + c] = S[x][r]; } }
        } else if (cc + 1 < nc && !chunk_last(chunk)) la_write_sb<SSD>(lds, S, w, lane);
        __syncthreads();
    }
}

template <bool PASS_C> DI void lru_chunk(const Ctx& F0, int layer, int chunk, bool dry = false) {
    Ctx F = F0; OPAQUE_CTX(F);
    const int h = F.wave, lane = F.lane, q = lane >> 4, c = lane & 15, row0 = 64 * chunk; const bool first = chunk_first(chunk);
    LAS unsigned char* T = F.lds + h * 9216; constexpr int TP = 144;
    bf16_t* proj = wsb(F, WS_R);
    {
        const int cc = lane & 7, rg = lane >> 3, ch = 64 * h + 8 * cc; float xr[11][8];
#pragma unroll
        for (int i = 0; i < 11; ++i) { const int tt = 8 * rg - 3 + i;
            if (tt >= 0 || !first) { const u32x4 v = *(const u32x4*)(proj + (size_t)(row0 + tt) * DINP + PC_AX + ch); unpack8(v, xr[i]); }
            else if (chunk >= 256) { const float* sp = F.in[I_SLC] + ((size_t)(layer * 8 + (chunk - 256)) * 3 + (tt + 3)) * 512 + ch; const f32x4 a = *(const f32x4*)sp, b = *(const f32x4*)(sp + 4);
                xr[i][0] = a.x; xr[i][1] = a.y; xr[i][2] = a.z; xr[i][3] = a.w; xr[i][4] = b.x; xr[i][5] = b.y; xr[i][6] = b.z; xr[i][7] = b.w; }
            else {
#pragma unroll
                for (int e = 0; e < 8; ++e) xr[i][e] = 0.f; }
        }
        const float* cwp = F.in[I_LCW] + (size_t)layer * 4 * 512 + ch; const float* cbp = F.in[I_LCB] + layer * 512 + ch;
        float wv[4][8], bv[8];
#pragma unroll
        for (int j = 0; j < 4; ++j) { const f32x4 a = *(const f32x4*)(cwp + j * 512), b = *(const f32x4*)(cwp + j * 512 + 4); wv[j][0] = a.x; wv[j][1] = a.y; wv[j][2] = a.z; wv[j][3] = a.w; wv[j][4] = b.x; wv[j][5] = b.y; wv[j][6] = b.z; wv[j][7] = b.w; }
        { const f32x4 a = *(const f32x4*)cbp, b = *(const f32x4*)(cbp + 4); bv[0] = a.x; bv[1] = a.y; bv[2] = a.z; bv[3] = a.w; bv[4] = b.x; bv[5] = b.y; bv[6] = b.z; bv[7] = b.w; }
#pragma unroll
        for (int r = 0; r < 8; ++r) { float o[8];
#pragma unroll
            for (int e = 0; e < 8; ++e) { float v = bv[e];
#pragma unroll
                for (int j = 0; j < 4; ++j) v += wv[j][e] * xr[r + j][e];
                o[e] = v; }
            *(LAS u32x4*)(T + (8 * rg + r) * TP + cc * 16) = pack8(o); }
    }
    LDS_WAIT();
    bf16x8 af[4][2];
#pragma unroll
    for (int mt = 0; mt < 4; ++mt)
#pragma unroll
        for (int ks = 0; ks < 2; ++ks) af[mt][ks] = frag_row(T, TP, 16 * mt, 32 * ks, lane);
    const bf16_t* wr_t = wsb(F, WS_LRUW) + (size_t)((layer * 2 + 0) * 8 + h) * 4096; const bf16_t* wi_t = wsb(F, WS_LRUW) + (size_t)((layer * 2 + 1) * 8 + h) * 4096;
#pragma unroll 1
    for (int nt = 0; nt < 4; ++nt) {
        bf16x8 br[2], bi[2];
#pragma unroll
        for (int ks = 0; ks < 2; ++ks) { const int o = (16 * nt + c) * 64 + 32 * ks + 8 * q; br[ks] = *(const bf16x8*)(wr_t + o); bi[ks] = *(const bf16x8*)(wi_t + o); }
        f32x4 ar[4], ai[4];
#pragma unroll
        for (int mt = 0; mt < 4; ++mt) { ar[mt] = (f32x4){0.f, 0.f, 0.f, 0.f}; ai[mt] = ar[mt];
#pragma unroll
            for (int ks = 0; ks < 2; ++ks) { ar[mt] = MFMA16(af[mt][ks], br[ks], ar[mt]); ai[mt] = MFMA16(af[mt][ks], bi[ks], ai[mt]); } }
        const int col = 64 * h + 16 * nt + c;
        const float b_r = F.in[I_LBR][layer * 512 + col], b_i = F.in[I_LBI][layer * 512 + col], c8 = -8.f * softplus_f(-F.in[I_LAM][layer * 512 + col]);
        float hc = 0.f, pc = 1.f;
        if (PASS_C) hc = chunk >= 256 ? F.in[I_SLH][(size_t)(layer * 8 + (chunk - 256)) * 512 + col] : wsf(F, WS_LRUS)[(size_t)(2 * NCH + chunk) * 512 + col];
#pragma unroll
        for (int mt = 0; mt < 4; ++mt) {
            float a[4], uu[4];
#pragma unroll
            for (int r = 0; r < 4; ++r) { const int t = 16 * mt + 4 * q + r; const float rg_ = sigm(ar[mt][r] + b_r), ig = sigm(ai[mt][r] + b_i), la = c8 * rg_;
                a[r] = __expf(la); uu[r] = sqrtf(fmaxf(-expm1f(2.f * la), 0.f)) * ig * ld_bf16(T, TP, t, 16 * nt + c); }
            const float P = (a[0] * a[1]) * (a[2] * a[3]); const float Hl = ((uu[0] * a[1] + uu[1]) * a[2] + uu[2]) * a[3] + uu[3];
            float hrun = hc, my_in = 0.f;
#pragma unroll
            for (int qq = 0; qq < 4; ++qq) { const float Pq = __shfl(P, c + 16 * qq), Hq = __shfl(Hl, c + 16 * qq); if (qq == q) my_in = hrun; hrun = Pq * hrun + Hq; pc *= Pq; }
            hc = hrun;
            if (PASS_C) { float hh = my_in;
#pragma unroll
                for (int r = 0; r < 4; ++r) { hh = a[r] * hh + uu[r]; st_bf16(T, TP, 16 * mt + 4 * q + r, 16 * nt + c, hh); } }
        }
        if (!PASS_C) { if (q == 0) { wsf(F, WS_LRUS)[(size_t)chunk * 512 + col] = pc; wsf(F, WS_LRUS)[(size_t)(NCH + chunk) * 512 + col] = hc; } }
        else if (chunk_last(chunk) && q == 0 && !dry) st_out(F, O_PLH, O_SLH, layer, chunk_seq(chunk), 512)[col] = hc;
    }
    if (PASS_C) {
        LDS_WAIT();
        const int cc = lane & 7, rg = lane >> 3;
#pragma unroll
        for (int i = 0; i < 8; ++i) { const int t = rg + 8 * i; u32x4* gp = (u32x4*)(proj + (size_t)(row0 + t) * DINP + PC_AG + 64 * h + 8 * cc);
            float hv[8], gv[8]; unpack8(*(const LAS u32x4*)(T + t * TP + cc * 16), hv); unpack8(*gp, gv);
#pragma unroll
            for (int e = 0; e < 8; ++e) hv[e] *= gelu_t(gv[e]);
            if (!dry) *gp = pack8(hv); }
        if (chunk_last(chunk) && !dry) { float* so = st_out(F, O_PLC, O_SLC, layer, chunk_seq(chunk), 3 * 512);
#pragma unroll
            for (int i = 0; i < 3; ++i) so[i * 512 + 64 * h + lane] = bf2f(proj[(size_t)(row0 + 61 + i) * DINP + PC_AX + 64 * h + lane]); }
    }
    LDS_WAIT();
}

DI void phase_mixer_a(const Ctx& F, int layer) {
    for (int it = blockIdx.x; it < 1034; it += F.G) {
        if (it < 256) la_pass_a<false>(F, layer, it >> 2, it & 3);
        else if (it < 768) la_pass_a<true>(F, layer, (it - 256) >> 3, (it - 256) & 7);
        else if (it < 1024) lru_chunk<false>(F, layer, it - 768);
        else { const int seq = it - 1024, lastrow = seq < 2 ? 8192 * (seq + 1) - 1 : MP + 64 * (seq - 1) - 1;
            float* so = st_out(F, O_PSC, O_SSC, layer, seq, 3 * 1024); const bf16_t* proj = wsb(F, WS_R);
            for (int e = F.tid; e < 3 * 1024; e += 512) so[e] = bf2f(proj[(size_t)(lastrow - 2 + (e >> 10)) * DINP + PC_XBC + (e & 1023)]); }
        __syncthreads();
    }
}
DI void phase_mixer_b(const Ctx& F, int layer, bool dry) {
    float* ds = wsf(F, WS_DS); const float* dec = wsf(F, WS_DEC);
    for (int e = blockIdx.x * 512 + F.tid; e < 2 * 12 * 8192; e += F.G * 512) {
        const int idx = e & 8191, hh = (e >> 13) % 12, b = e / (12 * 8192);
        const int ln = idx & 63, r = (idx >> 6) & 3, Tt = idx >> 8; const int a = 16 * (Tt >> 3) + 4 * (ln >> 4) + r;
        float v[32];
#pragma unroll
        for (int p = 0; p < 32; ++p) v[p] = ds[((size_t)(32 * b + p) * 12 + hh) * 8192 + idx];
        float S = 0.f;
#pragma unroll
        for (int p = 0; p < 32; ++p) { const int panel = 32 * b + p; const float dc = hh < 4 ? dec[(panel * 4 + hh) * 64 + a] : dec[64 * 4 * 64 + panel * 8 + (hh - 4)];
            if (!dry) ds[((size_t)panel * 12 + hh) * 8192 + idx] = S; S = dc * S + v[p]; }
    }
    {
        const int gw = blockIdx.x * NWAVES + F.wave; float* ls = wsf(F, WS_LRUS);
        if (gw < 1024) { const int b = gw >> 9, ch = gw & 511, l = F.lane; const int c0 = 128 * b + 2 * l;
            const float A0 = ls[(size_t)c0 * 512 + ch], H0 = ls[(size_t)(NCH + c0) * 512 + ch], A1 = ls[(size_t)(c0 + 1) * 512 + ch], H1 = ls[(size_t)(NCH + c0 + 1) * 512 + ch];
            float A = A1 * A0, H = A1 * H0 + H1;
#pragma unroll
            for (int o = 1; o < 64; o <<= 1) { const float Ap = __shfl_up(A, o), Hp = __shfl_up(H, o); if (l >= o) { H = A * Hp + H; A = A * Ap; } }
            float E = __shfl_up(H, 1); if (l == 0) E = 0.f;
            ls[(size_t)(2 * NCH + c0) * 512 + ch] = E; ls[(size_t)(2 * NCH + c0 + 1) * 512 + ch] = A0 * E + H0; }
    }
}
#ifndef MIX_MASK
#define MIX_MASK 7
#endif
DI void phase_mixer_c(const Ctx& F, int layer, bool dry) {
    for (int it = blockIdx.x; it < 1128; it += F.G) {
        if (it < 512) { if (MIX_MASK & 1) la_pass_c<true>(F, layer, 4 * (it >> 3), 4, it & 7, dry); }
        else if (it < 768) { if (MIX_MASK & 2) la_pass_c<false>(F, layer, 4 * ((it - 512) >> 2), 4, (it - 512) & 3, dry); }
        else if (it < 1032) { if (MIX_MASK & 4) lru_chunk<true>(F, layer, it - 768, dry); }
        else if (it < 1096) { if (MIX_MASK & 1) la_pass_c<true>(F, layer, 256 + ((it - 1032) >> 3), 1, (it - 1032) & 7, dry); }
        else { if (MIX_MASK & 2) la_pass_c<false>(F, layer, 256 + ((it - 1096) >> 2), 1, (it - 1096) & 3, dry); }
        __syncthreads();
    }
}
DI void phase_ssd_norm(const Ctx& F, int layer, bool dry) {
    const int gw = F.vcu * NWAVES + F.wave, NGW = F.G * NWAVES; bf16_t* proj = wsb(F, WS_R); const float* pss = wsf(F, WS_PSS);
    float gn[8]; { const float* gp = F.in[I_SNORM] + layer * 512 + 8 * F.lane; const f32x4 a = *(const f32x4*)gp, b = *(const f32x4*)(gp + 4); gn[0] = a.x; gn[1] = a.y; gn[2] = a.z; gn[3] = a.w; gn[4] = b.x; gn[5] = b.y; gn[6] = b.z; gn[7] = b.w; }
    for (int m = gw; m < M; m += NGW) {
        const f32x4* p = (const f32x4*)(pss + (size_t)m * 16); const f32x4 a = p[0], b = p[1], c = p[2], d = p[3];
        const float s = ((a.x + a.y) + (a.z + a.w)) + ((b.x + b.y) + (b.z + b.w)) + ((c.x + c.y) + (c.z + c.w)) + ((d.x + d.y) + (d.z + d.w));
        const float rstd = rsqrtf(s * (1.f / 512.f) + EPS);
        u32x4* yp = (u32x4*)(proj + (size_t)m * DINP + PC_CZ + 8 * F.lane); float v[8]; unpack8(*yp, v);
#pragma unroll
        for (int e = 0; e < 8; ++e) v[e] *= rstd * gn[e];
        *yp = pack8(v);
    }
}
DI void phase_final(const Ctx& F) {
    const int gw = F.vcu * NWAVES + F.wave, NGW = F.G * NWAVES; const float* rss = wsf(F, WS_RSSN) + (size_t)XB_PAD * 16; const float* gf = F.in[I_NFIN];
    for (int m = gw; m < M; m += NGW) { const float rs = row_rstd(rss, m); f32x4* x4 = (f32x4*)(F.out + (size_t)m * D) + F.lane;
#pragma unroll
        for (int j = 0; j < 4; ++j) { const f32x4 g = *((const f32x4*)gf + F.lane + 64 * j); x4[64 * j] = x4[64 * j] * rs * g; } }
}

constexpr int PH_PER_LAYER = 9, N_PHASES = 1 + DEPTH * PH_PER_LAYER + 1;
__global__ void __launch_bounds__(NWAVES * 64, 2) mk_fwd(Args args) {
    extern __shared__ __attribute__((aligned(16))) unsigned char lds_raw[];
    Ctx F; F.lds = (LAS unsigned char*)lds_raw; F.in = args.in; F.out = args.out; F.ws = args.ws;
    F.wave = __builtin_amdgcn_readfirstlane((int)threadIdx.x >> 6); F.lane = 0; F.tid = 0;
#define T0() (F.wave == 0 && lane_id() == 0)
    F.G = gridDim.x; { const int bx = blockIdx.x; F.vcu = (F.G % 8 == 0) ? (bx % 8) * (F.G / 8) + bx / 8 : bx; }
    volatile LAS unsigned* MISC = (volatile LAS unsigned*)(F.lds + MISC_OFF);
    if (F.wave == 0) MISC[lane_id()] = 0u;
    __syncthreads();
    XcdBarrier bar; bar.bar = (unsigned*)(args.ws + WS_CTL); bar.x = 0; bar.st = nullptr;
    if (args.use_bar) bar = xcd_barrier_post((unsigned*)(args.ws + WS_CTL), MISC + 8, T0());
    const int lo = args.ph_lo, hi = args.ph_hi;
#ifndef PH_MASK
#define PH_MASK 0xFFFFu
#endif
#define IN(k) (lo <= (k) && (k) < hi)
#define ON(b) ((PH_MASK >> (b)) & 1u)
#define SEAM(k) do { if (IN(k) && IN((k) + 1)) xcd_barrier(bar, T0()); } while (0)
#ifndef REP_MASK
#define REP_MASK 0
#endif
#define REPS(b) ((REP_MASK >> (b)) & 1)
#define XBAR() do { if (args.use_bar) xcd_barrier(bar, T0()); } while (0)
#define GP float* X = C.out; bf16_t* XB = wsb(C, WS_XB) + (size_t)XB_PAD * D; float* RSS = wsf(C, WS_RSS) + (size_t)XB_PAD * 16; bf16_t* XBN = wsb(C, WS_XBN); float* RSSN = wsf(C, WS_RSSN) + (size_t)XB_PAD * 16; \
    (void)X; (void)XB; (void)RSS; (void)XBN; (void)RSSN
#define PHC Ctx C = F; C.lane = lane_id(); C.tid = C.wave * 64 + C.lane; OPAQUE_CTX(C); { size_t zz_ = 0; asm volatile("" : "+s"(zz_)); C.ws = F.ws + zz_; C.out = (float*)((char*)F.out + zz_); }
    for (int rr_ = 0; rr_ <= REPS(0); ++rr_) { if (IN(0) && ON(0)) { PHC; convert_set(C, 0, 1 | 2 | 4 | 8 | 16 | 32 | 64 | 128, C.vcu, C.G); p0_rows(C); } if (rr_ < REPS(0)) XBAR(); }
    SEAM(0);
    for (int layer = 0; layer < DEPTH; ++layer) {
        const int pb = 1 + layer * PH_PER_LAYER;
        for (int rr_ = 0; rr_ <= REPS(1); ++rr_) { if (rr_) XBAR();
        if (IN(pb + 0) && ON(1)) { PHC; GP;
            pg8::Gemm g{XBN, wsb(C, WS_WIN), D, D, D}; pg8::StaticOrder S; S.init(M / 256, DINP / 256, C.G, (int)blockIdx.x, 0);
            EpiProj E{wsb(C, WS_R), RSSN}; pg8::gemm_phase<EpiProj, pg8::StaticOrder>(C.lds, g, S, E, C.wave);
        } }
        SEAM(pb + 0);
        for (int rr_ = 0; rr_ <= REPS(2); ++rr_) { if (rr_) XBAR(); if (IN(pb + 1) && ON(2)) { PHC; phase_mixer_a(C, layer); } }
        SEAM(pb + 1);
        for (int rr_ = 0; rr_ <= REPS(3); ++rr_) { if (rr_) XBAR();
        if (IN(pb + 2) && ON(3)) { PHC; phase_mixer_b(C, layer, rr_ < REPS(3));
            if (layer >= 1) convert_set(C, layer, 2, C.vcu, C.G); } }
        SEAM(pb + 2);
        for (int rr_ = 0; rr_ <= REPS(4); ++rr_) { if (rr_) XBAR(); if (IN(pb + 3) && ON(4)) { PHC; phase_mixer_c(C, layer, rr_ < REPS(4)); } }
        SEAM(pb + 3);
        for (int rr_ = 0; rr_ <= REPS(5); ++rr_) { if (rr_) XBAR(); if (IN(pb + 4) && ON(5)) { PHC; phase_ssd_norm(C, layer, rr_ < REPS(5)); } }
        SEAM(pb + 4);
        for (int rr_ = 0; rr_ <= REPS(6); ++rr_) { if (rr_) XBAR(); const bool dry_ = rr_ < REPS(6);
        if (IN(pb + 5) && ON(6)) { PHC; GP;
            pg8::Gemm g{wsb(C, WS_R) + PC_Y, wsb(C, WS_WOUT), DINP, DMIX, DMIX}; pg8::StaticOrder S; S.init(M / 256, D / 256, C.G, (int)blockIdx.x, 0);
            EpiRes E{layer == 0 ? C.in[I_XP] : X, layer == 0 ? C.in[I_XS] : X + (size_t)MP * D, X, XB, RSS, dry_};
            pg8::gemm_phase<EpiRes, pg8::StaticOrder>(C.lds, g, S, E, C.wave);
            if (!dry_ && C.G > 8 && (int)blockIdx.x >= 8) { __syncthreads();
                if (layer + 1 < DEPTH) convert_set(C, layer + 1, 1, (int)blockIdx.x - 8, C.G - 8);
                if (layer >= 1) convert_set(C, layer, 4 | 8 | 16 | 32 | 64, (int)blockIdx.x - 8, C.G - 8); }
        } }
        SEAM(pb + 5);
        for (int rr_ = 0; rr_ <= REPS(7); ++rr_) { if (rr_) XBAR();
        if (IN(pb + 6) && ON(7)) { PHC; GP;
            pg8::Gemm g{XB, wsb(C, WS_WGU), D, D, D}; pg8::StaticOrder S; S.init(67, 2 * DFF / 256, C.G, (int)blockIdx.x, 1);
            EpiFfn E{wsb(C, WS_R), RSS, C.in[I_FCW] + (size_t)layer * 3 * DFF, C.in[I_FCB] + layer * DFF, C.in[I_SFC] + (size_t)layer * 8 * 2 * DFF,
                     C.out + O_PFC + (size_t)layer * 2 * 2 * DFF, C.out + O_SFC + (size_t)layer * 8 * 2 * DFF};
            pg8::gemm_phase<EpiFfn, pg8::StaticOrder>(C.lds, g, S, E, C.wave);
        } }
        SEAM(pb + 6);
        for (int rr_ = 0; rr_ <= REPS(8); ++rr_) { if (rr_) XBAR(); const bool dry_ = rr_ < REPS(8);
        if (IN(pb + 7) && ON(8)) { PHC; GP;
            pg8::Gemm g{wsb(C, WS_R), wsb(C, WS_WD), DFF, DFF, DFF}; pg8::StaticOrder S; S.init(M / 256, D / 256, C.G, (int)blockIdx.x, 0);
            EpiRes E{X, X + (size_t)MP * D, X, XB, RSS, dry_}; pg8::gemm_phase<EpiRes, pg8::StaticOrder>(C.lds, g, S, E, C.wave);
            if (!dry_ && (C.G <= 8 || (int)blockIdx.x >= 8)) { const int sh = C.G > 8 ? 8 : 0;
                pg8::Gemm g2{wsb(C, WS_PB), wsb(C, WS_WPP), DPLE, DPLE, DPLE}; pg8::StaticOrder S2; S2.init(M / 256, D / 256, C.G - sh, (int)blockIdx.x - sh, 0);
                EpiPP E2{wsb(C, WS_PPO)}; pg8::gemm_phase<EpiPP, pg8::StaticOrder>(C.lds, g2, S2, E2, C.wave); }
        } }
        SEAM(pb + 7);
        for (int rr_ = 0; rr_ <= REPS(9); ++rr_) { if (rr_) XBAR(); const bool dry_ = rr_ < REPS(9);
        if (IN(pb + 8) && ON(9)) {
            { PHC; GP; pg8::Gemm g{XB, wsb(C, WS_WPG), D, D, D}; pg8::StaticOrder S; S.init(M / 256, D / 256, C.G, (int)blockIdx.x, 0);
              EpiPle E{X, X, XBN, RSS, RSSN, wsb(C, WS_PPO), dry_}; pg8::gemm_phase<EpiPle, pg8::StaticOrder>(C.lds, g, S, E, C.wave); }
        } }
        SEAM(pb + 8);
    }
    if (IN(N_PHASES - 1) && ON(10)) { PHC; phase_final(C); }
#undef IN
#undef ON
#undef SEAM
}

extern "C" void kernel_launch(void* const* d_in, const int* in_sizes, int n_in, void* d_out, int out_size, void* d_ws, size_t ws_size, hipStream_t stream) {
    static int grid = 0;
    if (grid == 0) {
        if (n_in != N_IN || (size_t)out_size != O_END || ws_size < WS_END) { fprintf(stderr, "kernel_launch: unexpected shapes: n_in %d out %d ws %zu (need %d, %zu, %zu)\n", n_in, out_size, ws_size, (int)N_IN, (size_t)O_END, (size_t)WS_END); grid = -1; return; }
        int dev = 0, cus = 0, per_cu = 0;
        if (hipGetDevice(&dev) != hipSuccess || hipDeviceGetAttribute(&cus, hipDeviceAttributeMultiprocessorCount, dev) != hipSuccess) { grid = -1; return; }
        if (hipFuncSetAttribute((const void*)mk_fwd, hipFuncAttributeMaxDynamicSharedMemorySize, LDS_BYTES) != hipSuccess) { fprintf(stderr, "kernel_launch: hipFuncSetAttribute failed\n"); grid = -1; return; }
        if (hipOccupancyMaxActiveBlocksPerMultiprocessor(&per_cu, (const void*)mk_fwd, NWAVES * 64, LDS_BYTES) != hipSuccess || per_cu < 1) { fprintf(stderr, "kernel_launch: occupancy query says %d\n", per_cu); per_cu = 1; }
        (void)hipGetLastError();
        grid = cus;
    }
    if (grid < 0) return;
    (void)hipMemsetAsync((char*)d_ws + WS_CTL, 0, CTL_ZERO_BYTES, stream);
    Args a{};
    for (int i = 0; i < N_IN; ++i) a.in[i] = (const float*)d_in[i];
    a.out = (float*)d_out; a.ws = (unsigned char*)d_ws;
#if MK_PER_PHASE
    for (int p = 0; p < N_PHASES; ++p) { a.ph_lo = p; a.ph_hi = p + 1; a.use_bar = 0; hipLaunchKernelGGL(mk_fwd, dim3(grid), dim3(NWAVES * 64), LDS_BYTES, stream, a); }
#else
    a.ph_lo = 0; a.ph_hi = N_PHASES; a.use_bar = 1;
    void* kargs[] = {&a};
    hipError_t e = hipLaunchCooperativeKernel((const void*)mk_fwd, dim3(grid), dim3(NWAVES * 64), kargs, LDS_BYTES, stream);
    if (e != hipSuccess) fprintf(stderr, "kernel_launch: cooperative launch failed: %s\n", hipGetErrorString(e));
#endif
}
```

```cpp
#include <hip/hip_runtime.h>
#include <cstdio>
#include <cstdint>

#define DI __device__ __forceinline__
#define LAS __attribute__((address_space(3)))
typedef unsigned short bf16_t;
typedef short bf16x8 __attribute__((ext_vector_type(8)));
typedef short s16x4 __attribute__((ext_vector_type(4)));
typedef float f32x4 __attribute__((ext_vector_type(4)));
typedef float f32x2 __attribute__((ext_vector_type(2)));
typedef unsigned u32x4 __attribute__((ext_vector_type(4)));
typedef unsigned u32x2 __attribute__((ext_vector_type(2)));

#ifndef MK_PER_PHASE
#define MK_PER_PHASE 0
#endif

constexpr int DEPTH = 2, D = 1024, MP = 16384, MS = 512, M = MP + MS;
constexpr int DIN = 4120, DINP = 4352, DFF = 3072, DMIX = 1536, DPLE = 256;
constexpr int NCH = M / 64;
constexpr float EPS = 1e-6f;
constexpr int PC_AX = 0, PC_BQ = 512, PC_BK = 768, PC_BV = 1024, PC_BLR = 1536, PC_XBC = 1552, PC_DT = 2576, PC_PAD = 2584, PC_Y = 2816, PC_AG = 2816, PC_BG = 3328, PC_CZ = 3840;

enum { I_XP = 0, I_XS, I_SLC, I_SLH, I_SG, I_SSC, I_SS, I_SFC, I_PP, I_PS, I_NMIX, I_WIN, I_LCW, I_LCB, I_LWR, I_LBR, I_LWI, I_LBI, I_LAM, I_GWLR, I_GBLR, I_GNORM,
       I_SCW, I_SCB, I_SDTB, I_SALOG, I_SD, I_SNORM, I_WOUT, I_NFFN, I_WG, I_WU, I_FCW, I_FCB, I_WD, I_NPLE, I_PWG, I_PWP, I_NFIN, N_IN };
constexpr size_t O_Y = 0;
constexpr size_t O_PLC = (size_t)M * D;
constexpr size_t O_PLH = O_PLC + 2 * 2 * 3 * 512;
constexpr size_t O_PG = O_PLH + 2 * 2 * 512;
constexpr size_t O_PSC = O_PG + 2 * 2 * 4 * 64 * 128;
constexpr size_t O_PS = O_PSC + 2 * 2 * 3 * 1024;
constexpr size_t O_PFC = O_PS + 2 * 2 * 8 * 64 * 128;
constexpr size_t O_SLC = O_PFC + 2 * 2 * 2 * 3072;
constexpr size_t O_SLH = O_SLC + 2 * 8 * 3 * 512;
constexpr size_t O_SG = O_SLH + 2 * 8 * 512;
constexpr size_t O_SSC = O_SG + 2 * 8 * 4 * 64 * 128;
constexpr size_t O_SS = O_SSC + 2 * 8 * 3 * 1024;
constexpr size_t O_SFC = O_SS + 2 * 8 * 8 * 64 * 128;
constexpr size_t O_END = O_SFC + 2 * 8 * 2 * 3072;

constexpr size_t MiB = 1u << 20;
constexpr size_t al4k(size_t x) { return (x + 4095) & ~(size_t)4095; }
constexpr int XB_PAD = 256;
constexpr int XB_ROWS = XB_PAD + M + 128;
constexpr size_t WS_CTL = 0, CTL_ZERO_BYTES = 64 * 1024;
constexpr size_t WS_WIN = al4k(WS_CTL + CTL_ZERO_BYTES);
constexpr size_t WS_WOUT = al4k(WS_WIN + (size_t)DINP * D * 2);
constexpr size_t WS_WGU = al4k(WS_WOUT + (size_t)D * DMIX * 2);
constexpr size_t WS_WD = al4k(WS_WGU + (size_t)2 * DFF * D * 2);
constexpr size_t WS_WPG = al4k(WS_WD + (size_t)D * DFF * 2);
constexpr size_t WS_WPP = al4k(WS_WPG + (size_t)D * D * 2);
constexpr size_t WS_LRUW = al4k(WS_WPP + (size_t)D * DPLE * 2);
constexpr size_t WS_RSS = al4k(WS_LRUW + (size_t)DEPTH * 2 * 8 * 4096 * 2);
constexpr size_t WS_RSSN = al4k(WS_RSS + (size_t)XB_ROWS * 64);
constexpr size_t WS_PSS = al4k(WS_RSSN + (size_t)XB_ROWS * 64);
constexpr size_t WS_LRUS = al4k(WS_PSS + (size_t)M * 64);
constexpr size_t WS_DEC = al4k(WS_LRUS + (size_t)3 * NCH * 512 * 4);
constexpr size_t WS_PB = al4k(WS_DEC + (size_t)(64 * 4 * 64 + 64 * 8) * 4);
constexpr size_t WS_XB = al4k(WS_PB + (size_t)M * DPLE * 2);
constexpr size_t WS_DS = al4k(WS_XB + (size_t)XB_ROWS * D * 2);
constexpr size_t WS_XBN = WS_DS;
constexpr size_t WS_R = al4k(WS_DS + (size_t)M * D * 2);
constexpr size_t WS_PPO = WS_R + 100 * MiB;
constexpr size_t WS_END = WS_R + (size_t)M * DINP * 2;
static_assert(WS_END <= 256 * MiB, "workspace");
static_assert((size_t)64 * 12 * 8192 * 4 <= (size_t)M * D * 2, "DS fits the XBN slot");
static_assert((size_t)M * DFF * 2 <= 100 * MiB && WS_PPO + (size_t)M * D * 2 <= WS_END, "overlay");

DI float bf2f(bf16_t b) { return __uint_as_float(((unsigned)b) << 16); }
DI unsigned f2bf(float f) { unsigned u = __float_as_uint(f); return (u + 0x7fffu + ((u >> 16) & 1u)) >> 16; }
DI unsigned pk2(float lo, float hi) { return f2bf(lo) | (f2bf(hi) << 16); }
DI float sigm(float x) { return __builtin_amdgcn_rcpf(1.f + __expf(-x)); }
DI float silu_f(float x) { return x * __builtin_amdgcn_rcpf(1.f + __expf(-x)); }
DI float gelu_t(float x) { const float u = 1.5957691216f * (x + 0.044715f * x * x * x); return x * __builtin_amdgcn_rcpf(1.f + __expf(-u)); }
DI float softplus_f(float x) { return fmaxf(x, 0.f) + log1pf(__expf(-fabsf(x))); }
DI float logsig_f(float x) { return fminf(x, 0.f) - log1pf(__expf(-fabsf(x))); }
template <int CTRL> DI float dpp_ror(float x) { return __builtin_bit_cast(float, __builtin_amdgcn_update_dpp(0, __builtin_bit_cast(int, x), CTRL, 0xf, 0xf, false)); }
DI void unpack8(const u32x4 v, float (&o)[8]) {
#pragma unroll
    for (int i = 0; i < 4; ++i) { o[2 * i] = __uint_as_float(v[i] << 16); o[2 * i + 1] = __uint_as_float(v[i] & 0xffff0000u); }
}
DI u32x4 pack8(const float (&o)[8]) { u32x4 r; r.x = pk2(o[0], o[1]); r.y = pk2(o[2], o[3]); r.z = pk2(o[4], o[5]); r.w = pk2(o[6], o[7]); return r; }
DI int lane_id() { int l; asm volatile("v_mbcnt_lo_u32_b32 %0, -1, 0\n\tv_mbcnt_hi_u32_b32 %0, -1, %0" : "=v"(l)); return l; }
#define LDS_WAIT() asm volatile("s_waitcnt lgkmcnt(0)" ::: "memory")
#define VM_WAIT() asm volatile("s_waitcnt vmcnt(0)" ::: "memory")

namespace pg8 {
constexpr int BM = 256, BK = 64, HALF = 128, HTB = HALF * BK * 2, STAGE_BYTES = 8 * HTB, NXCD = 8, WGM = 8;
__host__ __device__ __forceinline__ int lds_byte(int r, int c) { const int st = (r >> 4) * 2 + (c >> 5), rr = r & 15, cc = c & 31, ob = rr * 64 + cc * 2; return st * 1024 + (ob ^ (((ob >> 9) & 1) << 5)); }
__host__ __device__ __forceinline__ void stage_rc(int b, int& R, int& C) { const int st = b / 1024, sb = b % 1024, swz = sb ^ (((sb >> 9) & 1) << 5); R = (st >> 1) * 16 + swz / 64; C = (st & 1) * 32 + (swz % 64) / 2; }
__host__ __device__ __forceinline__ int perm32(int rho) { const int n = rho >> 4, i = rho & 15; return 8 * (i >> 2) + 4 * n + (i & 3); }

struct Unit { int pm, pn, arow; };
struct Gemm { const bf16_t* A; const bf16_t* Bt; int lda, ldb, K; };

struct StaticOrder {
    int nM, nN, nwg, G, c, shifted;
    __device__ void init(int nM_, int nN_, int G_, int c_, int shifted_) { nM = nM_; nN = nN_; nwg = nM * nN; G = G_; c = c_; shifted = shifted_; }
    __device__ bool next(int i, Unit& u) const {
        const long L = (long)i * G + c; if (L >= nwg) return false;
        int wgid = (int)L; { const int q = nwg / NXCD, r = nwg % NXCD, xcd = wgid % NXCD, off = wgid / NXCD; wgid = (xcd < r ? xcd * (q + 1) : r * (q + 1) + (xcd - r) * q) + off; }
        const int nig = WGM * nN, gid = wgid / nig, fm = gid * WGM, gsz = (nM - fm) < WGM ? (nM - fm) : WGM;
        u.pm = fm + ((wgid % nig) % gsz); u.pn = (wgid % nig) / gsz; u.arow = shifted ? 254 * u.pm - 2 : 256 * u.pm; return true;
    }
};
DI unsigned cvt_pk_bf16(float lo, float hi) { unsigned r; asm volatile("v_cvt_pk_bf16_f32 %0, %1, %2" : "=v"(r) : "v"(lo), "v"(hi)); return r; }

template <class Epi, class Sched>
DI void gemm_phase(LAS unsigned char* lds, const Gemm g, const Sched& S, const Epi& E, int wid) {
    const int lane = lane_id(), tid = wid * 64 + lane, wr = wid >> 2, wc = wid & 3, fr = lane & 15, fq = lane >> 4;
    const int K = g.K, nt = K / BK;
    unsigned voffA[2], voffB[2];
#pragma unroll
    for (int i = 0; i < 2; ++i) { int R, C; stage_rc(tid * 16 + i * 8192, R, C); const int Rb = Epi::PERM ? ((R & ~31) + perm32(R & 31)) : R;
        voffA[i] = (unsigned)(R * g.lda + C) * 2u; voffB[i] = (unsigned)(Rb * g.ldb + C) * 2u; }
    const size_t kstep = (size_t)(BK * 2);
    const size_t hstepA = (size_t)HALF * g.lda * 2, hstepB = (size_t)HALF * g.ldb * 2;
    const unsigned ldsw = (unsigned)wid * 1024u;
    const int aoff = lds_byte(wr * 64 + fr, fq * 8), boff = lds_byte(wc * 32 + fr, fq * 8);
#define PG8_SA(b, h) (((b) * 2 + (h)) * HTB)
#define PG8_SB(b, h) ((4 + (b) * 2 + (h)) * HTB)
#define PG8_STAGE(bufoff, gbase, voff) do { _Pragma("unroll") for (int _i = 0; _i < 2; ++_i) \
        __builtin_amdgcn_global_load_lds((const unsigned*)((const char*)(gbase) + (voff)[_i]), (LAS unsigned*)(lds + (bufoff) + ldsw + _i * 8192), 16, 0, 0); } while (0)
#define PG8_LDA(dst, b, h) do { _Pragma("unroll") for (int m = 0; m < 4; ++m) _Pragma("unroll") for (int k = 0; k < 2; ++k) dst[m][k] = *(const LAS bf16x8*)(lds + PG8_SA(b, h) + aoff + m * 2048 + k * 1024); } while (0)
#define PG8_LDB(dst, b, h) do { _Pragma("unroll") for (int n = 0; n < 2; ++n) _Pragma("unroll") for (int k = 0; k < 2; ++k) dst[n][k] = *(const LAS bf16x8*)(lds + PG8_SB(b, h) + boff + n * 2048 + k * 1024); } while (0)
#define PG8_MMA(ai, bj, At, Bt) do { __builtin_amdgcn_s_setprio(1); _Pragma("unroll") for (int m = 0; m < 4; ++m) _Pragma("unroll") for (int n = 0; n < 2; ++n) _Pragma("unroll") for (int k = 0; k < 2; ++k) \
        acc[ai][bj][m][n] = __builtin_amdgcn_mfma_f32_16x16x32_bf16(Bt[n][k], At[m][k], acc[ai][bj][m][n], 0, 0, 0); __builtin_amdgcn_s_setprio(0); } while (0)
#define PG8_WAIT_V(n) asm volatile("s_waitcnt vmcnt(" #n ")" ::: "memory")
#define PG8_WAIT_L(n) asm volatile("s_waitcnt lgkmcnt(" #n ")" ::: "memory")
#define PG8_BAR __builtin_amdgcn_s_barrier()
#define PG8_SCHED __builtin_amdgcn_sched_barrier(0)
    Unit cur, nxt; int ui = 0;
    if (!S.next(0, cur)) return;
    f32x4 acc[2][2][4][2];
#pragma unroll
    for (int a = 0; a < 2; ++a)
#pragma unroll
        for (int b = 0; b < 2; ++b)
#pragma unroll
            for (int m = 0; m < 4; ++m)
#pragma unroll
                for (int n = 0; n < 2; ++n) acc[a][b][m][n] = (f32x4){0.f, 0.f, 0.f, 0.f};
    bf16x8 At[4][2], B0[2][2], B1[2][2];
    const char* cA = (const char*)g.A + (long)cur.arow * g.lda * 2; const char* cB = (const char*)g.Bt + (size_t)cur.pn * 256 * g.ldb * 2;
    PG8_STAGE(PG8_SB(0, 0), cB, voffB); PG8_STAGE(PG8_SB(0, 1), cB + hstepB, voffB); PG8_STAGE(PG8_SA(0, 0), cA, voffA); PG8_STAGE(PG8_SA(0, 1), cA + hstepA, voffA);
    if (wr == 1) PG8_BAR;
    PG8_WAIT_V(2); PG8_BAR;
    PG8_STAGE(PG8_SB(1, 0), cB + kstep, voffB); PG8_STAGE(PG8_SA(1, 0), cA + kstep, voffA); PG8_STAGE(PG8_SB(1, 1), cB + hstepB + kstep, voffB);
    PG8_WAIT_V(6); PG8_BAR;
    for (;;) {
        const bool has_next = S.next(ui + 1, nxt);
        const char* nA = has_next ? (const char*)g.A + (long)nxt.arow * g.lda * 2 : cA; const char* nB = has_next ? (const char*)g.Bt + (size_t)nxt.pn * 256 * g.ldb * 2 : cB;
#pragma unroll 1
        for (int t = 0; t < nt; t += 2) {
            const bool last = (t == nt - 2);
            const char* a1 = cA + (size_t)(t + 1) * kstep;
            const char* a2 = last ? nA : cA + (size_t)(t + 2) * kstep; const char* b2 = last ? nB : cB + (size_t)(t + 2) * kstep;
            const char* a3 = a2 + kstep; const char* b3 = b2 + kstep;
            PG8_LDB(B0, 0, 0); PG8_LDB(B1, 0, 1); PG8_SCHED; PG8_LDA(At, 0, 0); PG8_STAGE(PG8_SA(1, 1), a1 + hstepA, voffA);
            PG8_WAIT_V(8); PG8_WAIT_L(0); PG8_BAR; PG8_MMA(0, 0, At, B0); PG8_MMA(0, 1, At, B1); PG8_BAR; PG8_SCHED;
            PG8_LDA(At, 0, 1); PG8_STAGE(PG8_SB(0, 0), b2, voffB); PG8_STAGE(PG8_SB(0, 1), b2 + hstepB, voffB); PG8_STAGE(PG8_SA(0, 0), a2, voffA);
            PG8_WAIT_V(8); PG8_WAIT_L(0); PG8_BAR; PG8_MMA(1, 0, At, B0); PG8_MMA(1, 1, At, B1); PG8_BAR; PG8_SCHED;
            PG8_LDB(B0, 1, 0); PG8_LDB(B1, 1, 1); PG8_SCHED; PG8_LDA(At, 1, 0); PG8_STAGE(PG8_SA(0, 1), a2 + hstepA, voffA);
            PG8_WAIT_V(8); PG8_WAIT_L(0); PG8_BAR; PG8_MMA(0, 0, At, B0); PG8_MMA(0, 1, At, B1); PG8_BAR; PG8_SCHED;
            PG8_LDA(At, 1, 1); PG8_STAGE(PG8_SB(1, 0), b3, voffB); PG8_STAGE(PG8_SB(1, 1), b3 + hstepB, voffB); PG8_STAGE(PG8_SA(1, 0), a3, voffA);
            PG8_WAIT_V(8); PG8_WAIT_L(0); PG8_BAR; PG8_MMA(1, 0, At, B0); PG8_MMA(1, 1, At, B1); PG8_BAR; PG8_SCHED;
        }
        if (wr == 0) PG8_BAR;
        { const int l2 = lane_id(); E(acc, cur, wr, wc, l2 & 15, l2 >> 4, lds); }
        if (!has_next) break;
#pragma unroll
        for (int a = 0; a < 2; ++a)
#pragma unroll
            for (int b = 0; b < 2; ++b)
#pragma unroll
                for (int m = 0; m < 4; ++m)
#pragma unroll
                    for (int n = 0; n < 2; ++n) acc[a][b][m][n] = (f32x4){0.f, 0.f, 0.f, 0.f};
        cur = nxt; cA = nA; cB = nB; ++ui;
        if (wr == 1) PG8_BAR;
    }
    PG8_WAIT_V(0);
    PG8_BAR;
#undef PG8_SA
#undef PG8_SB
#undef PG8_STAGE
#undef PG8_LDA
#undef PG8_LDB
#undef PG8_MMA
#undef PG8_WAIT_V
#undef PG8_WAIT_L
#undef PG8_BAR
#undef PG8_SCHED
}
}

#define XB_TMO      128
#define XB_XCNT(j)  (256  + 64 * (j))
#define XB_XSUB(j)  (1280 + 64 * (j))
#define XB_XGEN(j)  (2304 + 64 * (j))
#define XB_TOP      3328
#define XB_TOPGEN   3392
#define XCD_BAR_WORDS 3456
#define XB_SPIN_CAP (1u << 18)
DI unsigned xb_ld(unsigned* p)              { return __hip_atomic_load(p, __ATOMIC_RELAXED, __HIP_MEMORY_SCOPE_AGENT); }
DI unsigned xb_add(unsigned* p, unsigned v) { return __hip_atomic_fetch_add(p, v, __ATOMIC_RELAXED, __HIP_MEMORY_SCOPE_AGENT); }
DI unsigned xb_xcc_id() { return (unsigned)__builtin_amdgcn_s_getreg((3 << 11) | 20) & 0xFu; }
#define XB_SPIN(cond, bar) do { unsigned _sp = 0; while (cond) { __builtin_amdgcn_s_sleep(1); \
    if ((++_sp & 255u) == 0u) { if (xb_ld(&(bar)[XB_TMO])) break; if (_sp > XB_SPIN_CAP) { atomicAdd(&(bar)[XB_TMO], 1u); break; } } } } while (0)
struct XcdBarrier { unsigned* bar; unsigned x; volatile LAS unsigned* st; };
DI XcdBarrier xcd_barrier_post(unsigned* bar, volatile LAS unsigned* st, bool t0) {
    XcdBarrier b; b.bar = bar; b.x = xb_xcc_id(); b.st = st;
    if (t0) (void)xb_add(&bar[XB_XCNT(b.x)], 1u);
    return b;
}
DI void xcd_barrier_complete(unsigned* bar, unsigned x, unsigned& nloc, unsigned& nx) {
    const unsigned G = gridDim.x * gridDim.y * gridDim.z;
    unsigned sum, cnt, mine, sp = 0u;
    for (;;) {
        sum = 0u; cnt = 0u; mine = 0u;
#pragma unroll
        for (unsigned j = 0; j < 16; ++j) { const unsigned c = xb_ld(&bar[XB_XCNT(j)]); sum += c; cnt += (c > 0u) ? 1u : 0u; mine = (j == x) ? c : mine; }
        if (sum == G) break;
        __builtin_amdgcn_s_sleep(1);
        if ((++sp & 255u) == 0u) { if (xb_ld(&bar[XB_TMO])) break; if (sp > XB_SPIN_CAP) { atomicAdd(&bar[XB_TMO], 1u); break; } }
    }
    nloc = mine > 0u ? mine : 1u; nx = cnt > 0u ? cnt : 1u;
}
DI void xcd_barrier(const XcdBarrier& b, bool t0) {
    asm volatile("s_waitcnt vmcnt(0)" ::: "memory");
    __syncthreads();
    if (t0) {
        unsigned* bar = b.bar;
        __builtin_amdgcn_s_waitcnt(0);
        unsigned nloc = b.st[0], nx = b.st[1];
        if (nloc == 0u) { xcd_barrier_complete(bar, b.x, nloc, nx); b.st[0] = nloc; b.st[1] = nx; }
        const unsigned old = xb_add(&bar[XB_XSUB(b.x)], 1u);
        const unsigned gen = old / nloc;
        if (old + 1u == (gen + 1u) * nloc) {
            __builtin_amdgcn_fence(__ATOMIC_RELEASE, "agent");
            asm volatile("s_waitcnt vmcnt(0)" ::: "memory");
            const unsigned og = xb_add(&bar[XB_TOP], 1u);
            const unsigned tg = og / nx;
            if (og + 1u == (tg + 1u) * nx) xb_add(&bar[XB_TOPGEN], 1u);
            else XB_SPIN(xb_ld(&bar[XB_TOPGEN]) == tg, bar);
            __builtin_amdgcn_fence(__ATOMIC_ACQUIRE, "agent");
            xb_add(&bar[XB_XGEN(b.x)], 1u);
            asm volatile("s_waitcnt vmcnt(0)" ::: "memory");
        } else {
            XB_SPIN(xb_ld(&bar[XB_XGEN(b.x)]) == gen, bar);
            __builtin_amdgcn_fence(__ATOMIC_ACQUIRE, "agent");
            asm volatile("s_waitcnt vmcnt(0)" ::: "memory");
        }
    }
    __syncthreads();
}

constexpr int NWAVES = 8;
constexpr int RING_BYTES = 131072;
constexpr int XG_OFF = RING_BYTES;
constexpr int MISC_OFF = RING_BYTES + 8192;
constexpr int LDS_BYTES = 147456;

struct Args { const float* in[N_IN]; float* out; unsigned char* ws; int ph_lo, ph_hi, use_bar, pad; };

struct Ctx {
    LAS unsigned char* lds;
    const float* const* in; float* out; unsigned char* ws;
    int tid, lane, wave, G, vcu;
};
#define OPAQUE_CTX(C) do { asm volatile("" : "+v"((C).tid), "+v"((C).lane)); asm volatile("" : "+s"((C).wave), "+s"((C).vcu)); } while (0)
DI bf16_t* wsb(const Ctx& F, size_t off) { return (bf16_t*)(F.ws + off); }
DI float* wsf(const Ctx& F, size_t off) { return (float*)(F.ws + off); }

DI bool chunk_first(int c) { return c == 0 || c == 128 || c >= 256; }
DI bool chunk_last(int c) { return c == 127 || c >= 255; }
DI int chunk_seq(int c) { return c < 128 ? 0 : (c < 256 ? 1 : c - 254); }
DI float* st_out(const Ctx& F, size_t offp, size_t offs, int layer, int seq, int per) {
    return seq < 2 ? F.out + offp + (size_t)(layer * 2 + seq) * per : F.out + offs + (size_t)(layer * 8 + (seq - 2)) * per;
}

DI float wave_sum(float v) {
#pragma unroll
    for (int o = 1; o < 64; o <<= 1) v += __shfl_xor(v, o);
    return v;
}
DI int win_dst(int n) {
    if (n < 512) return PC_AX + n;
    if (n < 1024) return PC_AG + (n - 512);
    if (n < 1280) return PC_BQ + (n - 1024);
    if (n < 1536) return PC_BK + (n - 1280);
    if (n < 2048) return PC_BV + (n - 1536);
    if (n < 2560) return PC_BG + (n - 2048);
    if (n < 2576) return PC_BLR + (n - 2560);
    if (n < 3088) return PC_CZ + (n - 2576);
    if (n < 4112) return PC_XBC + (n - 3088);
    return PC_DT + (n - 4112);
}
DI int map_row(int mode, int n) {
    if (mode == 1) return win_dst(n);
    if (mode == 2) return 256 * (n >> 7) + (n & 127);
    if (mode == 3) return 256 * (n >> 7) + 128 + (n & 127);
    return n;
}
DI void tr_item(const float* W, int K, int N, bf16_t* WT, int mode, const float* g, LAS float* scr, int item, int lane) {
    const int nblk = (N + 31) / 32, kb = item / nblk, nb = item % nblk, k0 = 64 * kb, n0 = 32 * nb;
#pragma unroll 8
    for (int i = 0; i < 32; ++i) { const int kk = 2 * i + (lane >> 5), n = n0 + (lane & 31); float v = n < N ? W[(size_t)(k0 + kk) * N + n] : 0.f; if (g) v *= g[k0 + kk]; scr[kk * 33 + (lane & 31)] = v; }
    LDS_WAIT();
    const int c = lane & 7;
#pragma unroll
    for (int j = 0; j < 4; ++j) { const int n = (lane >> 3) + 8 * j; const LAS float* s = scr + (8 * c) * 33 + n;
        u32x4 o; o.x = pk2(s[0 * 33], s[1 * 33]); o.y = pk2(s[2 * 33], s[3 * 33]); o.z = pk2(s[4 * 33], s[5 * 33]); o.w = pk2(s[6 * 33], s[7 * 33]);
        if (n0 + n < N) *(u32x4*)(WT + (size_t)map_row(mode, n0 + n) * K + k0 + 8 * c) = o; }
    LDS_WAIT();
}
DI void convert_set(const Ctx& F, int layer, int which, int wgi, int nwg) {
    LAS float* scr = (LAS float*)(F.lds + F.wave * 16384);
    const int gw = wgi * NWAVES + F.wave, NGW = nwg * NWAVES;
    int base = 0;
#define CONV_MAT(cond, Wp, K_, N_, WTp, mode_, gp) if (cond) { const int ni = ((K_) / 64) * (((N_) + 31) / 32); \
        for (int it = gw - base; it < ni; it += NGW) { if (it >= 0) tr_item(Wp, K_, N_, WTp, mode_, gp, scr, it, F.lane); } base = (base + ni) % NGW; }
    CONV_MAT(which & 1, F.in[I_WIN] + (size_t)layer * D * DIN, D, DIN, wsb(F, WS_WIN), 1, F.in[I_NMIX] + layer * D)
    CONV_MAT(which & 2, F.in[I_WOUT] + (size_t)layer * DMIX * D, DMIX, D, wsb(F, WS_WOUT), 0, (const float*)nullptr)
    CONV_MAT(which & 4, F.in[I_WG] + (size_t)layer * D * DFF, D, DFF, wsb(F, WS_WGU), 2, F.in[I_NFFN] + layer * D)
    CONV_MAT(which & 4, F.in[I_WU] + (size_t)layer * D * DFF, D, DFF, wsb(F, WS_WGU), 3, F.in[I_NFFN] + layer * D)
    CONV_MAT(which & 8, F.in[I_WD] + (size_t)layer * DFF * D, DFF, D, wsb(F, WS_WD), 0, (const float*)nullptr)
    CONV_MAT(which & 16, F.in[I_PWG] + (size_t)layer * D * D, D, D, wsb(F, WS_WPG), 0, F.in[I_NPLE] + layer * D)
    CONV_MAT(which & 32, F.in[I_PWP] + (size_t)layer * DPLE * D, DPLE, D, wsb(F, WS_WPP), 0, (const float*)nullptr)
    if (which & 128) {
        for (int it = gw; it < DEPTH * 2 * 8 * 2; it += NGW) { const int mat = it >> 1, sub = it & 1, l = mat >> 4, ri = (mat >> 3) & 1, h = mat & 7;
            tr_item(F.in[ri ? I_LWI : I_LWR] + (size_t)(l * 8 + h) * 4096, 64, 64, wsb(F, WS_LRUW) + (size_t)((l * 2 + ri) * 8 + h) * 4096, 0, nullptr, scr, sub, F.lane); }
    }
#undef CONV_MAT
    if (which & 1) {
        u32x4* z = (u32x4*)(wsb(F, WS_WIN) + (size_t)PC_PAD * D); const int n16 = (PC_Y - PC_PAD) * D * 2 / 16;
        u32x4 zv = (u32x4){0u, 0u, 0u, 0u}; asm volatile("" : "+v"(zv));
        for (int i = wgi * 512 + F.tid; i < n16; i += nwg * 512) z[i] = zv;
    }
    if (which & 64) {
        const float* pp = F.in[I_PP] + (size_t)layer * MP * DPLE; const float* ps = F.in[I_PS] + (size_t)layer * MS * DPLE; bf16_t* pb = wsb(F, WS_PB);
        const int n8 = M * DPLE / 8;
        for (int i = wgi * 512 + F.tid; i < n8; i += nwg * 512) { const size_t e = (size_t)i * 8; const float* src = e < (size_t)MP * DPLE ? pp + e : ps + (e - (size_t)MP * DPLE);
            const f32x4 a = *(const f32x4*)src, b = *(const f32x4*)(src + 4); u32x4 o; o.x = pk2(a.x, a.y); o.y = pk2(a.z, a.w); o.z = pk2(b.x, b.y); o.w = pk2(b.z, b.w); *(u32x4*)(pb + e) = o; }
    }
}
DI void p0_rows(const Ctx& F) {
    const int gw = F.vcu * NWAVES + F.wave, NGW = F.G * NWAVES;
    bf16_t* xb = wsb(F, WS_XBN); float* rss = wsf(F, WS_RSSN) + (size_t)XB_PAD * 16;
    for (int m = gw; m < M; m += NGW) {
        const float* xr = m < MP ? F.in[I_XP] + (size_t)m * D : F.in[I_XS] + (size_t)(m - MP) * D;
        const f32x4* x4 = (const f32x4*)xr + F.lane; f32x4 v[4]; float s = 0.f;
#pragma unroll
        for (int j = 0; j < 4; ++j) { v[j] = x4[64 * j]; s += (v[j].x * v[j].x + v[j].y * v[j].y) + (v[j].z * v[j].z + v[j].w * v[j].w); }
        s = wave_sum(s);
        u32x2* o8 = (u32x2*)(xb + (size_t)m * D) + F.lane;
#pragma unroll
        for (int j = 0; j < 4; ++j) { u32x2 w; w.x = pk2(v[j].x, v[j].y); w.y = pk2(v[j].z, v[j].w); o8[64 * j] = w; }
        if (F.lane < 16) rss[(size_t)m * 16 + F.lane] = F.lane == 0 ? s : 0.f;
    }
}

DI float row_rstd(const float* rss, long row) {
    const f32x4* p = (const f32x4*)(rss + row * 16); const f32x4 a = p[0], b = p[1], c = p[2], d = p[3];
    const float s = ((a.x + a.y) + (a.z + a.w)) + ((b.x + b.y) + (b.z + b.w)) + ((c.x + c.y) + (c.z + c.w)) + ((d.x + d.y) + (d.z + d.w));
    return rsqrtf(fmaxf(s, 0.f) * (1.f / D) + EPS);
}
DI float row_rstd_q(const float* rss, long row, int fq) {
    const f32x4 a = *(const f32x4*)(rss + row * 16 + 4 * fq); float s = (a.x + a.y) + (a.z + a.w);
    s += __shfl_xor(s, 16); s += __shfl_xor(s, 32);
    return rsqrtf(fmaxf(s, 0.f) * (1.f / D) + EPS);
}
struct EpiProj {
    static constexpr bool PERM = true;
    bf16_t* O; const float* rss;
    DI void operator()(const f32x4 (&acc)[2][2][4][2], const pg8::Unit& u, int wr, int wc, int fr_, int fq_, LAS unsigned char*) const {
        int fr = fr_, fq = fq_; asm volatile("" : "+v"(fr), "+v"(fq));
        const int row0 = u.arow + wr * 64 + fr, col0 = u.pn * 256 + wc * 32 + 8 * fq;
#pragma unroll
        for (int ai = 0; ai < 2; ++ai)
#pragma unroll
            for (int m = 0; m < 4; ++m) { const int r = row0 + ai * 128 + m * 16; const float rs = row_rstd_q(rss, r, fq); bf16_t* rowp = O + (size_t)r * DINP + col0;
#pragma unroll
                for (int bj = 0; bj < 2; ++bj) { const f32x4 v0 = acc[ai][bj][m][0] * rs, v1 = acc[ai][bj][m][1] * rs;
                    u32x4 w; w.x = pg8::cvt_pk_bf16(v0[0], v0[1]); w.y = pg8::cvt_pk_bf16(v0[2], v0[3]); w.z = pg8::cvt_pk_bf16(v1[0], v1[1]); w.w = pg8::cvt_pk_bf16(v1[2], v1[3]);
                    *(u32x4*)(rowp + bj * 128) = w; } }
    }
};
struct EpiRes {
    static constexpr bool PERM = false;
    const float* xin_p; const float* xin_s; float* xout; bf16_t* xb; float* rss; bool dry;
    DI void operator()(const f32x4 (&acc)[2][2][4][2], const pg8::Unit& u, int wr, int wc, int fr_, int fq_, LAS unsigned char*) const {
        int fr = fr_, fq = fq_; asm volatile("" : "+v"(fr), "+v"(fq));
        const int row0 = u.arow + wr * 64 + fr, col0 = u.pn * 256 + wc * 32 + 4 * fq;
#pragma unroll
        for (int ai = 0; ai < 2; ++ai)
#pragma unroll
            for (int m = 0; m < 4; ++m) { const int r = row0 + ai * 128 + m * 16; const size_t off = (size_t)r * D + col0;
                const float* xi = r < MP ? xin_p + off : xin_s + (off - (size_t)MP * D);
                float ss = 0.f;
#pragma unroll
                for (int bj = 0; bj < 2; ++bj)
#pragma unroll
                    for (int n = 0; n < 2; ++n) { const int co = bj * 128 + n * 16;
                        const f32x4 xn = *(const f32x4*)(xi + co) + acc[ai][bj][m][n]; if (!dry) *(f32x4*)(xout + off + co) = xn;
                        u32x2 w; w.x = pg8::cvt_pk_bf16(xn[0], xn[1]); w.y = pg8::cvt_pk_bf16(xn[2], xn[3]); if (!dry) *(u32x2*)(xb + off + co) = w;
                        ss += (xn[0] * xn[0] + xn[1] * xn[1]) + (xn[2] * xn[2] + xn[3] * xn[3]); }
                ss += __shfl_xor(ss, 16); ss += __shfl_xor(ss, 32);
                if (fq == 0 && !dry) rss[(size_t)r * 16 + u.pn * 4 + wc] = ss;
                asm volatile("" ::: "memory"); }
    }
};
struct EpiPle {
    static constexpr bool PERM = false;
    const float* xin; float* xout; bf16_t* xb; const float* rss_in; float* rss_out; const bf16_t* pp; bool dry;
    DI void operator()(const f32x4 (&acc)[2][2][4][2], const pg8::Unit& u, int wr, int wc, int fr_, int fq_, LAS unsigned char*) const {
        int fr = fr_, fq = fq_; asm volatile("" : "+v"(fr), "+v"(fq));
        const int row0 = u.arow + wr * 64 + fr, col0 = u.pn * 256 + wc * 32 + 4 * fq;
#pragma unroll
        for (int ai = 0; ai < 2; ++ai)
#pragma unroll
            for (int m = 0; m < 4; ++m) { const int r = row0 + ai * 128 + m * 16; const size_t off = (size_t)r * D + col0;
                const float rs = row_rstd_q(rss_in, r, fq); float ss = 0.f;
#pragma unroll
                for (int bj = 0; bj < 2; ++bj)
#pragma unroll
                    for (int n = 0; n < 2; ++n) { const int co = bj * 128 + n * 16; f32x4 f = acc[ai][bj][m][n];
                        const u32x2 pw = *(const u32x2*)(pp + off + co);
                        f[0] = sigm(f[0] * rs) * __uint_as_float(pw.x << 16); f[1] = sigm(f[1] * rs) * __uint_as_float(pw.x & 0xffff0000u);
                        f[2] = sigm(f[2] * rs) * __uint_as_float(pw.y << 16); f[3] = sigm(f[3] * rs) * __uint_as_float(pw.y & 0xffff0000u);
                        const f32x4 xn = *(const f32x4*)(xin + off + co) + f; if (!dry) *(f32x4*)(xout + off + co) = xn;
                        u32x2 w; w.x = pg8::cvt_pk_bf16(xn[0], xn[1]); w.y = pg8::cvt_pk_bf16(xn[2], xn[3]); if (!dry) *(u32x2*)(xb + off + co) = w;
                        ss += (xn[0] * xn[0] + xn[1] * xn[1]) + (xn[2] * xn[2] + xn[3] * xn[3]); }
                ss += __shfl_xor(ss, 16); ss += __shfl_xor(ss, 32);
                if (fq == 0 && !dry) rss_out[(size_t)r * 16 + u.pn * 4 + wc] = ss;
                asm volatile("" ::: "memory"); }
    }
};
struct EpiPP {
    static constexpr bool PERM = false;
    bf16_t* pp;
    DI void operator()(const f32x4 (&acc)[2][2][4][2], const pg8::Unit& u, int wr, int wc, int fr_, int fq_, LAS unsigned char*) const {
        int fr = fr_, fq = fq_; asm volatile("" : "+v"(fr), "+v"(fq));
        const int row0 = u.arow + wr * 64 + fr, col0 = u.pn * 256 + wc * 32 + 4 * fq;
#pragma unroll
        for (int ai = 0; ai < 2; ++ai)
#pragma unroll
            for (int m = 0; m < 4; ++m) { const size_t off = (size_t)(row0 + ai * 128 + m * 16) * D + col0;
#pragma unroll
                for (int bj = 0; bj < 2; ++bj)
#pragma unroll
                    for (int n = 0; n < 2; ++n) { const f32x4 f = acc[ai][bj][m][n]; u32x2 w; w.x = pg8::cvt_pk_bf16(f[0], f[1]); w.y = pg8::cvt_pk_bf16(f[2], f[3]); *(u32x2*)(pp + off + bj * 128 + n * 16) = w; } }
    }
};
struct EpiFfn {
    static constexpr bool PERM = true;
    bf16_t* H; const float* rss; const float* cw; const float* cb; const float* st_in; float* st_p; float* st_s;
    DI void operator()(f32x4 (&acc)[2][2][4][2], const pg8::Unit& u, int wr, int wc, int fr_, int fq_, LAS unsigned char* lds) const {
        int fr = fr_, fq = fq_; asm volatile("" : "+v"(fr), "+v"(fq));
        const int lane = fr + 16 * fq;
        const int gc0 = u.pn * 128 + wc * 32 + 8 * fq;
        LAS float* XG = (LAS float*)(lds + XG_OFF);
#pragma unroll
        for (int ai = 0; ai < 2; ++ai)
#pragma unroll
            for (int m = 0; m < 4; ++m) { const float rs = row_rstd_q(rss, (long)u.arow + ai * 128 + wr * 64 + m * 16 + fr, fq);
#pragma unroll
                for (int bj = 0; bj < 2; ++bj)
#pragma unroll
                    for (int n = 0; n < 2; ++n) acc[ai][bj][m][n] *= rs;
                asm volatile("" : "+v"(acc[ai][0][m][0]), "+v"(acc[ai][0][m][1]), "+v"(acc[ai][1][m][0]), "+v"(acc[ai][1][m][1]) :: "memory"); }
        if (fr >= 14) {
#pragma unroll
            for (int ai = 0; ai < 2; ++ai)
#pragma unroll
                for (int n = 0; n < 2; ++n) *(LAS f32x4*)(XG + ((2 * ai + wr) * 2 + (fr - 14)) * 128 + wc * 32 + 8 * fq + 4 * n) = acc[ai][0][3][n];
        }
        LDS_WAIT(); __builtin_amdgcn_s_barrier(); asm volatile("" ::: "memory");
#pragma unroll
        for (int n = 0; n < 2; ++n) {
            const int gc = gc0 + 4 * n;
            const f32x4 w0 = *(const f32x4*)(cw + gc), w1 = *(const f32x4*)(cw + DFF + gc), w2 = *(const f32x4*)(cw + 2 * DFF + gc), bb = *(const f32x4*)(cb + gc);
#pragma unroll
            for (int ai = 0; ai < 2; ++ai) {
                f32x4 pr1, pr2;
                const int pb = 2 * ai + wr - 1;
                if (pb >= 0) { pr1 = *(const LAS f32x4*)(XG + (pb * 2 + 1) * 128 + wc * 32 + 8 * fq + 4 * n);
                               pr2 = *(const LAS f32x4*)(XG + (pb * 2 + (fr & 1)) * 128 + wc * 32 + 8 * fq + 4 * n); }
                else { pr1 = (f32x4){0.f, 0.f, 0.f, 0.f}; pr2 = pr1; }
#pragma unroll
                for (int m = 0; m < 4; ++m) {
                    const int j = ai * 128 + wr * 64 + m * 16 + fr; const long r = (long)u.arow + j;
                    int t, seq; if (r < MP) { t = (int)r & 8191; seq = (int)(r >> 13); } else { t = (int)(r - MP) & 63; seq = 2 + (int)((r - MP) >> 6); }
                    const int T = r < MP ? 8192 : 64;
                    const bool valid = j >= 2 && r < M;
                    const f32x4 cur = acc[ai][0][m][n]; f32x4 r1, r2;
#pragma unroll
                    for (int i = 0; i < 4; ++i) { r1[i] = dpp_ror<0x121>(cur[i]); r2[i] = dpp_ror<0x122>(cur[i]); }
                    f32x4 p1 = fr >= 1 ? r1 : pr1, p2 = fr >= 2 ? r2 : pr2;
                    pr1 = r1; pr2 = r2;
                    if (valid && t < 2) {
                        const f32x4 z = (f32x4){0.f, 0.f, 0.f, 0.f}; f32x4 s0 = z, s1 = z;
                        if (seq >= 2) { const float* sp = st_in + (size_t)(seq - 2) * 2 * DFF + gc; s0 = *(const f32x4*)sp; s1 = *(const f32x4*)(sp + DFF); }
                        if (t == 0) { p1 = s1; p2 = s0; } else { p2 = s1; }
                    }
                    const f32x4 gpre = bb + w0 * p2 + w1 * p1 + w2 * cur; const f32x4 up = acc[ai][1][m][n];
                    const float h0 = gelu_t(gpre[0]) * up[0], h1 = gelu_t(gpre[1]) * up[1], h2 = gelu_t(gpre[2]) * up[2], h3 = gelu_t(gpre[3]) * up[3];
                    if (valid) { u32x2 hw; hw.x = pg8::cvt_pk_bf16(h0, h1); hw.y = pg8::cvt_pk_bf16(h2, h3); *(u32x2*)(H + (size_t)r * DFF + gc) = hw;
                        if (t >= T - 2) { float* so = (seq < 2 ? st_p + (size_t)seq * 2 * DFF : st_s + (size_t)(seq - 2) * 2 * DFF) + (size_t)(t - (T - 2)) * DFF + gc; *(f32x4*)so = cur; } }
                    asm volatile("" ::: "memory");
                }
            }
        }
    }
};

DI bf16x8 frag_row(const LAS unsigned char* img, int pitch, int row0, int k0, int lane) {
    return *(const LAS bf16x8*)(img + (row0 + (lane & 15)) * pitch + (k0 + 8 * (lane >> 4)) * 2);
}
DI bf16x8 frag_tr(const LAS unsigned char* img, int pitch, int k0, int n0, int lane) {
    const int g = lane >> 4, i = lane & 15, q = i >> 2, p = i & 3;
    const LAS unsigned char* a = img + (k0 + 8 * g + q) * pitch + (n0 + 4 * p) * 2;
    const s16x4 lo = __builtin_amdgcn_ds_read_tr16_b64_v4i16((LAS s16x4*)a);
    const s16x4 hi = __builtin_amdgcn_ds_read_tr16_b64_v4i16((LAS s16x4*)(a + 4 * pitch));
    return __builtin_shufflevector(lo, hi, 0, 1, 2, 3, 4, 5, 6, 7);
}
#define MFMA16(a, b, c) __builtin_amdgcn_mfma_f32_16x16x32_bf16((a), (b), (c), 0, 0, 0)
DI void st_bf16(LAS unsigned char* img, int pitch, int row, int col, float v) { *(LAS bf16_t*)(img + row * pitch + col * 2) = (bf16_t)f2bf(v); }
DI float ld_bf16(const LAS unsigned char* img, int pitch, int row, int col) { return bf2f(*(const LAS bf16_t*)(img + row * pitch + col * 2)); }

#define WG_BAR() do { asm volatile("s_waitcnt lgkmcnt(0)" ::: "memory"); __builtin_amdgcn_s_barrier(); asm volatile("" ::: "memory"); } while (0)
template <bool SSD> struct LAT {
    static constexpr int DA = SSD ? 128 : 64, DB = SSD ? 64 : 128;
    static constexpr int PA = (DA + 8) * 2, PV = (DB + 8) * 2, PPI = 144, PS = (DB + 8) * 2, POT = (DB + 4) * 4;
    static constexpr int O_QD = 0, O_KI = O_QD + 64 * PA, O_VV = O_KI + 64 * PA, O_VW = O_VV + 64 * PV, O_P = O_VW + (SSD ? 64 * PV : 0), O_SB = O_P + 64 * PPI, O_OT = O_SB + DA * PS, O_TAB = O_OT + 64 * POT;
    static constexpr int NT_O = DB / 32;
};
static_assert(LAT<true>::O_TAB + 8192 <= RING_BYTES && LAT<false>::O_TAB + 8192 <= RING_BYTES, "mixer LDS");
template <bool SSD> DI void la_mt_nt(int T, int& mt, int& nt) { if (SSD) { mt = T >> 2; nt = T & 3; } else { mt = T >> 3; nt = T & 7; } }

template <bool SSD> DI void la_state_update(LAS unsigned char* lds, f32x4 (&S)[4], int w, int lane) {
    typedef LAT<SSD> L; const LAS float* tab = (const LAS float*)(lds + L::O_TAB); const int q = lane >> 4;
#pragma unroll
    for (int x = 0; x < 4; ++x) { int mt, nt; la_mt_nt<SSD>(4 * w + x, mt, nt);
        if (SSD) { const float d = tab[256]; S[x] *= d; }
#pragma unroll
        for (int ks = 0; ks < 2; ++ks) { const bf16x8 a = frag_tr(lds + L::O_KI, L::PA, 32 * ks, 16 * mt, lane); const bf16x8 b = frag_tr(lds + (SSD ? L::O_VW : L::O_VV), L::PV, 32 * ks, 16 * nt, lane); S[x] = MFMA16(a, b, S[x]); }
        if (!SSD) {
#pragma unroll
            for (int r = 0; r < 4; ++r) S[x][r] *= tab[1536 + 16 * mt + 4 * q + r]; }
    }
}
template <bool SSD> DI void la_write_sb(LAS unsigned char* lds, const f32x4 (&S)[4], int w, int lane) {
    typedef LAT<SSD> L; const int q = lane >> 4, c = lane & 15;
#pragma unroll
    for (int x = 0; x < 4; ++x) { int mt, nt; la_mt_nt<SSD>(4 * w + x, mt, nt);
#pragma unroll
        for (int r = 0; r < 4; ++r) st_bf16(lds + L::O_SB, L::PS, 16 * mt + 4 * q + r, 16 * nt + c, S[x][r]); }
}
template <bool SSD> DI void la_compute_p(LAS unsigned char* lds, int w, int lane) {
    typedef LAT<SSD> L; const LAS float* tab = (const LAS float*)(lds + L::O_TAB); const int q = lane >> 4, c = lane & 15, mt = w >> 1;
#pragma unroll
    for (int x = 0; x < 2; ++x) { const int nt = (w & 1) * 2 + x; f32x4 acc = {0.f, 0.f, 0.f, 0.f};
#pragma unroll
        for (int ks = 0; ks < L::DA / 32; ++ks) { const bf16x8 a = frag_row(lds + L::O_QD, L::PA, 16 * mt, 32 * ks, lane); const bf16x8 b = frag_row(lds + L::O_KI, L::PA, 16 * nt, 32 * ks, lane); acc = MFMA16(a, b, acc); }
        const int j = 16 * nt + c;
#pragma unroll
        for (int r = 0; r < 4; ++r) { const int i = 16 * mt + 4 * q + r; float v = acc[r];
            if (SSD) v *= __expf(tab[64 + i] - tab[64 + j]) * tab[j];
            v = (j > i) ? 0.f : v; st_bf16(lds + L::O_P, L::PPI, i, j, v); }
    }
}
template <bool SSD> DI void la_compute_out(LAS unsigned char* lds, f32x4 (&o1)[LAT<SSD>::NT_O], f32x4 (&o2)[LAT<SSD>::NT_O], int w, int lane) {
    typedef LAT<SSD> L; const int mt = w >> 1;
#pragma unroll
    for (int x = 0; x < L::NT_O; ++x) { const int nt = (w & 1) * L::NT_O + x; f32x4 a1 = {0.f, 0.f, 0.f, 0.f}, a2 = {0.f, 0.f, 0.f, 0.f};
#pragma unroll
        for (int ks = 0; ks < 2; ++ks) { const bf16x8 a = frag_row(lds + L::O_P, L::PPI, 16 * mt, 32 * ks, lane); const bf16x8 b = frag_tr(lds + L::O_VV, L::PV, 32 * ks, 16 * nt, lane); a1 = MFMA16(a, b, a1); }
#pragma unroll
        for (int ks = 0; ks < L::DA / 32; ++ks) { const bf16x8 a = frag_row(lds + L::O_QD, L::PA, 16 * mt, 32 * ks, lane); const bf16x8 b = frag_tr(lds + L::O_SB, L::PS, 32 * ks, 16 * nt, lane); a2 = MFMA16(a, b, a2); }
        o1[x] = a1; o2[x] = a2; }
}
DI void la_store_ds(float* ds, const f32x4 (&S)[4], int w, int lane) {
#pragma unroll
    for (int x = 0; x < 4; ++x)
#pragma unroll
        for (int r = 0; r < 4; ++r) ds[((4 * w + x) * 4 + r) * 64 + lane] = S[x][r];
}
DI void la_load_ds(const float* ds, f32x4 (&S)[4], int w, int lane) {
#pragma unroll
    for (int x = 0; x < 4; ++x)
#pragma unroll
        for (int r = 0; r < 4; ++r) S[x][r] = ds[((4 * w + x) * 4 + r) * 64 + lane];
}

struct GlaCoef { float wlr[16]; float blr; };
struct GlaRaw { unsigned short qk[8][2]; u32x4 v[2]; u32x4 lr; u32x4 g[2]; };
DI void gla_load(const Ctx& F, int h, int chunk, GlaRaw& R) {
    const bf16_t* proj = wsb(F, WS_R); const int row0 = 64 * chunk, d = F.lane, w = F.wave;
#pragma unroll
    for (int i = 0; i < 8; ++i) { const size_t ro = (size_t)(row0 + 8 * w + i) * DINP; R.qk[i][0] = proj[ro + PC_BQ + 64 * h + d]; R.qk[i][1] = proj[ro + PC_BK + 64 * h + d]; }
#pragma unroll
    for (int i = 0; i < 2; ++i) { const int idx = F.tid + 512 * i, t = idx >> 4, c16 = idx & 15;
        R.v[i] = *(const u32x4*)(proj + (size_t)(row0 + t) * DINP + PC_BV + 128 * h + 8 * c16);
        R.g[i] = *(const u32x4*)(proj + (size_t)(row0 + t) * DINP + PC_BG + 128 * h + 8 * c16); }
    R.lr = *(const u32x4*)(proj + (size_t)(row0 + ((F.tid >> 1) & 63)) * DINP + PC_BLR + 8 * (F.tid & 1));
}
DI void gla_stage(const Ctx& F, const GlaCoef& cf, const GlaRaw& R) {
    typedef LAT<false> L; LAS unsigned char* lds = F.lds; LAS float* tab = (LAS float*)(lds + L::O_TAB); const int d = F.lane, w = F.wave;
    if (F.tid < 128) { const int t = F.tid >> 1, half = F.tid & 1; float f[8]; unpack8(R.lr, f);
#pragma unroll
        for (int i = 0; i < 8; ++i) tab[t * 16 + 8 * half + i] = f[i]; }
#pragma unroll
    for (int i = 0; i < 2; ++i) { const int idx = F.tid + 512 * i, t = idx >> 4, c16 = idx & 15; *(LAS u32x4*)(lds + L::O_VV + t * L::PV + c16 * 16) = R.v[i]; }
    WG_BAR();
    float pre[8]; float run = 0.f;
#pragma unroll
    for (int i = 0; i < 8; ++i) { const int t = 8 * w + i; float z = cf.blr;
#pragma unroll
        for (int r = 0; r < 16; ++r) z += tab[t * 16 + r] * cf.wlr[r];
        run += logsig_f(z) * (1.f / 16.f); pre[i] = run; }
    tab[1024 + w * 64 + d] = run;
    WG_BAR();
    float off = 0.f, last = 0.f;
#pragma unroll
    for (int ww = 0; ww < 8; ++ww) { const float tv = tab[1024 + ww * 64 + d]; last += tv; if (ww < w) off += tv; }
#pragma unroll
    for (int i = 0; i < 8; ++i) { const int t = 8 * w + i; const float cum = off + pre[i];
        st_bf16(lds + L::O_QD, L::PA, t, d, bf2f(R.qk[i][0]) * 0.125f * __expf(cum)); st_bf16(lds + L::O_KI, L::PA, t, d, bf2f(R.qk[i][1]) * __expf(-cum)); }
    if (w == 0) tab[1536 + d] = __expf(last);
    WG_BAR();
}
struct SsdRaw { u32x4 x[11]; u32x4 z; unsigned short dtr; };
DI void ssd_task(const Ctx& F, int h, int& cidx, int& rg, int& ch) {
    cidx = F.tid % 40; rg = F.tid / 40; const int g = h >> 2;
    ch = cidx < 8 ? 64 * h + 8 * cidx : (cidx < 24 ? 512 + 128 * g + 8 * (cidx - 8) : 768 + 128 * g + 8 * (cidx - 24));
    asm volatile("" : "+v"(ch));
}
DI void ssd_load(const Ctx& F, int layer, int h, int chunk, SsdRaw& R) {
    const bf16_t* proj = wsb(F, WS_R); const int row0 = 64 * chunk; const bool first = chunk_first(chunk);
    if (F.tid < 320) { int cidx, rg, ch; ssd_task(F, h, cidx, rg, ch);
#pragma unroll
        for (int i = 0; i < 11; ++i) { const int tt = 8 * rg - 3 + i;
            if (tt >= 0 || !first) R.x[i] = *(const u32x4*)(proj + (size_t)(row0 + tt) * DINP + PC_XBC + ch);
            else if (chunk >= 256) { const float* sp = F.in[I_SSC] + ((size_t)(layer * 8 + (chunk - 256)) * 3 + (tt + 3)) * 1024 + ch; const f32x4 a = *(const f32x4*)sp, b = *(const f32x4*)(sp + 4);
                u32x4 o; o.x = pk2(a.x, a.y); o.y = pk2(a.z, a.w); o.z = pk2(b.x, b.y); o.w = pk2(b.z, b.w); R.x[i] = o; }
            else R.x[i] = (u32x4){0u, 0u, 0u, 0u};
        }
    }
    R.z = *(const u32x4*)(proj + (size_t)(row0 + (F.tid >> 3)) * DINP + PC_CZ + 64 * h + 8 * (F.tid & 7));
    R.dtr = proj[(size_t)(row0 + F.lane) * DINP + PC_DT + h];
}
DI float ssd_stage(const Ctx& F, int layer, int h, const SsdRaw& R) {
    typedef LAT<true> L; LAS unsigned char* lds = F.lds; LAS float* tab = (LAS float*)(lds + L::O_TAB);
    float last = 0.f;
    if (F.wave == 0) { const int t = F.lane;
        const float dt = softplus_f(bf2f(R.dtr) + F.in[I_SDTB][layer * 8 + h]); float cum = -dt * __expf(F.in[I_SALOG][layer * 8 + h]);
#pragma unroll
        for (int o = 1; o < 64; o <<= 1) { const float v = __shfl_up(cum, o); if (t >= o) cum += v; }
        last = __shfl(cum, 63);
        tab[t] = dt; tab[64 + t] = cum; tab[128 + t] = __expf(last - cum) * dt; tab[192 + t] = __expf(cum); if (t == 0) tab[256] = __expf(last); }
    WG_BAR();
    if (F.tid < 320) { int cidx, rg, ch; ssd_task(F, h, cidx, rg, ch);
        const float* cwp = F.in[I_SCW] + (size_t)layer * 4 * 1024 + ch; const float* cbp = F.in[I_SCB] + layer * 1024 + ch;
        float wv[4][8], bv[8];
#pragma unroll
        for (int j = 0; j < 4; ++j) { const f32x4 a = *(const f32x4*)(cwp + j * 1024), b = *(const f32x4*)(cwp + j * 1024 + 4); wv[j][0] = a.x; wv[j][1] = a.y; wv[j][2] = a.z; wv[j][3] = a.w; wv[j][4] = b.x; wv[j][5] = b.y; wv[j][6] = b.z; wv[j][7] = b.w; }
        { const f32x4 a = *(const f32x4*)cbp, b = *(const f32x4*)(cbp + 4); bv[0] = a.x; bv[1] = a.y; bv[2] = a.z; bv[3] = a.w; bv[4] = b.x; bv[5] = b.y; bv[6] = b.z; bv[7] = b.w; }
        float x0[8], x1[8], x2[8], x3[8]; unpack8(R.x[0], x0); unpack8(R.x[1], x1); unpack8(R.x[2], x2);
#pragma unroll
        for (int r = 0; r < 8; ++r) { const int t = 8 * rg + r; float o[8]; unpack8(R.x[r + 3], x3);
#pragma unroll
            for (int e = 0; e < 8; ++e) { const float v = bv[e] + wv[0][e] * x0[e] + wv[1][e] * x1[e] + wv[2][e] * x2[e] + wv[3][e] * x3[e]; o[e] = silu_f(v); x0[e] = x1[e]; x1[e] = x2[e]; x2[e] = x3[e]; }
            if (cidx < 8) { *(LAS u32x4*)(lds + L::O_VV + t * L::PV + cidx * 16) = pack8(o); const float we = tab[128 + t];
#pragma unroll
                for (int e = 0; e < 8; ++e) o[e] *= we;
                *(LAS u32x4*)(lds + L::O_VW + t * L::PV + cidx * 16) = pack8(o); }
            else if (cidx < 24) *(LAS u32x4*)(lds + L::O_KI + t * L::PA + (cidx - 8) * 16) = pack8(o);
            else *(LAS u32x4*)(lds + L::O_QD + t * L::PA + (cidx - 24) * 16) = pack8(o);
        }
    }
    WG_BAR();
    return last;
}

DI void gla_pass_a(const Ctx& F0, int layer, int panel, int h) {
    Ctx F = F0; OPAQUE_CTX(F);
    LAS unsigned char* lds = F.lds; const int w = F.wave, lane = F.lane, d = lane; const bf16_t* proj = wsb(F, WS_R); const int row0 = 256 * panel;
    constexpr int PK = 144, PVV = 272, O_KE = 0, O_V = 256 * PK, O_LR = O_V + 256 * PVV, O_TOT = O_LR + 256 * 16 * 4;
    static_assert(O_TOT + 2048 <= RING_BYTES, "gla pass A LDS");
    LAS float* lr = (LAS float*)(lds + O_LR); LAS float* tot = (LAS float*)(lds + O_TOT);
    float wlr[16];
#pragma unroll
    for (int r = 0; r < 16; ++r) wlr[r] = F.in[I_GWLR][(size_t)(layer * 16 + r) * 256 + 64 * h + d];
    const float blr = F.in[I_GBLR][layer * 256 + 64 * h + d];
    { const int t = F.tid >> 1, half = F.tid & 1; const u32x4 v = *(const u32x4*)(proj + (size_t)(row0 + t) * DINP + PC_BLR + 8 * half); float f[8]; unpack8(v, f);
#pragma unroll
        for (int i = 0; i < 8; ++i) lr[t * 16 + 8 * half + i] = f[i]; }
    unsigned short kr[32];
#pragma unroll
    for (int i = 0; i < 32; ++i) kr[i] = proj[(size_t)(row0 + 32 * w + i) * DINP + PC_BK + 64 * h + d];
#pragma unroll
    for (int i = 0; i < 8; ++i) { const int idx = F.tid + 512 * i, t = idx >> 4, c16 = idx & 15;
        *(LAS u32x4*)(lds + O_V + t * PVV + c16 * 16) = *(const u32x4*)(proj + (size_t)(row0 + t) * DINP + PC_BV + 128 * h + 8 * c16); }
    WG_BAR();
    float pre[32]; float run = 0.f;
#pragma unroll
    for (int i = 0; i < 32; ++i) { const int t = 32 * w + i; float z = blr;
#pragma unroll
        for (int r = 0; r < 16; ++r) z += lr[t * 16 + r] * wlr[r];
        run += logsig_f(z) * (1.f / 16.f); pre[i] = run; }
    tot[w * 64 + d] = run;
    WG_BAR();
    float off = 0.f, last = 0.f;
#pragma unroll
    for (int ww = 0; ww < 8; ++ww) { const float tv = tot[ww * 64 + d]; last += tv; if (ww < w) off += tv; }
#pragma unroll
    for (int i = 0; i < 32; ++i) st_bf16(lds + O_KE, PK, 32 * w + i, d, bf2f(kr[i]) * __expf(last - (off + pre[i])));
    WG_BAR();
    f32x4 S[4];
#pragma unroll
    for (int x = 0; x < 4; ++x) S[x] = (f32x4){0.f, 0.f, 0.f, 0.f};
    const int mt = w >> 1;
#pragma unroll
    for (int ks = 0; ks < 8; ++ks) { const bf16x8 a = frag_tr(lds + O_KE, PK, 32 * ks, 16 * mt, lane);
#pragma unroll
        for (int x = 0; x < 4; ++x) { const bf16x8 b = frag_tr(lds + O_V, PVV, 32 * ks, 16 * (((4 * w + x) & 7)), lane); S[x] = MFMA16(a, b, S[x]); } }
    la_store_ds(wsf(F, WS_DS) + ((size_t)panel * 12 + h) * 8192, S, w, lane);
    if (w == 0) wsf(F, WS_DEC)[(panel * 4 + h) * 64 + d] = __expf(last);
    WG_BAR();
}
DI void ssd_pass_a(const Ctx& F0, int layer, int panel, int h) {
    Ctx F = F0; OPAQUE_CTX(F);
    LAS unsigned char* lds = F.lds; const int w = F.wave, lane = F.lane, g = h >> 2; const bf16_t* proj = wsb(F, WS_R); const int row0 = 256 * panel; const bool first = (panel & 31) == 0;
    constexpr int PB_ = 272, PX = 144, O_B = 0, O_XW = 256 * PB_, O_WE = O_XW + 256 * PX;
    static_assert(O_WE + 1024 <= RING_BYTES, "ssd pass A LDS");
    LAS float* wend = (LAS float*)(lds + O_WE);
    float last = 0.f;
    if (w == 0) {
        const float bias = F.in[I_SDTB][layer * 8 + h], A = -__expf(F.in[I_SALOG][layer * 8 + h]); float dt[4], cs[4]; float run = 0.f;
#pragma unroll
        for (int i = 0; i < 4; ++i) { dt[i] = softplus_f(bf2f(proj[(size_t)(row0 + 4 * lane + i) * DINP + PC_DT + h]) + bias); run += dt[i] * A; cs[i] = run; }
        float inc = run;
#pragma unroll
        for (int o = 1; o < 64; o <<= 1) { const float v = __shfl_up(inc, o); if (lane >= o) inc += v; }
        const float excl = inc - run; last = __shfl(inc, 63);
#pragma unroll
        for (int i = 0; i < 4; ++i) wend[4 * lane + i] = __expf(last - (excl + cs[i])) * dt[i];
    }
    WG_BAR();
    for (int pass = 0; pass < 2; ++pass) { const int task = F.tid + 512 * pass;
        if (task < 768) { const int cidx = task % 24, rg = task / 24;
            const int ch = cidx < 8 ? 64 * h + 8 * cidx : 512 + 128 * g + 8 * (cidx - 8);
            const float* cwp = F.in[I_SCW] + (size_t)layer * 4 * 1024 + ch; const float* cbp = F.in[I_SCB] + layer * 1024 + ch;
            float wv[4][8], bv[8];
#pragma unroll
            for (int j = 0; j < 4; ++j) { const f32x4 a = *(const f32x4*)(cwp + j * 1024), b = *(const f32x4*)(cwp + j * 1024 + 4); wv[j][0] = a.x; wv[j][1] = a.y; wv[j][2] = a.z; wv[j][3] = a.w; wv[j][4] = b.x; wv[j][5] = b.y; wv[j][6] = b.z; wv[j][7] = b.w; }
            { const f32x4 a = *(const f32x4*)cbp, b = *(const f32x4*)(cbp + 4); bv[0] = a.x; bv[1] = a.y; bv[2] = a.z; bv[3] = a.w; bv[4] = b.x; bv[5] = b.y; bv[6] = b.z; bv[7] = b.w; }
            u32x4 xr[11];
#pragma unroll
            for (int i = 0; i < 11; ++i) { const int tt = 8 * rg - 3 + i;
                if (tt >= 0 || !first) xr[i] = *(const u32x4*)(proj + (size_t)(row0 + tt) * DINP + PC_XBC + ch); else xr[i] = (u32x4){0u, 0u, 0u, 0u}; }
            float x0[8], x1[8], x2[8], x3[8]; unpack8(xr[0], x0); unpack8(xr[1], x1); unpack8(xr[2], x2);
#pragma unroll
            for (int r = 0; r < 8; ++r) { const int t = 8 * rg + r; float o[8]; unpack8(xr[r + 3], x3);
#pragma unroll
                for (int e = 0; e < 8; ++e) { const float v = bv[e] + wv[0][e] * x0[e] + wv[1][e] * x1[e] + wv[2][e] * x2[e] + wv[3][e] * x3[e]; o[e] = silu_f(v); x0[e] = x1[e]; x1[e] = x2[e]; x2[e] = x3[e]; }
                if (cidx < 8) { const float we = wend[t];
#pragma unroll
                    for (int e = 0; e < 8; ++e) o[e] *= we;
                    *(LAS u32x4*)(lds + O_XW + t * PX + cidx * 16) = pack8(o); }
                else *(LAS u32x4*)(lds + O_B + t * PB_ + (cidx - 8) * 16) = pack8(o);
            }
        }
    }
    WG_BAR();
    f32x4 S[4];
#pragma unroll
    for (int x = 0; x < 4; ++x) S[x] = (f32x4){0.f, 0.f, 0.f, 0.f};
#pragma unroll
    for (int ks = 0; ks < 8; ++ks) { const bf16x8 a = frag_tr(lds + O_B, PB_, 32 * ks, 16 * w, lane);
#pragma unroll
        for (int x = 0; x < 4; ++x) { const bf16x8 b = frag_tr(lds + O_XW, PX, 32 * ks, 16 * x, lane); S[x] = MFMA16(a, b, S[x]); } }
    la_store_ds(wsf(F, WS_DS) + ((size_t)panel * 12 + 4 + h) * 8192, S, w, lane);
    if (w == 0 && lane == 0) wsf(F, WS_DEC)[64 * 4 * 64 + panel * 8 + h] = __expf(last);
    WG_BAR();
}

template <bool SSD> DI void la_pass_c(const Ctx& F0, int layer, int c0, int nc, int h, bool dry) {
    Ctx F = F0; OPAQUE_CTX(F);
    typedef LAT<SSD> L; const int w = F.wave, lane = F.lane, q = lane >> 4, c = lane & 15, mt = w >> 1;
    bf16_t* proj = wsb(F, WS_R);
    f32x4 S[4];
    GlaCoef cf; GlaRaw gr; SsdRaw sr;
    if (!SSD) {
#pragma unroll
        for (int r = 0; r < 16; ++r) cf.wlr[r] = F.in[I_GWLR][(size_t)(layer * 16 + r) * 256 + 64 * h + lane];
        cf.blr = F.in[I_GBLR][layer * 256 + 64 * h + lane]; gla_load(F, h, c0, gr); }
    else ssd_load(F, layer, h, c0, sr);
    const int hh = SSD ? 4 + h : h;
    const Ctx Fp = F;
#pragma unroll 1
    for (int cc = 0; cc < nc; ++cc) { const int chunk = c0 + cc, row0 = 64 * chunk;
        Ctx F = Fp; { unsigned z_ = 0; asm volatile("" : "+s"(z_)); F.lds = Fp.lds + z_; } LAS unsigned char* lds = F.lds; LAS float* tab = (LAS float*)(lds + L::O_TAB);
        if (cc == 0 || chunk_first(chunk)) {
            if (chunk < 256) la_load_ds(wsf(F, WS_DS) + ((size_t)(chunk >> 2) * 12 + hh) * 8192, S, w, lane);
            else { const int b = chunk - 256;
#pragma unroll
                for (int x = 0; x < 4; ++x) { int smt, snt; la_mt_nt<SSD>(4 * w + x, smt, snt);
                    if (SSD) { const float* sp = F.in[I_SS] + ((size_t)((layer * 8 + b) * 8 + h) * 64 + 16 * snt + c) * 128 + 16 * smt + 4 * q; S[x] = *(const f32x4*)sp; }
                    else { const float* sp = F.in[I_SG] + ((size_t)((layer * 8 + b) * 4 + h) * 64 + 16 * smt + 4 * q) * 128 + 16 * snt + c;
#pragma unroll
                        for (int r = 0; r < 4; ++r) S[x][r] = sp[r * 128]; } } }
            la_write_sb<SSD>(lds, S, w, lane);
        }
        u32x4 gate0, gate1;
        if (SSD) { ssd_stage(F, layer, h, sr); gate0 = sr.z; gate1 = gate0; if (cc + 1 < nc) ssd_load(F, layer, h, chunk + 1, sr); }
        else { gla_stage(F, cf, gr); gate0 = gr.g[0]; gate1 = gr.g[1]; if (cc + 1 < nc) gla_load(F, h, chunk + 1, gr); }
        la_compute_p<SSD>(lds, w, lane);
        WG_BAR();
        f32x4 o1[L::NT_O], o2[L::NT_O];
        la_compute_out<SSD>(lds, o1, o2, w, lane);
        la_state_update<SSD>(lds, S, w, lane);
        if (SSD) {
            const float Dh = F.in[I_SD][layer * 8 + h];
#pragma unroll
            for (int x = 0; x < L::NT_O; ++x) { const int p = 16 * ((w & 1) * L::NT_O + x) + c;
#pragma unroll
                for (int r = 0; r < 4; ++r) { const int i = 16 * mt + 4 * q + r; *(LAS float*)(lds + L::O_OT + i * L::POT + p * 4) = o1[x][r] + tab[192 + i] * o2[x][r] + Dh * ld_bf16(lds + L::O_VV, L::PV, i, p); } }
        } else {
            float ss[4] = {0.f, 0.f, 0.f, 0.f};
#pragma unroll
            for (int x = 0; x < L::NT_O; ++x) { const int e = 16 * ((w & 1) * L::NT_O + x) + c;
#pragma unroll
                for (int r = 0; r < 4; ++r) { const float o = o1[x][r] + o2[x][r]; ss[r] += o * o; *(LAS float*)(lds + L::O_OT + (16 * mt + 4 * q + r) * L::POT + e * 4) = o; } }
#pragma unroll
            for (int r = 0; r < 4; ++r) { float s = ss[r]; s += __shfl_xor(s, 1); s += __shfl_xor(s, 2); s += __shfl_xor(s, 4); s += __shfl_xor(s, 8);
                if (c == 0) tab[1600 + (16 * mt + 4 * q + r) * 2 + (w & 1)] = s; }
        }
        WG_BAR();
        if (SSD) { const int i = F.tid >> 3, p0 = 8 * (F.tid & 7); float zv[8], yv[8]; unpack8(gate0, zv); float ss = 0.f;
            const f32x4 ya = *(const LAS f32x4*)(lds + L::O_OT + i * L::POT + p0 * 4), yb = *(const LAS f32x4*)(lds + L::O_OT + i * L::POT + p0 * 4 + 16);
            yv[0] = ya.x; yv[1] = ya.y; yv[2] = ya.z; yv[3] = ya.w; yv[4] = yb.x; yv[5] = yb.y; yv[6] = yb.z; yv[7] = yb.w;
#pragma unroll
            for (int e = 0; e < 8; ++e) { yv[e] *= silu_f(zv[e]); ss += yv[e] * yv[e]; }
            ss += __shfl_xor(ss, 1); ss += __shfl_xor(ss, 2); ss += __shfl_xor(ss, 4);
            if (!dry) { *(u32x4*)(proj + (size_t)(row0 + i) * DINP + PC_CZ + 64 * h + p0) = pack8(yv);
                if ((F.tid & 7) == 0) { f32x2 pv; pv.x = ss; pv.y = 0.f; *(f32x2*)(wsf(F, WS_PSS) + (size_t)(row0 + i) * 16 + 2 * h) = pv; } }
        } else {
#pragma unroll
            for (int k = 0; k < 2; ++k) { const int idx = F.tid + 512 * k, i = idx >> 4, e0 = 8 * (idx & 15); float gv[8], yv[8]; unpack8(k ? gate1 : gate0, gv);
                const float rstd = rsqrtf((tab[1600 + 2 * i] + tab[1600 + 2 * i + 1]) * (1.f / 128.f) + EPS);
                const f32x4 ya = *(const LAS f32x4*)(lds + L::O_OT + i * L::POT + e0 * 4), yb = *(const LAS f32x4*)(lds + L::O_OT + i * L::POT + e0 * 4 + 16);
                const float* gn = F.in[I_GNORM] + layer * 512 + 128 * h + e0; const f32x4 na = *(const f32x4*)gn, nb = *(const f32x4*)(gn + 4);
                yv[0] = ya.x * na.x; yv[1] = ya.y * na.y; yv[2] = ya.z * na.z; yv[3] = ya.w * na.w; yv[4] = yb.x * nb.x; yv[5] = yb.y * nb.y; yv[6] = yb.z * nb.z; yv[7] = yb.w * nb.w;
#pragma unroll
                for (int e = 0; e < 8; ++e) yv[e] *= rstd * silu_f(gv[e]);
                if (!dry) *(u32x4*)(proj + (size_t)(row0 + i) * DINP + PC_BG + 128 * h + e0) = pack8(yv); }
        }
        if (chunk_last(chunk)) { if (!dry) { const int seq = chunk_seq(chunk);
            if (SSD) { float* so = st_out(F, O_PS, O_SS, layer, seq, 8 * 64 * 128) + (size_t)h * 64 * 128;
#pragma unroll
                for (int x = 0; x < 4; ++x) { int smt, snt; la_mt_nt<SSD>(4 * w + x, smt, snt); *(f32x4*)(so + (size_t)(16 * snt + c) * 128 + 16 * smt + 4 * q) = S[x]; } }
            else { float* so = st_out(F, O_PG, O_SG, layer, seq, 4 * 64 * 128) + (size_t)h * 64 * 128;
#pragma unroll
                for (int x = 0; x < 4; ++x) { int smt, snt; la_mt_nt<SSD>(4 * w + x, smt, snt);
#pragma unroll
                    for (int r = 0; r < 4; ++r) so[(size_t)(16 * smt + 4 * q + r) * 128 + 16 * snt + c] = S[x][r]; } } }
        } else if (cc + 1 < nc) la_write_sb<SSD>(lds, S, w, lane);
        WG_BAR();
    }
}

template <bool PASS_C> DI void lru_chunk(const Ctx& F0, int layer, int chunk, bool dry = false) {
    Ctx F = F0; OPAQUE_CTX(F);
    const int h = F.wave, lane = F.lane, q = lane >> 4, c = lane & 15, row0 = 64 * chunk; const bool first = chunk_first(chunk);
    LAS unsigned char* T = F.lds + h * 9216; constexpr int TP = 144;
    bf16_t* proj = wsb(F, WS_R);
    {
        const int cc = lane & 7, rg = lane >> 3, ch = 64 * h + 8 * cc; float xr[11][8];
#pragma unroll
        for (int i = 0; i < 11; ++i) { const int tt = 8 * rg - 3 + i;
            if (tt >= 0 || !first) { const u32x4 v = *(const u32x4*)(proj + (size_t)(row0 + tt) * DINP + PC_AX + ch); unpack8(v, xr[i]); }
            else if (chunk >= 256) { const float* sp = F.in[I_SLC] + ((size_t)(layer * 8 + (chunk - 256)) * 3 + (tt + 3)) * 512 + ch; const f32x4 a = *(const f32x4*)sp, b = *(const f32x4*)(sp + 4);
                xr[i][0] = a.x; xr[i][1] = a.y; xr[i][2] = a.z; xr[i][3] = a.w; xr[i][4] = b.x; xr[i][5] = b.y; xr[i][6] = b.z; xr[i][7] = b.w; }
            else {
#pragma unroll
                for (int e = 0; e < 8; ++e) xr[i][e] = 0.f; }
        }
        const float* cwp = F.in[I_LCW] + (size_t)layer * 4 * 512 + ch; const float* cbp = F.in[I_LCB] + layer * 512 + ch;
        float wv[4][8], bv[8];
#pragma unroll
        for (int j = 0; j < 4; ++j) { const f32x4 a = *(const f32x4*)(cwp + j * 512), b = *(const f32x4*)(cwp + j * 512 + 4); wv[j][0] = a.x; wv[j][1] = a.y; wv[j][2] = a.z; wv[j][3] = a.w; wv[j][4] = b.x; wv[j][5] = b.y; wv[j][6] = b.z; wv[j][7] = b.w; }
        { const f32x4 a = *(const f32x4*)cbp, b = *(const f32x4*)(cbp + 4); bv[0] = a.x; bv[1] = a.y; bv[2] = a.z; bv[3] = a.w; bv[4] = b.x; bv[5] = b.y; bv[6] = b.z; bv[7] = b.w; }
#pragma unroll
        for (int r = 0; r < 8; ++r) { float o[8];
#pragma unroll
            for (int e = 0; e < 8; ++e) { float v = bv[e];
#pragma unroll
                for (int j = 0; j < 4; ++j) v += wv[j][e] * xr[r + j][e];
                o[e] = v; }
            *(LAS u32x4*)(T + (8 * rg + r) * TP + cc * 16) = pack8(o); }
    }
    LDS_WAIT();
    bf16x8 af[4][2];
#pragma unroll
    for (int mt = 0; mt < 4; ++mt)
#pragma unroll
        for (int ks = 0; ks < 2; ++ks) af[mt][ks] = frag_row(T, TP, 16 * mt, 32 * ks, lane);
    const bf16_t* wr_t = wsb(F, WS_LRUW) + (size_t)((layer * 2 + 0) * 8 + h) * 4096; const bf16_t* wi_t = wsb(F, WS_LRUW) + (size_t)((layer * 2 + 1) * 8 + h) * 4096;
#pragma unroll 1
    for (int nt = 0; nt < 4; ++nt) {
        bf16x8 br[2], bi[2];
#pragma unroll
        for (int ks = 0; ks < 2; ++ks) { const int o = (16 * nt + c) * 64 + 32 * ks + 8 * q; br[ks] = *(const bf16x8*)(wr_t + o); bi[ks] = *(const bf16x8*)(wi_t + o); }
        f32x4 ar[4], ai[4];
#pragma unroll
        for (int mt = 0; mt < 4; ++mt) { ar[mt] = (f32x4){0.f, 0.f, 0.f, 0.f}; ai[mt] = ar[mt];
#pragma unroll
            for (int ks = 0; ks < 2; ++ks) { ar[mt] = MFMA16(af[mt][ks], br[ks], ar[mt]); ai[mt] = MFMA16(af[mt][ks], bi[ks], ai[mt]); } }
        const int col = 64 * h + 16 * nt + c;
        const float b_r = F.in[I_LBR][layer * 512 + col], b_i = F.in[I_LBI][layer * 512 + col], c8 = -8.f * softplus_f(-F.in[I_LAM][layer * 512 + col]);
        float hc = 0.f, pc = 1.f;
        if (PASS_C) hc = chunk >= 256 ? F.in[I_SLH][(size_t)(layer * 8 + (chunk - 256)) * 512 + col] : wsf(F, WS_LRUS)[(size_t)(2 * NCH + chunk) * 512 + col];
#pragma unroll
        for (int mt = 0; mt < 4; ++mt) {
            float a[4], uu[4];
#pragma unroll
            for (int r = 0; r < 4; ++r) { const int t = 16 * mt + 4 * q + r; const float rg_ = sigm(ar[mt][r] + b_r), ig = sigm(ai[mt][r] + b_i), la = c8 * rg_;
                a[r] = __expf(la); uu[r] = sqrtf(fmaxf(1.f - a[r] * a[r], 0.f)) * ig * ld_bf16(T, TP, t, 16 * nt + c); }
            const float P = (a[0] * a[1]) * (a[2] * a[3]); const float Hl = ((uu[0] * a[1] + uu[1]) * a[2] + uu[2]) * a[3] + uu[3];
            float hrun = hc, my_in = 0.f;
#pragma unroll
            for (int qq = 0; qq < 4; ++qq) { const float Pq = __shfl(P, c + 16 * qq), Hq = __shfl(Hl, c + 16 * qq); if (qq == q) my_in = hrun; hrun = Pq * hrun + Hq; pc *= Pq; }
            hc = hrun;
            if (PASS_C) { float hh = my_in;
#pragma unroll
                for (int r = 0; r < 4; ++r) { hh = a[r] * hh + uu[r]; st_bf16(T, TP, 16 * mt + 4 * q + r, 16 * nt + c, hh); } }
        }
        if (!PASS_C) { if (q == 0) { wsf(F, WS_LRUS)[(size_t)chunk * 512 + col] = pc; wsf(F, WS_LRUS)[(size_t)(NCH + chunk) * 512 + col] = hc; } }
        else if (chunk_last(chunk) && q == 0 && !dry) st_out(F, O_PLH, O_SLH, layer, chunk_seq(chunk), 512)[col] = hc;
    }
    if (PASS_C) {
        LDS_WAIT();
        const int cc = lane & 7, rg = lane >> 3;
#pragma unroll
        for (int i = 0; i < 8; ++i) { const int t = rg + 8 * i; u32x4* gp = (u32x4*)(proj + (size_t)(row0 + t) * DINP + PC_AG + 64 * h + 8 * cc);
            float hv[8], gv[8]; unpack8(*(const LAS u32x4*)(T + t * TP + cc * 16), hv); unpack8(*gp, gv);
#pragma unroll
            for (int e = 0; e < 8; ++e) hv[e] *= gelu_t(gv[e]);
            if (!dry) *gp = pack8(hv); }
        if (chunk_last(chunk) && !dry) { float* so = st_out(F, O_PLC, O_SLC, layer, chunk_seq(chunk), 3 * 512);
#pragma unroll
            for (int i = 0; i < 3; ++i) so[i * 512 + 64 * h + lane] = bf2f(proj[(size_t)(row0 + 61 + i) * DINP + PC_AX + 64 * h + lane]); }
    }
    LDS_WAIT();
}

DI void phase_mixer_a(const Ctx& F, int layer) {
    for (int it = blockIdx.x; it < 1034; it += F.G) {
        if (it < 256) gla_pass_a(F, layer, it >> 2, it & 3);
        else if (it < 768) ssd_pass_a(F, layer, (it - 256) >> 3, (it - 256) & 7);
        else if (it < 1024) lru_chunk<false>(F, layer, it - 768);
        else { const int seq = it - 1024, lastrow = seq < 2 ? 8192 * (seq + 1) - 1 : MP + 64 * (seq - 1) - 1;
            float* so = st_out(F, O_PSC, O_SSC, layer, seq, 3 * 1024); const bf16_t* proj = wsb(F, WS_R);
            for (int e = F.tid; e < 3 * 1024; e += 512) so[e] = bf2f(proj[(size_t)(lastrow - 2 + (e >> 10)) * DINP + PC_XBC + (e & 1023)]); }
        __syncthreads();
    }
}
DI void phase_mixer_b(const Ctx& F, int layer, bool dry) {
    float* ds = wsf(F, WS_DS); const float* dec = wsf(F, WS_DEC);
    for (int e = blockIdx.x * 512 + F.tid; e < 2 * 12 * 8192; e += F.G * 512) {
        const int idx = e & 8191, hh = (e >> 13) % 12, b = e / (12 * 8192);
        const int ln = idx & 63, r = (idx >> 6) & 3, Tt = idx >> 8; const int a = 16 * (Tt >> 3) + 4 * (ln >> 4) + r;
        float v[32];
#pragma unroll
        for (int p = 0; p < 32; ++p) v[p] = ds[((size_t)(32 * b + p) * 12 + hh) * 8192 + idx];
        float S = 0.f;
#pragma unroll
        for (int p = 0; p < 32; ++p) { const int panel = 32 * b + p; const float dc = hh < 4 ? dec[(panel * 4 + hh) * 64 + a] : dec[64 * 4 * 64 + panel * 8 + (hh - 4)];
            if (!dry) ds[((size_t)panel * 12 + hh) * 8192 + idx] = S; S = dc * S + v[p]; }
    }
    {
        const int gw = blockIdx.x * NWAVES + F.wave; float* ls = wsf(F, WS_LRUS);
        if (gw < 1024) { const int b = gw >> 9, ch = gw & 511, l = F.lane; const int c0 = 128 * b + 2 * l;
            const float A0 = ls[(size_t)c0 * 512 + ch], H0 = ls[(size_t)(NCH + c0) * 512 + ch], A1 = ls[(size_t)(c0 + 1) * 512 + ch], H1 = ls[(size_t)(NCH + c0 + 1) * 512 + ch];
            float A = A1 * A0, H = A1 * H0 + H1;
#pragma unroll
            for (int o = 1; o < 64; o <<= 1) { const float Ap = __shfl_up(A, o), Hp = __shfl_up(H, o); if (l >= o) { H = A * Hp + H; A = A * Ap; } }
            float E = __shfl_up(H, 1); if (l == 0) E = 0.f;
            ls[(size_t)(2 * NCH + c0) * 512 + ch] = E; ls[(size_t)(2 * NCH + c0 + 1) * 512 + ch] = A0 * E + H0; }
    }
}
#ifndef MIX_MASK
#define MIX_MASK 7
#endif
DI void phase_mixer_c(const Ctx& F, int layer, bool dry) {
    for (int it = blockIdx.x; it < 1128; it += F.G) {
        if (it < 512) { if (MIX_MASK & 1) la_pass_c<true>(F, layer, 4 * (it >> 3), 4, it & 7, dry); }
        else if (it < 768) { if (MIX_MASK & 2) la_pass_c<false>(F, layer, 4 * ((it - 512) >> 2), 4, (it - 512) & 3, dry); }
        else if (it < 1032) { if (MIX_MASK & 4) lru_chunk<true>(F, layer, it - 768, dry); }
        else if (it < 1096) { if (MIX_MASK & 1) la_pass_c<true>(F, layer, 256 + ((it - 1032) >> 3), 1, (it - 1032) & 7, dry); }
        else { if (MIX_MASK & 2) la_pass_c<false>(F, layer, 256 + ((it - 1096) >> 2), 1, (it - 1096) & 3, dry); }
        __syncthreads();
    }
}
DI void phase_ssd_norm(const Ctx& F, int layer, bool dry) {
    const int gw = F.vcu * NWAVES + F.wave, NGW = F.G * NWAVES; bf16_t* proj = wsb(F, WS_R); const float* pss = wsf(F, WS_PSS);
    float gn[8]; { const float* gp = F.in[I_SNORM] + layer * 512 + 8 * F.lane; const f32x4 a = *(const f32x4*)gp, b = *(const f32x4*)(gp + 4); gn[0] = a.x; gn[1] = a.y; gn[2] = a.z; gn[3] = a.w; gn[4] = b.x; gn[5] = b.y; gn[6] = b.z; gn[7] = b.w; }
    for (int m = gw; m < M; m += NGW) {
        const f32x4* p = (const f32x4*)(pss + (size_t)m * 16); const f32x4 a = p[0], b = p[1], c = p[2], d = p[3];
        const float s = ((a.x + a.y) + (a.z + a.w)) + ((b.x + b.y) + (b.z + b.w)) + ((c.x + c.y) + (c.z + c.w)) + ((d.x + d.y) + (d.z + d.w));
        const float rstd = rsqrtf(s * (1.f / 512.f) + EPS);
        u32x4* yp = (u32x4*)(proj + (size_t)m * DINP + PC_CZ + 8 * F.lane); float v[8]; unpack8(*yp, v);
#pragma unroll
        for (int e = 0; e < 8; ++e) v[e] *= rstd * gn[e];
        *yp = pack8(v);
    }
}
DI void phase_final(const Ctx& F) {
    const int gw = F.vcu * NWAVES + F.wave, NGW = F.G * NWAVES; const float* rss = wsf(F, WS_RSSN) + (size_t)XB_PAD * 16; const float* gf = F.in[I_NFIN];
    for (int m = gw; m < M; m += NGW) { const float rs = row_rstd(rss, m); f32x4* x4 = (f32x4*)(F.out + (size_t)m * D) + F.lane;
#pragma unroll
        for (int j = 0; j < 4; ++j) { const f32x4 g = *((const f32x4*)gf + F.lane + 64 * j); x4[64 * j] = x4[64 * j] * rs * g; } }
}

constexpr int PH_PER_LAYER = 9, N_PHASES = 1 + DEPTH * PH_PER_LAYER + 1;
__global__ void __launch_bounds__(NWAVES * 64, 2) mk_fwd(Args args) {
    extern __shared__ __attribute__((aligned(16))) unsigned char lds_raw[];
    Ctx F; F.lds = (LAS unsigned char*)lds_raw; F.in = args.in; F.out = args.out; F.ws = args.ws;
    F.wave = __builtin_amdgcn_readfirstlane((int)threadIdx.x >> 6); F.lane = 0; F.tid = 0;
#define T0() (F.wave == 0 && lane_id() == 0)
    F.G = gridDim.x; { const int bx = blockIdx.x; F.vcu = (F.G % 8 == 0) ? (bx % 8) * (F.G / 8) + bx / 8 : bx; }
    volatile LAS unsigned* MISC = (volatile LAS unsigned*)(F.lds + MISC_OFF);
    if (F.wave == 0) MISC[lane_id()] = 0u;
    __syncthreads();
    XcdBarrier bar; bar.bar = (unsigned*)(args.ws + WS_CTL); bar.x = 0; bar.st = nullptr;
    if (args.use_bar) bar = xcd_barrier_post((unsigned*)(args.ws + WS_CTL), MISC + 8, T0());
    const int lo = args.ph_lo, hi = args.ph_hi;
#ifndef PH_MASK
#define PH_MASK 0xFFFFu
#endif
#define IN(k) (lo <= (k) && (k) < hi)
#define ON(b) ((PH_MASK >> (b)) & 1u)
#define SEAM(k) do { if (IN(k) && IN((k) + 1)) xcd_barrier(bar, T0()); } while (0)
#ifndef REP_MASK
#define REP_MASK 0
#endif
#define REPS(b) ((REP_MASK >> (b)) & 1)
#define XBAR() do { if (args.use_bar) xcd_barrier(bar, T0()); } while (0)
#define GP float* X = C.out; bf16_t* XB = wsb(C, WS_XB) + (size_t)XB_PAD * D; float* RSS = wsf(C, WS_RSS) + (size_t)XB_PAD * 16; bf16_t* XBN = wsb(C, WS_XBN); float* RSSN = wsf(C, WS_RSSN) + (size_t)XB_PAD * 16; \
    (void)X; (void)XB; (void)RSS; (void)XBN; (void)RSSN
#define PHC Ctx C = F; C.lane = lane_id(); C.tid = C.wave * 64 + C.lane; OPAQUE_CTX(C); { size_t zz_ = 0; asm volatile("" : "+s"(zz_)); C.ws = F.ws + zz_; C.out = (float*)((char*)F.out + zz_); }
    for (int rr_ = 0; rr_ <= REPS(0); ++rr_) { if (IN(0) && ON(0)) { PHC; convert_set(C, 0, 1 | 2 | 4 | 8 | 16 | 32 | 64 | 128, C.vcu, C.G); p0_rows(C); } if (rr_ < REPS(0)) XBAR(); }
    SEAM(0);
    for (int layer = 0; layer < DEPTH; ++layer) {
        const int pb = 1 + layer * PH_PER_LAYER;
        for (int rr_ = 0; rr_ <= REPS(1); ++rr_) { if (rr_) XBAR();
        if (IN(pb + 0) && ON(1)) { PHC; GP;
            pg8::Gemm g{XBN, wsb(C, WS_WIN), D, D, D}; pg8::StaticOrder S; S.init(M / 256, DINP / 256, C.G, (int)blockIdx.x, 0);
            EpiProj E{wsb(C, WS_R), RSSN}; pg8::gemm_phase<EpiProj, pg8::StaticOrder>(C.lds, g, S, E, C.wave);
        } }
        SEAM(pb + 0);
        for (int rr_ = 0; rr_ <= REPS(2); ++rr_) { if (rr_) XBAR(); if (IN(pb + 1) && ON(2)) { PHC; phase_mixer_a(C, layer); } }
        SEAM(pb + 1);
        for (int rr_ = 0; rr_ <= REPS(3); ++rr_) { if (rr_) XBAR();
        if (IN(pb + 2) && ON(3)) { PHC; phase_mixer_b(C, layer, rr_ < REPS(3));
            if (layer >= 1) convert_set(C, layer, 2, C.vcu, C.G); } }
        SEAM(pb + 2);
        for (int rr_ = 0; rr_ <= REPS(4); ++rr_) { if (rr_) XBAR(); if (IN(pb + 3) && ON(4)) { PHC; phase_mixer_c(C, layer, rr_ < REPS(4)); } }
        SEAM(pb + 3);
        for (int rr_ = 0; rr_ <= REPS(5); ++rr_) { if (rr_) XBAR(); if (IN(pb + 4) && ON(5)) { PHC; phase_ssd_norm(C, layer, rr_ < REPS(5)); } }
        SEAM(pb + 4);
        for (int rr_ = 0; rr_ <= REPS(6); ++rr_) { if (rr_) XBAR(); const bool dry_ = rr_ < REPS(6);
        if (IN(pb + 5) && ON(6)) { PHC; GP;
            pg8::Gemm g{wsb(C, WS_R) + PC_Y, wsb(C, WS_WOUT), DINP, DMIX, DMIX}; pg8::StaticOrder S; S.init(M / 256, D / 256, C.G, (int)blockIdx.x, 0);
            EpiRes E{layer == 0 ? C.in[I_XP] : X, layer == 0 ? C.in[I_XS] : X + (size_t)MP * D, X, XB, RSS, dry_};
            pg8::gemm_phase<EpiRes, pg8::StaticOrder>(C.lds, g, S, E, C.wave);
            if (!dry_ && C.G > 8 && (int)blockIdx.x >= 8) { __syncthreads();
                if (layer + 1 < DEPTH) convert_set(C, layer + 1, 1, (int)blockIdx.x - 8, C.G - 8);
                if (layer >= 1) convert_set(C, layer, 4 | 8 | 16 | 32 | 64, (int)blockIdx.x - 8, C.G - 8); }
        } }
        SEAM(pb + 5);
        for (int rr_ = 0; rr_ <= REPS(7); ++rr_) { if (rr_) XBAR();
        if (IN(pb + 6) && ON(7)) { PHC; GP;
            pg8::Gemm g{XB, wsb(C, WS_WGU), D, D, D}; pg8::StaticOrder S; S.init(67, 2 * DFF / 256, C.G, (int)blockIdx.x, 1);
            EpiFfn E{wsb(C, WS_R), RSS, C.in[I_FCW] + (size_t)layer * 3 * DFF, C.in[I_FCB] + layer * DFF, C.in[I_SFC] + (size_t)layer * 8 * 2 * DFF,
                     C.out + O_PFC + (size_t)layer * 2 * 2 * DFF, C.out + O_SFC + (size_t)layer * 8 * 2 * DFF};
            pg8::gemm_phase<EpiFfn, pg8::StaticOrder>(C.lds, g, S, E, C.wave);
        } }
        SEAM(pb + 6);
        for (int rr_ = 0; rr_ <= REPS(8); ++rr_) { if (rr_) XBAR(); const bool dry_ = rr_ < REPS(8);
        if (IN(pb + 7) && ON(8)) { PHC; GP;
            pg8::Gemm g{wsb(C, WS_R), wsb(C, WS_WD), DFF, DFF, DFF}; pg8::StaticOrder S; S.init(M / 256, D / 256, C.G, (int)blockIdx.x, 0);
            EpiRes E{X, X + (size_t)MP * D, X, XB, RSS, dry_}; pg8::gemm_phase<EpiRes, pg8::StaticOrder>(C.lds, g, S, E, C.wave);
            if (!dry_ && (C.G <= 8 || (int)blockIdx.x >= 8)) { const int sh = C.G > 8 ? 8 : 0;
                pg8::Gemm g2{wsb(C, WS_PB), wsb(C, WS_WPP), DPLE, DPLE, DPLE}; pg8::StaticOrder S2; S2.init(M / 256, D / 256, C.G - sh, (int)blockIdx.x - sh, 0);
                EpiPP E2{wsb(C, WS_PPO)}; pg8::gemm_phase<EpiPP, pg8::StaticOrder>(C.lds, g2, S2, E2, C.wave); }
        } }
        SEAM(pb + 7);
        for (int rr_ = 0; rr_ <= REPS(9); ++rr_) { if (rr_) XBAR(); const bool dry_ = rr_ < REPS(9);
        if (IN(pb + 8) && ON(9)) {
            { PHC; GP; pg8::Gemm g{XB, wsb(C, WS_WPG), D, D, D}; pg8::StaticOrder S; S.init(M / 256, D / 256, C.G, (int)blockIdx.x, 0);
              EpiPle E{X, X, XBN, RSS, RSSN, wsb(C, WS_PPO), dry_}; pg8::gemm_phase<EpiPle, pg8::StaticOrder>(C.lds, g, S, E, C.wave); }
        } }
        SEAM(pb + 8);
    }
    if (IN(N_PHASES - 1) && ON(10)) { PHC; phase_final(C); }
#undef IN
#undef ON
#undef SEAM
}

extern "C" void kernel_launch(void* const* d_in, const int* in_sizes, int n_in, void* d_out, int out_size, void* d_ws, size_t ws_size, hipStream_t stream) {
    static int grid = 0;
    if (grid == 0) {
        if (n_in != N_IN || (size_t)out_size != O_END || ws_size < WS_END) { fprintf(stderr, "kernel_launch: unexpected shapes: n_in %d out %d ws %zu (need %d, %zu, %zu)\n", n_in, out_size, ws_size, (int)N_IN, (size_t)O_END, (size_t)WS_END); grid = -1; return; }
        int dev = 0, cus = 0, per_cu = 0;
        if (hipGetDevice(&dev) != hipSuccess || hipDeviceGetAttribute(&cus, hipDeviceAttributeMultiprocessorCount, dev) != hipSuccess) { grid = -1; return; }
        if (hipFuncSetAttribute((const void*)mk_fwd, hipFuncAttributeMaxDynamicSharedMemorySize, LDS_BYTES) != hipSuccess) { fprintf(stderr, "kernel_launch: hipFuncSetAttribute failed\n"); grid = -1; return; }
        if (hipOccupancyMaxActiveBlocksPerMultiprocessor(&per_cu, (const void*)mk_fwd, NWAVES * 64, LDS_BYTES) != hipSuccess || per_cu < 1) { fprintf(stderr, "kernel_launch: occupancy query says %d\n", per_cu); per_cu = 1; }
        (void)hipGetLastError();
        grid = cus;
    }
    if (grid < 0) return;
    (void)hipMemsetAsync((char*)d_ws + WS_CTL, 0, CTL_ZERO_BYTES, stream);
    Args a{};
    for (int i = 0; i < N_IN; ++i) a.in[i] = (const float*)d_in[i];
    a.out = (float*)d_out; a.ws = (unsigned char*)d_ws;
#if MK_PER_PHASE
    for (int p = 0; p < N_PHASES; ++p) { a.ph_lo = p; a.ph_hi = p + 1; a.use_bar = 0; hipLaunchKernelGGL(mk_fwd, dim3(grid), dim3(NWAVES * 64), LDS_BYTES, stream, a); }
#else
    a.ph_lo = 0; a.ph_hi = N_PHASES; a.use_bar = 1;
    void* kargs[] = {&a};
    hipError_t e = hipLaunchCooperativeKernel((const void*)mk_fwd, dim3(grid), dim3(NWAVES * 64), kargs, LDS_BYTES, stream);
    if (e != hipSuccess) fprintf(stderr, "kernel_launch: cooperative launch failed: %s\n", hipGetErrorString(e));
#endif
}
```

```cpp
#include <hip/hip_runtime.h>
#include <cstdio>
#include <cstdint>

#define DI __device__ __forceinline__
#define LAS __attribute__((address_space(3)))
typedef unsigned short bf16_t;
typedef short bf16x8 __attribute__((ext_vector_type(8)));
typedef short s16x4 __attribute__((ext_vector_type(4)));
typedef float f32x4 __attribute__((ext_vector_type(4)));
typedef float f32x2 __attribute__((ext_vector_type(2)));
typedef unsigned u32x4 __attribute__((ext_vector_type(4)));
typedef unsigned u32x2 __attribute__((ext_vector_type(2)));

#ifndef MK_PER_PHASE
#define MK_PER_PHASE 0
#endif

constexpr int DEPTH = 2, D = 1024, MP = 16384, MS = 512, M = MP + MS;
constexpr int DIN = 4120, DINP = 4352, DFF = 3072, DMIX = 1536, DPLE = 256;
constexpr int NCH = M / 64;
constexpr float EPS = 1e-6f;
constexpr int PC_AX = 0, PC_BQ = 512, PC_BK = 768, PC_BV = 1024, PC_BLR = 1536, PC_XBC = 1552, PC_DT = 2576, PC_PAD = 2584, PC_Y = 2816, PC_AG = 2816, PC_BG = 3328, PC_CZ = 3840;

enum { I_XP = 0, I_XS, I_SLC, I_SLH, I_SG, I_SSC, I_SS, I_SFC, I_PP, I_PS, I_NMIX, I_WIN, I_LCW, I_LCB, I_LWR, I_LBR, I_LWI, I_LBI, I_LAM, I_GWLR, I_GBLR, I_GNORM,
       I_SCW, I_SCB, I_SDTB, I_SALOG, I_SD, I_SNORM, I_WOUT, I_NFFN, I_WG, I_WU, I_FCW, I_FCB, I_WD, I_NPLE, I_PWG, I_PWP, I_NFIN, N_IN };
constexpr size_t O_Y = 0;
constexpr size_t O_PLC = (size_t)M * D;
constexpr size_t O_PLH = O_PLC + 2 * 2 * 3 * 512;
constexpr size_t O_PG = O_PLH + 2 * 2 * 512;
constexpr size_t O_PSC = O_PG + 2 * 2 * 4 * 64 * 128;
constexpr size_t O_PS = O_PSC + 2 * 2 * 3 * 1024;
constexpr size_t O_PFC = O_PS + 2 * 2 * 8 * 64 * 128;
constexpr size_t O_SLC = O_PFC + 2 * 2 * 2 * 3072;
constexpr size_t O_SLH = O_SLC + 2 * 8 * 3 * 512;
constexpr size_t O_SG = O_SLH + 2 * 8 * 512;
constexpr size_t O_SSC = O_SG + 2 * 8 * 4 * 64 * 128;
constexpr size_t O_SS = O_SSC + 2 * 8 * 3 * 1024;
constexpr size_t O_SFC = O_SS + 2 * 8 * 8 * 64 * 128;
constexpr size_t O_END = O_SFC + 2 * 8 * 2 * 3072;

constexpr size_t MiB = 1u << 20;
constexpr size_t al4k(size_t x) { return (x + 4095) & ~(size_t)4095; }
constexpr int XB_PAD = 256;
constexpr int XB_ROWS = XB_PAD + M + 128;
constexpr size_t WS_CTL = 0, CTL_ZERO_BYTES = 64 * 1024;
constexpr size_t WS_WIN = al4k(WS_CTL + CTL_ZERO_BYTES);
constexpr size_t WS_WOUT = al4k(WS_WIN + (size_t)DINP * D * 2);
constexpr size_t WS_WGU = al4k(WS_WOUT + (size_t)D * DMIX * 2);
constexpr size_t WS_WD = al4k(WS_WGU + (size_t)2 * DFF * D * 2);
constexpr size_t WS_WPG = al4k(WS_WD + (size_t)D * DFF * 2);
constexpr size_t WS_WPP = al4k(WS_WPG + (size_t)D * D * 2);
constexpr size_t WS_LRUW = al4k(WS_WPP + (size_t)D * DPLE * 2);
constexpr size_t WS_RSS = al4k(WS_LRUW + (size_t)DEPTH * 2 * 8 * 4096 * 2);
constexpr size_t WS_RSSN = al4k(WS_RSS + (size_t)XB_ROWS * 64);
constexpr size_t WS_PSS = al4k(WS_RSSN + (size_t)XB_ROWS * 64);
constexpr size_t WS_LRUS = al4k(WS_PSS + (size_t)M * 64);
constexpr size_t WS_DEC = al4k(WS_LRUS + (size_t)3 * NCH * 512 * 4);
constexpr size_t WS_PB = al4k(WS_DEC + (size_t)(64 * 4 * 64 + 64 * 8) * 4);
constexpr size_t WS_XB = al4k(WS_PB + (size_t)M * DPLE * 2);
constexpr size_t WS_DS = al4k(WS_XB + (size_t)XB_ROWS * D * 2);
constexpr size_t WS_XBN = WS_DS;
constexpr size_t WS_R = al4k(WS_DS + (size_t)M * D * 2);
constexpr size_t WS_PPO = WS_R + 100 * MiB;
constexpr size_t WS_END = WS_R + (size_t)M * DINP * 2;
static_assert(WS_END <= 256 * MiB, "workspace");
static_assert((size_t)64 * 12 * 8192 * 4 <= (size_t)M * D * 2, "DS fits the XBN slot");
static_assert((size_t)M * DFF * 2 <= 100 * MiB && WS_PPO + (size_t)M * D * 2 <= WS_END, "overlay");

constexpr int MISC_OFF = 147456 + 4096;
DI float bf2f(bf16_t b) { return __uint_as_float(((unsigned)b) << 16); }
DI unsigned f2bf(float f) { unsigned u = __float_as_uint(f); return (u + 0x7fffu + ((u >> 16) & 1u)) >> 16; }
DI unsigned pk2(float lo, float hi) { return f2bf(lo) | (f2bf(hi) << 16); }
DI float sigm(float x) { return __builtin_amdgcn_rcpf(1.f + __expf(-x)); }
DI float silu_f(float x) { return x * __builtin_amdgcn_rcpf(1.f + __expf(-x)); }
DI float gelu_t(float x) { const float u = 1.5957691216f * (x + 0.044715f * x * x * x); return x * __builtin_amdgcn_rcpf(1.f + __expf(-u)); }
DI float softplus_f(float x) { return fmaxf(x, 0.f) + log1pf(__expf(-fabsf(x))); }
DI float logsig_f(float x) { return fminf(x, 0.f) - log1pf(__expf(-fabsf(x))); }
template <int CTRL> DI float dpp_ror(float x) { return __builtin_bit_cast(float, __builtin_amdgcn_update_dpp(0, __builtin_bit_cast(int, x), CTRL, 0xf, 0xf, false)); }
DI float log1p_small(float e) { return e < 0.01f ? e * (1.f - e * (0.5f - e * 0.33333334f)) : __logf(1.f + e); }
DI float softplus_fast(float x) { return fmaxf(x, 0.f) + log1p_small(__expf(-fabsf(x))); }
DI float logsig_fast(float x) { return fminf(x, 0.f) - __logf(1.f + __expf(-fabsf(x))); }
DI float wave_incl_scan(float v) {
#define DPPF(x, ctrl, rm, bc) __builtin_bit_cast(float, __builtin_amdgcn_update_dpp(0, __builtin_bit_cast(int, (x)), (ctrl), (rm), 0xf, (bc)))
    v += DPPF(v, 0x111, 0xf, true); v += DPPF(v, 0x112, 0xf, true); v += DPPF(v, 0x114, 0xf, true); v += DPPF(v, 0x118, 0xf, true);
    v += DPPF(v, 0x142, 0xa, false); v += DPPF(v, 0x143, 0xc, false);
#undef DPPF
    return v;
}
DI void unpack8(const u32x4 v, float (&o)[8]) {
#pragma unroll
    for (int i = 0; i < 4; ++i) { o[2 * i] = __uint_as_float(v[i] << 16); o[2 * i + 1] = __uint_as_float(v[i] & 0xffff0000u); }
}
DI u32x4 pack8(const float (&o)[8]) { u32x4 r; r.x = pk2(o[0], o[1]); r.y = pk2(o[2], o[3]); r.z = pk2(o[4], o[5]); r.w = pk2(o[6], o[7]); return r; }
DI int lane_id() { int l; asm volatile("v_mbcnt_lo_u32_b32 %0, -1, 0\n\tv_mbcnt_hi_u32_b32 %0, -1, %0" : "=v"(l)); return l; }
#define LDS_WAIT() asm volatile("s_waitcnt lgkmcnt(0)" ::: "memory")
#define VM_WAIT() asm volatile("s_waitcnt vmcnt(0)" ::: "memory")

namespace pg8 {
constexpr int BM = 256, BK = 64, HALF = 128, HTB = HALF * BK * 2, STAGE_BYTES = 8 * HTB, NXCD = 8, WGM = 8;
__host__ __device__ __forceinline__ int lds_byte(int r, int c) { const int st = (r >> 4) * 2 + (c >> 5), rr = r & 15, cc = c & 31, ob = rr * 64 + cc * 2; return st * 1024 + (ob ^ (((ob >> 9) & 1) << 5)); }
__host__ __device__ __forceinline__ void stage_rc(int b, int& R, int& C) { const int st = b / 1024, sb = b % 1024, swz = sb ^ (((sb >> 9) & 1) << 5); R = (st >> 1) * 16 + swz / 64; C = (st & 1) * 32 + (swz % 64) / 2; }
__host__ __device__ __forceinline__ int perm32(int rho) { const int n = rho >> 4, i = rho & 15; return 8 * (i >> 2) + 4 * n + (i & 3); }

struct Unit { int pm, pn, arow; };
struct Gemm { const bf16_t* A; const bf16_t* Bt; int lda, ldb, K; };

struct StaticOrder {
    int nM, nN, nwg, G, c, shifted;
    __device__ void init(int nM_, int nN_, int G_, int c_, int shifted_) { nM = nM_; nN = nN_; nwg = nM * nN; G = G_; c = c_; shifted = shifted_; }
    __device__ bool next(int i, Unit& u) const {
        const long L = (long)i * G + c; if (L >= nwg) return false;
        int wgid = (int)L; { const int q = nwg / NXCD, r = nwg % NXCD, xcd = wgid % NXCD, off = wgid / NXCD; wgid = (xcd < r ? xcd * (q + 1) : r * (q + 1) + (xcd - r) * q) + off; }
        const int nig = WGM * nN, gid = wgid / nig, fm = gid * WGM, gsz = (nM - fm) < WGM ? (nM - fm) : WGM;
        u.pm = fm + ((wgid % nig) % gsz); u.pn = (wgid % nig) / gsz; u.arow = shifted ? 254 * u.pm - 2 : 256 * u.pm; return true;
    }
};
typedef __bf16 bf16x2_t __attribute__((ext_vector_type(2)));
DI unsigned cvt_pk_bf16(float lo, float hi) { const f32x2 v = {lo, hi}; const bf16x2_t r = __builtin_convertvector(v, bf16x2_t); return __builtin_bit_cast(unsigned, r); }

template <class Epi, class Sched>
DI void gemm_phase(LAS unsigned char* lds, const Gemm g, const Sched& S, const Epi& E, int wid) {
    const int lane = lane_id(), tid = wid * 64 + lane, wr = wid >> 2, wc = wid & 3, fr = lane & 15, fq = lane >> 4;
    const int K = g.K, nt = K / BK;
    unsigned voffA[2], voffB[2];
#pragma unroll
    for (int i = 0; i < 2; ++i) { int R, C; stage_rc(tid * 16 + i * 8192, R, C); const int Rb = Epi::PERM ? ((R & ~31) + perm32(R & 31)) : R;
        voffA[i] = (unsigned)(R * g.lda + C) * 2u; voffB[i] = (unsigned)(Rb * g.ldb + C) * 2u; }
    const size_t kstep = (size_t)(BK * 2);
    const size_t hstepA = (size_t)HALF * g.lda * 2, hstepB = (size_t)HALF * g.ldb * 2;
    const unsigned ldsw = (unsigned)wid * 1024u;
    const int aoff = lds_byte(wr * 64 + fr, fq * 8), boff = lds_byte(wc * 32 + fr, fq * 8);
#define PG8_SA(b, h) (((b) * 2 + (h)) * HTB)
#define PG8_SB(b, h) ((4 + (b) * 2 + (h)) * HTB)
#define PG8_STAGE(bufoff, gbase, voff) do { _Pragma("unroll") for (int _i = 0; _i < 2; ++_i) \
        __builtin_amdgcn_global_load_lds((const unsigned*)((const char*)(gbase) + (voff)[_i]), (LAS unsigned*)(lds + (bufoff) + ldsw + _i * 8192), 16, 0, 0); } while (0)
#define PG8_LDA(dst, b, h) do { _Pragma("unroll") for (int m = 0; m < 4; ++m) _Pragma("unroll") for (int k = 0; k < 2; ++k) dst[m][k] = *(const LAS bf16x8*)(lds + PG8_SA(b, h) + aoff + m * 2048 + k * 1024); } while (0)
#define PG8_LDB(dst, b, h) do { _Pragma("unroll") for (int n = 0; n < 2; ++n) _Pragma("unroll") for (int k = 0; k < 2; ++k) dst[n][k] = *(const LAS bf16x8*)(lds + PG8_SB(b, h) + boff + n * 2048 + k * 1024); } while (0)
#define PG8_MMA(ai, bj, At, Bt) do { __builtin_amdgcn_s_setprio(1); _Pragma("unroll") for (int m = 0; m < 4; ++m) _Pragma("unroll") for (int n = 0; n < 2; ++n) _Pragma("unroll") for (int k = 0; k < 2; ++k) \
        acc[ai][bj][m][n] = __builtin_amdgcn_mfma_f32_16x16x32_bf16(Bt[n][k], At[m][k], acc[ai][bj][m][n], 0, 0, 0); __builtin_amdgcn_s_setprio(0); } while (0)
#define PG8_WAIT_V(n) asm volatile("s_waitcnt vmcnt(" #n ")" ::: "memory")
#define PG8_WAIT_L(n) asm volatile("s_waitcnt lgkmcnt(" #n ")" ::: "memory")
#define PG8_BAR __builtin_amdgcn_s_barrier()
#define PG8_SCHED __builtin_amdgcn_sched_barrier(0)
    Unit cur, nxt; int ui = 0;
    if (!S.next(0, cur)) return;
    f32x4 acc[2][2][4][2];
#pragma unroll
    for (int a = 0; a < 2; ++a)
#pragma unroll
        for (int b = 0; b < 2; ++b)
#pragma unroll
            for (int m = 0; m < 4; ++m)
#pragma unroll
                for (int n = 0; n < 2; ++n) acc[a][b][m][n] = (f32x4){0.f, 0.f, 0.f, 0.f};
    bf16x8 At[4][2], B0[2][2], B1[2][2];
    const char* cA = (const char*)g.A + (long)cur.arow * g.lda * 2; const char* cB = (const char*)g.Bt + (size_t)cur.pn * 256 * g.ldb * 2;
    PG8_STAGE(PG8_SB(0, 0), cB, voffB); PG8_STAGE(PG8_SB(0, 1), cB + hstepB, voffB); PG8_STAGE(PG8_SA(0, 0), cA, voffA); PG8_STAGE(PG8_SA(0, 1), cA + hstepA, voffA);
    if (wr == 1) PG8_BAR;
    PG8_WAIT_V(2); PG8_BAR;
    PG8_STAGE(PG8_SB(1, 0), cB + kstep, voffB); PG8_STAGE(PG8_SA(1, 0), cA + kstep, voffA); PG8_STAGE(PG8_SB(1, 1), cB + hstepB + kstep, voffB);
    PG8_WAIT_V(6); PG8_BAR;
    for (;;) {
        const bool has_next = S.next(ui + 1, nxt);
        const char* nA = has_next ? (const char*)g.A + (long)nxt.arow * g.lda * 2 : cA; const char* nB = has_next ? (const char*)g.Bt + (size_t)nxt.pn * 256 * g.ldb * 2 : cB;
#pragma unroll 1
        for (int t = 0; t < nt; t += 2) {
            const bool last = (t == nt - 2);
            const char* a1 = cA + (size_t)(t + 1) * kstep;
            const char* a2 = last ? nA : cA + (size_t)(t + 2) * kstep; const char* b2 = last ? nB : cB + (size_t)(t + 2) * kstep;
            const char* a3 = a2 + kstep; const char* b3 = b2 + kstep;
            PG8_LDB(B0, 0, 0); PG8_LDB(B1, 0, 1); PG8_SCHED; PG8_LDA(At, 0, 0); PG8_STAGE(PG8_SA(1, 1), a1 + hstepA, voffA);
            PG8_WAIT_V(8); PG8_WAIT_L(0); PG8_BAR; PG8_MMA(0, 0, At, B0); PG8_MMA(0, 1, At, B1); PG8_BAR; PG8_SCHED;
            PG8_LDA(At, 0, 1); PG8_STAGE(PG8_SB(0, 0), b2, voffB); PG8_STAGE(PG8_SB(0, 1), b2 + hstepB, voffB); PG8_STAGE(PG8_SA(0, 0), a2, voffA);
            PG8_WAIT_V(8); PG8_WAIT_L(0); PG8_BAR; PG8_MMA(1, 0, At, B0); PG8_MMA(1, 1, At, B1); PG8_BAR; PG8_SCHED;
            PG8_LDB(B0, 1, 0); PG8_LDB(B1, 1, 1); PG8_SCHED; PG8_LDA(At, 1, 0); PG8_STAGE(PG8_SA(0, 1), a2 + hstepA, voffA);
            PG8_WAIT_V(8); PG8_WAIT_L(0); PG8_BAR; PG8_MMA(0, 0, At, B0); PG8_MMA(0, 1, At, B1); PG8_BAR; PG8_SCHED;
            PG8_LDA(At, 1, 1); PG8_STAGE(PG8_SB(1, 0), b3, voffB); PG8_STAGE(PG8_SB(1, 1), b3 + hstepB, voffB); PG8_STAGE(PG8_SA(1, 0), a3, voffA);
            PG8_WAIT_V(8); PG8_WAIT_L(0); PG8_BAR; PG8_MMA(1, 0, At, B0); PG8_MMA(1, 1, At, B1); PG8_BAR; PG8_SCHED;
        }
        if (wr == 0) PG8_BAR;
        { const int l2 = lane_id(); E(acc, cur, wr, wc, l2 & 15, l2 >> 4, lds); }
        if (!has_next) break;
#pragma unroll
        for (int a = 0; a < 2; ++a)
#pragma unroll
            for (int b = 0; b < 2; ++b)
#pragma unroll
                for (int m = 0; m < 4; ++m)
#pragma unroll
                    for (int n = 0; n < 2; ++n) acc[a][b][m][n] = (f32x4){0.f, 0.f, 0.f, 0.f};
        cur = nxt; cA = nA; cB = nB; ++ui;
        if (wr == 1) PG8_BAR;
    }
    PG8_WAIT_V(0);
    PG8_BAR;
#undef PG8_SA
#undef PG8_SB
#undef PG8_STAGE
#undef PG8_LDA
#undef PG8_LDB
#undef PG8_MMA
#undef PG8_WAIT_V
#undef PG8_WAIT_L
#undef PG8_BAR
#undef PG8_SCHED
}
}

#define XB_TMO      128
#define XB_XCNT(j)  (256  + 64 * (j))
#define XB_XSUB(j)  (1280 + 64 * (j))
#define XB_XGEN(j)  (2304 + 64 * (j))
#define XB_TOP      3328
#define XB_TOPGEN   3392
#define XCD_BAR_WORDS 3456
#define XB_SPIN_CAP (1u << 18)
DI unsigned xb_ld(unsigned* p)              { return __hip_atomic_load(p, __ATOMIC_RELAXED, __HIP_MEMORY_SCOPE_AGENT); }
DI unsigned xb_add(unsigned* p, unsigned v) { return __hip_atomic_fetch_add(p, v, __ATOMIC_RELAXED, __HIP_MEMORY_SCOPE_AGENT); }
DI unsigned xb_xcc_id() { return (unsigned)__builtin_amdgcn_s_getreg((3 << 11) | 20) & 0xFu; }
#define XB_SPIN(cond, bar) do { unsigned _sp = 0; while (cond) { __builtin_amdgcn_s_sleep(1); \
    if ((++_sp & 255u) == 0u) { if (xb_ld(&(bar)[XB_TMO])) break; if (_sp > XB_SPIN_CAP) { atomicAdd(&(bar)[XB_TMO], 1u); break; } } } } while (0)
struct XcdBarrier { unsigned* bar; unsigned x; volatile LAS unsigned* st; };
DI XcdBarrier xcd_barrier_post(unsigned* bar, volatile LAS unsigned* st, bool t0) {
    XcdBarrier b; b.bar = bar; b.x = xb_xcc_id(); b.st = st;
    if (t0) (void)xb_add(&bar[XB_XCNT(b.x)], 1u);
    return b;
}
DI void xcd_barrier_complete(unsigned* bar, unsigned x, unsigned& nloc, unsigned& nx) {
    const unsigned G = gridDim.x * gridDim.y * gridDim.z;
    unsigned sum, cnt, mine, sp = 0u;
    for (;;) {
        sum = 0u; cnt = 0u; mine = 0u;
#pragma unroll
        for (unsigned j = 0; j < 16; ++j) { const unsigned c = xb_ld(&bar[XB_XCNT(j)]); sum += c; cnt += (c > 0u) ? 1u : 0u; mine = (j == x) ? c : mine; }
        if (sum == G) break;
        __builtin_amdgcn_s_sleep(1);
        if ((++sp & 255u) == 0u) { if (xb_ld(&bar[XB_TMO])) break; if (sp > XB_SPIN_CAP) { atomicAdd(&bar[XB_TMO], 1u); break; } }
    }
    nloc = mine > 0u ? mine : 1u; nx = cnt > 0u ? cnt : 1u;
}
DI void xcd_barrier(const XcdBarrier& b, bool t0) {
    asm volatile("s_waitcnt vmcnt(0)" ::: "memory");
    __syncthreads();
    if (t0) {
        unsigned* bar = b.bar;
        __builtin_amdgcn_s_waitcnt(0);
        unsigned nloc = b.st[0], nx = b.st[1];
        if (nloc == 0u) { xcd_barrier_complete(bar, b.x, nloc, nx); b.st[0] = nloc; b.st[1] = nx; }
        const unsigned old = xb_add(&bar[XB_XSUB(b.x)], 1u);
        const unsigned gen = old / nloc;
        if (old + 1u == (gen + 1u) * nloc) {
            __builtin_amdgcn_fence(__ATOMIC_RELEASE, "agent");
            asm volatile("s_waitcnt vmcnt(0)" ::: "memory");
            const unsigned og = xb_add(&bar[XB_TOP], 1u);
            const unsigned tg = og / nx;
            if (og + 1u == (tg + 1u) * nx) xb_add(&bar[XB_TOPGEN], 1u);
            else XB_SPIN(xb_ld(&bar[XB_TOPGEN]) == tg, bar);
            __builtin_amdgcn_fence(__ATOMIC_ACQUIRE, "agent");
            xb_add(&bar[XB_XGEN(b.x)], 1u);
            asm volatile("s_waitcnt vmcnt(0)" ::: "memory");
        } else {
            XB_SPIN(xb_ld(&bar[XB_XGEN(b.x)]) == gen, bar);
            __builtin_amdgcn_fence(__ATOMIC_ACQUIRE, "agent");
            asm volatile("s_waitcnt vmcnt(0)" ::: "memory");
        }
    }
    __syncthreads();
}

#ifndef PROBE_ID
#define PROBE_ID 0
#endif
#ifndef PROBE_WG
#define PROBE_WG 0
#endif
#ifndef PROBE_MULT
#define PROBE_MULT 8
#endif
constexpr int NWAVES = 8;
constexpr int RING_BYTES = 131072;
constexpr int MIX_LDS = 147456;
constexpr int XG_OFF = MIX_LDS;
static_assert(MISC_OFF == MIX_LDS + 4096, "LDS map");
constexpr int LDS_BYTES = 155648;

struct Args { const float* in[N_IN]; float* out; unsigned char* ws; int ph_lo, ph_hi, use_bar, pad; };

struct Ctx {
    LAS unsigned char* lds;
    const float* const* in; float* out; unsigned char* ws;
    int tid, lane, wave, G, vcu;
};
#define OPAQUE_CTX(C) do { asm volatile("" : "+v"((C).tid), "+v"((C).lane)); asm volatile("" : "+s"((C).wave), "+s"((C).vcu)); } while (0)
#define PB(id) do { if ((id) == PROBE_ID && PROBE_ID != 0 && (int)blockIdx.x == PROBE_WG && F.wave == 0 && lane_id() == 0) { volatile LAS unsigned* pw_ = (volatile LAS unsigned*)(F.lds + MISC_OFF); pw_[33] = (unsigned)__builtin_amdgcn_s_memrealtime(); } } while (0)
#define PE(id) do { if ((id) == PROBE_ID && PROBE_ID != 0 && (int)blockIdx.x == PROBE_WG && F.wave == 0 && lane_id() == 0) { volatile LAS unsigned* pw_ = (volatile LAS unsigned*)(F.lds + MISC_OFF); pw_[32] += (unsigned)__builtin_amdgcn_s_memrealtime() - pw_[33]; } } while (0)
DI bf16_t* wsb(const Ctx& F, size_t off) { return (bf16_t*)(F.ws + off); }
DI float* wsf(const Ctx& F, size_t off) { return (float*)(F.ws + off); }

DI bool chunk_first(int c) { return c == 0 || c == 128 || c >= 256; }
DI bool chunk_last(int c) { return c == 127 || c >= 255; }
DI int chunk_seq(int c) { return c < 128 ? 0 : (c < 256 ? 1 : c - 254); }
DI float* st_out(const Ctx& F, size_t offp, size_t offs, int layer, int seq, int per) {
    return seq < 2 ? F.out + offp + (size_t)(layer * 2 + seq) * per : F.out + offs + (size_t)(layer * 8 + (seq - 2)) * per;
}

DI float wave_sum(float v) {
#pragma unroll
    for (int o = 1; o < 64; o <<= 1) v += __shfl_xor(v, o);
    return v;
}
DI int win_dst(int n) {
    if (n < 512) return PC_AX + n;
    if (n < 1024) return PC_AG + (n - 512);
    if (n < 1280) return PC_BQ + (n - 1024);
    if (n < 1536) return PC_BK + (n - 1280);
    if (n < 2048) return PC_BV + (n - 1536);
    if (n < 2560) return PC_BG + (n - 2048);
    if (n < 2576) return PC_BLR + (n - 2560);
    if (n < 3088) return PC_CZ + (n - 2576);
    if (n < 4112) return PC_XBC + (n - 3088);
    return PC_DT + (n - 4112);
}
DI int map_row(int mode, int n) {
    if (mode == 1) return win_dst(n);
    if (mode == 2) return 256 * (n >> 7) + (n & 127);
    if (mode == 3) return 256 * (n >> 7) + 128 + (n & 127);
    return n;
}
constexpr int TR_PITCH = 68, TR_WAVE_BYTES = 64 * TR_PITCH * 4;
DI void tr_item(const float* W, int K, int N, bf16_t* WT, int mode, const float* g, LAS float* scr, int item, int lane) {
    const int nblk = (N + 63) / 64, kb = item / nblk, nb = item % nblk, k0 = 64 * kb, n0 = 64 * nb;
    const int c4 = (lane & 15) * 4, kr = lane >> 4;
#pragma unroll 8
    for (int i = 0; i < 16; ++i) { const int kk = 4 * i + kr, n = n0 + c4; f32x4 v = {0.f, 0.f, 0.f, 0.f}; if (n < N) v = *(const f32x4*)(W + (size_t)(k0 + kk) * N + n);
        if (g) v *= g[k0 + kk]; *(LAS f32x4*)(scr + kk * TR_PITCH + c4) = v; }
    LDS_WAIT();
    const int c = lane & 7;
#pragma unroll
    for (int j = 0; j < 8; ++j) { const int n = (lane >> 3) + 8 * j; const LAS float* s = scr + (8 * c) * TR_PITCH + n;
        u32x4 o; o.x = pk2(s[0 * TR_PITCH], s[1 * TR_PITCH]); o.y = pk2(s[2 * TR_PITCH], s[3 * TR_PITCH]); o.z = pk2(s[4 * TR_PITCH], s[5 * TR_PITCH]); o.w = pk2(s[6 * TR_PITCH], s[7 * TR_PITCH]);
        if (n0 + n < N) *(u32x4*)(WT + (size_t)map_row(mode, n0 + n) * K + k0 + 8 * c) = o; }
    LDS_WAIT();
}
DI void convert_set(const Ctx& F, int layer, int which, int wgi, int nwg) {
    LAS float* scr = (LAS float*)(F.lds + F.wave * TR_WAVE_BYTES);
    const int gw = wgi * NWAVES + F.wave, NGW = nwg * NWAVES;
    int base = 0;
#define CONV_MAT(cond, Wp, K_, N_, WTp, mode_, gp) if (cond) { const int ni = ((K_) / 64) * (((N_) + 63) / 64); \
        for (int it = gw - base; it < ni; it += NGW) { if (it >= 0) tr_item(Wp, K_, N_, WTp, mode_, gp, scr, it, F.lane); } base = (base + ni) % NGW; }
    CONV_MAT(which & 1, F.in[I_WIN] + (size_t)layer * D * DIN, D, DIN, wsb(F, WS_WIN), 1, F.in[I_NMIX] + layer * D)
    CONV_MAT(which & 2, F.in[I_WOUT] + (size_t)layer * DMIX * D, DMIX, D, wsb(F, WS_WOUT), 0, (const float*)nullptr)
    CONV_MAT(which & 4, F.in[I_WG] + (size_t)layer * D * DFF, D, DFF, wsb(F, WS_WGU), 2, F.in[I_NFFN] + layer * D)
    CONV_MAT(which & 4, F.in[I_WU] + (size_t)layer * D * DFF, D, DFF, wsb(F, WS_WGU), 3, F.in[I_NFFN] + layer * D)
    CONV_MAT(which & 8, F.in[I_WD] + (size_t)layer * DFF * D, DFF, D, wsb(F, WS_WD), 0, (const float*)nullptr)
    CONV_MAT(which & 16, F.in[I_PWG] + (size_t)layer * D * D, D, D, wsb(F, WS_WPG), 0, F.in[I_NPLE] + layer * D)
    CONV_MAT(which & 32, F.in[I_PWP] + (size_t)layer * DPLE * D, DPLE, D, wsb(F, WS_WPP), 0, (const float*)nullptr)
    if (which & 128) {
        for (int it = gw; it < DEPTH * 2 * 8; it += NGW) { const int mat = it, l = mat >> 4, ri = (mat >> 3) & 1, h = mat & 7;
            tr_item(F.in[ri ? I_LWI : I_LWR] + (size_t)(l * 8 + h) * 4096, 64, 64, wsb(F, WS_LRUW) + (size_t)((l * 2 + ri) * 8 + h) * 4096, 0, nullptr, scr, 0, F.lane); }
    }
#undef CONV_MAT
    if (which & 1) {
        u32x4* z = (u32x4*)(wsb(F, WS_WIN) + (size_t)PC_PAD * D); const int n16 = (PC_Y - PC_PAD) * D * 2 / 16;
        u32x4 zv = (u32x4){0u, 0u, 0u, 0u}; asm volatile("" : "+v"(zv));
        for (int i = wgi * 512 + F.tid; i < n16; i += nwg * 512) z[i] = zv;
    }
    if (which & 64) {
        const float* pp = F.in[I_PP] + (size_t)layer * MP * DPLE; const float* ps = F.in[I_PS] + (size_t)layer * MS * DPLE; bf16_t* pb = wsb(F, WS_PB);
        const int n8 = M * DPLE / 8;
        for (int i = wgi * 512 + F.tid; i < n8; i += nwg * 512) { const size_t e = (size_t)i * 8; const float* src = e < (size_t)MP * DPLE ? pp + e : ps + (e - (size_t)MP * DPLE);
            const f32x4 a = *(const f32x4*)src, b = *(const f32x4*)(src + 4); u32x4 o; o.x = pk2(a.x, a.y); o.y = pk2(a.z, a.w); o.z = pk2(b.x, b.y); o.w = pk2(b.z, b.w); *(u32x4*)(pb + e) = o; }
    }
}
DI void p0_rows(const Ctx& F) {
    const int gw = F.vcu * NWAVES + F.wave, NGW = F.G * NWAVES;
    bf16_t* xb = (bf16_t*)F.out; float* rss = wsf(F, WS_RSSN) + (size_t)XB_PAD * 16;
    for (int m0 = gw; m0 < M; m0 += 2 * NGW) {
        f32x4 v[2][4]; float s[2];
#pragma unroll
        for (int k = 0; k < 2; ++k) { const int m = m0 + k * NGW < M ? m0 + k * NGW : m0; const float* xr = m < MP ? F.in[I_XP] + (size_t)m * D : F.in[I_XS] + (size_t)(m - MP) * D; const f32x4* x4 = (const f32x4*)xr + F.lane;
#pragma unroll
            for (int j = 0; j < 4; ++j) v[k][j] = x4[64 * j]; }
#pragma unroll
        for (int k = 0; k < 2; ++k) { const int m = m0 + k * NGW; if (m >= M) break; float ss = 0.f;
#pragma unroll
            for (int j = 0; j < 4; ++j) ss += (v[k][j].x * v[k][j].x + v[k][j].y * v[k][j].y) + (v[k][j].z * v[k][j].z + v[k][j].w * v[k][j].w);
            s[k] = wave_sum(ss);
            u32x2* o8 = (u32x2*)(xb + (size_t)m * D) + F.lane;
#pragma unroll
            for (int j = 0; j < 4; ++j) { u32x2 w; w.x = pk2(v[k][j].x, v[k][j].y); w.y = pk2(v[k][j].z, v[k][j].w); o8[64 * j] = w; }
            if (F.lane < 16) rss[(size_t)m * 16 + F.lane] = F.lane == 0 ? s[k] : 0.f; }
    }
}

#define PBE(id, lds_, pred_) do { if ((id) == PROBE_ID && PROBE_ID != 0 && (int)blockIdx.x == PROBE_WG && (pred_)) { volatile LAS unsigned* pw_ = (volatile LAS unsigned*)((lds_) + MISC_OFF); pw_[33] = (unsigned)__builtin_amdgcn_s_memrealtime(); } } while (0)
#define PEE(id, lds_, pred_) do { if ((id) == PROBE_ID && PROBE_ID != 0 && (int)blockIdx.x == PROBE_WG && (pred_)) { volatile LAS unsigned* pw_ = (volatile LAS unsigned*)((lds_) + MISC_OFF); pw_[32] += (unsigned)__builtin_amdgcn_s_memrealtime() - pw_[33]; } } while (0)
DI float row_rstd(const float* rss, long row) {
    const f32x4* p = (const f32x4*)(rss + row * 16); const f32x4 a = p[0], b = p[1], c = p[2], d = p[3];
    const float s = ((a.x + a.y) + (a.z + a.w)) + ((b.x + b.y) + (b.z + b.w)) + ((c.x + c.y) + (c.z + c.w)) + ((d.x + d.y) + (d.z + d.w));
    return rsqrtf(fmaxf(s, 0.f) * (1.f / D) + EPS);
}
DI float row_rstd_q(const float* rss, long row, int fq) {
    const f32x4 a = *(const f32x4*)(rss + row * 16 + 4 * fq); float s = (a.x + a.y) + (a.z + a.w);
    s += __shfl_xor(s, 16); s += __shfl_xor(s, 32);
    return rsqrtf(fmaxf(s, 0.f) * (1.f / D) + EPS);
}
struct EpiProj {
    static constexpr bool PERM = true;
    bf16_t* O; const float* rss;
    DI void operator()(const f32x4 (&acc)[2][2][4][2], const pg8::Unit& u, int wr, int wc, int fr_, int fq_, LAS unsigned char*) const {
        int fr = fr_, fq = fq_; asm volatile("" : "+v"(fr), "+v"(fq));
        const int row0 = u.arow + wr * 64 + fr, col0 = u.pn * 256 + wc * 32 + 8 * fq;
#pragma unroll
        for (int ai = 0; ai < 2; ++ai)
#pragma unroll
            for (int m = 0; m < 4; ++m) { const int r = row0 + ai * 128 + m * 16; const float rs = row_rstd_q(rss, r, fq); bf16_t* rowp = O + (size_t)r * DINP + col0;
#pragma unroll
                for (int bj = 0; bj < 2; ++bj) { const f32x4 v0 = acc[ai][bj][m][0] * rs, v1 = acc[ai][bj][m][1] * rs;
                    u32x4 w; w.x = pg8::cvt_pk_bf16(v0[0], v0[1]); w.y = pg8::cvt_pk_bf16(v0[2], v0[3]); w.z = pg8::cvt_pk_bf16(v1[0], v1[1]); w.w = pg8::cvt_pk_bf16(v1[2], v1[3]);
                    *(u32x4*)(rowp + bj * 128) = w; } }
    }
};
struct EpiRes {
    static constexpr bool PERM = false;
    const bf16_t* xs; bf16_t* xb; float* rss; bool dry;
    DI void operator()(const f32x4 (&acc)[2][2][4][2], const pg8::Unit& u, int wr, int wc, int fr_, int fq_, LAS unsigned char*) const {
        int fr = fr_, fq = fq_; asm volatile("" : "+v"(fr), "+v"(fq));
        const int row0 = u.arow + wr * 64 + fr, col0 = u.pn * 256 + wc * 32 + 4 * fq;
#pragma unroll
        for (int ai = 0; ai < 2; ++ai)
#pragma unroll
            for (int m = 0; m < 4; ++m) { const int r = row0 + ai * 128 + m * 16; const size_t off = (size_t)r * D + col0;
                float ss = 0.f;
#pragma unroll
                for (int bj = 0; bj < 2; ++bj)
#pragma unroll
                    for (int n = 0; n < 2; ++n) { const int co = bj * 128 + n * 16; const u32x2 xw = *(const u32x2*)(xs + off + co);
                        f32x4 xn = acc[ai][bj][m][n]; xn[0] += __uint_as_float(xw.x << 16); xn[1] += __uint_as_float(xw.x & 0xffff0000u); xn[2] += __uint_as_float(xw.y << 16); xn[3] += __uint_as_float(xw.y & 0xffff0000u);
                        u32x2 w; w.x = pg8::cvt_pk_bf16(xn[0], xn[1]); w.y = pg8::cvt_pk_bf16(xn[2], xn[3]); if (!dry) *(u32x2*)(xb + off + co) = w;
                        ss += (xn[0] * xn[0] + xn[1] * xn[1]) + (xn[2] * xn[2] + xn[3] * xn[3]); }
                ss += __shfl_xor(ss, 16); ss += __shfl_xor(ss, 32);
                if (fq == 0 && !dry) rss[(size_t)r * 16 + u.pn * 4 + wc] = ss;
                asm volatile("" ::: "memory"); }
    }
};
struct EpiPle {
    static constexpr bool PERM = false;
    const bf16_t* xs; bf16_t* xb; const float* rss_in; float* rss_out; const bf16_t* pp; bool dry;
    DI void operator()(const f32x4 (&acc)[2][2][4][2], const pg8::Unit& u, int wr, int wc, int fr_, int fq_, LAS unsigned char*) const {
        int fr = fr_, fq = fq_; asm volatile("" : "+v"(fr), "+v"(fq));
        const int row0 = u.arow + wr * 64 + fr, col0 = u.pn * 256 + wc * 32 + 4 * fq;
#pragma unroll
        for (int ai = 0; ai < 2; ++ai)
#pragma unroll
            for (int m = 0; m < 4; ++m) { const int r = row0 + ai * 128 + m * 16; const size_t off = (size_t)r * D + col0;
                const float rs = row_rstd_q(rss_in, r, fq); float ss = 0.f;
#pragma unroll
                for (int bj = 0; bj < 2; ++bj)
#pragma unroll
                    for (int n = 0; n < 2; ++n) { const int co = bj * 128 + n * 16; const f32x4 f = acc[ai][bj][m][n];
                        const u32x2 pw = *(const u32x2*)(pp + off + co), xw = *(const u32x2*)(xs + off + co);
                        f32x4 xn;
                        xn[0] = __uint_as_float(xw.x << 16) + sigm(f[0] * rs) * __uint_as_float(pw.x << 16); xn[1] = __uint_as_float(xw.x & 0xffff0000u) + sigm(f[1] * rs) * __uint_as_float(pw.x & 0xffff0000u);
                        xn[2] = __uint_as_float(xw.y << 16) + sigm(f[2] * rs) * __uint_as_float(pw.y << 16); xn[3] = __uint_as_float(xw.y & 0xffff0000u) + sigm(f[3] * rs) * __uint_as_float(pw.y & 0xffff0000u);
                        u32x2 w; w.x = pg8::cvt_pk_bf16(xn[0], xn[1]); w.y = pg8::cvt_pk_bf16(xn[2], xn[3]); if (!dry) *(u32x2*)(xb + off + co) = w;
                        ss += (xn[0] * xn[0] + xn[1] * xn[1]) + (xn[2] * xn[2] + xn[3] * xn[3]); }
                ss += __shfl_xor(ss, 16); ss += __shfl_xor(ss, 32);
                if (fq == 0 && !dry) rss_out[(size_t)r * 16 + u.pn * 4 + wc] = ss;
                asm volatile("" ::: "memory"); }
    }
};
struct EpiPP {
    static constexpr bool PERM = false;
    bf16_t* pp;
    DI void operator()(const f32x4 (&acc)[2][2][4][2], const pg8::Unit& u, int wr, int wc, int fr_, int fq_, LAS unsigned char*) const {
        int fr = fr_, fq = fq_; asm volatile("" : "+v"(fr), "+v"(fq));
        const int row0 = u.arow + wr * 64 + fr, col0 = u.pn * 256 + wc * 32 + 4 * fq;
#pragma unroll
        for (int ai = 0; ai < 2; ++ai)
#pragma unroll
            for (int m = 0; m < 4; ++m) { const size_t off = (size_t)(row0 + ai * 128 + m * 16) * D + col0;
#pragma unroll
                for (int bj = 0; bj < 2; ++bj)
#pragma unroll
                    for (int n = 0; n < 2; ++n) { const f32x4 f = acc[ai][bj][m][n]; u32x2 w; w.x = pg8::cvt_pk_bf16(f[0], f[1]); w.y = pg8::cvt_pk_bf16(f[2], f[3]); *(u32x2*)(pp + off + bj * 128 + n * 16) = w; } }
    }
};
struct EpiFfn {
    static constexpr bool PERM = true;
    bf16_t* H; const float* rss; const float* cw; const float* cb; const float* st_in; float* st_p; float* st_s;
    DI void operator()(f32x4 (&acc)[2][2][4][2], const pg8::Unit& u, int wr, int wc, int fr_, int fq_, LAS unsigned char* lds) const {
        int fr = fr_, fq = fq_; asm volatile("" : "+v"(fr), "+v"(fq));
        const int lane = fr + 16 * fq;
        const bool p0_ = (wr == 0 && wc == 0 && lane == 0);
        PBE(41, lds, p0_); PBE(42, lds, p0_);
        const int gc0 = u.pn * 128 + wc * 32 + 8 * fq;
        LAS float* XG = (LAS float*)(lds + XG_OFF);
#pragma unroll
        for (int ai = 0; ai < 2; ++ai)
#pragma unroll
            for (int m = 0; m < 4; ++m) { const float rs = row_rstd_q(rss, (long)u.arow + ai * 128 + wr * 64 + m * 16 + fr, fq);
#pragma unroll
                for (int bj = 0; bj < 2; ++bj)
#pragma unroll
                    for (int n = 0; n < 2; ++n) acc[ai][bj][m][n] *= rs;
                asm volatile("" : "+v"(acc[ai][0][m][0]), "+v"(acc[ai][0][m][1]), "+v"(acc[ai][1][m][0]), "+v"(acc[ai][1][m][1]) :: "memory"); }
        if (fr >= 14) {
#pragma unroll
            for (int ai = 0; ai < 2; ++ai)
#pragma unroll
                for (int n = 0; n < 2; ++n) *(LAS f32x4*)(XG + ((2 * ai + wr) * 2 + (fr - 14)) * 128 + wc * 32 + 8 * fq + 4 * n) = acc[ai][0][3][n];
        }
        LDS_WAIT(); __builtin_amdgcn_s_barrier(); asm volatile("" ::: "memory");
        PEE(42, lds, p0_); PBE(43, lds, p0_);
#pragma unroll
        for (int n = 0; n < 2; ++n) {
            const int gc = gc0 + 4 * n;
            const f32x4 w0 = *(const f32x4*)(cw + gc), w1 = *(const f32x4*)(cw + DFF + gc), w2 = *(const f32x4*)(cw + 2 * DFF + gc), bb = *(const f32x4*)(cb + gc);
#pragma unroll
            for (int ai = 0; ai < 2; ++ai) {
                f32x4 pr1, pr2;
                const int pb = 2 * ai + wr - 1;
                if (pb >= 0) { pr1 = *(const LAS f32x4*)(XG + (pb * 2 + 1) * 128 + wc * 32 + 8 * fq + 4 * n);
                               pr2 = *(const LAS f32x4*)(XG + (pb * 2 + (fr & 1)) * 128 + wc * 32 + 8 * fq + 4 * n); }
                else { pr1 = (f32x4){0.f, 0.f, 0.f, 0.f}; pr2 = pr1; }
#pragma unroll
                for (int m = 0; m < 4; ++m) {
                    const int j = ai * 128 + wr * 64 + m * 16 + fr; const long r = (long)u.arow + j;
                    int t, seq; if (r < MP) { t = (int)r & 8191; seq = (int)(r >> 13); } else { t = (int)(r - MP) & 63; seq = 2 + (int)((r - MP) >> 6); }
                    const int T = r < MP ? 8192 : 64;
                    const bool valid = j >= 2 && r < M;
                    const f32x4 cur = acc[ai][0][m][n]; f32x4 r1, r2;
#pragma unroll
                    for (int i = 0; i < 4; ++i) { r1[i] = dpp_ror<0x121>(cur[i]); r2[i] = dpp_ror<0x122>(cur[i]); }
                    f32x4 p1 = fr >= 1 ? r1 : pr1, p2 = fr >= 2 ? r2 : pr2;
                    pr1 = r1; pr2 = r2;
                    if (valid && t < 2) {
                        const f32x4 z = (f32x4){0.f, 0.f, 0.f, 0.f}; f32x4 s0 = z, s1 = z;
                        if (seq >= 2) { const float* sp = st_in + (size_t)(seq - 2) * 2 * DFF + gc; s0 = *(const f32x4*)sp; s1 = *(const f32x4*)(sp + DFF); }
                        if (t == 0) { p1 = s1; p2 = s0; } else { p2 = s1; }
                    }
                    const f32x4 gpre = bb + w0 * p2 + w1 * p1 + w2 * cur; const f32x4 up = acc[ai][1][m][n];
                    const float h0 = gelu_t(gpre[0]) * up[0], h1 = gelu_t(gpre[1]) * up[1], h2 = gelu_t(gpre[2]) * up[2], h3 = gelu_t(gpre[3]) * up[3];
                    if (valid) { u32x2 hw; hw.x = pg8::cvt_pk_bf16(h0, h1); hw.y = pg8::cvt_pk_bf16(h2, h3); *(u32x2*)(H + (size_t)r * DFF + gc) = hw;
                        if (t >= T - 2) { float* so = (seq < 2 ? st_p + (size_t)seq * 2 * DFF : st_s + (size_t)(seq - 2) * 2 * DFF) + (size_t)(t - (T - 2)) * DFF + gc; *(f32x4*)so = cur; } }
                    if (m == 3) asm volatile("" ::: "memory");
                }
            }
        }
        PEE(43, lds, p0_); PEE(41, lds, p0_);
    }
};

struct OneUnit { int pm, pn; bool on;
    __device__ bool next(int i, pg8::Unit& u) const { if (i != 0 || !on) return false; u.pm = pm; u.pn = pn; u.arow = 256 * pm; return true; } };
struct EpiPart {
    static constexpr bool PERM = false;
    float* base;
    DI void operator()(const f32x4 (&acc)[2][2][4][2], const pg8::Unit&, int wr, int wc, int fr_, int fq_, LAS unsigned char*) const {
        int fr = fr_, fq = fq_; asm volatile("" : "+v"(fr), "+v"(fq));
#pragma unroll
        for (int ai = 0; ai < 2; ++ai)
#pragma unroll
            for (int m = 0; m < 4; ++m) { float* rowp = base + (size_t)(ai * 128 + wr * 64 + m * 16 + fr) * 256 + wc * 32 + 4 * fq;
#pragma unroll
                for (int bj = 0; bj < 2; ++bj)
#pragma unroll
                    for (int n = 0; n < 2; ++n) *(f32x4*)(rowp + bj * 128 + n * 16) = acc[ai][bj][m][n]; }
    }
};
template <int MODE> DI void reduce_tail(const Ctx& F, const float* part, int S, const bf16_t* xs, bf16_t* xb, const float* rss_in, float* rss_out, const bf16_t* pp) {
    for (int t = blockIdx.x; t < 256; t += F.G) { const int j = t >> 5, rl = 8 * (t & 31) + F.wave, pm = 64 + (j >> 2), pn = j & 3; const int r = 256 * pm + rl, col = 256 * pn + 4 * F.lane;
        f32x4 sum = {0.f, 0.f, 0.f, 0.f};
        for (int sl = 0; sl < S; ++sl) sum += *(const f32x4*)(part + ((size_t)(j * S + sl) * 256 + rl) * 256 + 4 * F.lane);
        const size_t off = (size_t)r * D + col; const u32x2 xw = *(const u32x2*)(xs + off);
        f32x4 xn; xn[0] = __uint_as_float(xw.x << 16); xn[1] = __uint_as_float(xw.x & 0xffff0000u); xn[2] = __uint_as_float(xw.y << 16); xn[3] = __uint_as_float(xw.y & 0xffff0000u);
        if (MODE == 0) xn += sum;
        else { const float rs = row_rstd(rss_in, r); const u32x2 pw = *(const u32x2*)(pp + off);
            xn[0] += sigm(sum[0] * rs) * __uint_as_float(pw.x << 16); xn[1] += sigm(sum[1] * rs) * __uint_as_float(pw.x & 0xffff0000u);
            xn[2] += sigm(sum[2] * rs) * __uint_as_float(pw.y << 16); xn[3] += sigm(sum[3] * rs) * __uint_as_float(pw.y & 0xffff0000u); }
        u32x2 w; w.x = pg8::cvt_pk_bf16(xn[0], xn[1]); w.y = pg8::cvt_pk_bf16(xn[2], xn[3]); *(u32x2*)(xb + off) = w;
        float ss = (xn[0] * xn[0] + xn[1] * xn[1]) + (xn[2] * xn[2] + xn[3] * xn[3]);
        ss += __shfl_xor(ss, 1); ss += __shfl_xor(ss, 2); ss += __shfl_xor(ss, 4); ss += __shfl_xor(ss, 8);
        if ((F.lane & 15) == 0) rss_out[(size_t)r * 16 + pn * 4 + (F.lane >> 4)] = ss;
    }
}

DI bf16x8 frag_row(const LAS unsigned char* img, int pitch, int row0, int k0, int lane) {
    return *(const LAS bf16x8*)(img + (row0 + (lane & 15)) * pitch + (k0 + 8 * (lane >> 4)) * 2);
}
DI bf16x8 frag_tr(const LAS unsigned char* img, int pitch, int k0, int n0, int lane) {
    const int g = lane >> 4, i = lane & 15, q = i >> 2, p = i & 3;
    const LAS unsigned char* a = img + (k0 + 8 * g + q) * pitch + (n0 + 4 * p) * 2;
    const s16x4 lo = __builtin_amdgcn_ds_read_tr16_b64_v4i16((LAS s16x4*)a);
    const s16x4 hi = __builtin_amdgcn_ds_read_tr16_b64_v4i16((LAS s16x4*)(a + 4 * pitch));
    return __builtin_shufflevector(lo, hi, 0, 1, 2, 3, 4, 5, 6, 7);
}
#define MFMA16(a, b, c) __builtin_amdgcn_mfma_f32_16x16x32_bf16((a), (b), (c), 0, 0, 0)
DI void st_bf16(LAS unsigned char* img, int pitch, int row, int col, float v) { *(LAS bf16_t*)(img + row * pitch + col * 2) = (bf16_t)f2bf(v); }
DI float ld_bf16(const LAS unsigned char* img, int pitch, int row, int col) { return bf2f(*(const LAS bf16_t*)(img + row * pitch + col * 2)); }

#define WG_BAR() do { asm volatile("s_waitcnt lgkmcnt(0)" ::: "memory"); __builtin_amdgcn_s_barrier(); asm volatile("" ::: "memory"); } while (0)
template <bool SSD> struct LAT {
    static constexpr int DA = SSD ? 128 : 64, DB = SSD ? 64 : 128;
    static constexpr int PA = (DA + 8) * 2, PV = (DB + 8) * 2, PPI = 144, PS = (DB + 8) * 2, POT = (DB + 4) * 4;
    static constexpr int O_QD = 0, O_KI = O_QD + 64 * PA, O_VV = O_KI + 64 * PA, O_VW = O_VV + 64 * PV, O_P = O_VW + (SSD ? 64 * PV : 0), O_SB = O_P + 64 * PPI, O_OT = O_SB + DA * PS, O_TAB = O_OT + 64 * POT;
    static constexpr int NT_O = DB / 32;
};
static_assert(LAT<true>::O_TAB + 8192 <= RING_BYTES && LAT<false>::O_TAB + 8192 <= RING_BYTES, "mixer LDS");
template <bool SSD> DI void la_mt_nt(int T, int& mt, int& nt) { if (SSD) { mt = T >> 2; nt = T & 3; } else { mt = T >> 3; nt = T & 7; } }

template <bool SSD> DI void la_state_update(LAS unsigned char* lds, f32x4 (&S)[4], int w, int lane) {
    typedef LAT<SSD> L; const LAS float* tab = (const LAS float*)(lds + L::O_TAB); const int q = lane >> 4;
#pragma unroll
    for (int x = 0; x < 4; ++x) { int mt, nt; la_mt_nt<SSD>(4 * w + x, mt, nt);
        if (SSD) { const float d = tab[256]; S[x] *= d; }
#pragma unroll
        for (int ks = 0; ks < 2; ++ks) { const bf16x8 a = frag_tr(lds + L::O_KI, L::PA, 32 * ks, 16 * mt, lane); const bf16x8 b = frag_tr(lds + (SSD ? L::O_VW : L::O_VV), L::PV, 32 * ks, 16 * nt, lane); S[x] = MFMA16(a, b, S[x]); }
        if (!SSD) {
#pragma unroll
            for (int r = 0; r < 4; ++r) S[x][r] *= tab[1536 + 16 * mt + 4 * q + r]; }
    }
}
template <bool SSD> DI void la_write_sb(LAS unsigned char* lds, const f32x4 (&S)[4], int w, int lane) {
    typedef LAT<SSD> L; const int q = lane >> 4, c = lane & 15;
#pragma unroll
    for (int x = 0; x < 4; ++x) { int mt, nt; la_mt_nt<SSD>(4 * w + x, mt, nt);
#pragma unroll
        for (int r = 0; r < 4; ++r) st_bf16(lds + L::O_SB, L::PS, 16 * mt + 4 * q + r, 16 * nt + c, S[x][r]); }
}
template <bool SSD> DI void la_compute_p(LAS unsigned char* lds, int w, int lane) {
    typedef LAT<SSD> L; const LAS float* tab = (const LAS float*)(lds + L::O_TAB); const int q = lane >> 4, c = lane & 15, mt = w >> 1;
#pragma unroll
    for (int x = 0; x < 2; ++x) { const int nt = (w & 1) * 2 + x; f32x4 acc = {0.f, 0.f, 0.f, 0.f};
#pragma unroll
        for (int ks = 0; ks < L::DA / 32; ++ks) { const bf16x8 a = frag_row(lds + L::O_QD, L::PA, 16 * mt, 32 * ks, lane); const bf16x8 b = frag_row(lds + L::O_KI, L::PA, 16 * nt, 32 * ks, lane); acc = MFMA16(a, b, acc); }
        const int j = 16 * nt + c;
#pragma unroll
        for (int r = 0; r < 4; ++r) { const int i = 16 * mt + 4 * q + r; float v = acc[r];
            if (SSD) v *= __expf(tab[64 + i] - tab[64 + j]) * tab[j];
            v = (j > i) ? 0.f : v; st_bf16(lds + L::O_P, L::PPI, i, j, v); }
    }
}
template <bool SSD> DI void la_compute_out(LAS unsigned char* lds, f32x4 (&o1)[LAT<SSD>::NT_O], f32x4 (&o2)[LAT<SSD>::NT_O], int w, int lane) {
    typedef LAT<SSD> L; const int mt = w >> 1;
#pragma unroll
    for (int x = 0; x < L::NT_O; ++x) { const int nt = (w & 1) * L::NT_O + x; f32x4 a1 = {0.f, 0.f, 0.f, 0.f}, a2 = {0.f, 0.f, 0.f, 0.f};
#pragma unroll
        for (int ks = 0; ks < 2; ++ks) { const bf16x8 a = frag_row(lds + L::O_P, L::PPI, 16 * mt, 32 * ks, lane); const bf16x8 b = frag_tr(lds + L::O_VV, L::PV, 32 * ks, 16 * nt, lane); a1 = MFMA16(a, b, a1); }
#pragma unroll
        for (int ks = 0; ks < L::DA / 32; ++ks) { const bf16x8 a = frag_row(lds + L::O_QD, L::PA, 16 * mt, 32 * ks, lane); const bf16x8 b = frag_tr(lds + L::O_SB, L::PS, 32 * ks, 16 * nt, lane); a2 = MFMA16(a, b, a2); }
        o1[x] = a1; o2[x] = a2; }
}
DI void la_store_ds(float* ds, const f32x4 (&S)[4], int w, int lane) {
#pragma unroll
    for (int x = 0; x < 4; ++x)
#pragma unroll
        for (int r = 0; r < 4; ++r) ds[((4 * w + x) * 4 + r) * 64 + lane] = S[x][r];
}
DI void la_load_ds(const float* ds, f32x4 (&S)[4], int w, int lane) {
#pragma unroll
    for (int x = 0; x < 4; ++x)
#pragma unroll
        for (int r = 0; r < 4; ++r) S[x][r] = ds[((4 * w + x) * 4 + r) * 64 + lane];
}

struct GlaCoef { float wlr[16]; float blr; };
struct GlaRaw { unsigned short qk[8][2]; u32x4 v[2]; u32x4 lr; u32x4 g[2]; };
DI void gla_load(const Ctx& F, int h, int chunk, GlaRaw& R) {
    const bf16_t* proj = wsb(F, WS_R); const int row0 = 64 * chunk, d = F.lane, w = F.wave;
#pragma unroll
    for (int i = 0; i < 8; ++i) { const size_t ro = (size_t)(row0 + 8 * w + i) * DINP; R.qk[i][0] = proj[ro + PC_BQ + 64 * h + d]; R.qk[i][1] = proj[ro + PC_BK + 64 * h + d]; }
#pragma unroll
    for (int i = 0; i < 2; ++i) { const int idx = F.tid + 512 * i, t = idx >> 4, c16 = idx & 15;
        R.v[i] = *(const u32x4*)(proj + (size_t)(row0 + t) * DINP + PC_BV + 128 * h + 8 * c16);
        R.g[i] = *(const u32x4*)(proj + (size_t)(row0 + t) * DINP + PC_BG + 128 * h + 8 * c16); }
    R.lr = *(const u32x4*)(proj + (size_t)(row0 + ((F.tid >> 1) & 63)) * DINP + PC_BLR + 8 * (F.tid & 1));
}
DI void gla_stage(const Ctx& F, const GlaCoef& cf, const GlaRaw& R) {
    typedef LAT<false> L; LAS unsigned char* lds = F.lds; LAS float* tab = (LAS float*)(lds + L::O_TAB); const int d = F.lane, w = F.wave;
    if (F.tid < 128) { const int t = F.tid >> 1, half = F.tid & 1; float f[8]; unpack8(R.lr, f);
#pragma unroll
        for (int i = 0; i < 8; ++i) tab[t * 16 + 8 * half + i] = f[i]; }
#pragma unroll
    for (int i = 0; i < 2; ++i) { const int idx = F.tid + 512 * i, t = idx >> 4, c16 = idx & 15; *(LAS u32x4*)(lds + L::O_VV + t * L::PV + c16 * 16) = R.v[i]; }
    WG_BAR();
    float pre[8]; float run = 0.f;
#pragma unroll
    for (int i = 0; i < 8; ++i) { const int t = 8 * w + i; float z = cf.blr;
#pragma unroll
        for (int r = 0; r < 16; ++r) z += tab[t * 16 + r] * cf.wlr[r];
        run += logsig_fast(z) * (1.f / 16.f); pre[i] = run; }
    tab[1024 + w * 64 + d] = run;
    WG_BAR();
    float off = 0.f, last = 0.f;
#pragma unroll
    for (int ww = 0; ww < 8; ++ww) { const float tv = tab[1024 + ww * 64 + d]; last += tv; if (ww < w) off += tv; }
#pragma unroll
    for (int i = 0; i < 8; ++i) { const int t = 8 * w + i; const float cum = off + pre[i];
        st_bf16(lds + L::O_QD, L::PA, t, d, bf2f(R.qk[i][0]) * 0.125f * __expf(cum)); st_bf16(lds + L::O_KI, L::PA, t, d, bf2f(R.qk[i][1]) * __expf(-cum)); }
    if (w == 0) tab[1536 + d] = __expf(last);
    WG_BAR();
}
struct SsdRaw { u32x4 x[11]; u32x4 z; unsigned short dtr; };
DI void ssd_task(const Ctx& F, int h, int& cidx, int& rg, int& ch) {
    cidx = F.tid % 40; rg = F.tid / 40; const int g = h >> 2;
    ch = cidx < 8 ? 64 * h + 8 * cidx : (cidx < 24 ? 512 + 128 * g + 8 * (cidx - 8) : 768 + 128 * g + 8 * (cidx - 24));
}
DI void ssd_load(const Ctx& F, int layer, int h, int chunk, SsdRaw& R) {
    const bf16_t* proj = wsb(F, WS_R); const int row0 = 64 * chunk; const bool first = chunk_first(chunk);
    if (F.tid < 320) { int cidx, rg, ch; ssd_task(F, h, cidx, rg, ch);
#pragma unroll
        for (int i = 0; i < 11; ++i) { const int tt = 8 * rg - 3 + i;
            if (tt >= 0 || !first) R.x[i] = *(const u32x4*)(proj + (size_t)(row0 + tt) * DINP + PC_XBC + ch);
            else if (chunk >= 256) { const float* sp = F.in[I_SSC] + ((size_t)(layer * 8 + (chunk - 256)) * 3 + (tt + 3)) * 1024 + ch; const f32x4 a = *(const f32x4*)sp, b = *(const f32x4*)(sp + 4);
                u32x4 o; o.x = pk2(a.x, a.y); o.y = pk2(a.z, a.w); o.z = pk2(b.x, b.y); o.w = pk2(b.z, b.w); R.x[i] = o; }
            else R.x[i] = (u32x4){0u, 0u, 0u, 0u};
        }
    }
    R.z = *(const u32x4*)(proj + (size_t)(row0 + (F.tid >> 3)) * DINP + PC_CZ + 64 * h + 8 * (F.tid & 7));
    R.dtr = proj[(size_t)(row0 + F.lane) * DINP + PC_DT + h];
}
constexpr int SSD_WCV = 512;
DI void ssd_item_weights(const Ctx& F, int layer, int h) {
    typedef LAT<true> L; LAS float* tab = (LAS float*)(F.lds + L::O_TAB);
    if (F.tid < 200) { const int cidx = F.tid / 5, j = F.tid % 5, g = h >> 2;
        const int ch = cidx < 8 ? 64 * h + 8 * cidx : (cidx < 24 ? 512 + 128 * g + 8 * (cidx - 8) : 768 + 128 * g + 8 * (cidx - 24));
        const float* sp = j < 4 ? F.in[I_SCW] + (size_t)(layer * 4 + j) * 1024 + ch : F.in[I_SCB] + layer * 1024 + ch;
        *(LAS f32x4*)(tab + SSD_WCV + (cidx * 5 + j) * 8) = *(const f32x4*)sp; *(LAS f32x4*)(tab + SSD_WCV + (cidx * 5 + j) * 8 + 4) = *(const f32x4*)(sp + 4); }
    WG_BAR();
}
DI void ssd_stage(const Ctx& F, int layer, int h, const SsdRaw& R) {
    typedef LAT<true> L; LAS unsigned char* lds = F.lds; LAS float* tab = (LAS float*)(lds + L::O_TAB);
    if (F.wave == 7) { const int t = F.lane;
        const float dt = softplus_fast(bf2f(R.dtr) + F.in[I_SDTB][layer * 8 + h]); const float cum = wave_incl_scan(-dt * __expf(F.in[I_SALOG][layer * 8 + h]));
        const float last = __shfl(cum, 63);
        tab[t] = dt; tab[64 + t] = cum; tab[128 + t] = __expf(last - cum) * dt; tab[192 + t] = __expf(cum); if (t == 0) tab[256] = __expf(last); }
    if (F.tid < 320) { int cidx, rg, ch; ssd_task(F, h, cidx, rg, ch);
        float wv[4][8], bv[8];
#pragma unroll
        for (int j = 0; j < 4; ++j) { const f32x4 a = *(const LAS f32x4*)(tab + SSD_WCV + (cidx * 5 + j) * 8), b = *(const LAS f32x4*)(tab + SSD_WCV + (cidx * 5 + j) * 8 + 4); wv[j][0] = a.x; wv[j][1] = a.y; wv[j][2] = a.z; wv[j][3] = a.w; wv[j][4] = b.x; wv[j][5] = b.y; wv[j][6] = b.z; wv[j][7] = b.w; }
        { const f32x4 a = *(const LAS f32x4*)(tab + SSD_WCV + (cidx * 5 + 4) * 8), b = *(const LAS f32x4*)(tab + SSD_WCV + (cidx * 5 + 4) * 8 + 4); bv[0] = a.x; bv[1] = a.y; bv[2] = a.z; bv[3] = a.w; bv[4] = b.x; bv[5] = b.y; bv[6] = b.z; bv[7] = b.w; }
        float x0[8], x1[8], x2[8], x3[8]; unpack8(R.x[0], x0); unpack8(R.x[1], x1); unpack8(R.x[2], x2);
#pragma unroll
        for (int r = 0; r < 8; ++r) { const int t = 8 * rg + r; float o[8]; unpack8(R.x[r + 3], x3);
#pragma unroll
            for (int e = 0; e < 8; ++e) { const float v = bv[e] + wv[0][e] * x0[e] + wv[1][e] * x1[e] + wv[2][e] * x2[e] + wv[3][e] * x3[e]; o[e] = silu_f(v); x0[e] = x1[e]; x1[e] = x2[e]; x2[e] = x3[e]; }
            if (cidx < 8) *(LAS u32x4*)(lds + L::O_VV + t * L::PV + cidx * 16) = pack8(o);
            else if (cidx < 24) *(LAS u32x4*)(lds + L::O_KI + t * L::PA + (cidx - 8) * 16) = pack8(o);
            else *(LAS u32x4*)(lds + L::O_QD + t * L::PA + (cidx - 24) * 16) = pack8(o);
        }
    }
    WG_BAR();
    { const int t = F.tid >> 3, c8 = F.tid & 7; float xv[8]; unpack8(*(const LAS u32x4*)(lds + L::O_VV + t * L::PV + c8 * 16), xv); const float we = tab[128 + t];
#pragma unroll
        for (int e = 0; e < 8; ++e) xv[e] *= we;
        *(LAS u32x4*)(lds + L::O_VW + t * L::PV + c8 * 16) = pack8(xv); }
}

DI void gla_pass_a(const Ctx& F0, int layer, int panel, int h) {
    Ctx F = F0; OPAQUE_CTX(F);
    LAS unsigned char* lds = F.lds; const int w = F.wave, lane = F.lane, d = lane; const bf16_t* proj = wsb(F, WS_R); const int row0 = 256 * panel;
    constexpr int PK = 144, PVV = 272, O_KE = 0, O_V = 256 * PK, O_LR = O_V + 256 * PVV, O_TOT = O_LR + 256 * 16 * 4;
    static_assert(O_TOT + 2048 <= RING_BYTES, "gla pass A LDS");
    LAS float* lr = (LAS float*)(lds + O_LR); LAS float* tot = (LAS float*)(lds + O_TOT);
    float wlr[16];
#pragma unroll
    for (int r = 0; r < 16; ++r) wlr[r] = F.in[I_GWLR][(size_t)(layer * 16 + r) * 256 + 64 * h + d];
    const float blr = F.in[I_GBLR][layer * 256 + 64 * h + d];
    { const int t = F.tid >> 1, half = F.tid & 1; const u32x4 v = *(const u32x4*)(proj + (size_t)(row0 + t) * DINP + PC_BLR + 8 * half); float f[8]; unpack8(v, f);
#pragma unroll
        for (int i = 0; i < 8; ++i) lr[t * 16 + 8 * half + i] = f[i]; }
    unsigned short kr[32];
#pragma unroll
    for (int i = 0; i < 32; ++i) kr[i] = proj[(size_t)(row0 + 32 * w + i) * DINP + PC_BK + 64 * h + d];
#pragma unroll
    for (int i = 0; i < 8; ++i) { const int idx = F.tid + 512 * i, t = idx >> 4, c16 = idx & 15;
        *(LAS u32x4*)(lds + O_V + t * PVV + c16 * 16) = *(const u32x4*)(proj + (size_t)(row0 + t) * DINP + PC_BV + 128 * h + 8 * c16); }
    WG_BAR();
    float pre[32]; float run = 0.f;
#pragma unroll
    for (int i = 0; i < 32; ++i) { const int t = 32 * w + i; float z = blr;
#pragma unroll
        for (int r = 0; r < 16; ++r) z += lr[t * 16 + r] * wlr[r];
        run += logsig_fast(z) * (1.f / 16.f); pre[i] = run; }
    tot[w * 64 + d] = run;
    WG_BAR();
    float off = 0.f, last = 0.f;
#pragma unroll
    for (int ww = 0; ww < 8; ++ww) { const float tv = tot[ww * 64 + d]; last += tv; if (ww < w) off += tv; }
#pragma unroll
    for (int i = 0; i < 32; ++i) st_bf16(lds + O_KE, PK, 32 * w + i, d, bf2f(kr[i]) * __expf(last - (off + pre[i])));
    WG_BAR();
    f32x4 S[4];
#pragma unroll
    for (int x = 0; x < 4; ++x) S[x] = (f32x4){0.f, 0.f, 0.f, 0.f};
    const int mt = w >> 1;
#pragma unroll
    for (int ks = 0; ks < 8; ++ks) { const bf16x8 a = frag_tr(lds + O_KE, PK, 32 * ks, 16 * mt, lane);
#pragma unroll
        for (int x = 0; x < 4; ++x) { const bf16x8 b = frag_tr(lds + O_V, PVV, 32 * ks, 16 * (((4 * w + x) & 7)), lane); S[x] = MFMA16(a, b, S[x]); } }
    la_store_ds(wsf(F, WS_DS) + ((size_t)panel * 12 + h) * 8192, S, w, lane);
    if (w == 0) wsf(F, WS_DEC)[(panel * 4 + h) * 64 + d] = __expf(last);
    WG_BAR();
}
DI void ssd_pass_a(const Ctx& F0, int layer, int panel, int h) {
    Ctx F = F0; OPAQUE_CTX(F);
    LAS unsigned char* lds = F.lds; const int w = F.wave, lane = F.lane, g = h >> 2; const bf16_t* proj = wsb(F, WS_R); const int row0 = 256 * panel; const bool first = (panel & 31) == 0;
    constexpr int PB_ = 272, PX = 144, O_B = 0, O_XW = 256 * PB_, O_WE = O_XW + 256 * PX;
    static_assert(O_WE + 1024 <= RING_BYTES, "ssd pass A LDS");
    LAS float* wend = (LAS float*)(lds + O_WE);
    float last = 0.f;
    if (w == 0) {
        const float bias = F.in[I_SDTB][layer * 8 + h], A = -__expf(F.in[I_SALOG][layer * 8 + h]); float dt[4], cs[4]; float run = 0.f;
#pragma unroll
        for (int i = 0; i < 4; ++i) { dt[i] = softplus_fast(bf2f(proj[(size_t)(row0 + 4 * lane + i) * DINP + PC_DT + h]) + bias); run += dt[i] * A; cs[i] = run; }
        const float inc = wave_incl_scan(run);
        const float excl = inc - run; last = __shfl(inc, 63);
#pragma unroll
        for (int i = 0; i < 4; ++i) wend[4 * lane + i] = __expf(last - (excl + cs[i])) * dt[i];
    }
    WG_BAR();
    for (int pass = 0; pass < 2; ++pass) { const int task = F.tid + 512 * pass;
        if (task < 768) { const int cidx = task % 24, rg = task / 24;
            const int ch = cidx < 8 ? 64 * h + 8 * cidx : 512 + 128 * g + 8 * (cidx - 8);
            const float* cwp = F.in[I_SCW] + (size_t)layer * 4 * 1024 + ch; const float* cbp = F.in[I_SCB] + layer * 1024 + ch;
            float wv[4][8], bv[8];
#pragma unroll
            for (int j = 0; j < 4; ++j) { const f32x4 a = *(const f32x4*)(cwp + j * 1024), b = *(const f32x4*)(cwp + j * 1024 + 4); wv[j][0] = a.x; wv[j][1] = a.y; wv[j][2] = a.z; wv[j][3] = a.w; wv[j][4] = b.x; wv[j][5] = b.y; wv[j][6] = b.z; wv[j][7] = b.w; }
            { const f32x4 a = *(const f32x4*)cbp, b = *(const f32x4*)(cbp + 4); bv[0] = a.x; bv[1] = a.y; bv[2] = a.z; bv[3] = a.w; bv[4] = b.x; bv[5] = b.y; bv[6] = b.z; bv[7] = b.w; }
            u32x4 xr[11];
#pragma unroll
            for (int i = 0; i < 11; ++i) { const int tt = 8 * rg - 3 + i;
                if (tt >= 0 || !first) xr[i] = *(const u32x4*)(proj + (size_t)(row0 + tt) * DINP + PC_XBC + ch); else xr[i] = (u32x4){0u, 0u, 0u, 0u}; }
            float x0[8], x1[8], x2[8], x3[8]; unpack8(xr[0], x0); unpack8(xr[1], x1); unpack8(xr[2], x2);
#pragma unroll
            for (int r = 0; r < 8; ++r) { const int t = 8 * rg + r; float o[8]; unpack8(xr[r + 3], x3);
#pragma unroll
                for (int e = 0; e < 8; ++e) { const float v = bv[e] + wv[0][e] * x0[e] + wv[1][e] * x1[e] + wv[2][e] * x2[e] + wv[3][e] * x3[e]; o[e] = silu_f(v); x0[e] = x1[e]; x1[e] = x2[e]; x2[e] = x3[e]; }
                if (cidx < 8) { const float we = wend[t];
#pragma unroll
                    for (int e = 0; e < 8; ++e) o[e] *= we;
                    *(LAS u32x4*)(lds + O_XW + t * PX + cidx * 16) = pack8(o); }
                else *(LAS u32x4*)(lds + O_B + t * PB_ + (cidx - 8) * 16) = pack8(o);
            }
        }
    }
    WG_BAR();
    f32x4 S[4];
#pragma unroll
    for (int x = 0; x < 4; ++x) S[x] = (f32x4){0.f, 0.f, 0.f, 0.f};
#pragma unroll
    for (int ks = 0; ks < 8; ++ks) { const bf16x8 a = frag_tr(lds + O_B, PB_, 32 * ks, 16 * w, lane);
#pragma unroll
        for (int x = 0; x < 4; ++x) { const bf16x8 b = frag_tr(lds + O_XW, PX, 32 * ks, 16 * x, lane); S[x] = MFMA16(a, b, S[x]); } }
    la_store_ds(wsf(F, WS_DS) + ((size_t)panel * 12 + 4 + h) * 8192, S, w, lane);
    if (w == 0 && lane == 0) wsf(F, WS_DEC)[64 * 4 * 64 + panel * 8 + h] = __expf(last);
    WG_BAR();
}

template <bool SSD> DI void la_pass_c(const Ctx& F0, int layer, int c0, int nc, int h, bool dry) {
    Ctx F = F0; OPAQUE_CTX(F);
    typedef LAT<SSD> L; const int w = F.wave, lane = F.lane, q = lane >> 4, c = lane & 15, mt = w >> 1;
    bf16_t* proj = wsb(F, WS_R);
    f32x4 S[4];
    GlaCoef cf; GlaRaw gr; SsdRaw sr;
    if (!SSD) {
#pragma unroll
        for (int r = 0; r < 16; ++r) cf.wlr[r] = F.in[I_GWLR][(size_t)(layer * 16 + r) * 256 + 64 * h + lane];
        cf.blr = F.in[I_GBLR][layer * 256 + 64 * h + lane]; gla_load(F, h, c0, gr); }
    else { ssd_load(F, layer, h, c0, sr); ssd_item_weights(F, layer, h); }
    const int hh = SSD ? 4 + h : h;
    const Ctx Fp = F;
#pragma unroll 1
    for (int cc = 0; cc < nc; ++cc) { const int chunk = c0 + cc, row0 = 64 * chunk;
        Ctx F = Fp; { unsigned z_ = 0; asm volatile("" : "+s"(z_)); F.lds = Fp.lds + z_; } LAS unsigned char* lds = F.lds; LAS float* tab = (LAS float*)(lds + L::O_TAB);
        PB(SSD ? 5 : 15);
        if (cc == 0 || chunk_first(chunk)) {
            if (chunk < 256) la_load_ds(wsf(F, WS_DS) + ((size_t)(chunk >> 2) * 12 + hh) * 8192, S, w, lane);
            else { const int b = chunk - 256;
#pragma unroll
                for (int x = 0; x < 4; ++x) { int smt, snt; la_mt_nt<SSD>(4 * w + x, smt, snt);
                    if (SSD) { const float* sp = F.in[I_SS] + ((size_t)((layer * 8 + b) * 8 + h) * 64 + 16 * snt + c) * 128 + 16 * smt + 4 * q; S[x] = *(const f32x4*)sp; }
                    else { const float* sp = F.in[I_SG] + ((size_t)((layer * 8 + b) * 4 + h) * 64 + 16 * smt + 4 * q) * 128 + 16 * snt + c;
#pragma unroll
                        for (int r = 0; r < 4; ++r) S[x][r] = sp[r * 128]; } } }
            la_write_sb<SSD>(lds, S, w, lane);
        }
        PE(SSD ? 5 : 15);
        PB(SSD ? 1 : 11);
        u32x4 gate0, gate1;
        if (SSD) { ssd_stage(F, layer, h, sr); gate0 = sr.z; gate1 = gate0; if (cc + 1 < nc) ssd_load(F, layer, h, chunk + 1, sr); }
        else { gla_stage(F, cf, gr); gate0 = gr.g[0]; gate1 = gr.g[1]; if (cc + 1 < nc) gla_load(F, h, chunk + 1, gr); }
        PE(SSD ? 1 : 11); PB(SSD ? 2 : 12);
        la_compute_p<SSD>(lds, w, lane);
        WG_BAR();
        PE(SSD ? 2 : 12); PB(SSD ? 3 : 13);
        f32x4 o1[L::NT_O], o2[L::NT_O];
        la_compute_out<SSD>(lds, o1, o2, w, lane);
        la_state_update<SSD>(lds, S, w, lane);
        if (SSD) {
            const float Dh = F.in[I_SD][layer * 8 + h];
#pragma unroll
            for (int x = 0; x < L::NT_O; ++x) { const int p = 16 * ((w & 1) * L::NT_O + x) + c;
#pragma unroll
                for (int r = 0; r < 4; ++r) { const int i = 16 * mt + 4 * q + r; *(LAS float*)(lds + L::O_OT + i * L::POT + p * 4) = o1[x][r] + tab[192 + i] * o2[x][r] + Dh * ld_bf16(lds + L::O_VV, L::PV, i, p); } }
        } else {
            float ss[4] = {0.f, 0.f, 0.f, 0.f};
#pragma unroll
            for (int x = 0; x < L::NT_O; ++x) { const int e = 16 * ((w & 1) * L::NT_O + x) + c;
#pragma unroll
                for (int r = 0; r < 4; ++r) { const float o = o1[x][r] + o2[x][r]; ss[r] += o * o; *(LAS float*)(lds + L::O_OT + (16 * mt + 4 * q + r) * L::POT + e * 4) = o; } }
#pragma unroll
            for (int r = 0; r < 4; ++r) { float s = ss[r]; s += __shfl_xor(s, 1); s += __shfl_xor(s, 2); s += __shfl_xor(s, 4); s += __shfl_xor(s, 8);
                if (c == 0) tab[1600 + (16 * mt + 4 * q + r) * 2 + (w & 1)] = s; }
        }
        WG_BAR();
        PE(SSD ? 3 : 13); PB(SSD ? 4 : 14);
        if (SSD) { const int i = F.tid >> 3, p0 = 8 * (F.tid & 7); float zv[8], yv[8]; unpack8(gate0, zv); float ss = 0.f;
            const f32x4 ya = *(const LAS f32x4*)(lds + L::O_OT + i * L::POT + p0 * 4), yb = *(const LAS f32x4*)(lds + L::O_OT + i * L::POT + p0 * 4 + 16);
            yv[0] = ya.x; yv[1] = ya.y; yv[2] = ya.z; yv[3] = ya.w; yv[4] = yb.x; yv[5] = yb.y; yv[6] = yb.z; yv[7] = yb.w;
#pragma unroll
            for (int e = 0; e < 8; ++e) { yv[e] *= silu_f(zv[e]); ss += yv[e] * yv[e]; }
            ss += __shfl_xor(ss, 1); ss += __shfl_xor(ss, 2); ss += __shfl_xor(ss, 4);
            if (!dry) { *(u32x4*)(proj + (size_t)(row0 + i) * DINP + PC_CZ + 64 * h + p0) = pack8(yv);
                if ((F.tid & 7) == 0) { f32x2 pv; pv.x = ss; pv.y = 0.f; *(f32x2*)(wsf(F, WS_PSS) + (size_t)(row0 + i) * 16 + 2 * h) = pv; } }
        } else {
#pragma unroll
            for (int k = 0; k < 2; ++k) { const int idx = F.tid + 512 * k, i = idx >> 4, e0 = 8 * (idx & 15); float gv[8], yv[8]; unpack8(k ? gate1 : gate0, gv);
                const float rstd = rsqrtf((tab[1600 + 2 * i] + tab[1600 + 2 * i + 1]) * (1.f / 128.f) + EPS);
                const f32x4 ya = *(const LAS f32x4*)(lds + L::O_OT + i * L::POT + e0 * 4), yb = *(const LAS f32x4*)(lds + L::O_OT + i * L::POT + e0 * 4 + 16);
                const float* gn = F.in[I_GNORM] + layer * 512 + 128 * h + e0; const f32x4 na = *(const f32x4*)gn, nb = *(const f32x4*)(gn + 4);
                yv[0] = ya.x * na.x; yv[1] = ya.y * na.y; yv[2] = ya.z * na.z; yv[3] = ya.w * na.w; yv[4] = yb.x * nb.x; yv[5] = yb.y * nb.y; yv[6] = yb.z * nb.z; yv[7] = yb.w * nb.w;
#pragma unroll
                for (int e = 0; e < 8; ++e) yv[e] *= rstd * silu_f(gv[e]);
                if (!dry) *(u32x4*)(proj + (size_t)(row0 + i) * DINP + PC_BG + 128 * h + e0) = pack8(yv); }
        }
        if (chunk_last(chunk)) { if (!dry) { const int seq = chunk_seq(chunk);
            if (SSD) { float* so = st_out(F, O_PS, O_SS, layer, seq, 8 * 64 * 128) + (size_t)h * 64 * 128;
#pragma unroll
                for (int x = 0; x < 4; ++x) { int smt, snt; la_mt_nt<SSD>(4 * w + x, smt, snt); *(f32x4*)(so + (size_t)(16 * snt + c) * 128 + 16 * smt + 4 * q) = S[x]; } }
            else { float* so = st_out(F, O_PG, O_SG, layer, seq, 4 * 64 * 128) + (size_t)h * 64 * 128;
#pragma unroll
                for (int x = 0; x < 4; ++x) { int smt, snt; la_mt_nt<SSD>(4 * w + x, smt, snt);
#pragma unroll
                    for (int r = 0; r < 4; ++r) so[(size_t)(16 * smt + 4 * q + r) * 128 + 16 * snt + c] = S[x][r]; } } }
        } else if (cc + 1 < nc) la_write_sb<SSD>(lds, S, w, lane);
        WG_BAR();
        PE(SSD ? 4 : 14);
    }
}

struct LruSP { bf16x8 br[2], bi[2]; float b_r, b_i, lam, hin; };
template <bool PASS_C> DI void lru_load_sp(const Ctx& F, int layer, int h, int chunk, int nt, LruSP& p) {
    const int lane = F.lane, q = lane >> 4, c = lane & 15, col = 64 * h + 16 * nt + c;
    const bf16_t* wr_t = wsb(F, WS_LRUW) + (size_t)((layer * 2 + 0) * 8 + h) * 4096; const bf16_t* wi_t = wsb(F, WS_LRUW) + (size_t)((layer * 2 + 1) * 8 + h) * 4096;
#pragma unroll
    for (int ks = 0; ks < 2; ++ks) { const int o = (16 * nt + c) * 64 + 32 * ks + 8 * q; p.br[ks] = *(const bf16x8*)(wr_t + o); p.bi[ks] = *(const bf16x8*)(wi_t + o); }
    p.b_r = F.in[I_LBR][layer * 512 + col]; p.b_i = F.in[I_LBI][layer * 512 + col]; p.lam = F.in[I_LAM][layer * 512 + col]; p.hin = 0.f;
    if (PASS_C) p.hin = chunk >= 256 ? F.in[I_SLH][(size_t)(layer * 8 + (chunk - 256)) * 512 + col] : wsf(F, WS_LRUS)[(size_t)(2 * NCH + chunk) * 512 + col];
}
template <bool PASS_C> DI void lru_chunk(const Ctx& F0, int layer, int chunk, bool dry = false) {
    Ctx F = F0; OPAQUE_CTX(F);
    const int h = F.wave, lane = F.lane, q = lane >> 4, c = lane & 15, row0 = 64 * chunk; const bool first = chunk_first(chunk);
    LAS unsigned char* T = F.lds + h * 18432; LAS unsigned char* OT = T + 9216; constexpr int TP = 144;
    bf16_t* proj = wsb(F, WS_R);
    const int cc = lane & 7, rg = lane >> 3;
    PB(PASS_C ? 21 : 31);
    LruSP cur; lru_load_sp<PASS_C>(F, layer, h, chunk, 0, cur);
    {
        const int ch = 64 * h + 8 * cc; u32x4 xr[11];
#pragma unroll
        for (int i = 0; i < 11; ++i) { const int tt = 8 * rg - 3 + i;
            if (tt >= 0 || !first) xr[i] = *(const u32x4*)(proj + (size_t)(row0 + tt) * DINP + PC_AX + ch);
            else if (chunk >= 256) { const float* sp = F.in[I_SLC] + ((size_t)(layer * 8 + (chunk - 256)) * 3 + (tt + 3)) * 512 + ch; const f32x4 a = *(const f32x4*)sp, b = *(const f32x4*)(sp + 4);
                u32x4 o; o.x = pk2(a.x, a.y); o.y = pk2(a.z, a.w); o.z = pk2(b.x, b.y); o.w = pk2(b.z, b.w); xr[i] = o; }
            else xr[i] = (u32x4){0u, 0u, 0u, 0u};
        }
        const float* cwp = F.in[I_LCW] + (size_t)layer * 4 * 512 + ch; const float* cbp = F.in[I_LCB] + layer * 512 + ch;
        float wv[4][8], bv[8];
#pragma unroll
        for (int j = 0; j < 4; ++j) { const f32x4 a = *(const f32x4*)(cwp + j * 512), b = *(const f32x4*)(cwp + j * 512 + 4); wv[j][0] = a.x; wv[j][1] = a.y; wv[j][2] = a.z; wv[j][3] = a.w; wv[j][4] = b.x; wv[j][5] = b.y; wv[j][6] = b.z; wv[j][7] = b.w; }
        { const f32x4 a = *(const f32x4*)cbp, b = *(const f32x4*)(cbp + 4); bv[0] = a.x; bv[1] = a.y; bv[2] = a.z; bv[3] = a.w; bv[4] = b.x; bv[5] = b.y; bv[6] = b.z; bv[7] = b.w; }
        float x0[8], x1[8], x2[8], x3[8]; unpack8(xr[0], x0); unpack8(xr[1], x1); unpack8(xr[2], x2);
#pragma unroll
        for (int r = 0; r < 8; ++r) { float o[8]; unpack8(xr[r + 3], x3);
#pragma unroll
            for (int e = 0; e < 8; ++e) { o[e] = bv[e] + wv[0][e] * x0[e] + wv[1][e] * x1[e] + wv[2][e] * x2[e] + wv[3][e] * x3[e]; x0[e] = x1[e]; x1[e] = x2[e]; x2[e] = x3[e]; }
            *(LAS u32x4*)(T + (8 * rg + r) * TP + cc * 16) = pack8(o); }
    }
    LDS_WAIT();
    PE(PASS_C ? 21 : 31); PB(PASS_C ? 22 : 32);
#pragma unroll 1
    for (int nt = 0; nt < 4; ++nt) {
        LruSP nx = cur; if (nt < 3) lru_load_sp<PASS_C>(F, layer, h, chunk, nt + 1, nx);
        const int col = 64 * h + 16 * nt + c;
        const float c8 = -8.f * softplus_f(-cur.lam);
        float hc = cur.hin, pc = 1.f;
#pragma unroll
        for (int mt = 0; mt < 4; ++mt) {
            const bf16x8 a0 = frag_row(T, TP, 16 * mt, 0, lane), a1 = frag_row(T, TP, 16 * mt, 32, lane);
            f32x4 ar = {0.f, 0.f, 0.f, 0.f}, ai = {0.f, 0.f, 0.f, 0.f};
            ar = MFMA16(a0, cur.br[0], ar); ar = MFMA16(a1, cur.br[1], ar); ai = MFMA16(a0, cur.bi[0], ai); ai = MFMA16(a1, cur.bi[1], ai);
            float a[4], uu[4];
#pragma unroll
            for (int r = 0; r < 4; ++r) { const int t = 16 * mt + 4 * q + r; const float rg_ = sigm(ar[r] + cur.b_r), ig = sigm(ai[r] + cur.b_i), la = c8 * rg_;
                a[r] = __expf(la); uu[r] = __builtin_amdgcn_sqrtf(fmaxf(1.f - a[r] * a[r], 0.f)) * ig * ld_bf16(T, TP, t, 16 * nt + c); }
            const float P = (a[0] * a[1]) * (a[2] * a[3]); const float Hl = ((uu[0] * a[1] + uu[1]) * a[2] + uu[2]) * a[3] + uu[3];
            float hrun = hc, my_in = 0.f;
#pragma unroll
            for (int qq = 0; qq < 4; ++qq) { const float Pq = __shfl(P, c + 16 * qq), Hq = __shfl(Hl, c + 16 * qq); if (qq == q) my_in = hrun; hrun = Pq * hrun + Hq; pc *= Pq; }
            hc = hrun;
            if (PASS_C) { float hh = my_in;
#pragma unroll
                for (int r = 0; r < 4; ++r) { hh = a[r] * hh + uu[r]; st_bf16(OT, TP, 16 * mt + 4 * q + r, 16 * nt + c, hh); } }
        }
        if (!PASS_C) { if (q == 0) { wsf(F, WS_LRUS)[(size_t)chunk * 512 + col] = pc; wsf(F, WS_LRUS)[(size_t)(NCH + chunk) * 512 + col] = hc; } }
        else if (chunk_last(chunk) && q == 0 && !dry) st_out(F, O_PLH, O_SLH, layer, chunk_seq(chunk), 512)[col] = hc;
        cur = nx;
    }
    PE(PASS_C ? 22 : 32); PB(PASS_C ? 23 : 33);
    if (PASS_C) {
        LDS_WAIT();
        u32x4* gp = (u32x4*)(proj + (size_t)(row0 + rg) * DINP + PC_AG + 64 * h + 8 * cc); u32x4 gnx = *gp;
#pragma unroll 1
        for (int i = 0; i < 8; ++i) { const int t = rg + 8 * i; const u32x4 gc = gnx; u32x4* gq = gp + (size_t)i * (8 * DINP * 2 / 16);
            if (i < 7) gnx = *(gq + (8 * DINP * 2 / 16));
            float hv[8], gv[8]; unpack8(*(const LAS u32x4*)(OT + t * TP + cc * 16), hv); unpack8(gc, gv);
#pragma unroll
            for (int e = 0; e < 8; ++e) hv[e] *= gelu_t(gv[e]);
            if (!dry) *gq = pack8(hv); }
        if (chunk_last(chunk) && !dry) { float* so = st_out(F, O_PLC, O_SLC, layer, chunk_seq(chunk), 3 * 512);
#pragma unroll
            for (int i = 0; i < 3; ++i) so[i * 512 + 64 * h + lane] = bf2f(proj[(size_t)(row0 + 61 + i) * DINP + PC_AX + 64 * h + lane]); }
    }
    LDS_WAIT();
    PE(PASS_C ? 23 : 33);
}

DI void phase_mixer_a(const Ctx& F, int layer) {
    for (int it = blockIdx.x; it < 1034; it += F.G) {
        if (it < 256) gla_pass_a(F, layer, it >> 2, it & 3);
        else if (it < 768) ssd_pass_a(F, layer, (it - 256) >> 3, (it - 256) & 7);
        else if (it < 1024) lru_chunk<false>(F, layer, it - 768);
        else { const int seq = it - 1024, lastrow = seq < 2 ? 8192 * (seq + 1) - 1 : MP + 64 * (seq - 1) - 1;
            float* so = st_out(F, O_PSC, O_SSC, layer, seq, 3 * 1024); const bf16_t* proj = wsb(F, WS_R);
            for (int e = F.tid; e < 3 * 1024; e += 512) so[e] = bf2f(proj[(size_t)(lastrow - 2 + (e >> 10)) * DINP + PC_XBC + (e & 1023)]); }
        __syncthreads();
    }
}
DI void phase_mixer_b(const Ctx& F, int layer, bool dry) {
    float* ds = wsf(F, WS_DS); const float* dec = wsf(F, WS_DEC);
    for (int e = blockIdx.x * 512 + F.tid; e < 2 * 12 * 8192; e += F.G * 512) {
        const int idx = e & 8191, hh = (e >> 13) % 12, b = e / (12 * 8192);
        const int ln = idx & 63, r = (idx >> 6) & 3, Tt = idx >> 8; const int a = 16 * (Tt >> 3) + 4 * (ln >> 4) + r;
        float v[32];
#pragma unroll
        for (int p = 0; p < 32; ++p) v[p] = ds[((size_t)(32 * b + p) * 12 + hh) * 8192 + idx];
        float S = 0.f;
#pragma unroll
        for (int p = 0; p < 32; ++p) { const int panel = 32 * b + p; const float dc = hh < 4 ? dec[(panel * 4 + hh) * 64 + a] : dec[64 * 4 * 64 + panel * 8 + (hh - 4)];
            if (!dry) ds[((size_t)panel * 12 + hh) * 8192 + idx] = S; S = dc * S + v[p]; }
    }
    {
        const int gw = blockIdx.x * NWAVES + F.wave; float* ls = wsf(F, WS_LRUS);
        if (gw < 1024) { const int b = gw >> 9, ch = gw & 511, l = F.lane; const int c0 = 128 * b + 2 * l;
            const float A0 = ls[(size_t)c0 * 512 + ch], H0 = ls[(size_t)(NCH + c0) * 512 + ch], A1 = ls[(size_t)(c0 + 1) * 512 + ch], H1 = ls[(size_t)(NCH + c0 + 1) * 512 + ch];
            float A = A1 * A0, H = A1 * H0 + H1;
#pragma unroll
            for (int o = 1; o < 64; o <<= 1) { const float Ap = __shfl_up(A, o), Hp = __shfl_up(H, o); if (l >= o) { H = A * Hp + H; A = A * Ap; } }
            float E = __shfl_up(H, 1); if (l == 0) E = 0.f;
            ls[(size_t)(2 * NCH + c0) * 512 + ch] = E; ls[(size_t)(2 * NCH + c0 + 1) * 512 + ch] = A0 * E + H0; }
    }
}
#ifndef MIX_MASK
#define MIX_MASK 7
#endif
#ifndef DRY_MIX
#define DRY_MIX 7
#endif
DI void phase_mixer_c(const Ctx& F, int layer, bool dry) {
    const int mm = dry ? DRY_MIX : MIX_MASK;
    for (int it = blockIdx.x; it < 1128; it += F.G) {
        if (it < 512) { if (mm & 1) la_pass_c<true>(F, layer, 4 * (it >> 3), 4, it & 7, dry); }
        else if (it < 768) { if (mm & 2) la_pass_c<false>(F, layer, 4 * ((it - 512) >> 2), 4, (it - 512) & 3, dry); }
        else if (it < 1032) { if (mm & 4) lru_chunk<true>(F, layer, it - 768, dry); }
        else if (it < 1096) { if (mm & 1) la_pass_c<true>(F, layer, 256 + ((it - 1032) >> 3), 1, (it - 1032) & 7, dry); }
        else { if (mm & 2) la_pass_c<false>(F, layer, 256 + ((it - 1096) >> 2), 1, (it - 1096) & 3, dry); }
        __syncthreads();
    }
}
DI void phase_ssd_norm(const Ctx& F, int layer, bool dry) {
    const int gw = F.vcu * NWAVES + F.wave, NGW = F.G * NWAVES; bf16_t* proj = wsb(F, WS_R); const float* pss = wsf(F, WS_PSS);
    float gn[8]; { const float* gp = F.in[I_SNORM] + layer * 512 + 8 * F.lane; const f32x4 a = *(const f32x4*)gp, b = *(const f32x4*)(gp + 4); gn[0] = a.x; gn[1] = a.y; gn[2] = a.z; gn[3] = a.w; gn[4] = b.x; gn[5] = b.y; gn[6] = b.z; gn[7] = b.w; }
    for (int m = gw; m < M; m += NGW) {
        const f32x4* p = (const f32x4*)(pss + (size_t)m * 16); const f32x4 a = p[0], b = p[1], c = p[2], d = p[3];
        const float s = ((a.x + a.y) + (a.z + a.w)) + ((b.x + b.y) + (b.z + b.w)) + ((c.x + c.y) + (c.z + c.w)) + ((d.x + d.y) + (d.z + d.w));
        const float rstd = rsqrtf(s * (1.f / 512.f) + EPS);
        u32x4* yp = (u32x4*)(proj + (size_t)m * DINP + PC_CZ + 8 * F.lane); float v[8]; unpack8(*yp, v);
#pragma unroll
        for (int e = 0; e < 8; ++e) v[e] *= rstd * gn[e];
        *yp = pack8(v);
    }
}
DI void phase_final(const Ctx& F) {
    const int gw = F.vcu * NWAVES + F.wave, NGW = F.G * NWAVES; const float* rss = wsf(F, WS_RSSN) + (size_t)XB_PAD * 16; const float* gf = F.in[I_NFIN]; const bf16_t* xs = wsb(F, WS_XBN);
    for (int m = gw; m < M; m += NGW) { const float rs = row_rstd(rss, m); f32x4* y4 = (f32x4*)(F.out + (size_t)m * D) + F.lane; const u32x2* x2 = (const u32x2*)(xs + (size_t)m * D) + F.lane;
#pragma unroll
        for (int j = 0; j < 4; ++j) { const f32x4 g = *((const f32x4*)gf + F.lane + 64 * j); const u32x2 xw = x2[64 * j];
            f32x4 y; y[0] = __uint_as_float(xw.x << 16) * rs * g[0]; y[1] = __uint_as_float(xw.x & 0xffff0000u) * rs * g[1]; y[2] = __uint_as_float(xw.y << 16) * rs * g[2]; y[3] = __uint_as_float(xw.y & 0xffff0000u) * rs * g[3];
            y4[64 * j] = y; } }
}

constexpr int PH_PER_LAYER = 9, N_PHASES = 1 + DEPTH * PH_PER_LAYER + 1;
__global__ void __launch_bounds__(NWAVES * 64, 2) mk_fwd(Args args) {
    extern __shared__ __attribute__((aligned(16))) unsigned char lds_raw[];
    Ctx F; F.lds = (LAS unsigned char*)lds_raw; F.in = args.in; F.out = args.out; F.ws = args.ws;
    F.wave = __builtin_amdgcn_readfirstlane((int)threadIdx.x >> 6); F.lane = 0; F.tid = 0;
#define T0() (F.wave == 0 && lane_id() == 0)
    F.G = gridDim.x; { const int bx = blockIdx.x; F.vcu = (F.G % 8 == 0) ? (bx % 8) * (F.G / 8) + bx / 8 : bx; }
    volatile LAS unsigned* MISC = (volatile LAS unsigned*)(F.lds + MISC_OFF);
    if (F.wave == 0) MISC[lane_id()] = 0u;
    __syncthreads();
    XcdBarrier bar; bar.bar = (unsigned*)(args.ws + WS_CTL); bar.x = 0; bar.st = nullptr;
    if (args.use_bar) bar = xcd_barrier_post((unsigned*)(args.ws + WS_CTL), MISC + 8, T0());
    const int lo = args.ph_lo, hi = args.ph_hi;
#ifndef PH_MASK
#define PH_MASK 0xFFFFu
#endif
#define IN(k) (lo <= (k) && (k) < hi)
#define ON(b) ((PH_MASK >> (b)) & 1u)
#define SEAM(k) do { if (IN(k) && IN((k) + 1)) xcd_barrier(bar, T0()); } while (0)
#ifndef REP_MASK
#define REP_MASK 0
#endif
#define REPS(b) ((REP_MASK >> (b)) & 1)
#define XBAR() do { if (args.use_bar) xcd_barrier(bar, T0()); } while (0)
#define GP bf16_t* XB = wsb(C, WS_XB) + (size_t)XB_PAD * D; float* RSS = wsf(C, WS_RSS) + (size_t)XB_PAD * 16; bf16_t* XBN = (bf16_t*)C.out; bf16_t* XBNO = layer + 1 < DEPTH ? (bf16_t*)C.out : wsb(C, WS_XBN); float* RSSN = wsf(C, WS_RSSN) + (size_t)XB_PAD * 16; \
    (void)XB; (void)RSS; (void)XBN; (void)XBNO; (void)RSSN
#define PHC Ctx C = F; C.lane = lane_id(); C.tid = C.wave * 64 + C.lane; OPAQUE_CTX(C); { size_t zz_ = 0; asm volatile("" : "+s"(zz_)); C.ws = F.ws + zz_; C.out = (float*)((char*)F.out + zz_); }
    PB(100);
    for (int rr_ = 0; rr_ <= REPS(0); ++rr_) { if (IN(0) && ON(0)) { PHC; convert_set(C, 0, 1 | 2 | 4 | 8 | 16 | 32 | 64 | 128, C.vcu, C.G); p0_rows(C); } if (rr_ < REPS(0)) XBAR(); }
    PE(100); PB(120); SEAM(0); PE(120);
    for (int layer = 0; layer < DEPTH; ++layer) {
        const int pb = 1 + layer * PH_PER_LAYER;
        PB(101);
        for (int rr_ = 0; rr_ <= REPS(1); ++rr_) { if (rr_) XBAR();
        if (IN(pb + 0) && ON(1)) { PHC; GP;
            pg8::Gemm g{XBN, wsb(C, WS_WIN), D, D, D}; pg8::StaticOrder S; S.init(M / 256, DINP / 256, C.G, (int)blockIdx.x, 0);
            EpiProj E{wsb(C, WS_R), RSSN}; pg8::gemm_phase<EpiProj, pg8::StaticOrder>(C.lds, g, S, E, C.wave);
            if (layer >= 1 && rr_ == 0 && C.G == 256 && (int)blockIdx.x >= 98) { __syncthreads(); convert_set(C, layer, 2 | 4 | 8 | 16 | 32 | 64, (int)blockIdx.x - 98, C.G - 98); }
            else if (layer >= 1 && rr_ == 0 && C.G != 256) { __syncthreads(); convert_set(C, layer, 2 | 4 | 8 | 16 | 32 | 64, C.vcu, C.G); }
        } }
        PE(101); PB(120); PB(121); SEAM(pb + 0); PE(121); PE(120); PB(102);
        for (int rr_ = 0; rr_ <= REPS(2); ++rr_) { if (rr_) XBAR(); if (IN(pb + 1) && ON(2)) { PHC; phase_mixer_a(C, layer); } }
        PE(102); PB(120); PB(123); SEAM(pb + 1); PE(123); PE(120); PB(103);
        for (int rr_ = 0; rr_ <= REPS(3); ++rr_) { if (rr_) XBAR();
        if (IN(pb + 2) && ON(3)) { PHC; phase_mixer_b(C, layer, rr_ < REPS(3));
            if (layer + 1 < DEPTH) convert_set(C, layer + 1, 1, C.vcu, C.G); } }
        PE(103); PB(120); PB(122); SEAM(pb + 2); PE(122); PE(120); PB(104);
        for (int rr_ = 0; rr_ <= REPS(4); ++rr_) { if (rr_) XBAR(); if (IN(pb + 3) && ON(4)) { PHC; phase_mixer_c(C, layer, rr_ < REPS(4)); } }
        PE(104); PB(120); PB(124); SEAM(pb + 3); PE(124); PE(120); PB(105);
        for (int rr_ = 0; rr_ <= REPS(5); ++rr_) { if (rr_) XBAR(); if (IN(pb + 4) && ON(5)) { PHC; phase_ssd_norm(C, layer, rr_ < REPS(5)); } }
        PE(105); PB(120); SEAM(pb + 4); PE(120); PB(106);
        for (int rr_ = 0; rr_ <= REPS(6); ++rr_) { if (rr_) XBAR(); const bool dry_ = rr_ < REPS(6);
        if (IN(pb + 5) && ON(6)) { PHC; GP;
            pg8::Gemm g{wsb(C, WS_R) + PC_Y, wsb(C, WS_WOUT), DINP, DMIX, DMIX}; pg8::StaticOrder S; S.init(MP / 256, D / 256, C.G, (int)blockIdx.x, 0);
            EpiRes E{XBN, XB, RSS, dry_};
            pg8::gemm_phase<EpiRes, pg8::StaticOrder>(C.lds, g, S, E, C.wave);
            { constexpr int SK = 6, KS = DMIX / SK; const int c = (int)blockIdx.x, j = c / SK, sl = c % SK;
              pg8::Gemm g2{wsb(C, WS_R) + PC_Y + sl * KS, wsb(C, WS_WOUT) + sl * KS, DINP, DMIX, KS}; OneUnit S2{64 + (j >> 2), j & 3, c < 8 * SK};
              EpiPart E2{C.out + (size_t)M * D / 2 + (size_t)(c < 8 * SK ? c : 0) * 65536}; pg8::gemm_phase<EpiPart, OneUnit>(C.lds, g2, S2, E2, C.wave); }
        } }
        XBAR();
        if (IN(pb + 5) && ON(6)) { PHC; GP; reduce_tail<0>(C, C.out + (size_t)M * D / 2, 6, XBN, XB, RSS, RSS, nullptr); }
        PE(106); PB(120); SEAM(pb + 5); PE(120); PB(107);
        for (int rr_ = 0; rr_ <= REPS(7); ++rr_) { if (rr_) XBAR();
        if (IN(pb + 6) && ON(7)) { PHC; GP;
            pg8::Gemm g{XB, wsb(C, WS_WGU), D, D, D}; pg8::StaticOrder S; S.init(67, 2 * DFF / 256, C.G, (int)blockIdx.x, 1);
            EpiFfn E{wsb(C, WS_R), RSS, C.in[I_FCW] + (size_t)layer * 3 * DFF, C.in[I_FCB] + layer * DFF, C.in[I_SFC] + (size_t)layer * 8 * 2 * DFF,
                     C.out + O_PFC + (size_t)layer * 2 * 2 * DFF, C.out + O_SFC + (size_t)layer * 8 * 2 * DFF};
            pg8::gemm_phase<EpiFfn, pg8::StaticOrder>(C.lds, g, S, E, C.wave);
            if (rr_ == 0) { const int sh = C.G == 256 ? 72 : 0;
                if ((int)blockIdx.x >= sh) { pg8::Gemm g2{wsb(C, WS_PB), wsb(C, WS_WPP), DPLE, DPLE, DPLE}; pg8::StaticOrder S2; S2.init(M / 256, D / 256, C.G - sh, (int)blockIdx.x - sh, 0);
                    EpiPP E2{wsb(C, WS_PPO)}; pg8::gemm_phase<EpiPP, pg8::StaticOrder>(C.lds, g2, S2, E2, C.wave); } }
        } }
        PE(107); PB(120); SEAM(pb + 6); PE(120); PB(108);
        for (int rr_ = 0; rr_ <= REPS(8); ++rr_) { if (rr_) XBAR(); const bool dry_ = rr_ < REPS(8);
        if (IN(pb + 7) && ON(8)) { PHC; GP;
            pg8::Gemm g{wsb(C, WS_R), wsb(C, WS_WD), DFF, DFF, DFF}; pg8::StaticOrder S; S.init(MP / 256, D / 256, C.G, (int)blockIdx.x, 0);
            EpiRes E{XB, XB, RSS, dry_}; pg8::gemm_phase<EpiRes, pg8::StaticOrder>(C.lds, g, S, E, C.wave);
            { constexpr int SK = 12, KS = DFF / SK; const int c = (int)blockIdx.x, j = c / SK, sl = c % SK;
              pg8::Gemm g2{wsb(C, WS_R) + sl * KS, wsb(C, WS_WD) + sl * KS, DFF, DFF, KS}; OneUnit S2{64 + (j >> 2), j & 3, c < 8 * SK};
              EpiPart E2{C.out + (size_t)M * D / 2 + (size_t)(c < 8 * SK ? c : 0) * 65536}; pg8::gemm_phase<EpiPart, OneUnit>(C.lds, g2, S2, E2, C.wave); }
        } }
        XBAR();
        if (IN(pb + 7) && ON(8)) { PHC; GP; reduce_tail<0>(C, C.out + (size_t)M * D / 2, 12, XB, XB, RSS, RSS, nullptr); }
        PE(108); PB(120); SEAM(pb + 7); PE(120); PB(109);
        for (int rr_ = 0; rr_ <= REPS(9); ++rr_) { if (rr_) XBAR(); const bool dry_ = rr_ < REPS(9);
        if (IN(pb + 8) && ON(9)) { PHC; GP;
            pg8::Gemm g{XB, wsb(C, WS_WPG), D, D, D}; pg8::StaticOrder S; S.init(MP / 256, D / 256, C.G, (int)blockIdx.x, 0);
            EpiPle E{XB, XBNO, RSS, RSSN, wsb(C, WS_PPO), dry_}; pg8::gemm_phase<EpiPle, pg8::StaticOrder>(C.lds, g, S, E, C.wave);
            { constexpr int SK = 4, KS = D / SK; const int c = (int)blockIdx.x, j = c / SK, sl = c % SK;
              pg8::Gemm g2{XB + sl * KS, wsb(C, WS_WPG) + sl * KS, D, D, KS}; OneUnit S2{64 + (j >> 2), j & 3, c < 8 * SK};
              EpiPart E2{C.out + (size_t)M * D / 2 + (size_t)(c < 8 * SK ? c : 0) * 65536}; pg8::gemm_phase<EpiPart, OneUnit>(C.lds, g2, S2, E2, C.wave); }
        } }
        XBAR();
        if (IN(pb + 8) && ON(9)) { PHC; GP; reduce_tail<1>(C, C.out + (size_t)M * D / 2, 4, XB, XBNO, RSS, RSSN, wsb(C, WS_PPO)); }
        PE(109); PB(120); SEAM(pb + 8); PE(120); PB(110);
    }
    PB(111);
    if (IN(N_PHASES - 1) && ON(10)) { PHC; phase_final(C); }
    PE(111);
    if (PROBE_ID != 0 && (int)blockIdx.x == PROBE_WG) { __syncthreads(); if (F.wave == 0) { const unsigned tot = MISC[32] * PROBE_MULT; const unsigned t0 = (unsigned)__builtin_amdgcn_s_memrealtime();
        while ((unsigned)__builtin_amdgcn_s_memrealtime() - t0 < tot) __builtin_amdgcn_s_sleep(8); } }
#undef IN
#undef ON
#undef SEAM
}

extern "C" void kernel_launch(void* const* d_in, const int* in_sizes, int n_in, void* d_out, int out_size, void* d_ws, size_t ws_size, hipStream_t stream) {
    static int grid = 0;
    if (grid == 0) {
        if (n_in != N_IN || (size_t)out_size != O_END || ws_size < WS_END) { fprintf(stderr, "kernel_launch: unexpected shapes: n_in %d out %d ws %zu (need %d, %zu, %zu)\n", n_in, out_size, ws_size, (int)N_IN, (size_t)O_END, (size_t)WS_END); grid = -1; return; }
        int dev = 0, cus = 0, per_cu = 0;
        if (hipGetDevice(&dev) != hipSuccess || hipDeviceGetAttribute(&cus, hipDeviceAttributeMultiprocessorCount, dev) != hipSuccess) { grid = -1; return; }
        if (hipFuncSetAttribute((const void*)mk_fwd, hipFuncAttributeMaxDynamicSharedMemorySize, LDS_BYTES) != hipSuccess) { fprintf(stderr, "kernel_launch: hipFuncSetAttribute failed\n"); grid = -1; return; }
        if (hipOccupancyMaxActiveBlocksPerMultiprocessor(&per_cu, (const void*)mk_fwd, NWAVES * 64, LDS_BYTES) != hipSuccess || per_cu < 1) { fprintf(stderr, "kernel_launch: occupancy query says %d\n", per_cu); per_cu = 1; }
        (void)hipGetLastError();
        grid = cus;
    }
    if (grid < 0) return;
    (void)hipMemsetAsync((char*)d_ws + WS_CTL, 0, CTL_ZERO_BYTES, stream);
    Args a{};
    for (int i = 0; i < N_IN; ++i) a.in[i] = (const float*)d_in[i];
    a.out = (float*)d_out; a.ws = (unsigned char*)d_ws;
#if MK_PER_PHASE
    for (int p = 0; p < N_PHASES; ++p) { a.ph_lo = p; a.ph_hi = p + 1; a.use_bar = 0; hipLaunchKernelGGL(mk_fwd, dim3(grid), dim3(NWAVES * 64), LDS_BYTES, stream, a); }
#else
    a.ph_lo = 0; a.ph_hi = N_PHASES; a.use_bar = 1;
    void* kargs[] = {&a};
    hipError_t e = hipLaunchCooperativeKernel((const void*)mk_fwd, dim3(grid), dim3(NWAVES * 64), kargs, LDS_BYTES, stream);
    if (e != hipSuccess) fprintf(stderr, "kernel_launch: cooperative launch failed: %s\n", hipGetErrorString(e));
#endif
}
```

```cpp
#include <hip/hip_runtime.h>
#include <cstdio>
#include <cstdint>

#define DI __device__ __forceinline__
#define LAS __attribute__((address_space(3)))
typedef unsigned short bf16_t;
typedef short bf16x8 __attribute__((ext_vector_type(8)));
typedef short s16x4 __attribute__((ext_vector_type(4)));
typedef float f32x4 __attribute__((ext_vector_type(4)));
typedef float f32x2 __attribute__((ext_vector_type(2)));
typedef unsigned u32x4 __attribute__((ext_vector_type(4)));
typedef unsigned u32x2 __attribute__((ext_vector_type(2)));

#ifndef MK_PER_PHASE
#define MK_PER_PHASE 0
#endif

constexpr int DEPTH = 2, D = 1024, MP = 16384, MS = 512, M = MP + MS;
constexpr int DIN = 4120, DINP = 4352, DFF = 3072, DMIX = 1536, DPLE = 256;
constexpr int NCH = M / 64;
constexpr float EPS = 1e-6f;
constexpr int PC_AX = 0, PC_BQ = 512, PC_BK = 768, PC_BV = 1024, PC_BLR = 1536, PC_XBC = 1552, PC_DT = 2576, PC_PAD = 2584, PC_Y = 2816, PC_AG = 2816, PC_BG = 3328, PC_CZ = 3840;

enum { I_XP = 0, I_XS, I_SLC, I_SLH, I_SG, I_SSC, I_SS, I_SFC, I_PP, I_PS, I_NMIX, I_WIN, I_LCW, I_LCB, I_LWR, I_LBR, I_LWI, I_LBI, I_LAM, I_GWLR, I_GBLR, I_GNORM,
       I_SCW, I_SCB, I_SDTB, I_SALOG, I_SD, I_SNORM, I_WOUT, I_NFFN, I_WG, I_WU, I_FCW, I_FCB, I_WD, I_NPLE, I_PWG, I_PWP, I_NFIN, N_IN };
constexpr size_t O_Y = 0;
constexpr size_t O_PLC = (size_t)M * D;
constexpr size_t O_PLH = O_PLC + 2 * 2 * 3 * 512;
constexpr size_t O_PG = O_PLH + 2 * 2 * 512;
constexpr size_t O_PSC = O_PG + 2 * 2 * 4 * 64 * 128;
constexpr size_t O_PS = O_PSC + 2 * 2 * 3 * 1024;
constexpr size_t O_PFC = O_PS + 2 * 2 * 8 * 64 * 128;
constexpr size_t O_SLC = O_PFC + 2 * 2 * 2 * 3072;
constexpr size_t O_SLH = O_SLC + 2 * 8 * 3 * 512;
constexpr size_t O_SG = O_SLH + 2 * 8 * 512;
constexpr size_t O_SSC = O_SG + 2 * 8 * 4 * 64 * 128;
constexpr size_t O_SS = O_SSC + 2 * 8 * 3 * 1024;
constexpr size_t O_SFC = O_SS + 2 * 8 * 8 * 64 * 128;
constexpr size_t O_END = O_SFC + 2 * 8 * 2 * 3072;

constexpr size_t MiB = 1u << 20;
constexpr size_t al4k(size_t x) { return (x + 4095) & ~(size_t)4095; }
constexpr int XB_PAD = 256;
constexpr int XB_ROWS = XB_PAD + M + 128;
constexpr size_t WS_CTL = 0, CTL_ZERO_BYTES = 64 * 1024;
constexpr size_t WS_WIN = al4k(WS_CTL + CTL_ZERO_BYTES);
constexpr size_t WS_WOUT = al4k(WS_WIN + (size_t)DINP * D * 2);
constexpr size_t WS_WGU = al4k(WS_WOUT + (size_t)D * DMIX * 2);
constexpr size_t WS_WD = al4k(WS_WGU + (size_t)2 * DFF * D * 2);
constexpr size_t WS_WPG = al4k(WS_WD + (size_t)D * DFF * 2);
constexpr size_t WS_WPP = al4k(WS_WPG + (size_t)D * D * 2);
constexpr size_t WS_LRUW = al4k(WS_WPP + (size_t)D * DPLE * 2);
constexpr size_t WS_RSS = al4k(WS_LRUW + (size_t)DEPTH * 2 * 8 * 4096 * 2);
constexpr size_t WS_RSSN = al4k(WS_RSS + (size_t)XB_ROWS * 64);
constexpr size_t WS_PSS = al4k(WS_RSSN + (size_t)XB_ROWS * 64);
constexpr size_t WS_LRUS = al4k(WS_PSS + (size_t)M * 64);
constexpr size_t WS_DEC = al4k(WS_LRUS + (size_t)3 * NCH * 512 * 4);
constexpr size_t WS_PB = al4k(WS_DEC + (size_t)(64 * 4 * 64 + 64 * 8) * 4);
constexpr size_t WS_XB = al4k(WS_PB + (size_t)M * DPLE * 2);
constexpr size_t WS_DS = al4k(WS_XB + (size_t)XB_ROWS * D * 2);
constexpr size_t WS_XBN = WS_DS;
constexpr size_t WS_R = al4k(WS_DS + (size_t)M * D * 2);
constexpr size_t WS_PPO = WS_R + 100 * MiB;
constexpr size_t WS_END = WS_R + (size_t)M * DINP * 2;
static_assert(WS_END <= 256 * MiB, "workspace");
static_assert((size_t)64 * 12 * 8192 * 4 <= (size_t)M * D * 2, "DS fits the XBN slot");
static_assert((size_t)M * DFF * 2 <= 100 * MiB && WS_PPO + (size_t)M * D * 2 <= WS_END, "overlay");

constexpr int MISC_OFF = 147456 + 4096;
DI float bf2f(bf16_t b) { return __uint_as_float(((unsigned)b) << 16); }
DI unsigned f2bf(float f) { unsigned u = __float_as_uint(f); return (u + 0x7fffu + ((u >> 16) & 1u)) >> 16; }
DI unsigned pk2(float lo, float hi) { return f2bf(lo) | (f2bf(hi) << 16); }
DI float sigm(float x) { return __builtin_amdgcn_rcpf(1.f + __expf(-x)); }
DI float silu_f(float x) { return x * __builtin_amdgcn_rcpf(1.f + __expf(-x)); }
DI float gelu_t(float x) { const float u = 1.5957691216f * (x + 0.044715f * x * x * x); return x * __builtin_amdgcn_rcpf(1.f + __expf(-u)); }
DI float softplus_f(float x) { return fmaxf(x, 0.f) + log1pf(__expf(-fabsf(x))); }
DI float logsig_f(float x) { return fminf(x, 0.f) - log1pf(__expf(-fabsf(x))); }
template <int CTRL> DI float dpp_ror(float x) { return __builtin_bit_cast(float, __builtin_amdgcn_update_dpp(0, __builtin_bit_cast(int, x), CTRL, 0xf, 0xf, false)); }
DI float log1p_small(float e) { return e < 0.01f ? e * (1.f - e * (0.5f - e * 0.33333334f)) : __logf(1.f + e); }
DI float softplus_fast(float x) { return fmaxf(x, 0.f) + log1p_small(__expf(-fabsf(x))); }
DI float logsig_fast(float x) { return fminf(x, 0.f) - __logf(1.f + __expf(-fabsf(x))); }
DI float wave_incl_scan(float v) {
#define DPPF(x, ctrl, rm, bc) __builtin_bit_cast(float, __builtin_amdgcn_update_dpp(0, __builtin_bit_cast(int, (x)), (ctrl), (rm), 0xf, (bc)))
    v += DPPF(v, 0x111, 0xf, true); v += DPPF(v, 0x112, 0xf, true); v += DPPF(v, 0x114, 0xf, true); v += DPPF(v, 0x118, 0xf, true);
    v += DPPF(v, 0x142, 0xa, false); v += DPPF(v, 0x143, 0xc, false);
#undef DPPF
    return v;
}
DI void unpack8(const u32x4 v, float (&o)[8]) {
#pragma unroll
    for (int i = 0; i < 4; ++i) { o[2 * i] = __uint_as_float(v[i] << 16); o[2 * i + 1] = __uint_as_float(v[i] & 0xffff0000u); }
}
DI u32x4 pack8(const float (&o)[8]) { u32x4 r; r.x = pk2(o[0], o[1]); r.y = pk2(o[2], o[3]); r.z = pk2(o[4], o[5]); r.w = pk2(o[6], o[7]); return r; }
DI int lane_id() { int l; asm volatile("v_mbcnt_lo_u32_b32 %0, -1, 0\n\tv_mbcnt_hi_u32_b32 %0, -1, %0" : "=v"(l)); return l; }
#define LDS_WAIT() asm volatile("s_waitcnt lgkmcnt(0)" ::: "memory")
#define VM_WAIT() asm volatile("s_waitcnt vmcnt(0)" ::: "memory")

namespace pg8 {
constexpr int BM = 256, BK = 64, HALF = 128, HTB = HALF * BK * 2, STAGE_BYTES = 8 * HTB, NXCD = 8, WGM = 8;
__host__ __device__ __forceinline__ int lds_byte(int r, int c) { const int st = (r >> 4) * 2 + (c >> 5), rr = r & 15, cc = c & 31, ob = rr * 64 + cc * 2; return st * 1024 + (ob ^ (((ob >> 9) & 1) << 5)); }
__host__ __device__ __forceinline__ void stage_rc(int b, int& R, int& C) { const int st = b / 1024, sb = b % 1024, swz = sb ^ (((sb >> 9) & 1) << 5); R = (st >> 1) * 16 + swz / 64; C = (st & 1) * 32 + (swz % 64) / 2; }
__host__ __device__ __forceinline__ int perm32(int rho) { const int n = rho >> 4, i = rho & 15; return 8 * (i >> 2) + 4 * n + (i & 3); }

struct Unit { int pm, pn, arow; };
struct Gemm { const bf16_t* A; const bf16_t* Bt; int lda, ldb, K; };

struct StaticOrder {
    int nM, nN, nwg, G, c, shifted;
    __device__ void init(int nM_, int nN_, int G_, int c_, int shifted_) { nM = nM_; nN = nN_; nwg = nM * nN; G = G_; c = c_; shifted = shifted_; }
    __device__ bool next(int i, Unit& u) const {
        const long L = (long)i * G + c; if (L >= nwg) return false;
        int wgid = (int)L; { const int q = nwg / NXCD, r = nwg % NXCD, xcd = wgid % NXCD, off = wgid / NXCD; wgid = (xcd < r ? xcd * (q + 1) : r * (q + 1) + (xcd - r) * q) + off; }
        const int nig = WGM * nN, gid = wgid / nig, fm = gid * WGM, gsz = (nM - fm) < WGM ? (nM - fm) : WGM;
        u.pm = fm + ((wgid % nig) % gsz); u.pn = (wgid % nig) / gsz; u.arow = shifted ? 254 * u.pm - 2 : 256 * u.pm; return true;
    }
};
typedef __bf16 bf16x2_t __attribute__((ext_vector_type(2)));
DI unsigned cvt_pk_bf16(float lo, float hi) { const f32x2 v = {lo, hi}; const bf16x2_t r = __builtin_convertvector(v, bf16x2_t); return __builtin_bit_cast(unsigned, r); }

template <class Epi, class Sched>
DI void gemm_phase(LAS unsigned char* lds, const Gemm g, const Sched& S, const Epi& E, int wid) {
    const int lane = lane_id(), tid = wid * 64 + lane, wr = wid >> 2, wc = wid & 3, fr = lane & 15, fq = lane >> 4;
    const int K = g.K, nt = K / BK;
    unsigned voffA[2], voffB[2];
#pragma unroll
    for (int i = 0; i < 2; ++i) { int R, C; stage_rc(tid * 16 + i * 8192, R, C); const int Rb = Epi::PERM ? ((R & ~31) + perm32(R & 31)) : R;
        voffA[i] = (unsigned)(R * g.lda + C) * 2u; voffB[i] = (unsigned)(Rb * g.ldb + C) * 2u; }
    const size_t kstep = (size_t)(BK * 2);
    const size_t hstepA = (size_t)HALF * g.lda * 2, hstepB = (size_t)HALF * g.ldb * 2;
    const unsigned ldsw = (unsigned)wid * 1024u;
    const int aoff = lds_byte(wr * 64 + fr, fq * 8), boff = lds_byte(wc * 32 + fr, fq * 8);
#define PG8_SA(b, h) (((b) * 2 + (h)) * HTB)
#define PG8_SB(b, h) ((4 + (b) * 2 + (h)) * HTB)
#define PG8_STAGE(bufoff, gbase, voff) do { _Pragma("unroll") for (int _i = 0; _i < 2; ++_i) \
        __builtin_amdgcn_global_load_lds((const unsigned*)((const char*)(gbase) + (voff)[_i]), (LAS unsigned*)(lds + (bufoff) + ldsw + _i * 8192), 16, 0, 0); } while (0)
#define PG8_LDA(dst, b, h) do { _Pragma("unroll") for (int m = 0; m < 4; ++m) _Pragma("unroll") for (int k = 0; k < 2; ++k) dst[m][k] = *(const LAS bf16x8*)(lds + PG8_SA(b, h) + aoff + m * 2048 + k * 1024); } while (0)
#define PG8_LDB(dst, b, h) do { _Pragma("unroll") for (int n = 0; n < 2; ++n) _Pragma("unroll") for (int k = 0; k < 2; ++k) dst[n][k] = *(const LAS bf16x8*)(lds + PG8_SB(b, h) + boff + n * 2048 + k * 1024); } while (0)
#define PG8_MMA(ai, bj, At, Bt) do { __builtin_amdgcn_s_setprio(1); _Pragma("unroll") for (int m = 0; m < 4; ++m) _Pragma("unroll") for (int n = 0; n < 2; ++n) _Pragma("unroll") for (int k = 0; k < 2; ++k) \
        acc[ai][bj][m][n] = __builtin_amdgcn_mfma_f32_16x16x32_bf16(Bt[n][k], At[m][k], acc[ai][bj][m][n], 0, 0, 0); __builtin_amdgcn_s_setprio(0); } while (0)
#define PG8_WAIT_V(n) asm volatile("s_waitcnt vmcnt(" #n ")" ::: "memory")
#define PG8_WAIT_L(n) asm volatile("s_waitcnt lgkmcnt(" #n ")" ::: "memory")
#define PG8_BAR __builtin_amdgcn_s_barrier()
#define PG8_SCHED __builtin_amdgcn_sched_barrier(0)
    Unit cur, nxt; int ui = 0;
    if (!S.next(0, cur)) return;
    f32x4 acc[2][2][4][2];
#pragma unroll
    for (int a = 0; a < 2; ++a)
#pragma unroll
        for (int b = 0; b < 2; ++b)
#pragma unroll
            for (int m = 0; m < 4; ++m)
#pragma unroll
                for (int n = 0; n < 2; ++n) acc[a][b][m][n] = (f32x4){0.f, 0.f, 0.f, 0.f};
    bf16x8 At[4][2], B0[2][2], B1[2][2];
    const char* cA = (const char*)g.A + (long)cur.arow * g.lda * 2; const char* cB = (const char*)g.Bt + (size_t)cur.pn * 256 * g.ldb * 2;
    PG8_STAGE(PG8_SB(0, 0), cB, voffB); PG8_STAGE(PG8_SB(0, 1), cB + hstepB, voffB); PG8_STAGE(PG8_SA(0, 0), cA, voffA); PG8_STAGE(PG8_SA(0, 1), cA + hstepA, voffA);
    if (wr == 1) PG8_BAR;
    PG8_WAIT_V(2); PG8_BAR;
    PG8_STAGE(PG8_SB(1, 0), cB + kstep, voffB); PG8_STAGE(PG8_SA(1, 0), cA + kstep, voffA); PG8_STAGE(PG8_SB(1, 1), cB + hstepB + kstep, voffB);
    PG8_WAIT_V(6); PG8_BAR;
    for (;;) {
        const bool has_next = S.next(ui + 1, nxt);
        const char* nA = has_next ? (const char*)g.A + (long)nxt.arow * g.lda * 2 : cA; const char* nB = has_next ? (const char*)g.Bt + (size_t)nxt.pn * 256 * g.ldb * 2 : cB;
#pragma unroll 1
        for (int t = 0; t < nt; t += 2) {
            const bool last = (t == nt - 2);
            const char* a1 = cA + (size_t)(t + 1) * kstep;
            const char* a2 = last ? nA : cA + (size_t)(t + 2) * kstep; const char* b2 = last ? nB : cB + (size_t)(t + 2) * kstep;
            const char* a3 = a2 + kstep; const char* b3 = b2 + kstep;
            PG8_LDB(B0, 0, 0); PG8_LDB(B1, 0, 1); PG8_SCHED; PG8_LDA(At, 0, 0); PG8_STAGE(PG8_SA(1, 1), a1 + hstepA, voffA);
            PG8_WAIT_V(8); PG8_WAIT_L(0); PG8_BAR; PG8_MMA(0, 0, At, B0); PG8_MMA(0, 1, At, B1); PG8_BAR; PG8_SCHED;
            PG8_LDA(At, 0, 1); PG8_STAGE(PG8_SB(0, 0), b2, voffB); PG8_STAGE(PG8_SB(0, 1), b2 + hstepB, voffB); PG8_STAGE(PG8_SA(0, 0), a2, voffA);
            PG8_WAIT_V(8); PG8_WAIT_L(0); PG8_BAR; PG8_MMA(1, 0, At, B0); PG8_MMA(1, 1, At, B1); PG8_BAR; PG8_SCHED;
            PG8_LDB(B0, 1, 0); PG8_LDB(B1, 1, 1); PG8_SCHED; PG8_LDA(At, 1, 0); PG8_STAGE(PG8_SA(0, 1), a2 + hstepA, voffA);
            PG8_WAIT_V(8); PG8_WAIT_L(0); PG8_BAR; PG8_MMA(0, 0, At, B0); PG8_MMA(0, 1, At, B1); PG8_BAR; PG8_SCHED;
            PG8_LDA(At, 1, 1); PG8_STAGE(PG8_SB(1, 0), b3, voffB); PG8_STAGE(PG8_SB(1, 1), b3 + hstepB, voffB); PG8_STAGE(PG8_SA(1, 0), a3, voffA);
            PG8_WAIT_V(8); PG8_WAIT_L(0); PG8_BAR; PG8_MMA(1, 0, At, B0); PG8_MMA(1, 1, At, B1); PG8_BAR; PG8_SCHED;
        }
        if (wr == 0) PG8_BAR;
        { const int l2 = lane_id(); E(acc, cur, wr, wc, l2 & 15, l2 >> 4, lds); }
        if (!has_next) break;
#pragma unroll
        for (int a = 0; a < 2; ++a)
#pragma unroll
            for (int b = 0; b < 2; ++b)
#pragma unroll
                for (int m = 0; m < 4; ++m)
#pragma unroll
                    for (int n = 0; n < 2; ++n) acc[a][b][m][n] = (f32x4){0.f, 0.f, 0.f, 0.f};
        cur = nxt; cA = nA; cB = nB; ++ui;
        if (wr == 1) PG8_BAR;
    }
    PG8_WAIT_V(0);
    PG8_BAR;
#undef PG8_SA
#undef PG8_SB
#undef PG8_STAGE
#undef PG8_LDA
#undef PG8_LDB
#undef PG8_MMA
#undef PG8_WAIT_V
#undef PG8_WAIT_L
#undef PG8_BAR
#undef PG8_SCHED
}
}

#define XB_TMO      128
#define XB_XCNT(j)  (256  + 64 * (j))
#define XB_XSUB(j)  (1280 + 64 * (j))
#define XB_XGEN(j)  (2304 + 64 * (j))
#define XB_TOP      3328
#define XB_TOPGEN   3392
#define XCD_BAR_WORDS 3456
#define XB_SPIN_CAP (1u << 18)
DI unsigned xb_ld(unsigned* p)              { return __hip_atomic_load(p, __ATOMIC_RELAXED, __HIP_MEMORY_SCOPE_AGENT); }
DI unsigned xb_add(unsigned* p, unsigned v) { return __hip_atomic_fetch_add(p, v, __ATOMIC_RELAXED, __HIP_MEMORY_SCOPE_AGENT); }
DI unsigned xb_xcc_id() { return (unsigned)__builtin_amdgcn_s_getreg((3 << 11) | 20) & 0xFu; }
#define XB_SPIN(cond, bar) do { unsigned _sp = 0; while (cond) { __builtin_amdgcn_s_sleep(1); \
    if ((++_sp & 255u) == 0u) { if (xb_ld(&(bar)[XB_TMO])) break; if (_sp > XB_SPIN_CAP) { atomicAdd(&(bar)[XB_TMO], 1u); break; } } } } while (0)
struct XcdBarrier { unsigned* bar; unsigned x; volatile LAS unsigned* st; };
DI XcdBarrier xcd_barrier_post(unsigned* bar, volatile LAS unsigned* st, bool t0) {
    XcdBarrier b; b.bar = bar; b.x = xb_xcc_id(); b.st = st;
    if (t0) (void)xb_add(&bar[XB_XCNT(b.x)], 1u);
    return b;
}
DI void xcd_barrier_complete(unsigned* bar, unsigned x, unsigned& nloc, unsigned& nx) {
    const unsigned G = gridDim.x * gridDim.y * gridDim.z;
    unsigned sum, cnt, mine, sp = 0u;
    for (;;) {
        sum = 0u; cnt = 0u; mine = 0u;
#pragma unroll
        for (unsigned j = 0; j < 16; ++j) { const unsigned c = xb_ld(&bar[XB_XCNT(j)]); sum += c; cnt += (c > 0u) ? 1u : 0u; mine = (j == x) ? c : mine; }
        if (sum == G) break;
        __builtin_amdgcn_s_sleep(1);
        if ((++sp & 255u) == 0u) { if (xb_ld(&bar[XB_TMO])) break; if (sp > XB_SPIN_CAP) { atomicAdd(&bar[XB_TMO], 1u); break; } }
    }
    nloc = mine > 0u ? mine : 1u; nx = cnt > 0u ? cnt : 1u;
}
DI void xcd_barrier(const XcdBarrier& b, bool t0) {
    asm volatile("s_waitcnt vmcnt(0)" ::: "memory");
    __syncthreads();
    if (t0) {
        unsigned* bar = b.bar;
        __builtin_amdgcn_s_waitcnt(0);
        unsigned nloc = b.st[0], nx = b.st[1];
        if (nloc == 0u) { xcd_barrier_complete(bar, b.x, nloc, nx); b.st[0] = nloc; b.st[1] = nx; }
        const unsigned old = xb_add(&bar[XB_XSUB(b.x)], 1u);
        const unsigned gen = old / nloc;
        if (old + 1u == (gen + 1u) * nloc) {
            __builtin_amdgcn_fence(__ATOMIC_RELEASE, "agent");
            asm volatile("s_waitcnt vmcnt(0)" ::: "memory");
            const unsigned og = xb_add(&bar[XB_TOP], 1u);
            const unsigned tg = og / nx;
            if (og + 1u == (tg + 1u) * nx) xb_add(&bar[XB_TOPGEN], 1u);
            else XB_SPIN(xb_ld(&bar[XB_TOPGEN]) == tg, bar);
            __builtin_amdgcn_fence(__ATOMIC_ACQUIRE, "agent");
            xb_add(&bar[XB_XGEN(b.x)], 1u);
            asm volatile("s_waitcnt vmcnt(0)" ::: "memory");
        } else {
            XB_SPIN(xb_ld(&bar[XB_XGEN(b.x)]) == gen, bar);
            __builtin_amdgcn_fence(__ATOMIC_ACQUIRE, "agent");
            asm volatile("s_waitcnt vmcnt(0)" ::: "memory");
        }
    }
    __syncthreads();
}

#ifndef PROBE_ID
#define PROBE_ID 0
#endif
#ifndef PROBE_WG
#define PROBE_WG 0
#endif
#ifndef PROBE_MULT
#define PROBE_MULT 8
#endif
constexpr int NWAVES = 8;
constexpr int RING_BYTES = 131072;
constexpr int MIX_LDS = 147456;
constexpr int XG_OFF = MIX_LDS;
static_assert(MISC_OFF == MIX_LDS + 4096, "LDS map");
constexpr int LDS_BYTES = 155648;

struct Args { const float* in[N_IN]; float* out; unsigned char* ws; int ph_lo, ph_hi, use_bar, pad; };

struct Ctx {
    LAS unsigned char* lds;
    const float* const* in; float* out; unsigned char* ws;
    int tid, lane, wave, G, vcu;
};
#define OPAQUE_CTX(C) do { asm volatile("" : "+v"((C).tid), "+v"((C).lane)); asm volatile("" : "+s"((C).wave), "+s"((C).vcu)); } while (0)
#define PB(id) do { if ((id) == PROBE_ID && PROBE_ID != 0 && (int)blockIdx.x == PROBE_WG && F.wave == 0 && lane_id() == 0) { volatile LAS unsigned* pw_ = (volatile LAS unsigned*)(F.lds + MISC_OFF); pw_[33] = (unsigned)__builtin_amdgcn_s_memrealtime(); } } while (0)
#define PE(id) do { if ((id) == PROBE_ID && PROBE_ID != 0 && (int)blockIdx.x == PROBE_WG && F.wave == 0 && lane_id() == 0) { volatile LAS unsigned* pw_ = (volatile LAS unsigned*)(F.lds + MISC_OFF); pw_[32] += (unsigned)__builtin_amdgcn_s_memrealtime() - pw_[33]; } } while (0)
DI bf16_t* wsb(const Ctx& F, size_t off) { return (bf16_t*)(F.ws + off); }
DI float* wsf(const Ctx& F, size_t off) { return (float*)(F.ws + off); }

DI bool chunk_first(int c) { return c == 0 || c == 128 || c >= 256; }
DI bool chunk_last(int c) { return c == 127 || c >= 255; }
DI int chunk_seq(int c) { return c < 128 ? 0 : (c < 256 ? 1 : c - 254); }
DI float* st_out(const Ctx& F, size_t offp, size_t offs, int layer, int seq, int per) {
    return seq < 2 ? F.out + offp + (size_t)(layer * 2 + seq) * per : F.out + offs + (size_t)(layer * 8 + (seq - 2)) * per;
}

DI float wave_sum(float v) {
#pragma unroll
    for (int o = 1; o < 64; o <<= 1) v += __shfl_xor(v, o);
    return v;
}
DI int win_dst(int n) {
    if (n < 512) return PC_AX + n;
    if (n < 1024) return PC_AG + (n - 512);
    if (n < 1280) return PC_BQ + (n - 1024);
    if (n < 1536) return PC_BK + (n - 1280);
    if (n < 2048) return PC_BV + (n - 1536);
    if (n < 2560) return PC_BG + (n - 2048);
    if (n < 2576) return PC_BLR + (n - 2560);
    if (n < 3088) return PC_CZ + (n - 2576);
    if (n < 4112) return PC_XBC + (n - 3088);
    return PC_DT + (n - 4112);
}
DI int map_row(int mode, int n) {
    if (mode == 1) return win_dst(n);
    if (mode == 2) return 256 * (n >> 7) + (n & 127);
    if (mode == 3) return 256 * (n >> 7) + 128 + (n & 127);
    return n;
}
constexpr int TR_PITCH = 68, TR_WAVE_BYTES = 64 * TR_PITCH * 4;
DI void tr_item(const float* W, int K, int N, bf16_t* WT, int mode, const float* g, LAS float* scr, int item, int lane) {
    const int nblk = (N + 63) / 64, kb = item / nblk, nb = item % nblk, k0 = 64 * kb, n0 = 64 * nb;
    const int c4 = (lane & 15) * 4, kr = lane >> 4;
#pragma unroll 8
    for (int i = 0; i < 16; ++i) { const int kk = 4 * i + kr, n = n0 + c4; f32x4 v = {0.f, 0.f, 0.f, 0.f}; if (n < N) v = *(const f32x4*)(W + (size_t)(k0 + kk) * N + n);
        if (g) v *= g[k0 + kk]; *(LAS f32x4*)(scr + kk * TR_PITCH + c4) = v; }
    LDS_WAIT();
    const int c = lane & 7;
#pragma unroll
    for (int j = 0; j < 8; ++j) { const int n = (lane >> 3) + 8 * j; const LAS float* s = scr + (8 * c) * TR_PITCH + n;
        u32x4 o; o.x = pk2(s[0 * TR_PITCH], s[1 * TR_PITCH]); o.y = pk2(s[2 * TR_PITCH], s[3 * TR_PITCH]); o.z = pk2(s[4 * TR_PITCH], s[5 * TR_PITCH]); o.w = pk2(s[6 * TR_PITCH], s[7 * TR_PITCH]);
        if (n0 + n < N) *(u32x4*)(WT + (size_t)map_row(mode, n0 + n) * K + k0 + 8 * c) = o; }
    LDS_WAIT();
}
DI void convert_set(const Ctx& F, int layer, int which, int wgi, int nwg) {
    LAS float* scr = (LAS float*)(F.lds + F.wave * TR_WAVE_BYTES);
    const int gw = wgi * NWAVES + F.wave, NGW = nwg * NWAVES;
    int base = 0;
#define CONV_MAT(cond, Wp, K_, N_, WTp, mode_, gp) if (cond) { const int ni = ((K_) / 64) * (((N_) + 63) / 64); \
        for (int it = gw - base; it < ni; it += NGW) { if (it >= 0) tr_item(Wp, K_, N_, WTp, mode_, gp, scr, it, F.lane); } base = (base + ni) % NGW; }
    CONV_MAT(which & 1, F.in[I_WIN] + (size_t)layer * D * DIN, D, DIN, wsb(F, WS_WIN), 1, F.in[I_NMIX] + layer * D)
    CONV_MAT(which & 2, F.in[I_WOUT] + (size_t)layer * DMIX * D, DMIX, D, wsb(F, WS_WOUT), 0, (const float*)nullptr)
    CONV_MAT(which & 4, F.in[I_WG] + (size_t)layer * D * DFF, D, DFF, wsb(F, WS_WGU), 2, F.in[I_NFFN] + layer * D)
    CONV_MAT(which & 4, F.in[I_WU] + (size_t)layer * D * DFF, D, DFF, wsb(F, WS_WGU), 3, F.in[I_NFFN] + layer * D)
    CONV_MAT(which & 8, F.in[I_WD] + (size_t)layer * DFF * D, DFF, D, wsb(F, WS_WD), 0, (const float*)nullptr)
    CONV_MAT(which & 16, F.in[I_PWG] + (size_t)layer * D * D, D, D, wsb(F, WS_WPG), 0, F.in[I_NPLE] + layer * D)
    CONV_MAT(which & 32, F.in[I_PWP] + (size_t)layer * DPLE * D, DPLE, D, wsb(F, WS_WPP), 0, (const float*)nullptr)
    if (which & 128) {
        for (int it = gw; it < DEPTH * 2 * 8; it += NGW) { const int mat = it, l = mat >> 4, ri = (mat >> 3) & 1, h = mat & 7;
            tr_item(F.in[ri ? I_LWI : I_LWR] + (size_t)(l * 8 + h) * 4096, 64, 64, wsb(F, WS_LRUW) + (size_t)((l * 2 + ri) * 8 + h) * 4096, 0, nullptr, scr, 0, F.lane); }
    }
#undef CONV_MAT
    if (which & 1) {
        u32x4* z = (u32x4*)(wsb(F, WS_WIN) + (size_t)PC_PAD * D); const int n16 = (PC_Y - PC_PAD) * D * 2 / 16;
        u32x4 zv = (u32x4){0u, 0u, 0u, 0u}; asm volatile("" : "+v"(zv));
        for (int i = wgi * 512 + F.tid; i < n16; i += nwg * 512) z[i] = zv;
    }
    if (which & 64) {
        const float* pp = F.in[I_PP] + (size_t)layer * MP * DPLE; const float* ps = F.in[I_PS] + (size_t)layer * MS * DPLE; bf16_t* pb = wsb(F, WS_PB);
        const int n8 = M * DPLE / 8;
        for (int i = wgi * 512 + F.tid; i < n8; i += nwg * 512) { const size_t e = (size_t)i * 8; const float* src = e < (size_t)MP * DPLE ? pp + e : ps + (e - (size_t)MP * DPLE);
            const f32x4 a = *(const f32x4*)src, b = *(const f32x4*)(src + 4); u32x4 o; o.x = pk2(a.x, a.y); o.y = pk2(a.z, a.w); o.z = pk2(b.x, b.y); o.w = pk2(b.z, b.w); *(u32x4*)(pb + e) = o; }
    }
}
DI void p0_rows(const Ctx& F) {
    const int gw = F.vcu * NWAVES + F.wave, NGW = F.G * NWAVES;
    bf16_t* xb = (bf16_t*)F.out; float* rss = wsf(F, WS_RSSN) + (size_t)XB_PAD * 16;
    for (int m0 = gw; m0 < M; m0 += 2 * NGW) {
        f32x4 v[2][4]; float s[2];
#pragma unroll
        for (int k = 0; k < 2; ++k) { const int m = m0 + k * NGW < M ? m0 + k * NGW : m0; const float* xr = m < MP ? F.in[I_XP] + (size_t)m * D : F.in[I_XS] + (size_t)(m - MP) * D; const f32x4* x4 = (const f32x4*)xr + F.lane;
#pragma unroll
            for (int j = 0; j < 4; ++j) v[k][j] = x4[64 * j]; }
#pragma unroll
        for (int k = 0; k < 2; ++k) { const int m = m0 + k * NGW; if (m >= M) break; float ss = 0.f;
#pragma unroll
            for (int j = 0; j < 4; ++j) ss += (v[k][j].x * v[k][j].x + v[k][j].y * v[k][j].y) + (v[k][j].z * v[k][j].z + v[k][j].w * v[k][j].w);
            s[k] = wave_sum(ss);
            u32x2* o8 = (u32x2*)(xb + (size_t)m * D) + F.lane;
#pragma unroll
            for (int j = 0; j < 4; ++j) { u32x2 w; w.x = pk2(v[k][j].x, v[k][j].y); w.y = pk2(v[k][j].z, v[k][j].w); o8[64 * j] = w; }
            if (F.lane < 16) rss[(size_t)m * 16 + F.lane] = F.lane == 0 ? s[k] : 0.f; }
    }
}

#define PBE(id, lds_, pred_) do { if ((id) == PROBE_ID && PROBE_ID != 0 && (int)blockIdx.x == PROBE_WG && (pred_)) { volatile LAS unsigned* pw_ = (volatile LAS unsigned*)((lds_) + MISC_OFF); pw_[33] = (unsigned)__builtin_amdgcn_s_memrealtime(); } } while (0)
#define PEE(id, lds_, pred_) do { if ((id) == PROBE_ID && PROBE_ID != 0 && (int)blockIdx.x == PROBE_WG && (pred_)) { volatile LAS unsigned* pw_ = (volatile LAS unsigned*)((lds_) + MISC_OFF); pw_[32] += (unsigned)__builtin_amdgcn_s_memrealtime() - pw_[33]; } } while (0)
DI float row_rstd(const float* rss, long row) {
    const f32x4* p = (const f32x4*)(rss + row * 16); const f32x4 a = p[0], b = p[1], c = p[2], d = p[3];
    const float s = ((a.x + a.y) + (a.z + a.w)) + ((b.x + b.y) + (b.z + b.w)) + ((c.x + c.y) + (c.z + c.w)) + ((d.x + d.y) + (d.z + d.w));
    return rsqrtf(fmaxf(s, 0.f) * (1.f / D) + EPS);
}
DI float row_rstd_q(const float* rss, long row, int fq) {
    const f32x4 a = *(const f32x4*)(rss + row * 16 + 4 * fq); float s = (a.x + a.y) + (a.z + a.w);
    s += __shfl_xor(s, 16); s += __shfl_xor(s, 32);
    return rsqrtf(fmaxf(s, 0.f) * (1.f / D) + EPS);
}
struct EpiProj {
    static constexpr bool PERM = true;
    bf16_t* O; const float* rss;
    DI void operator()(const f32x4 (&acc)[2][2][4][2], const pg8::Unit& u, int wr, int wc, int fr_, int fq_, LAS unsigned char*) const {
        int fr = fr_, fq = fq_; asm volatile("" : "+v"(fr), "+v"(fq));
        const int row0 = u.arow + wr * 64 + fr, col0 = u.pn * 256 + wc * 32 + 8 * fq;
#pragma unroll
        for (int ai = 0; ai < 2; ++ai)
#pragma unroll
            for (int m = 0; m < 4; ++m) { const int r = row0 + ai * 128 + m * 16; const float rs = row_rstd_q(rss, r, fq); bf16_t* rowp = O + (size_t)r * DINP + col0;
#pragma unroll
                for (int bj = 0; bj < 2; ++bj) { const f32x4 v0 = acc[ai][bj][m][0] * rs, v1 = acc[ai][bj][m][1] * rs;
                    u32x4 w; w.x = pg8::cvt_pk_bf16(v0[0], v0[1]); w.y = pg8::cvt_pk_bf16(v0[2], v0[3]); w.z = pg8::cvt_pk_bf16(v1[0], v1[1]); w.w = pg8::cvt_pk_bf16(v1[2], v1[3]);
                    *(u32x4*)(rowp + bj * 128) = w; } }
    }
};
struct EpiRes {
    static constexpr bool PERM = false;
    const bf16_t* xs; bf16_t* xb; float* rss; bool dry;
    DI void operator()(const f32x4 (&acc)[2][2][4][2], const pg8::Unit& u, int wr, int wc, int fr_, int fq_, LAS unsigned char*) const {
        int fr = fr_, fq = fq_; asm volatile("" : "+v"(fr), "+v"(fq));
        const int row0 = u.arow + wr * 64 + fr, col0 = u.pn * 256 + wc * 32 + 4 * fq;
#pragma unroll
        for (int ai = 0; ai < 2; ++ai)
#pragma unroll
            for (int m = 0; m < 4; ++m) { const int r = row0 + ai * 128 + m * 16; const size_t off = (size_t)r * D + col0;
                float ss = 0.f;
#pragma unroll
                for (int bj = 0; bj < 2; ++bj)
#pragma unroll
                    for (int n = 0; n < 2; ++n) { const int co = bj * 128 + n * 16; const u32x2 xw = *(const u32x2*)(xs + off + co);
                        f32x4 xn = acc[ai][bj][m][n]; xn[0] += __uint_as_float(xw.x << 16); xn[1] += __uint_as_float(xw.x & 0xffff0000u); xn[2] += __uint_as_float(xw.y << 16); xn[3] += __uint_as_float(xw.y & 0xffff0000u);
                        u32x2 w; w.x = pg8::cvt_pk_bf16(xn[0], xn[1]); w.y = pg8::cvt_pk_bf16(xn[2], xn[3]); if (!dry) *(u32x2*)(xb + off + co) = w;
                        ss += (xn[0] * xn[0] + xn[1] * xn[1]) + (xn[2] * xn[2] + xn[3] * xn[3]); }
                ss += __shfl_xor(ss, 16); ss += __shfl_xor(ss, 32);
                if (fq == 0 && !dry) rss[(size_t)r * 16 + u.pn * 4 + wc] = ss;
                asm volatile("" ::: "memory"); }
    }
};
struct EpiPle {
    static constexpr bool PERM = false;
    const bf16_t* xs; bf16_t* xb; const float* rss_in; float* rss_out; const bf16_t* pp; bool dry;
    DI void operator()(const f32x4 (&acc)[2][2][4][2], const pg8::Unit& u, int wr, int wc, int fr_, int fq_, LAS unsigned char*) const {
        int fr = fr_, fq = fq_; asm volatile("" : "+v"(fr), "+v"(fq));
        const int row0 = u.arow + wr * 64 + fr, col0 = u.pn * 256 + wc * 32 + 4 * fq;
#pragma unroll
        for (int ai = 0; ai < 2; ++ai)
#pragma unroll
            for (int m = 0; m < 4; ++m) { const int r = row0 + ai * 128 + m * 16; const size_t off = (size_t)r * D + col0;
                const float rs = row_rstd_q(rss_in, r, fq); float ss = 0.f;
#pragma unroll
                for (int bj = 0; bj < 2; ++bj)
#pragma unroll
                    for (int n = 0; n < 2; ++n) { const int co = bj * 128 + n * 16; const f32x4 f = acc[ai][bj][m][n];
                        const u32x2 pw = *(const u32x2*)(pp + off + co), xw = *(const u32x2*)(xs + off + co);
                        f32x4 xn;
                        xn[0] = __uint_as_float(xw.x << 16) + sigm(f[0] * rs) * __uint_as_float(pw.x << 16); xn[1] = __uint_as_float(xw.x & 0xffff0000u) + sigm(f[1] * rs) * __uint_as_float(pw.x & 0xffff0000u);
                        xn[2] = __uint_as_float(xw.y << 16) + sigm(f[2] * rs) * __uint_as_float(pw.y << 16); xn[3] = __uint_as_float(xw.y & 0xffff0000u) + sigm(f[3] * rs) * __uint_as_float(pw.y & 0xffff0000u);
                        u32x2 w; w.x = pg8::cvt_pk_bf16(xn[0], xn[1]); w.y = pg8::cvt_pk_bf16(xn[2], xn[3]); if (!dry) *(u32x2*)(xb + off + co) = w;
                        ss += (xn[0] * xn[0] + xn[1] * xn[1]) + (xn[2] * xn[2] + xn[3] * xn[3]); }
                ss += __shfl_xor(ss, 16); ss += __shfl_xor(ss, 32);
                if (fq == 0 && !dry) rss_out[(size_t)r * 16 + u.pn * 4 + wc] = ss;
                asm volatile("" ::: "memory"); }
    }
};
struct EpiPP {
    static constexpr bool PERM = false;
    bf16_t* pp;
    DI void operator()(const f32x4 (&acc)[2][2][4][2], const pg8::Unit& u, int wr, int wc, int fr_, int fq_, LAS unsigned char*) const {
        int fr = fr_, fq = fq_; asm volatile("" : "+v"(fr), "+v"(fq));
        const int row0 = u.arow + wr * 64 + fr, col0 = u.pn * 256 + wc * 32 + 4 * fq;
#pragma unroll
        for (int ai = 0; ai < 2; ++ai)
#pragma unroll
            for (int m = 0; m < 4; ++m) { const size_t off = (size_t)(row0 + ai * 128 + m * 16) * D + col0;
#pragma unroll
                for (int bj = 0; bj < 2; ++bj)
#pragma unroll
                    for (int n = 0; n < 2; ++n) { const f32x4 f = acc[ai][bj][m][n]; u32x2 w; w.x = pg8::cvt_pk_bf16(f[0], f[1]); w.y = pg8::cvt_pk_bf16(f[2], f[3]); *(u32x2*)(pp + off + bj * 128 + n * 16) = w; } }
    }
};
struct EpiFfn {
    static constexpr bool PERM = true;
    bf16_t* H; const float* rss; const float* cw; const float* cb; const float* st_in; float* st_p; float* st_s;
    DI void operator()(f32x4 (&acc)[2][2][4][2], const pg8::Unit& u, int wr, int wc, int fr_, int fq_, LAS unsigned char* lds) const {
        int fr = fr_, fq = fq_; asm volatile("" : "+v"(fr), "+v"(fq));
        const int lane = fr + 16 * fq;
        const bool p0_ = (wr == 0 && wc == 0 && lane == 0);
        PBE(41, lds, p0_); PBE(42, lds, p0_);
        const int gc0 = u.pn * 128 + wc * 32 + 8 * fq;
        LAS float* XG = (LAS float*)(lds + XG_OFF);
        LAS float* RT = (LAS float*)(lds + MISC_OFF + 1024);
        {   const int tid_ = (wr * 4 + wc) * 64 + lane, row_ = tid_ >> 1, hf_ = tid_ & 1;
            const f32x4* p_ = (const f32x4*)(rss + ((long)u.arow + row_) * 16 + 8 * hf_); const f32x4 a_ = p_[0], b_ = p_[1];
            float s_ = ((a_.x + a_.y) + (a_.z + a_.w)) + ((b_.x + b_.y) + (b_.z + b_.w)); s_ += __shfl_xor(s_, 1);
            if (hf_ == 0) RT[row_] = rsqrtf(fmaxf(s_, 0.f) * (1.f / D) + EPS); }
        if (fr >= 14) {
#pragma unroll
            for (int ai = 0; ai < 2; ++ai)
#pragma unroll
                for (int n = 0; n < 2; ++n) *(LAS f32x4*)(XG + ((2 * ai + wr) * 2 + (fr - 14)) * 128 + wc * 32 + 8 * fq + 4 * n) = acc[ai][0][3][n];
        }
        LDS_WAIT(); __builtin_amdgcn_s_barrier(); asm volatile("" ::: "memory");
#pragma unroll
        for (int ai = 0; ai < 2; ++ai)
#pragma unroll
            for (int m = 0; m < 4; ++m) { const float rs = RT[ai * 128 + wr * 64 + m * 16 + fr];
#pragma unroll
                for (int bj = 0; bj < 2; ++bj)
#pragma unroll
                    for (int n = 0; n < 2; ++n) acc[ai][bj][m][n] *= rs; }
        PEE(42, lds, p0_); PBE(43, lds, p0_);
#pragma unroll
        for (int n = 0; n < 2; ++n) {
            const int gc = gc0 + 4 * n;
            const f32x4 w0 = *(const f32x4*)(cw + gc), w1 = *(const f32x4*)(cw + DFF + gc), w2 = *(const f32x4*)(cw + 2 * DFF + gc), bb = *(const f32x4*)(cb + gc);
#pragma unroll
            for (int ai = 0; ai < 2; ++ai) {
                f32x4 pr1, pr2;
                const int pb = 2 * ai + wr - 1;
                if (pb >= 0) { pr1 = *(const LAS f32x4*)(XG + (pb * 2 + 1) * 128 + wc * 32 + 8 * fq + 4 * n) * RT[64 * pb + 63];
                               pr2 = *(const LAS f32x4*)(XG + (pb * 2 + (fr & 1)) * 128 + wc * 32 + 8 * fq + 4 * n) * RT[64 * pb + 62 + (fr & 1)]; }
                else { pr1 = (f32x4){0.f, 0.f, 0.f, 0.f}; pr2 = pr1; }
#pragma unroll
                for (int m = 0; m < 4; ++m) {
                    const int j = ai * 128 + wr * 64 + m * 16 + fr; const long r = (long)u.arow + j;
                    int t, seq; if (r < MP) { t = (int)r & 8191; seq = (int)(r >> 13); } else { t = (int)(r - MP) & 63; seq = 2 + (int)((r - MP) >> 6); }
                    const int T = r < MP ? 8192 : 64;
                    const bool valid = j >= 2 && r < M;
                    const f32x4 cur = acc[ai][0][m][n]; f32x4 r1, r2;
#pragma unroll
                    for (int i = 0; i < 4; ++i) { r1[i] = dpp_ror<0x121>(cur[i]); r2[i] = dpp_ror<0x122>(cur[i]); }
                    f32x4 p1 = fr >= 1 ? r1 : pr1, p2 = fr >= 2 ? r2 : pr2;
                    pr1 = r1; pr2 = r2;
                    if (valid && t < 2) {
                        const f32x4 z = (f32x4){0.f, 0.f, 0.f, 0.f}; f32x4 s0 = z, s1 = z;
                        if (seq >= 2) { const float* sp = st_in + (size_t)(seq - 2) * 2 * DFF + gc; s0 = *(const f32x4*)sp; s1 = *(const f32x4*)(sp + DFF); }
                        if (t == 0) { p1 = s1; p2 = s0; } else { p2 = s1; }
                    }
                    const f32x4 gpre = bb + w0 * p2 + w1 * p1 + w2 * cur; const f32x4 up = acc[ai][1][m][n];
                    const float h0 = gelu_t(gpre[0]) * up[0], h1 = gelu_t(gpre[1]) * up[1], h2 = gelu_t(gpre[2]) * up[2], h3 = gelu_t(gpre[3]) * up[3];
                    if (valid) { u32x2 hw; hw.x = pg8::cvt_pk_bf16(h0, h1); hw.y = pg8::cvt_pk_bf16(h2, h3); *(u32x2*)(H + (size_t)r * DFF + gc) = hw;
                        if (t >= T - 2) { float* so = (seq < 2 ? st_p + (size_t)seq * 2 * DFF : st_s + (size_t)(seq - 2) * 2 * DFF) + (size_t)(t - (T - 2)) * DFF + gc; *(f32x4*)so = cur; } }
                    if (m == 3) asm volatile("" ::: "memory");
                }
            }
        }
        PEE(43, lds, p0_); PEE(41, lds, p0_);
    }
};

struct OneUnit { int pm, pn; bool on;
    __device__ bool next(int i, pg8::Unit& u) const { if (i != 0 || !on) return false; u.pm = pm; u.pn = pn; u.arow = 256 * pm; return true; } };
struct EpiPart {
    static constexpr bool PERM = false;
    float* base;
    DI void operator()(const f32x4 (&acc)[2][2][4][2], const pg8::Unit&, int wr, int wc, int fr_, int fq_, LAS unsigned char*) const {
        int fr = fr_, fq = fq_; asm volatile("" : "+v"(fr), "+v"(fq));
#pragma unroll
        for (int ai = 0; ai < 2; ++ai)
#pragma unroll
            for (int m = 0; m < 4; ++m) { float* rowp = base + (size_t)(ai * 128 + wr * 64 + m * 16 + fr) * 256 + wc * 32 + 4 * fq;
#pragma unroll
                for (int bj = 0; bj < 2; ++bj)
#pragma unroll
                    for (int n = 0; n < 2; ++n) *(f32x4*)(rowp + bj * 128 + n * 16) = acc[ai][bj][m][n]; }
    }
};
template <int MODE> DI void reduce_tail(const Ctx& F, const float* part, int S, const bf16_t* xs, bf16_t* xb, const float* rss_in, float* rss_out, const bf16_t* pp) {
    for (int t = blockIdx.x; t < 256; t += F.G) { const int j = t >> 5, rl = 8 * (t & 31) + F.wave, pm = 64 + (j >> 2), pn = j & 3; const int r = 256 * pm + rl, col = 256 * pn + 4 * F.lane;
        f32x4 sum = {0.f, 0.f, 0.f, 0.f};
        for (int sl = 0; sl < S; ++sl) sum += *(const f32x4*)(part + ((size_t)(j * S + sl) * 256 + rl) * 256 + 4 * F.lane);
        const size_t off = (size_t)r * D + col; const u32x2 xw = *(const u32x2*)(xs + off);
        f32x4 xn; xn[0] = __uint_as_float(xw.x << 16); xn[1] = __uint_as_float(xw.x & 0xffff0000u); xn[2] = __uint_as_float(xw.y << 16); xn[3] = __uint_as_float(xw.y & 0xffff0000u);
        if (MODE == 0) xn += sum;
        else { const float rs = row_rstd(rss_in, r); const u32x2 pw = *(const u32x2*)(pp + off);
            xn[0] += sigm(sum[0] * rs) * __uint_as_float(pw.x << 16); xn[1] += sigm(sum[1] * rs) * __uint_as_float(pw.x & 0xffff0000u);
            xn[2] += sigm(sum[2] * rs) * __uint_as_float(pw.y << 16); xn[3] += sigm(sum[3] * rs) * __uint_as_float(pw.y & 0xffff0000u); }
        u32x2 w; w.x = pg8::cvt_pk_bf16(xn[0], xn[1]); w.y = pg8::cvt_pk_bf16(xn[2], xn[3]); *(u32x2*)(xb + off) = w;
        float ss = (xn[0] * xn[0] + xn[1] * xn[1]) + (xn[2] * xn[2] + xn[3] * xn[3]);
        ss += __shfl_xor(ss, 1); ss += __shfl_xor(ss, 2); ss += __shfl_xor(ss, 4); ss += __shfl_xor(ss, 8);
        if ((F.lane & 15) == 0) rss_out[(size_t)r * 16 + pn * 4 + (F.lane >> 4)] = ss;
    }
}

DI bf16x8 frag_row(const LAS unsigned char* img, int pitch, int row0, int k0, int lane) {
    return *(const LAS bf16x8*)(img + (row0 + (lane & 15)) * pitch + (k0 + 8 * (lane >> 4)) * 2);
}
DI bf16x8 frag_tr(const LAS unsigned char* img, int pitch, int k0, int n0, int lane) {
    const int g = lane >> 4, i = lane & 15, q = i >> 2, p = i & 3;
    const LAS unsigned char* a = img + (k0 + 8 * g + q) * pitch + (n0 + 4 * p) * 2;
    const s16x4 lo = __builtin_amdgcn_ds_read_tr16_b64_v4i16((LAS s16x4*)a);
    const s16x4 hi = __builtin_amdgcn_ds_read_tr16_b64_v4i16((LAS s16x4*)(a + 4 * pitch));
    return __builtin_shufflevector(lo, hi, 0, 1, 2, 3, 4, 5, 6, 7);
}
#define MFMA16(a, b, c) __builtin_amdgcn_mfma_f32_16x16x32_bf16((a), (b), (c), 0, 0, 0)
DI void st_bf16(LAS unsigned char* img, int pitch, int row, int col, float v) { *(LAS bf16_t*)(img + row * pitch + col * 2) = (bf16_t)f2bf(v); }
DI float ld_bf16(const LAS unsigned char* img, int pitch, int row, int col) { return bf2f(*(const LAS bf16_t*)(img + row * pitch + col * 2)); }

#define WG_BAR() do { asm volatile("s_waitcnt lgkmcnt(0)" ::: "memory"); __builtin_amdgcn_s_barrier(); asm volatile("" ::: "memory"); } while (0)
template <bool SSD> struct LAT {
    static constexpr int DA = SSD ? 128 : 64, DB = SSD ? 64 : 128;
    static constexpr int PA = (DA + 8) * 2, PV = (DB + 8) * 2, PPI = 144, PS = (DB + 8) * 2, POT = (DB + 4) * 4;
    static constexpr int O_QD = 0, O_KI = O_QD + 64 * PA, O_VV = O_KI + 64 * PA, O_VW = O_VV + 64 * PV, O_P = O_VW + (SSD ? 64 * PV : 0), O_SB = O_P + 64 * PPI, O_OT = O_SB + DA * PS, O_TAB = O_OT + 64 * POT;
    static constexpr int NT_O = DB / 32;
};
static_assert(LAT<true>::O_TAB + 8192 <= RING_BYTES && LAT<false>::O_TAB + 8192 <= RING_BYTES, "mixer LDS");
template <bool SSD> DI void la_mt_nt(int T, int& mt, int& nt) { if (SSD) { mt = T >> 2; nt = T & 3; } else { mt = T >> 3; nt = T & 7; } }

template <bool SSD> DI void la_state_update(LAS unsigned char* lds, f32x4 (&S)[4], int w, int lane) {
    typedef LAT<SSD> L; const LAS float* tab = (const LAS float*)(lds + L::O_TAB); const int q = lane >> 4;
#pragma unroll
    for (int x = 0; x < 4; ++x) { int mt, nt; la_mt_nt<SSD>(4 * w + x, mt, nt);
        if (SSD) { const float d = tab[256]; S[x] *= d; }
#pragma unroll
        for (int ks = 0; ks < 2; ++ks) { const bf16x8 a = frag_tr(lds + L::O_KI, L::PA, 32 * ks, 16 * mt, lane); const bf16x8 b = frag_tr(lds + (SSD ? L::O_VW : L::O_VV), L::PV, 32 * ks, 16 * nt, lane); S[x] = MFMA16(a, b, S[x]); }
        if (!SSD) {
#pragma unroll
            for (int r = 0; r < 4; ++r) S[x][r] *= tab[1536 + 16 * mt + 4 * q + r]; }
    }
}
template <bool SSD> DI void la_write_sb(LAS unsigned char* lds, const f32x4 (&S)[4], int w, int lane) {
    typedef LAT<SSD> L; const int q = lane >> 4, c = lane & 15;
#pragma unroll
    for (int x = 0; x < 4; ++x) { int mt, nt; la_mt_nt<SSD>(4 * w + x, mt, nt);
#pragma unroll
        for (int r = 0; r < 4; ++r) st_bf16(lds + L::O_SB, L::PS, 16 * mt + 4 * q + r, 16 * nt + c, S[x][r]); }
}
template <bool SSD> DI void la_compute_p(LAS unsigned char* lds, int w, int lane) {
    typedef LAT<SSD> L; const LAS float* tab = (const LAS float*)(lds + L::O_TAB); const int q = lane >> 4, c = lane & 15, mt = w >> 1;
#pragma unroll
    for (int x = 0; x < 2; ++x) { const int nt = (w & 1) * 2 + x; f32x4 acc = {0.f, 0.f, 0.f, 0.f};
#pragma unroll
        for (int ks = 0; ks < L::DA / 32; ++ks) { const bf16x8 a = frag_row(lds + L::O_QD, L::PA, 16 * mt, 32 * ks, lane); const bf16x8 b = frag_row(lds + L::O_KI, L::PA, 16 * nt, 32 * ks, lane); acc = MFMA16(a, b, acc); }
        const int j = 16 * nt + c;
#pragma unroll
        for (int r = 0; r < 4; ++r) { const int i = 16 * mt + 4 * q + r; float v = acc[r];
            if (SSD) v *= __expf(tab[64 + i] - tab[64 + j]) * tab[j];
            v = (j > i) ? 0.f : v; st_bf16(lds + L::O_P, L::PPI, i, j, v); }
    }
}
template <bool SSD> DI void la_compute_out(LAS unsigned char* lds, f32x4 (&o1)[LAT<SSD>::NT_O], f32x4 (&o2)[LAT<SSD>::NT_O], int w, int lane) {
    typedef LAT<SSD> L; const int mt = w >> 1;
#pragma unroll
    for (int x = 0; x < L::NT_O; ++x) { const int nt = (w & 1) * L::NT_O + x; f32x4 a1 = {0.f, 0.f, 0.f, 0.f}, a2 = {0.f, 0.f, 0.f, 0.f};
#pragma unroll
        for (int ks = 0; ks < 2; ++ks) { const bf16x8 a = frag_row(lds + L::O_P, L::PPI, 16 * mt, 32 * ks, lane); const bf16x8 b = frag_tr(lds + L::O_VV, L::PV, 32 * ks, 16 * nt, lane); a1 = MFMA16(a, b, a1); }
#pragma unroll
        for (int ks = 0; ks < L::DA / 32; ++ks) { const bf16x8 a = frag_row(lds + L::O_QD, L::PA, 16 * mt, 32 * ks, lane); const bf16x8 b = frag_tr(lds + L::O_SB, L::PS, 32 * ks, 16 * nt, lane); a2 = MFMA16(a, b, a2); }
        o1[x] = a1; o2[x] = a2; }
}
DI void la_store_ds(float* ds, const f32x4 (&S)[4], int w, int lane) {
#pragma unroll
    for (int x = 0; x < 4; ++x)
#pragma unroll
        for (int r = 0; r < 4; ++r) ds[((4 * w + x) * 4 + r) * 64 + lane] = S[x][r];
}
DI void la_load_ds(const float* ds, f32x4 (&S)[4], int w, int lane) {
#pragma unroll
    for (int x = 0; x < 4; ++x)
#pragma unroll
        for (int r = 0; r < 4; ++r) S[x][r] = ds[((4 * w + x) * 4 + r) * 64 + lane];
}

struct GlaCoef { float wlr[16]; float blr; };
struct GlaRaw { unsigned short qk[8][2]; u32x4 v[2]; u32x4 lr; u32x4 g[2]; };
DI void gla_load(const Ctx& F, int h, int chunk, GlaRaw& R) {
    const bf16_t* proj = wsb(F, WS_R); const int row0 = 64 * chunk, d = F.lane, w = F.wave;
#pragma unroll
    for (int i = 0; i < 8; ++i) { const size_t ro = (size_t)(row0 + 8 * w + i) * DINP; R.qk[i][0] = proj[ro + PC_BQ + 64 * h + d]; R.qk[i][1] = proj[ro + PC_BK + 64 * h + d]; }
#pragma unroll
    for (int i = 0; i < 2; ++i) { const int idx = F.tid + 512 * i, t = idx >> 4, c16 = idx & 15;
        R.v[i] = *(const u32x4*)(proj + (size_t)(row0 + t) * DINP + PC_BV + 128 * h + 8 * c16);
        R.g[i] = *(const u32x4*)(proj + (size_t)(row0 + t) * DINP + PC_BG + 128 * h + 8 * c16); }
    R.lr = *(const u32x4*)(proj + (size_t)(row0 + ((F.tid >> 1) & 63)) * DINP + PC_BLR + 8 * (F.tid & 1));
}
DI void gla_stage(const Ctx& F, const GlaCoef& cf, const GlaRaw& R) {
    typedef LAT<false> L; LAS unsigned char* lds = F.lds; LAS float* tab = (LAS float*)(lds + L::O_TAB); const int d = F.lane, w = F.wave;
    if (F.tid < 128) { const int t = F.tid >> 1, half = F.tid & 1; float f[8]; unpack8(R.lr, f);
#pragma unroll
        for (int i = 0; i < 8; ++i) tab[t * 16 + 8 * half + i] = f[i]; }
#pragma unroll
    for (int i = 0; i < 2; ++i) { const int idx = F.tid + 512 * i, t = idx >> 4, c16 = idx & 15; *(LAS u32x4*)(lds + L::O_VV + t * L::PV + c16 * 16) = R.v[i]; }
    WG_BAR();
    float pre[8]; float run = 0.f;
#pragma unroll
    for (int i = 0; i < 8; ++i) { const int t = 8 * w + i; float z = cf.blr;
#pragma unroll
        for (int r = 0; r < 16; ++r) z += tab[t * 16 + r] * cf.wlr[r];
        run += logsig_fast(z) * (1.f / 16.f); pre[i] = run; }
    tab[1024 + w * 64 + d] = run;
    WG_BAR();
    float off = 0.f, last = 0.f;
#pragma unroll
    for (int ww = 0; ww < 8; ++ww) { const float tv = tab[1024 + ww * 64 + d]; last += tv; if (ww < w) off += tv; }
#pragma unroll
    for (int i = 0; i < 8; ++i) { const int t = 8 * w + i; const float cum = off + pre[i];
        st_bf16(lds + L::O_QD, L::PA, t, d, bf2f(R.qk[i][0]) * 0.125f * __expf(cum)); st_bf16(lds + L::O_KI, L::PA, t, d, bf2f(R.qk[i][1]) * __expf(-cum)); }
    if (w == 0) tab[1536 + d] = __expf(last);
    WG_BAR();
}
struct SsdRaw { u32x4 x[11]; u32x4 z; unsigned short dtr; };
DI void ssd_task(const Ctx& F, int h, int& cidx, int& rg, int& ch) {
    cidx = F.tid % 40; rg = F.tid / 40; const int g = h >> 2;
    ch = cidx < 8 ? 64 * h + 8 * cidx : (cidx < 24 ? 512 + 128 * g + 8 * (cidx - 8) : 768 + 128 * g + 8 * (cidx - 24));
}
DI void ssd_load(const Ctx& F, int layer, int h, int chunk, SsdRaw& R) {
    const bf16_t* proj = wsb(F, WS_R); const int row0 = 64 * chunk; const bool first = chunk_first(chunk);
    if (F.tid < 320) { int cidx, rg, ch; ssd_task(F, h, cidx, rg, ch);
#pragma unroll
        for (int i = 0; i < 11; ++i) { const int tt = 8 * rg - 3 + i;
            if (tt >= 0 || !first) R.x[i] = *(const u32x4*)(proj + (size_t)(row0 + tt) * DINP + PC_XBC + ch);
            else if (chunk >= 256) { const float* sp = F.in[I_SSC] + ((size_t)(layer * 8 + (chunk - 256)) * 3 + (tt + 3)) * 1024 + ch; const f32x4 a = *(const f32x4*)sp, b = *(const f32x4*)(sp + 4);
                u32x4 o; o.x = pk2(a.x, a.y); o.y = pk2(a.z, a.w); o.z = pk2(b.x, b.y); o.w = pk2(b.z, b.w); R.x[i] = o; }
            else R.x[i] = (u32x4){0u, 0u, 0u, 0u};
        }
    }
    R.z = *(const u32x4*)(proj + (size_t)(row0 + (F.tid >> 3)) * DINP + PC_CZ + 64 * h + 8 * (F.tid & 7));
    R.dtr = proj[(size_t)(row0 + F.lane) * DINP + PC_DT + h];
}
constexpr int SSD_WCV = 512;
DI void ssd_item_weights(const Ctx& F, int layer, int h) {
    typedef LAT<true> L; LAS float* tab = (LAS float*)(F.lds + L::O_TAB);
    if (F.tid < 200) { const int cidx = F.tid / 5, j = F.tid % 5, g = h >> 2;
        const int ch = cidx < 8 ? 64 * h + 8 * cidx : (cidx < 24 ? 512 + 128 * g + 8 * (cidx - 8) : 768 + 128 * g + 8 * (cidx - 24));
        const float* sp = j < 4 ? F.in[I_SCW] + (size_t)(layer * 4 + j) * 1024 + ch : F.in[I_SCB] + layer * 1024 + ch;
        *(LAS f32x4*)(tab + SSD_WCV + (cidx * 5 + j) * 8) = *(const f32x4*)sp; *(LAS f32x4*)(tab + SSD_WCV + (cidx * 5 + j) * 8 + 4) = *(const f32x4*)(sp + 4); }
    WG_BAR();
}
DI void ssd_stage(const Ctx& F, int layer, int h, const SsdRaw& R) {
    typedef LAT<true> L; LAS unsigned char* lds = F.lds; LAS float* tab = (LAS float*)(lds + L::O_TAB);
    if (F.wave == 7) { const int t = F.lane;
        const float dt = softplus_fast(bf2f(R.dtr) + F.in[I_SDTB][layer * 8 + h]); const float cum = wave_incl_scan(-dt * __expf(F.in[I_SALOG][layer * 8 + h]));
        const float last = __shfl(cum, 63);
        tab[t] = dt; tab[64 + t] = cum; tab[128 + t] = __expf(last - cum) * dt; tab[192 + t] = __expf(cum); if (t == 0) tab[256] = __expf(last); }
    if (F.tid < 320) { int cidx, rg, ch; ssd_task(F, h, cidx, rg, ch);
        float wv[4][8], bv[8];
#pragma unroll
        for (int j = 0; j < 4; ++j) { const f32x4 a = *(const LAS f32x4*)(tab + SSD_WCV + (cidx * 5 + j) * 8), b = *(const LAS f32x4*)(tab + SSD_WCV + (cidx * 5 + j) * 8 + 4); wv[j][0] = a.x; wv[j][1] = a.y; wv[j][2] = a.z; wv[j][3] = a.w; wv[j][4] = b.x; wv[j][5] = b.y; wv[j][6] = b.z; wv[j][7] = b.w; }
        { const f32x4 a = *(const LAS f32x4*)(tab + SSD_WCV + (cidx * 5 + 4) * 8), b = *(const LAS f32x4*)(tab + SSD_WCV + (cidx * 5 + 4) * 8 + 4); bv[0] = a.x; bv[1] = a.y; bv[2] = a.z; bv[3] = a.w; bv[4] = b.x; bv[5] = b.y; bv[6] = b.z; bv[7] = b.w; }
        float x0[8], x1[8], x2[8], x3[8]; unpack8(R.x[0], x0); unpack8(R.x[1], x1); unpack8(R.x[2], x2);
#pragma unroll
        for (int r = 0; r < 8; ++r) { const int t = 8 * rg + r; float o[8]; unpack8(R.x[r + 3], x3);
#pragma unroll
            for (int e = 0; e < 8; ++e) { const float v = bv[e] + wv[0][e] * x0[e] + wv[1][e] * x1[e] + wv[2][e] * x2[e] + wv[3][e] * x3[e]; o[e] = silu_f(v); x0[e] = x1[e]; x1[e] = x2[e]; x2[e] = x3[e]; }
            if (cidx < 8) *(LAS u32x4*)(lds + L::O_VV + t * L::PV + cidx * 16) = pack8(o);
            else if (cidx < 24) *(LAS u32x4*)(lds + L::O_KI + t * L::PA + (cidx - 8) * 16) = pack8(o);
            else *(LAS u32x4*)(lds + L::O_QD + t * L::PA + (cidx - 24) * 16) = pack8(o);
        }
    }
    WG_BAR();
    { const int t = F.tid >> 3, c8 = F.tid & 7; float xv[8]; unpack8(*(const LAS u32x4*)(lds + L::O_VV + t * L::PV + c8 * 16), xv); const float we = tab[128 + t];
#pragma unroll
        for (int e = 0; e < 8; ++e) xv[e] *= we;
        *(LAS u32x4*)(lds + L::O_VW + t * L::PV + c8 * 16) = pack8(xv); }
}

DI void gla_pass_a(const Ctx& F0, int layer, int panel, int h) {
    Ctx F = F0; OPAQUE_CTX(F);
    LAS unsigned char* lds = F.lds; const int w = F.wave, lane = F.lane, d = lane; const bf16_t* proj = wsb(F, WS_R); const int row0 = 256 * panel;
    constexpr int PK = 144, PVV = 272, O_KE = 0, O_V = 256 * PK, O_LR = O_V + 256 * PVV, O_TOT = O_LR + 256 * 16 * 4;
    static_assert(O_TOT + 2048 <= RING_BYTES, "gla pass A LDS");
    LAS float* lr = (LAS float*)(lds + O_LR); LAS float* tot = (LAS float*)(lds + O_TOT);
    float wlr[16];
#pragma unroll
    for (int r = 0; r < 16; ++r) wlr[r] = F.in[I_GWLR][(size_t)(layer * 16 + r) * 256 + 64 * h + d];
    const float blr = F.in[I_GBLR][layer * 256 + 64 * h + d];
    { const int t = F.tid >> 1, half = F.tid & 1; const u32x4 v = *(const u32x4*)(proj + (size_t)(row0 + t) * DINP + PC_BLR + 8 * half); float f[8]; unpack8(v, f);
#pragma unroll
        for (int i = 0; i < 8; ++i) lr[t * 16 + 8 * half + i] = f[i]; }
    unsigned short kr[32];
#pragma unroll
    for (int i = 0; i < 32; ++i) kr[i] = proj[(size_t)(row0 + 32 * w + i) * DINP + PC_BK + 64 * h + d];
#pragma unroll
    for (int i = 0; i < 8; ++i) { const int idx = F.tid + 512 * i, t = idx >> 4, c16 = idx & 15;
        *(LAS u32x4*)(lds + O_V + t * PVV + c16 * 16) = *(const u32x4*)(proj + (size_t)(row0 + t) * DINP + PC_BV + 128 * h + 8 * c16); }
    WG_BAR();
    float pre[32]; float run = 0.f;
#pragma unroll
    for (int i = 0; i < 32; ++i) { const int t = 32 * w + i; float z = blr;
#pragma unroll
        for (int r = 0; r < 16; ++r) z += lr[t * 16 + r] * wlr[r];
        run += logsig_fast(z) * (1.f / 16.f); pre[i] = run; }
    tot[w * 64 + d] = run;
    WG_BAR();
    float off = 0.f, last = 0.f;
#pragma unroll
    for (int ww = 0; ww < 8; ++ww) { const float tv = tot[ww * 64 + d]; last += tv; if (ww < w) off += tv; }
#pragma unroll
    for (int i = 0; i < 32; ++i) st_bf16(lds + O_KE, PK, 32 * w + i, d, bf2f(kr[i]) * __expf(last - (off + pre[i])));
    WG_BAR();
    f32x4 S[4];
#pragma unroll
    for (int x = 0; x < 4; ++x) S[x] = (f32x4){0.f, 0.f, 0.f, 0.f};
    const int mt = w >> 1;
#pragma unroll
    for (int ks = 0; ks < 8; ++ks) { const bf16x8 a = frag_tr(lds + O_KE, PK, 32 * ks, 16 * mt, lane);
#pragma unroll
        for (int x = 0; x < 4; ++x) { const bf16x8 b = frag_tr(lds + O_V, PVV, 32 * ks, 16 * (((4 * w + x) & 7)), lane); S[x] = MFMA16(a, b, S[x]); } }
    la_store_ds(wsf(F, WS_DS) + ((size_t)panel * 12 + h) * 8192, S, w, lane);
    if (w == 0) wsf(F, WS_DEC)[(panel * 4 + h) * 64 + d] = __expf(last);
    WG_BAR();
}
DI void ssd_pass_a(const Ctx& F0, int layer, int panel, int h) {
    Ctx F = F0; OPAQUE_CTX(F);
    LAS unsigned char* lds = F.lds; const int w = F.wave, lane = F.lane, g = h >> 2; const bf16_t* proj = wsb(F, WS_R); const int row0 = 256 * panel; const bool first = (panel & 31) == 0;
    constexpr int PB_ = 272, PX = 144, O_B = 0, O_XW = 256 * PB_, O_WE = O_XW + 256 * PX;
    static_assert(O_WE + 1024 <= RING_BYTES, "ssd pass A LDS");
    LAS float* wend = (LAS float*)(lds + O_WE);
    float last = 0.f;
    if (w == 0) {
        const float bias = F.in[I_SDTB][layer * 8 + h], A = -__expf(F.in[I_SALOG][layer * 8 + h]); float dt[4], cs[4]; float run = 0.f;
#pragma unroll
        for (int i = 0; i < 4; ++i) { dt[i] = softplus_fast(bf2f(proj[(size_t)(row0 + 4 * lane + i) * DINP + PC_DT + h]) + bias); run += dt[i] * A; cs[i] = run; }
        const float inc = wave_incl_scan(run);
        const float excl = inc - run; last = __shfl(inc, 63);
#pragma unroll
        for (int i = 0; i < 4; ++i) wend[4 * lane + i] = __expf(last - (excl + cs[i])) * dt[i];
    }
    WG_BAR();
    for (int pass = 0; pass < 2; ++pass) { const int task = F.tid + 512 * pass;
        if (task < 768) { const int cidx = task % 24, rg = task / 24;
            const int ch = cidx < 8 ? 64 * h + 8 * cidx : 512 + 128 * g + 8 * (cidx - 8);
            const float* cwp = F.in[I_SCW] + (size_t)layer * 4 * 1024 + ch; const float* cbp = F.in[I_SCB] + layer * 1024 + ch;
            float wv[4][8], bv[8];
#pragma unroll
            for (int j = 0; j < 4; ++j) { const f32x4 a = *(const f32x4*)(cwp + j * 1024), b = *(const f32x4*)(cwp + j * 1024 + 4); wv[j][0] = a.x; wv[j][1] = a.y; wv[j][2] = a.z; wv[j][3] = a.w; wv[j][4] = b.x; wv[j][5] = b.y; wv[j][6] = b.z; wv[j][7] = b.w; }
            { const f32x4 a = *(const f32x4*)cbp, b = *(const f32x4*)(cbp + 4); bv[0] = a.x; bv[1] = a.y; bv[2] = a.z; bv[3] = a.w; bv[4] = b.x; bv[5] = b.y; bv[6] = b.z; bv[7] = b.w; }
            u32x4 xr[11];
#pragma unroll
            for (int i = 0; i < 11; ++i) { const int tt = 8 * rg - 3 + i;
                if (tt >= 0 || !first) xr[i] = *(const u32x4*)(proj + (size_t)(row0 + tt) * DINP + PC_XBC + ch); else xr[i] = (u32x4){0u, 0u, 0u, 0u}; }
            float x0[8], x1[8], x2[8], x3[8]; unpack8(xr[0], x0); unpack8(xr[1], x1); unpack8(xr[2], x2);
#pragma unroll
            for (int r = 0; r < 8; ++r) { const int t = 8 * rg + r; float o[8]; unpack8(xr[r + 3], x3);
#pragma unroll
                for (int e = 0; e < 8; ++e) { const float v = bv[e] + wv[0][e] * x0[e] + wv[1][e] * x1[e] + wv[2][e] * x2[e] + wv[3][e] * x3[e]; o[e] = silu_f(v); x0[e] = x1[e]; x1[e] = x2[e]; x2[e] = x3[e]; }
                if (cidx < 8) { const float we = wend[t];
#pragma unroll
                    for (int e = 0; e < 8; ++e) o[e] *= we;
                    *(LAS u32x4*)(lds + O_XW + t * PX + cidx * 16) = pack8(o); }
                else *(LAS u32x4*)(lds + O_B + t * PB_ + (cidx - 8) * 16) = pack8(o);
            }
        }
    }
    WG_BAR();
    f32x4 S[4];
#pragma unroll
    for (int x = 0; x < 4; ++x) S[x] = (f32x4){0.f, 0.f, 0.f, 0.f};
#pragma unroll
    for (int ks = 0; ks < 8; ++ks) { const bf16x8 a = frag_tr(lds + O_B, PB_, 32 * ks, 16 * w, lane);
#pragma unroll
        for (int x = 0; x < 4; ++x) { const bf16x8 b = frag_tr(lds + O_XW, PX, 32 * ks, 16 * x, lane); S[x] = MFMA16(a, b, S[x]); } }
    la_store_ds(wsf(F, WS_DS) + ((size_t)panel * 12 + 4 + h) * 8192, S, w, lane);
    if (w == 0 && lane == 0) wsf(F, WS_DEC)[64 * 4 * 64 + panel * 8 + h] = __expf(last);
    WG_BAR();
}

template <bool SSD> DI void la_pass_c(const Ctx& F0, int layer, int c0, int nc, int h, bool dry) {
    Ctx F = F0; OPAQUE_CTX(F);
    typedef LAT<SSD> L; const int w = F.wave, lane = F.lane, q = lane >> 4, c = lane & 15, mt = w >> 1;
    bf16_t* proj = wsb(F, WS_R);
    f32x4 S[4];
    GlaCoef cf; GlaRaw gr; SsdRaw sr;
    if (!SSD) {
#pragma unroll
        for (int r = 0; r < 16; ++r) cf.wlr[r] = F.in[I_GWLR][(size_t)(layer * 16 + r) * 256 + 64 * h + lane];
        cf.blr = F.in[I_GBLR][layer * 256 + 64 * h + lane]; gla_load(F, h, c0, gr); }
    else { ssd_load(F, layer, h, c0, sr); ssd_item_weights(F, layer, h); }
    const int hh = SSD ? 4 + h : h;
    const Ctx Fp = F;
#pragma unroll 1
    for (int cc = 0; cc < nc; ++cc) { const int chunk = c0 + cc, row0 = 64 * chunk;
        Ctx F = Fp; { unsigned z_ = 0; asm volatile("" : "+s"(z_)); F.lds = Fp.lds + z_; } LAS unsigned char* lds = F.lds; LAS float* tab = (LAS float*)(lds + L::O_TAB);
        PB(SSD ? 5 : 15);
        if (cc == 0 || chunk_first(chunk)) {
            if (chunk < 256) la_load_ds(wsf(F, WS_DS) + ((size_t)(chunk >> 2) * 12 + hh) * 8192, S, w, lane);
            else { const int b = chunk - 256;
#pragma unroll
                for (int x = 0; x < 4; ++x) { int smt, snt; la_mt_nt<SSD>(4 * w + x, smt, snt);
                    if (SSD) { const float* sp = F.in[I_SS] + ((size_t)((layer * 8 + b) * 8 + h) * 64 + 16 * snt + c) * 128 + 16 * smt + 4 * q; S[x] = *(const f32x4*)sp; }
                    else { const float* sp = F.in[I_SG] + ((size_t)((layer * 8 + b) * 4 + h) * 64 + 16 * smt + 4 * q) * 128 + 16 * snt + c;
#pragma unroll
                        for (int r = 0; r < 4; ++r) S[x][r] = sp[r * 128]; } } }
            la_write_sb<SSD>(lds, S, w, lane);
        }
        PE(SSD ? 5 : 15);
        PB(SSD ? 1 : 11);
        u32x4 gate0, gate1;
        if (SSD) { ssd_stage(F, layer, h, sr); gate0 = sr.z; gate1 = gate0; if (cc + 1 < nc) ssd_load(F, layer, h, chunk + 1, sr); }
        else { gla_stage(F, cf, gr); gate0 = gr.g[0]; gate1 = gr.g[1]; if (cc + 1 < nc) gla_load(F, h, chunk + 1, gr); }
        PE(SSD ? 1 : 11); PB(SSD ? 2 : 12);
        la_compute_p<SSD>(lds, w, lane);
        WG_BAR();
        PE(SSD ? 2 : 12); PB(SSD ? 3 : 13);
        f32x4 o1[L::NT_O], o2[L::NT_O];
        la_compute_out<SSD>(lds, o1, o2, w, lane);
        la_state_update<SSD>(lds, S, w, lane);
        if (SSD) {
            const float Dh = F.in[I_SD][layer * 8 + h];
#pragma unroll
            for (int x = 0; x < L::NT_O; ++x) { const int p = 16 * ((w & 1) * L::NT_O + x) + c;
#pragma unroll
                for (int r = 0; r < 4; ++r) { const int i = 16 * mt + 4 * q + r; *(LAS float*)(lds + L::O_OT + i * L::POT + p * 4) = o1[x][r] + tab[192 + i] * o2[x][r] + Dh * ld_bf16(lds + L::O_VV, L::PV, i, p); } }
        } else {
            float ss[4] = {0.f, 0.f, 0.f, 0.f};
#pragma unroll
            for (int x = 0; x < L::NT_O; ++x) { const int e = 16 * ((w & 1) * L::NT_O + x) + c;
#pragma unroll
                for (int r = 0; r < 4; ++r) { const float o = o1[x][r] + o2[x][r]; ss[r] += o * o; *(LAS float*)(lds + L::O_OT + (16 * mt + 4 * q + r) * L::POT + e * 4) = o; } }
#pragma unroll
            for (int r = 0; r < 4; ++r) { float s = ss[r]; s += __shfl_xor(s, 1); s += __shfl_xor(s, 2); s += __shfl_xor(s, 4); s += __shfl_xor(s, 8);
                if (c == 0) tab[1600 + (16 * mt + 4 * q + r) * 2 + (w & 1)] = s; }
        }
        WG_BAR();
        PE(SSD ? 3 : 13); PB(SSD ? 4 : 14);
        if (SSD) { const int i = F.tid >> 3, p0 = 8 * (F.tid & 7); float zv[8], yv[8]; unpack8(gate0, zv); float ss = 0.f;
            const f32x4 ya = *(const LAS f32x4*)(lds + L::O_OT + i * L::POT + p0 * 4), yb = *(const LAS f32x4*)(lds + L::O_OT + i * L::POT + p0 * 4 + 16);
            yv[0] = ya.x; yv[1] = ya.y; yv[2] = ya.z; yv[3] = ya.w; yv[4] = yb.x; yv[5] = yb.y; yv[6] = yb.z; yv[7] = yb.w;
#pragma unroll
            for (int e = 0; e < 8; ++e) { yv[e] *= silu_f(zv[e]); ss += yv[e] * yv[e]; }
            ss += __shfl_xor(ss, 1); ss += __shfl_xor(ss, 2); ss += __shfl_xor(ss, 4);
            if (!dry) { *(u32x4*)(proj + (size_t)(row0 + i) * DINP + PC_CZ + 64 * h + p0) = pack8(yv);
                if ((F.tid & 7) == 0) { f32x2 pv; pv.x = ss; pv.y = 0.f; *(f32x2*)(wsf(F, WS_PSS) + (size_t)(row0 + i) * 16 + 2 * h) = pv; } }
        } else {
#pragma unroll
            for (int k = 0; k < 2; ++k) { const int idx = F.tid + 512 * k, i = idx >> 4, e0 = 8 * (idx & 15); float gv[8], yv[8]; unpack8(k ? gate1 : gate0, gv);
                const float rstd = rsqrtf((tab[1600 + 2 * i] + tab[1600 + 2 * i + 1]) * (1.f / 128.f) + EPS);
                const f32x4 ya = *(const LAS f32x4*)(lds + L::O_OT + i * L::POT + e0 * 4), yb = *(const LAS f32x4*)(lds + L::O_OT + i * L::POT + e0 * 4 + 16);
                const float* gn = F.in[I_GNORM] + layer * 512 + 128 * h + e0; const f32x4 na = *(const f32x4*)gn, nb = *(const f32x4*)(gn + 4);
                yv[0] = ya.x * na.x; yv[1] = ya.y * na.y; yv[2] = ya.z * na.z; yv[3] = ya.w * na.w; yv[4] = yb.x * nb.x; yv[5] = yb.y * nb.y; yv[6] = yb.z * nb.z; yv[7] = yb.w * nb.w;
#pragma unroll
                for (int e = 0; e < 8; ++e) yv[e] *= rstd * silu_f(gv[e]);
                if (!dry) *(u32x4*)(proj + (size_t)(row0 + i) * DINP + PC_BG + 128 * h + e0) = pack8(yv); }
        }
        if (chunk_last(chunk)) { if (!dry) { const int seq = chunk_seq(chunk);
            if (SSD) { float* so = st_out(F, O_PS, O_SS, layer, seq, 8 * 64 * 128) + (size_t)h * 64 * 128;
#pragma unroll
                for (int x = 0; x < 4; ++x) { int smt, snt; la_mt_nt<SSD>(4 * w + x, smt, snt); *(f32x4*)(so + (size_t)(16 * snt + c) * 128 + 16 * smt + 4 * q) = S[x]; } }
            else { float* so = st_out(F, O_PG, O_SG, layer, seq, 4 * 64 * 128) + (size_t)h * 64 * 128;
#pragma unroll
                for (int x = 0; x < 4; ++x) { int smt, snt; la_mt_nt<SSD>(4 * w + x, smt, snt);
#pragma unroll
                    for (int r = 0; r < 4; ++r) so[(size_t)(16 * smt + 4 * q + r) * 128 + 16 * snt + c] = S[x][r]; } } }
        } else if (cc + 1 < nc) la_write_sb<SSD>(lds, S, w, lane);
        WG_BAR();
        PE(SSD ? 4 : 14);
    }
}

struct LruSP { bf16x8 br[2], bi[2]; float b_r, b_i, lam, hin; };
template <bool PASS_C> DI void lru_load_sp(const Ctx& F, int layer, int h, int chunk, int nt, LruSP& p) {
    const int lane = F.lane, q = lane >> 4, c = lane & 15, col = 64 * h + 16 * nt + c;
    const bf16_t* wr_t = wsb(F, WS_LRUW) + (size_t)((layer * 2 + 0) * 8 + h) * 4096; const bf16_t* wi_t = wsb(F, WS_LRUW) + (size_t)((layer * 2 + 1) * 8 + h) * 4096;
#pragma unroll
    for (int ks = 0; ks < 2; ++ks) { const int o = (16 * nt + c) * 64 + 32 * ks + 8 * q; p.br[ks] = *(const bf16x8*)(wr_t + o); p.bi[ks] = *(const bf16x8*)(wi_t + o); }
    p.b_r = F.in[I_LBR][layer * 512 + col]; p.b_i = F.in[I_LBI][layer * 512 + col]; p.lam = F.in[I_LAM][layer * 512 + col]; p.hin = 0.f;
    if (PASS_C) p.hin = chunk >= 256 ? F.in[I_SLH][(size_t)(layer * 8 + (chunk - 256)) * 512 + col] : wsf(F, WS_LRUS)[(size_t)(2 * NCH + chunk) * 512 + col];
}
template <bool PASS_C> DI void lru_chunk(const Ctx& F0, int layer, int chunk, bool dry = false) {
    Ctx F = F0; OPAQUE_CTX(F);
    const int h = F.wave, lane = F.lane, q = lane >> 4, c = lane & 15, row0 = 64 * chunk; const bool first = chunk_first(chunk);
    LAS unsigned char* T = F.lds + h * 18432; LAS unsigned char* OT = T + 9216; constexpr int TP = 144;
    bf16_t* proj = wsb(F, WS_R);
    const int cc = lane & 7, rg = lane >> 3;
    PB(PASS_C ? 21 : 31);
    LruSP cur; lru_load_sp<PASS_C>(F, layer, h, chunk, 0, cur);
    {
        const int ch = 64 * h + 8 * cc; u32x4 xr[11];
#pragma unroll
        for (int i = 0; i < 11; ++i) { const int tt = 8 * rg - 3 + i;
            if (tt >= 0 || !first) xr[i] = *(const u32x4*)(proj + (size_t)(row0 + tt) * DINP + PC_AX + ch);
            else if (chunk >= 256) { const float* sp = F.in[I_SLC] + ((size_t)(layer * 8 + (chunk - 256)) * 3 + (tt + 3)) * 512 + ch; const f32x4 a = *(const f32x4*)sp, b = *(const f32x4*)(sp + 4);
                u32x4 o; o.x = pk2(a.x, a.y); o.y = pk2(a.z, a.w); o.z = pk2(b.x, b.y); o.w = pk2(b.z, b.w); xr[i] = o; }
            else xr[i] = (u32x4){0u, 0u, 0u, 0u};
        }
        const float* cwp = F.in[I_LCW] + (size_t)layer * 4 * 512 + ch; const float* cbp = F.in[I_LCB] + layer * 512 + ch;
        float wv[4][8], bv[8];
#pragma unroll
        for (int j = 0; j < 4; ++j) { const f32x4 a = *(const f32x4*)(cwp + j * 512), b = *(const f32x4*)(cwp + j * 512 + 4); wv[j][0] = a.x; wv[j][1] = a.y; wv[j][2] = a.z; wv[j][3] = a.w; wv[j][4] = b.x; wv[j][5] = b.y; wv[j][6] = b.z; wv[j][7] = b.w; }
        { const f32x4 a = *(const f32x4*)cbp, b = *(const f32x4*)(cbp + 4); bv[0] = a.x; bv[1] = a.y; bv[2] = a.z; bv[3] = a.w; bv[4] = b.x; bv[5] = b.y; bv[6] = b.z; bv[7] = b.w; }
        float x0[8], x1[8], x2[8], x3[8]; unpack8(xr[0], x0); unpack8(xr[1], x1); unpack8(xr[2], x2);
#pragma unroll
        for (int r = 0; r < 8; ++r) { float o[8]; unpack8(xr[r + 3], x3);
#pragma unroll
            for (int e = 0; e < 8; ++e) { o[e] = bv[e] + wv[0][e] * x0[e] + wv[1][e] * x1[e] + wv[2][e] * x2[e] + wv[3][e] * x3[e]; x0[e] = x1[e]; x1[e] = x2[e]; x2[e] = x3[e]; }
            *(LAS u32x4*)(T + (8 * rg + r) * TP + cc * 16) = pack8(o); }
    }
    LDS_WAIT();
    PE(PASS_C ? 21 : 31); PB(PASS_C ? 22 : 32);
#pragma unroll 1
    for (int nt = 0; nt < 4; ++nt) {
        LruSP nx = cur; if (nt < 3) lru_load_sp<PASS_C>(F, layer, h, chunk, nt + 1, nx);
        const int col = 64 * h + 16 * nt + c;
        const float c8 = -8.f * softplus_f(-cur.lam);
        float hc = cur.hin, pc = 1.f;
#pragma unroll
        for (int mt = 0; mt < 4; ++mt) {
            const bf16x8 a0 = frag_row(T, TP, 16 * mt, 0, lane), a1 = frag_row(T, TP, 16 * mt, 32, lane);
            f32x4 ar = {0.f, 0.f, 0.f, 0.f}, ai = {0.f, 0.f, 0.f, 0.f};
            ar = MFMA16(a0, cur.br[0], ar); ar = MFMA16(a1, cur.br[1], ar); ai = MFMA16(a0, cur.bi[0], ai); ai = MFMA16(a1, cur.bi[1], ai);
            float a[4], uu[4];
#pragma unroll
            for (int r = 0; r < 4; ++r) { const int t = 16 * mt + 4 * q + r; const float rg_ = sigm(ar[r] + cur.b_r), ig = sigm(ai[r] + cur.b_i), la = c8 * rg_;
                a[r] = __expf(la); uu[r] = __builtin_amdgcn_sqrtf(fmaxf(1.f - a[r] * a[r], 0.f)) * ig * ld_bf16(T, TP, t, 16 * nt + c); }
            const float P = (a[0] * a[1]) * (a[2] * a[3]); const float Hl = ((uu[0] * a[1] + uu[1]) * a[2] + uu[2]) * a[3] + uu[3];
            float hrun = hc, my_in = 0.f;
#pragma unroll
            for (int qq = 0; qq < 4; ++qq) { const float Pq = __shfl(P, c + 16 * qq), Hq = __shfl(Hl, c + 16 * qq); if (qq == q) my_in = hrun; hrun = Pq * hrun + Hq; pc *= Pq; }
            hc = hrun;
            if (PASS_C) { float hh = my_in;
#pragma unroll
                for (int r = 0; r < 4; ++r) { hh = a[r] * hh + uu[r]; st_bf16(OT, TP, 16 * mt + 4 * q + r, 16 * nt + c, hh); } }
        }
        if (!PASS_C) { if (q == 0) { wsf(F, WS_LRUS)[(size_t)chunk * 512 + col] = pc; wsf(F, WS_LRUS)[(size_t)(NCH + chunk) * 512 + col] = hc; } }
        else if (chunk_last(chunk) && q == 0 && !dry) st_out(F, O_PLH, O_SLH, layer, chunk_seq(chunk), 512)[col] = hc;
        cur = nx;
    }
    PE(PASS_C ? 22 : 32); PB(PASS_C ? 23 : 33);
    if (PASS_C) {
        LDS_WAIT();
        u32x4* gp = (u32x4*)(proj + (size_t)(row0 + rg) * DINP + PC_AG + 64 * h + 8 * cc); u32x4 gnx = *gp;
#pragma unroll 1
        for (int i = 0; i < 8; ++i) { const int t = rg + 8 * i; const u32x4 gc = gnx; u32x4* gq = gp + (size_t)i * (8 * DINP * 2 / 16);
            if (i < 7) gnx = *(gq + (8 * DINP * 2 / 16));
            float hv[8], gv[8]; unpack8(*(const LAS u32x4*)(OT + t * TP + cc * 16), hv); unpack8(gc, gv);
#pragma unroll
            for (int e = 0; e < 8; ++e) hv[e] *= gelu_t(gv[e]);
            if (!dry) *gq = pack8(hv); }
        if (chunk_last(chunk) && !dry) { float* so = st_out(F, O_PLC, O_SLC, layer, chunk_seq(chunk), 3 * 512);
#pragma unroll
            for (int i = 0; i < 3; ++i) so[i * 512 + 64 * h + lane] = bf2f(proj[(size_t)(row0 + 61 + i) * DINP + PC_AX + 64 * h + lane]); }
    }
    LDS_WAIT();
    PE(PASS_C ? 23 : 33);
}

DI void phase_mixer_a(const Ctx& F, int layer) {
    for (int it = blockIdx.x; it < 1034; it += F.G) {
        if (it < 256) gla_pass_a(F, layer, it >> 2, it & 3);
        else if (it < 768) ssd_pass_a(F, layer, (it - 256) >> 3, (it - 256) & 7);
        else if (it < 1024) lru_chunk<false>(F, layer, it - 768);
        else { const int seq = it - 1024, lastrow = seq < 2 ? 8192 * (seq + 1) - 1 : MP + 64 * (seq - 1) - 1;
            float* so = st_out(F, O_PSC, O_SSC, layer, seq, 3 * 1024); const bf16_t* proj = wsb(F, WS_R);
            for (int e = F.tid; e < 3 * 1024; e += 512) so[e] = bf2f(proj[(size_t)(lastrow - 2 + (e >> 10)) * DINP + PC_XBC + (e & 1023)]); }
        __syncthreads();
    }
}
DI void phase_mixer_b(const Ctx& F, int layer, bool dry) {
    float* ds = wsf(F, WS_DS); const float* dec = wsf(F, WS_DEC);
    for (int e = blockIdx.x * 512 + F.tid; e < 2 * 12 * 8192; e += F.G * 512) {
        const int idx = e & 8191, hh = (e >> 13) % 12, b = e / (12 * 8192);
        const int ln = idx & 63, r = (idx >> 6) & 3, Tt = idx >> 8; const int a = 16 * (Tt >> 3) + 4 * (ln >> 4) + r;
        float v[32];
#pragma unroll
        for (int p = 0; p < 32; ++p) v[p] = ds[((size_t)(32 * b + p) * 12 + hh) * 8192 + idx];
        float S = 0.f;
#pragma unroll
        for (int p = 0; p < 32; ++p) { const int panel = 32 * b + p; const float dc = hh < 4 ? dec[(panel * 4 + hh) * 64 + a] : dec[64 * 4 * 64 + panel * 8 + (hh - 4)];
            if (!dry) ds[((size_t)panel * 12 + hh) * 8192 + idx] = S; S = dc * S + v[p]; }
    }
    {
        const int gw = blockIdx.x * NWAVES + F.wave; float* ls = wsf(F, WS_LRUS);
        if (gw < 1024) { const int b = gw >> 9, ch = gw & 511, l = F.lane; const int c0 = 128 * b + 2 * l;
            const float A0 = ls[(size_t)c0 * 512 + ch], H0 = ls[(size_t)(NCH + c0) * 512 + ch], A1 = ls[(size_t)(c0 + 1) * 512 + ch], H1 = ls[(size_t)(NCH + c0 + 1) * 512 + ch];
            float A = A1 * A0, H = A1 * H0 + H1;
#pragma unroll
            for (int o = 1; o < 64; o <<= 1) { const float Ap = __shfl_up(A, o), Hp = __shfl_up(H, o); if (l >= o) { H = A * Hp + H; A = A * Ap; } }
            float E = __shfl_up(H, 1); if (l == 0) E = 0.f;
            ls[(size_t)(2 * NCH + c0) * 512 + ch] = E; ls[(size_t)(2 * NCH + c0 + 1) * 512 + ch] = A0 * E + H0; }
    }
}
#ifndef MIX_MASK
#define MIX_MASK 7
#endif
#ifndef DRY_MIX
#define DRY_MIX 7
#endif
DI void phase_mixer_c(const Ctx& F, int layer, bool dry) {
    const int mm = dry ? DRY_MIX : MIX_MASK;
    for (int it = blockIdx.x; it < 1128; it += F.G) {
        if (it < 512) { if (mm & 1) la_pass_c<true>(F, layer, 4 * (it >> 3), 4, it & 7, dry); }
        else if (it < 768) { if (mm & 2) la_pass_c<false>(F, layer, 4 * ((it - 512) >> 2), 4, (it - 512) & 3, dry); }
        else if (it < 1032) { if (mm & 4) lru_chunk<true>(F, layer, it - 768, dry); }
        else if (it < 1096) { if (mm & 1) la_pass_c<true>(F, layer, 256 + ((it - 1032) >> 3), 1, (it - 1032) & 7, dry); }
        else { if (mm & 2) la_pass_c<false>(F, layer, 256 + ((it - 1096) >> 2), 1, (it - 1096) & 3, dry); }
        __syncthreads();
    }
}
DI void phase_ssd_norm(const Ctx& F, int layer, bool dry) {
    const int gw = F.vcu * NWAVES + F.wave, NGW = F.G * NWAVES; bf16_t* proj = wsb(F, WS_R); const float* pss = wsf(F, WS_PSS);
    float gn[8]; { const float* gp = F.in[I_SNORM] + layer * 512 + 8 * F.lane; const f32x4 a = *(const f32x4*)gp, b = *(const f32x4*)(gp + 4); gn[0] = a.x; gn[1] = a.y; gn[2] = a.z; gn[3] = a.w; gn[4] = b.x; gn[5] = b.y; gn[6] = b.z; gn[7] = b.w; }
    for (int m = gw; m < M; m += NGW) {
        const f32x4* p = (const f32x4*)(pss + (size_t)m * 16); const f32x4 a = p[0], b = p[1], c = p[2], d = p[3];
        const float s = ((a.x + a.y) + (a.z + a.w)) + ((b.x + b.y) + (b.z + b.w)) + ((c.x + c.y) + (c.z + c.w)) + ((d.x + d.y) + (d.z + d.w));
        const float rstd = rsqrtf(s * (1.f / 512.f) + EPS);
        u32x4* yp = (u32x4*)(proj + (size_t)m * DINP + PC_CZ + 8 * F.lane); float v[8]; unpack8(*yp, v);
#pragma unroll
        for (int e = 0; e < 8; ++e) v[e] *= rstd * gn[e];
        *yp = pack8(v);
    }
}
DI void phase_final(const Ctx& F) {
    const int gw = F.vcu * NWAVES + F.wave, NGW = F.G * NWAVES; const float* rss = wsf(F, WS_RSSN) + (size_t)XB_PAD * 16; const float* gf = F.in[I_NFIN]; const bf16_t* xs = wsb(F, WS_XBN);
    for (int m = gw; m < M; m += NGW) { const float rs = row_rstd(rss, m); f32x4* y4 = (f32x4*)(F.out + (size_t)m * D) + F.lane; const u32x2* x2 = (const u32x2*)(xs + (size_t)m * D) + F.lane;
#pragma unroll
        for (int j = 0; j < 4; ++j) { const f32x4 g = *((const f32x4*)gf + F.lane + 64 * j); const u32x2 xw = x2[64 * j];
            f32x4 y; y[0] = __uint_as_float(xw.x << 16) * rs * g[0]; y[1] = __uint_as_float(xw.x & 0xffff0000u) * rs * g[1]; y[2] = __uint_as_float(xw.y << 16) * rs * g[2]; y[3] = __uint_as_float(xw.y & 0xffff0000u) * rs * g[3];
            y4[64 * j] = y; } }
}

constexpr int PH_PER_LAYER = 9, N_PHASES = 1 + DEPTH * PH_PER_LAYER + 1;
__global__ void __launch_bounds__(NWAVES * 64, 2) mk_fwd(Args args) {
    extern __shared__ __attribute__((aligned(16))) unsigned char lds_raw[];
    Ctx F; F.lds = (LAS unsigned char*)lds_raw; F.in = args.in; F.out = args.out; F.ws = args.ws;
    F.wave = __builtin_amdgcn_readfirstlane((int)threadIdx.x >> 6); F.lane = 0; F.tid = 0;
#define T0() (F.wave == 0 && lane_id() == 0)
    F.G = gridDim.x; { const int bx = blockIdx.x; F.vcu = (F.G % 8 == 0) ? (bx % 8) * (F.G / 8) + bx / 8 : bx; }
    volatile LAS unsigned* MISC = (volatile LAS unsigned*)(F.lds + MISC_OFF);
    if (F.wave == 0) MISC[lane_id()] = 0u;
    __syncthreads();
    XcdBarrier bar; bar.bar = (unsigned*)(args.ws + WS_CTL); bar.x = 0; bar.st = nullptr;
    if (args.use_bar) bar = xcd_barrier_post((unsigned*)(args.ws + WS_CTL), MISC + 8, T0());
    const int lo = args.ph_lo, hi = args.ph_hi;
#ifndef PH_MASK
#define PH_MASK 0xFFFFu
#endif
#define IN(k) (lo <= (k) && (k) < hi)
#define ON(b) ((PH_MASK >> (b)) & 1u)
#define SEAM(k) do { if (IN(k) && IN((k) + 1)) xcd_barrier(bar, T0()); } while (0)
#ifndef REP_MASK
#define REP_MASK 0
#endif
#define REPS(b) ((REP_MASK >> (b)) & 1)
#define XBAR() do { if (args.use_bar) xcd_barrier(bar, T0()); } while (0)
#define GP bf16_t* XB = wsb(C, WS_XB) + (size_t)XB_PAD * D; float* RSS = wsf(C, WS_RSS) + (size_t)XB_PAD * 16; bf16_t* XBN = (bf16_t*)C.out; bf16_t* XBNO = layer + 1 < DEPTH ? (bf16_t*)C.out : wsb(C, WS_XBN); float* RSSN = wsf(C, WS_RSSN) + (size_t)XB_PAD * 16; \
    (void)XB; (void)RSS; (void)XBN; (void)XBNO; (void)RSSN
#define PHC Ctx C = F; C.lane = lane_id(); C.tid = C.wave * 64 + C.lane; OPAQUE_CTX(C); { size_t zz_ = 0; asm volatile("" : "+s"(zz_)); C.ws = F.ws + zz_; C.out = (float*)((char*)F.out + zz_); }
    PB(100);
    for (int rr_ = 0; rr_ <= REPS(0); ++rr_) { if (IN(0) && ON(0)) { PHC; convert_set(C, 0, 1 | 2 | 4 | 8 | 16 | 32 | 64 | 128, C.vcu, C.G); p0_rows(C); } if (rr_ < REPS(0)) XBAR(); }
    PE(100); PB(120); SEAM(0); PE(120);
    for (int layer = 0; layer < DEPTH; ++layer) {
        const int pb = 1 + layer * PH_PER_LAYER;
        PB(101);
        for (int rr_ = 0; rr_ <= REPS(1); ++rr_) { if (rr_) XBAR();
        if (IN(pb + 0) && ON(1)) { PHC; GP;
            pg8::Gemm g{XBN, wsb(C, WS_WIN), D, D, D}; pg8::StaticOrder S; S.init(M / 256, DINP / 256, C.G, (int)blockIdx.x, 0);
            EpiProj E{wsb(C, WS_R), RSSN}; pg8::gemm_phase<EpiProj, pg8::StaticOrder>(C.lds, g, S, E, C.wave);
            if (layer >= 1 && rr_ == 0 && C.G == 256 && (int)blockIdx.x >= 98) { __syncthreads(); convert_set(C, layer, 2 | 4 | 8 | 16 | 32 | 64, (int)blockIdx.x - 98, C.G - 98); }
            else if (layer >= 1 && rr_ == 0 && C.G != 256) { __syncthreads(); convert_set(C, layer, 2 | 4 | 8 | 16 | 32 | 64, C.vcu, C.G); }
        } }
        PE(101); PB(120); PB(121); SEAM(pb + 0); PE(121); PE(120); PB(102);
        for (int rr_ = 0; rr_ <= REPS(2); ++rr_) { if (rr_) XBAR(); if (IN(pb + 1) && ON(2)) { PHC; phase_mixer_a(C, layer); } }
        PE(102); PB(120); PB(123); SEAM(pb + 1); PE(123); PE(120); PB(103);
        for (int rr_ = 0; rr_ <= REPS(3); ++rr_) { if (rr_) XBAR();
        if (IN(pb + 2) && ON(3)) { PHC; phase_mixer_b(C, layer, rr_ < REPS(3));
            if (layer + 1 < DEPTH) convert_set(C, layer + 1, 1, C.vcu, C.G); } }
        PE(103); PB(120); PB(122); SEAM(pb + 2); PE(122); PE(120); PB(104);
        for (int rr_ = 0; rr_ <= REPS(4); ++rr_) { if (rr_) XBAR(); if (IN(pb + 3) && ON(4)) { PHC; phase_mixer_c(C, layer, rr_ < REPS(4)); } }
        PE(104); PB(120); PB(124); SEAM(pb + 3); PE(124); PE(120); PB(105);
        for (int rr_ = 0; rr_ <= REPS(5); ++rr_) { if (rr_) XBAR(); if (IN(pb + 4) && ON(5)) { PHC; phase_ssd_norm(C, layer, rr_ < REPS(5)); } }
        PE(105); PB(120); SEAM(pb + 4); PE(120); PB(106);
        for (int rr_ = 0; rr_ <= REPS(6); ++rr_) { if (rr_) XBAR(); const bool dry_ = rr_ < REPS(6);
        if (IN(pb + 5) && ON(6)) { PHC; GP;
            pg8::Gemm g{wsb(C, WS_R) + PC_Y, wsb(C, WS_WOUT), DINP, DMIX, DMIX}; pg8::StaticOrder S; S.init(MP / 256, D / 256, C.G, (int)blockIdx.x, 0);
            EpiRes E{XBN, XB, RSS, dry_};
            pg8::gemm_phase<EpiRes, pg8::StaticOrder>(C.lds, g, S, E, C.wave);
            { constexpr int SK = 6, KS = DMIX / SK; const int c = (int)blockIdx.x, j = c / SK, sl = c % SK;
              pg8::Gemm g2{wsb(C, WS_R) + PC_Y + sl * KS, wsb(C, WS_WOUT) + sl * KS, DINP, DMIX, KS}; OneUnit S2{64 + (j >> 2), j & 3, c < 8 * SK};
              EpiPart E2{C.out + (size_t)M * D / 2 + (size_t)(c < 8 * SK ? c : 0) * 65536}; pg8::gemm_phase<EpiPart, OneUnit>(C.lds, g2, S2, E2, C.wave); }
        } }
        XBAR();
        if (IN(pb + 5) && ON(6)) { PHC; GP; reduce_tail<0>(C, C.out + (size_t)M * D / 2, 6, XBN, XB, RSS, RSS, nullptr); }
        PE(106); PB(120); SEAM(pb + 5); PE(120); PB(107);
        for (int rr_ = 0; rr_ <= REPS(7); ++rr_) { if (rr_) XBAR();
        if (IN(pb + 6) && ON(7)) { PHC; GP;
            pg8::Gemm g{XB, wsb(C, WS_WGU), D, D, D}; pg8::StaticOrder S; S.init(67, 2 * DFF / 256, C.G, (int)blockIdx.x, 1);
            EpiFfn E{wsb(C, WS_R), RSS, C.in[I_FCW] + (size_t)layer * 3 * DFF, C.in[I_FCB] + layer * DFF, C.in[I_SFC] + (size_t)layer * 8 * 2 * DFF,
                     C.out + O_PFC + (size_t)layer * 2 * 2 * DFF, C.out + O_SFC + (size_t)layer * 8 * 2 * DFF};
            pg8::gemm_phase<EpiFfn, pg8::StaticOrder>(C.lds, g, S, E, C.wave);
            if (rr_ == 0) { const int sh = C.G == 256 ? 72 : 0;
                if ((int)blockIdx.x >= sh) { pg8::Gemm g2{wsb(C, WS_PB), wsb(C, WS_WPP), DPLE, DPLE, DPLE}; pg8::StaticOrder S2; S2.init(M / 256, D / 256, C.G - sh, (int)blockIdx.x - sh, 0);
                    EpiPP E2{wsb(C, WS_PPO)}; pg8::gemm_phase<EpiPP, pg8::StaticOrder>(C.lds, g2, S2, E2, C.wave); } }
        } }
        PE(107); PB(120); SEAM(pb + 6); PE(120); PB(108);
        for (int rr_ = 0; rr_ <= REPS(8); ++rr_) { if (rr_) XBAR(); const bool dry_ = rr_ < REPS(8);
        if (IN(pb + 7) && ON(8)) { PHC; GP;
            pg8::Gemm g{wsb(C, WS_R), wsb(C, WS_WD), DFF, DFF, DFF}; pg8::StaticOrder S; S.init(MP / 256, D / 256, C.G, (int)blockIdx.x, 0);
            EpiRes E{XB, XB, RSS, dry_}; pg8::gemm_phase<EpiRes, pg8::StaticOrder>(C.lds, g, S, E, C.wave);
            { constexpr int SK = 12, KS = DFF / SK; const int c = (int)blockIdx.x, j = c / SK, sl = c % SK;
              pg8::Gemm g2{wsb(C, WS_R) + sl * KS, wsb(C, WS_WD) + sl * KS, DFF, DFF, KS}; OneUnit S2{64 + (j >> 2), j & 3, c < 8 * SK};
              EpiPart E2{C.out + (size_t)M * D / 2 + (size_t)(c < 8 * SK ? c : 0) * 65536}; pg8::gemm_phase<EpiPart, OneUnit>(C.lds, g2, S2, E2, C.wave); }
        } }
        XBAR();
        if (IN(pb + 7) && ON(8)) { PHC; GP; reduce_tail<0>(C, C.out + (size_t)M * D / 2, 12, XB, XB, RSS, RSS, nullptr); }
        PE(108); PB(120); SEAM(pb + 7); PE(120); PB(109);
        for (int rr_ = 0; rr_ <= REPS(9); ++rr_) { if (rr_) XBAR(); const bool dry_ = rr_ < REPS(9);
        if (IN(pb + 8) && ON(9)) { PHC; GP;
            pg8::Gemm g{XB, wsb(C, WS_WPG), D, D, D}; pg8::StaticOrder S; S.init(MP / 256, D / 256, C.G, (int)blockIdx.x, 0);
            EpiPle E{XB, XBNO, RSS, RSSN, wsb(C, WS_PPO), dry_}; pg8::gemm_phase<EpiPle, pg8::StaticOrder>(C.lds, g, S, E, C.wave);
            { constexpr int SK = 4, KS = D / SK; const int c = (int)blockIdx.x, j = c / SK, sl = c % SK;
              pg8::Gemm g2{XB + sl * KS, wsb(C, WS_WPG) + sl * KS, D, D, KS}; OneUnit S2{64 + (j >> 2), j & 3, c < 8 * SK};
              EpiPart E2{C.out + (size_t)M * D / 2 + (size_t)(c < 8 * SK ? c : 0) * 65536}; pg8::gemm_phase<EpiPart, OneUnit>(C.lds, g2, S2, E2, C.wave); }
        } }
        XBAR();
        if (IN(pb + 8) && ON(9)) { PHC; GP; reduce_tail<1>(C, C.out + (size_t)M * D / 2, 4, XB, XBNO, RSS, RSSN, wsb(C, WS_PPO)); }
        PE(109); PB(120); SEAM(pb + 8); PE(120); PB(110);
    }
    PB(111);
    if (IN(N_PHASES - 1) && ON(10)) { PHC; phase_final(C); }
    PE(111);
    if (PROBE_ID != 0 && (int)blockIdx.x == PROBE_WG) { __syncthreads(); if (F.wave == 0) { const unsigned tot = MISC[32] * PROBE_MULT; const unsigned t0 = (unsigned)__builtin_amdgcn_s_memrealtime();
        while ((unsigned)__builtin_amdgcn_s_memrealtime() - t0 < tot) __builtin_amdgcn_s_sleep(8); } }
#undef IN
#undef ON
#undef SEAM
}

extern "C" void kernel_launch(void* const* d_in, const int* in_sizes, int n_in, void* d_out, int out_size, void* d_ws, size_t ws_size, hipStream_t stream) {
    static int grid = 0;
    if (grid == 0) {
        if (n_in != N_IN || (size_t)out_size != O_END || ws_size < WS_END) { fprintf(stderr, "kernel_launch: unexpected shapes: n_in %d out %d ws %zu (need %d, %zu, %zu)\n", n_in, out_size, ws_size, (int)N_IN, (size_t)O_END, (size_t)WS_END); grid = -1; return; }
        int dev = 0, cus = 0, per_cu = 0;
        if (hipGetDevice(&dev) != hipSuccess || hipDeviceGetAttribute(&cus, hipDeviceAttributeMultiprocessorCount, dev) != hipSuccess) { grid = -1; return; }
        if (hipFuncSetAttribute((const void*)mk_fwd, hipFuncAttributeMaxDynamicSharedMemorySize, LDS_BYTES) != hipSuccess) { fprintf(stderr, "kernel_launch: hipFuncSetAttribute failed\n"); grid = -1; return; }
        if (hipOccupancyMaxActiveBlocksPerMultiprocessor(&per_cu, (const void*)mk_fwd, NWAVES * 64, LDS_BYTES) != hipSuccess || per_cu < 1) { fprintf(stderr, "kernel_launch: occupancy query says %d\n", per_cu); per_cu = 1; }
        (void)hipGetLastError();
        grid = cus;
    }
    if (grid < 0) return;
    (void)hipMemsetAsync((char*)d_ws + WS_CTL, 0, CTL_ZERO_BYTES, stream);
    Args a{};
    for (int i = 0; i < N_IN; ++i) a.in[i] = (const float*)d_in[i];
    a.out = (float*)d_out; a.ws = (unsigned char*)d_ws;
#if MK_PER_PHASE
    for (int p = 0; p < N_PHASES; ++p) { a.ph_lo = p; a.ph_hi = p + 1; a.use_bar = 0; hipLaunchKernelGGL(mk_fwd, dim3(grid), dim3(NWAVES * 64), LDS_BYTES, stream, a); }
#else
    a.ph_lo = 0; a.ph_hi = N_PHASES; a.use_bar = 1;
    void* kargs[] = {&a};
    hipError_t e = hipLaunchCooperativeKernel((const void*)mk_fwd, dim3(grid), dim3(NWAVES * 64), kargs, LDS_BYTES, stream);
    if (e != hipSuccess) fprintf(stderr, "kernel_launch: cooperative launch failed: %s\n", hipGetErrorString(e));
#endif
}
```

```cpp
#include <hip/hip_runtime.h>
#include <cstdio>
#include <cstdint>

#define DI __device__ __forceinline__
#define LAS __attribute__((address_space(3)))
typedef unsigned short bf16_t;
typedef short bf16x8 __attribute__((ext_vector_type(8)));
typedef short s16x4 __attribute__((ext_vector_type(4)));
typedef float f32x4 __attribute__((ext_vector_type(4)));
typedef float f32x2 __attribute__((ext_vector_type(2)));
typedef unsigned u32x4 __attribute__((ext_vector_type(4)));
typedef unsigned u32x2 __attribute__((ext_vector_type(2)));

#ifndef MK_PER_PHASE
#define MK_PER_PHASE 0
#endif

constexpr int DEPTH = 2, D = 1024, MP = 16384, MS = 512, M = MP + MS;
constexpr int DIN = 4120, DINP = 4352, DFF = 3072, DMIX = 1536, DPLE = 256;
constexpr int NCH = M / 64;
constexpr float EPS = 1e-6f;
constexpr int PC_AX = 0, PC_BQ = 512, PC_BK = 768, PC_BV = 1024, PC_BLR = 1536, PC_XBC = 1552, PC_DT = 2576, PC_PAD = 2584, PC_Y = 2816, PC_AG = 2816, PC_BG = 3328, PC_CZ = 3840;

enum { I_XP = 0, I_XS, I_SLC, I_SLH, I_SG, I_SSC, I_SS, I_SFC, I_PP, I_PS, I_NMIX, I_WIN, I_LCW, I_LCB, I_LWR, I_LBR, I_LWI, I_LBI, I_LAM, I_GWLR, I_GBLR, I_GNORM,
       I_SCW, I_SCB, I_SDTB, I_SALOG, I_SD, I_SNORM, I_WOUT, I_NFFN, I_WG, I_WU, I_FCW, I_FCB, I_WD, I_NPLE, I_PWG, I_PWP, I_NFIN, N_IN };
constexpr size_t O_Y = 0;
constexpr size_t O_PLC = (size_t)M * D;
constexpr size_t O_PLH = O_PLC + 2 * 2 * 3 * 512;
constexpr size_t O_PG = O_PLH + 2 * 2 * 512;
constexpr size_t O_PSC = O_PG + 2 * 2 * 4 * 64 * 128;
constexpr size_t O_PS = O_PSC + 2 * 2 * 3 * 1024;
constexpr size_t O_PFC = O_PS + 2 * 2 * 8 * 64 * 128;
constexpr size_t O_SLC = O_PFC + 2 * 2 * 2 * 3072;
constexpr size_t O_SLH = O_SLC + 2 * 8 * 3 * 512;
constexpr size_t O_SG = O_SLH + 2 * 8 * 512;
constexpr size_t O_SSC = O_SG + 2 * 8 * 4 * 64 * 128;
constexpr size_t O_SS = O_SSC + 2 * 8 * 3 * 1024;
constexpr size_t O_SFC = O_SS + 2 * 8 * 8 * 64 * 128;
constexpr size_t O_END = O_SFC + 2 * 8 * 2 * 3072;

constexpr size_t MiB = 1u << 20;
constexpr size_t al4k(size_t x) { return (x + 4095) & ~(size_t)4095; }
constexpr int XB_PAD = 256;
constexpr int XB_ROWS = XB_PAD + M + 128;
constexpr size_t WS_CTL = 0, CTL_ZERO_BYTES = 64 * 1024;
constexpr size_t WS_WIN = al4k(WS_CTL + CTL_ZERO_BYTES);
constexpr size_t WS_WOUT = al4k(WS_WIN + (size_t)DINP * D * 2);
constexpr size_t WS_WGU = al4k(WS_WOUT + (size_t)D * DMIX * 2);
constexpr size_t WS_WD = al4k(WS_WGU + (size_t)2 * DFF * D * 2);
constexpr size_t WS_WPG = al4k(WS_WD + (size_t)D * DFF * 2);
constexpr size_t WS_WPP = al4k(WS_WPG + (size_t)D * D * 2);
constexpr size_t WS_LRUW = al4k(WS_WPP + (size_t)D * DPLE * 2);
constexpr size_t WS_RSS = al4k(WS_LRUW + (size_t)DEPTH * 2 * 8 * 4096 * 2);
constexpr size_t WS_RSSN = al4k(WS_RSS + (size_t)XB_ROWS * 64);
constexpr size_t WS_PSS = al4k(WS_RSSN + (size_t)XB_ROWS * 64);
constexpr size_t WS_LRUS = al4k(WS_PSS + (size_t)M * 64);
constexpr size_t WS_DEC = al4k(WS_LRUS + (size_t)3 * NCH * 512 * 4);
constexpr size_t WS_PB = al4k(WS_DEC + (size_t)(64 * 4 * 64 + 64 * 8) * 4);
constexpr size_t WS_XB = al4k(WS_PB + (size_t)M * DPLE * 2);
constexpr size_t WS_DS = al4k(WS_XB + (size_t)XB_ROWS * D * 2);
constexpr size_t WS_XBN = WS_DS;
constexpr size_t WS_R = al4k(WS_DS + (size_t)M * D * 2);
constexpr size_t WS_PPO = WS_R + 100 * MiB;
constexpr size_t WS_END = WS_R + (size_t)M * DINP * 2;
static_assert(WS_END <= 256 * MiB, "workspace");
static_assert((size_t)64 * 12 * 8192 * 4 <= (size_t)M * D * 2, "DS fits the XBN slot");
static_assert((size_t)M * DFF * 2 <= 100 * MiB && WS_PPO + (size_t)M * D * 2 <= WS_END, "overlay");

constexpr int MISC_OFF = 147456 + 4096;
DI float bf2f(bf16_t b) { return __uint_as_float(((unsigned)b) << 16); }
DI unsigned f2bf(float f) { unsigned u = __float_as_uint(f); return (u + 0x7fffu + ((u >> 16) & 1u)) >> 16; }
DI unsigned pk2(float lo, float hi) { return f2bf(lo) | (f2bf(hi) << 16); }
DI float sigm(float x) { return __builtin_amdgcn_rcpf(1.f + __expf(-x)); }
DI float silu_f(float x) { return x * __builtin_amdgcn_rcpf(1.f + __expf(-x)); }
DI float gelu_t(float x) { const float u = 1.5957691216f * (x + 0.044715f * x * x * x); return x * __builtin_amdgcn_rcpf(1.f + __expf(-u)); }
DI float softplus_f(float x) { return fmaxf(x, 0.f) + log1pf(__expf(-fabsf(x))); }
DI float logsig_f(float x) { return fminf(x, 0.f) - log1pf(__expf(-fabsf(x))); }
template <int CTRL> DI float dpp_ror(float x) { return __builtin_bit_cast(float, __builtin_amdgcn_update_dpp(0, __builtin_bit_cast(int, x), CTRL, 0xf, 0xf, false)); }
DI float log1p_small(float e) { return e < 0.01f ? e * (1.f - e * (0.5f - e * 0.33333334f)) : __logf(1.f + e); }
DI float softplus_fast(float x) { return fmaxf(x, 0.f) + log1p_small(__expf(-fabsf(x))); }
DI float logsig_fast(float x) { return fminf(x, 0.f) - __logf(1.f + __expf(-fabsf(x))); }
DI float wave_incl_scan(float v) {
#define DPPF(x, ctrl, rm, bc) __builtin_bit_cast(float, __builtin_amdgcn_update_dpp(0, __builtin_bit_cast(int, (x)), (ctrl), (rm), 0xf, (bc)))
    v += DPPF(v, 0x111, 0xf, true); v += DPPF(v, 0x112, 0xf, true); v += DPPF(v, 0x114, 0xf, true); v += DPPF(v, 0x118, 0xf, true);
    v += DPPF(v, 0x142, 0xa, false); v += DPPF(v, 0x143, 0xc, false);
#undef DPPF
    return v;
}
DI void unpack8(const u32x4 v, float (&o)[8]) {
#pragma unroll
    for (int i = 0; i < 4; ++i) { o[2 * i] = __uint_as_float(v[i] << 16); o[2 * i + 1] = __uint_as_float(v[i] & 0xffff0000u); }
}
DI u32x4 pack8(const float (&o)[8]) { u32x4 r; r.x = pk2(o[0], o[1]); r.y = pk2(o[2], o[3]); r.z = pk2(o[4], o[5]); r.w = pk2(o[6], o[7]); return r; }
DI int lane_id() { int l; asm volatile("v_mbcnt_lo_u32_b32 %0, -1, 0\n\tv_mbcnt_hi_u32_b32 %0, -1, %0" : "=v"(l)); return l; }
#define LDS_WAIT() asm volatile("s_waitcnt lgkmcnt(0)" ::: "memory")
#define VM_WAIT() asm volatile("s_waitcnt vmcnt(0)" ::: "memory")

namespace pg8 {
constexpr int BM = 256, BK = 64, HALF = 128, HTB = HALF * BK * 2, STAGE_BYTES = 8 * HTB, NXCD = 8, WGM = 8;
__host__ __device__ __forceinline__ int lds_byte(int r, int c) { const int st = (r >> 4) * 2 + (c >> 5), rr = r & 15, cc = c & 31, ob = rr * 64 + cc * 2; return st * 1024 + (ob ^ (((ob >> 9) & 1) << 5)); }
__host__ __device__ __forceinline__ void stage_rc(int b, int& R, int& C) { const int st = b / 1024, sb = b % 1024, swz = sb ^ (((sb >> 9) & 1) << 5); R = (st >> 1) * 16 + swz / 64; C = (st & 1) * 32 + (swz % 64) / 2; }
__host__ __device__ __forceinline__ int perm32(int rho) { const int n = rho >> 4, i = rho & 15; return 8 * (i >> 2) + 4 * n + (i & 3); }

struct Unit { int pm, pn, arow; };
struct Gemm { const bf16_t* A; const bf16_t* Bt; int lda, ldb, K; };

struct StaticOrder {
    int nM, nN, nwg, G, c, shifted;
    __device__ void init(int nM_, int nN_, int G_, int c_, int shifted_) { nM = nM_; nN = nN_; nwg = nM * nN; G = G_; c = c_; shifted = shifted_; }
    __device__ bool next(int i, Unit& u) const {
        const long L = (long)i * G + c; if (L >= nwg) return false;
        int wgid = (int)L; { const int q = nwg / NXCD, r = nwg % NXCD, xcd = wgid % NXCD, off = wgid / NXCD; wgid = (xcd < r ? xcd * (q + 1) : r * (q + 1) + (xcd - r) * q) + off; }
        const int nig = WGM * nN, gid = wgid / nig, fm = gid * WGM, gsz = (nM - fm) < WGM ? (nM - fm) : WGM;
        u.pm = fm + ((wgid % nig) % gsz); u.pn = (wgid % nig) / gsz; u.arow = shifted ? 254 * u.pm - 2 : 256 * u.pm; return true;
    }
};
typedef __bf16 bf16x2_t __attribute__((ext_vector_type(2)));
DI unsigned cvt_pk_bf16(float lo, float hi) { const f32x2 v = {lo, hi}; const bf16x2_t r = __builtin_convertvector(v, bf16x2_t); return __builtin_bit_cast(unsigned, r); }

template <class Epi, class Sched>
DI void gemm_phase(LAS unsigned char* lds, const Gemm g, const Sched& S, const Epi& E, int wid) {
    const int lane = lane_id(), tid = wid * 64 + lane, wr = wid >> 2, wc = wid & 3, fr = lane & 15, fq = lane >> 4;
    const int K = g.K, nt = K / BK;
    unsigned voffA[2], voffB[2];
#pragma unroll
    for (int i = 0; i < 2; ++i) { int R, C; stage_rc(tid * 16 + i * 8192, R, C); const int Rb = Epi::PERM ? ((R & ~31) + perm32(R & 31)) : R;
        voffA[i] = (unsigned)(R * g.lda + C) * 2u; voffB[i] = (unsigned)(Rb * g.ldb + C) * 2u; }
    const size_t kstep = (size_t)(BK * 2);
    const size_t hstepA = (size_t)HALF * g.lda * 2, hstepB = (size_t)HALF * g.ldb * 2;
    const unsigned ldsw = (unsigned)wid * 1024u;
    const int aoff = lds_byte(wr * 64 + fr, fq * 8), boff = lds_byte(wc * 32 + fr, fq * 8);
#define PG8_SA(b, h) (((b) * 2 + (h)) * HTB)
#define PG8_SB(b, h) ((4 + (b) * 2 + (h)) * HTB)
#define PG8_STAGE(bufoff, gbase, voff) do { _Pragma("unroll") for (int _i = 0; _i < 2; ++_i) \
        __builtin_amdgcn_global_load_lds((const unsigned*)((const char*)(gbase) + (voff)[_i]), (LAS unsigned*)(lds + (bufoff) + ldsw + _i * 8192), 16, 0, 0); } while (0)
#define PG8_LDA(dst, b, h) do { _Pragma("unroll") for (int m = 0; m < 4; ++m) _Pragma("unroll") for (int k = 0; k < 2; ++k) dst[m][k] = *(const LAS bf16x8*)(lds + PG8_SA(b, h) + aoff + m * 2048 + k * 1024); } while (0)
#define PG8_LDB(dst, b, h) do { _Pragma("unroll") for (int n = 0; n < 2; ++n) _Pragma("unroll") for (int k = 0; k < 2; ++k) dst[n][k] = *(const LAS bf16x8*)(lds + PG8_SB(b, h) + boff + n * 2048 + k * 1024); } while (0)
#define PG8_MMA(ai, bj, At, Bt) do { __builtin_amdgcn_s_setprio(1); _Pragma("unroll") for (int m = 0; m < 4; ++m) _Pragma("unroll") for (int n = 0; n < 2; ++n) _Pragma("unroll") for (int k = 0; k < 2; ++k) \
        acc[ai][bj][m][n] = __builtin_amdgcn_mfma_f32_16x16x32_bf16(Bt[n][k], At[m][k], acc[ai][bj][m][n], 0, 0, 0); __builtin_amdgcn_s_setprio(0); } while (0)
#define PG8_WAIT_V(n) asm volatile("s_waitcnt vmcnt(" #n ")" ::: "memory")
#define PG8_WAIT_L(n) asm volatile("s_waitcnt lgkmcnt(" #n ")" ::: "memory")
#define PG8_BAR __builtin_amdgcn_s_barrier()
#define PG8_SCHED __builtin_amdgcn_sched_barrier(0)
    Unit cur, nxt; int ui = 0;
    if (!S.next(0, cur)) return;
    f32x4 acc[2][2][4][2];
#pragma unroll
    for (int a = 0; a < 2; ++a)
#pragma unroll
        for (int b = 0; b < 2; ++b)
#pragma unroll
            for (int m = 0; m < 4; ++m)
#pragma unroll
                for (int n = 0; n < 2; ++n) acc[a][b][m][n] = (f32x4){0.f, 0.f, 0.f, 0.f};
    bf16x8 At[4][2], B0[2][2], B1[2][2];
    const char* cA = (const char*)g.A + (long)cur.arow * g.lda * 2; const char* cB = (const char*)g.Bt + (size_t)cur.pn * 256 * g.ldb * 2;
    PG8_STAGE(PG8_SB(0, 0), cB, voffB); PG8_STAGE(PG8_SB(0, 1), cB + hstepB, voffB); PG8_STAGE(PG8_SA(0, 0), cA, voffA); PG8_STAGE(PG8_SA(0, 1), cA + hstepA, voffA);
    if (wr == 1) PG8_BAR;
    PG8_WAIT_V(2); PG8_BAR;
    PG8_STAGE(PG8_SB(1, 0), cB + kstep, voffB); PG8_STAGE(PG8_SA(1, 0), cA + kstep, voffA); PG8_STAGE(PG8_SB(1, 1), cB + hstepB + kstep, voffB);
    PG8_WAIT_V(6); PG8_BAR;
    for (;;) {
        const bool has_next = S.next(ui + 1, nxt);
        const char* nA = has_next ? (const char*)g.A + (long)nxt.arow * g.lda * 2 : cA; const char* nB = has_next ? (const char*)g.Bt + (size_t)nxt.pn * 256 * g.ldb * 2 : cB;
#pragma unroll 1
        for (int t = 0; t < nt; t += 2) {
            const bool last = (t == nt - 2);
            const char* a1 = cA + (size_t)(t + 1) * kstep;
            const char* a2 = last ? nA : cA + (size_t)(t + 2) * kstep; const char* b2 = last ? nB : cB + (size_t)(t + 2) * kstep;
            const char* a3 = a2 + kstep; const char* b3 = b2 + kstep;
            PG8_LDB(B0, 0, 0); PG8_LDB(B1, 0, 1); PG8_SCHED; PG8_LDA(At, 0, 0); PG8_STAGE(PG8_SA(1, 1), a1 + hstepA, voffA);
            PG8_WAIT_V(8); PG8_WAIT_L(0); PG8_BAR; PG8_MMA(0, 0, At, B0); PG8_MMA(0, 1, At, B1); PG8_BAR; PG8_SCHED;
            PG8_LDA(At, 0, 1); PG8_STAGE(PG8_SB(0, 0), b2, voffB); PG8_STAGE(PG8_SB(0, 1), b2 + hstepB, voffB); PG8_STAGE(PG8_SA(0, 0), a2, voffA);
            PG8_WAIT_V(8); PG8_WAIT_L(0); PG8_BAR; PG8_MMA(1, 0, At, B0); PG8_MMA(1, 1, At, B1); PG8_BAR; PG8_SCHED;
            PG8_LDB(B0, 1, 0); PG8_LDB(B1, 1, 1); PG8_SCHED; PG8_LDA(At, 1, 0); PG8_STAGE(PG8_SA(0, 1), a2 + hstepA, voffA);
            PG8_WAIT_V(8); PG8_WAIT_L(0); PG8_BAR; PG8_MMA(0, 0, At, B0); PG8_MMA(0, 1, At, B1); PG8_BAR; PG8_SCHED;
            PG8_LDA(At, 1, 1); PG8_STAGE(PG8_SB(1, 0), b3, voffB); PG8_STAGE(PG8_SB(1, 1), b3 + hstepB, voffB); PG8_STAGE(PG8_SA(1, 0), a3, voffA);
            PG8_WAIT_V(8); PG8_WAIT_L(0); PG8_BAR; PG8_MMA(1, 0, At, B0); PG8_MMA(1, 1, At, B1); PG8_BAR; PG8_SCHED;
        }
        if (wr == 0) PG8_BAR;
        { const int l2 = lane_id(); E(acc, cur, wr, wc, l2 & 15, l2 >> 4, lds); }
        if (!has_next) break;
#pragma unroll
        for (int a = 0; a < 2; ++a)
#pragma unroll
            for (int b = 0; b < 2; ++b)
#pragma unroll
                for (int m = 0; m < 4; ++m)
#pragma unroll
                    for (int n = 0; n < 2; ++n) acc[a][b][m][n] = (f32x4){0.f, 0.f, 0.f, 0.f};
        cur = nxt; cA = nA; cB = nB; ++ui;
        if (wr == 1) PG8_BAR;
    }
    PG8_WAIT_V(0);
    PG8_BAR;
#undef PG8_SA
#undef PG8_SB
#undef PG8_STAGE
#undef PG8_LDA
#undef PG8_LDB
#undef PG8_MMA
#undef PG8_WAIT_V
#undef PG8_WAIT_L
#undef PG8_BAR
#undef PG8_SCHED
}
}

#define XB_TMO      128
#define XB_XCNT(j)  (256  + 64 * (j))
#define XB_XSUB(j)  (1280 + 64 * (j))
#define XB_XGEN(j)  (2304 + 64 * (j))
#define XB_TOP      3328
#define XB_TOPGEN   3392
#define XCD_BAR_WORDS 3456
#define XB_SPIN_CAP (1u << 18)
DI unsigned xb_ld(unsigned* p)              { return __hip_atomic_load(p, __ATOMIC_RELAXED, __HIP_MEMORY_SCOPE_AGENT); }
DI unsigned xb_add(unsigned* p, unsigned v) { return __hip_atomic_fetch_add(p, v, __ATOMIC_RELAXED, __HIP_MEMORY_SCOPE_AGENT); }
DI unsigned xb_xcc_id() { return (unsigned)__builtin_amdgcn_s_getreg((3 << 11) | 20) & 0xFu; }
#define XB_SPIN(cond, bar) do { unsigned _sp = 0; while (cond) { __builtin_amdgcn_s_sleep(1); \
    if ((++_sp & 255u) == 0u) { if (xb_ld(&(bar)[XB_TMO])) break; if (_sp > XB_SPIN_CAP) { atomicAdd(&(bar)[XB_TMO], 1u); break; } } } } while (0)
struct XcdBarrier { unsigned* bar; unsigned x; volatile LAS unsigned* st; };
DI XcdBarrier xcd_barrier_post(unsigned* bar, volatile LAS unsigned* st, bool t0) {
    XcdBarrier b; b.bar = bar; b.x = xb_xcc_id(); b.st = st;
    if (t0) (void)xb_add(&bar[XB_XCNT(b.x)], 1u);
    return b;
}
DI void xcd_barrier_complete(unsigned* bar, unsigned x, unsigned& nloc, unsigned& nx) {
    const unsigned G = gridDim.x * gridDim.y * gridDim.z;
    unsigned sum, cnt, mine, sp = 0u;
    for (;;) {
        sum = 0u; cnt = 0u; mine = 0u;
#pragma unroll
        for (unsigned j = 0; j < 16; ++j) { const unsigned c = xb_ld(&bar[XB_XCNT(j)]); sum += c; cnt += (c > 0u) ? 1u : 0u; mine = (j == x) ? c : mine; }
        if (sum == G) break;
        __builtin_amdgcn_s_sleep(1);
        if ((++sp & 255u) == 0u) { if (xb_ld(&bar[XB_TMO])) break; if (sp > XB_SPIN_CAP) { atomicAdd(&bar[XB_TMO], 1u); break; } }
    }
    nloc = mine > 0u ? mine : 1u; nx = cnt > 0u ? cnt : 1u;
}
DI void xcd_barrier(const XcdBarrier& b, bool t0) {
    asm volatile("s_waitcnt vmcnt(0)" ::: "memory");
    __syncthreads();
    if (t0) {
        unsigned* bar = b.bar;
        __builtin_amdgcn_s_waitcnt(0);
        unsigned nloc = b.st[0], nx = b.st[1];
        if (nloc == 0u) { xcd_barrier_complete(bar, b.x, nloc, nx); b.st[0] = nloc; b.st[1] = nx; }
        const unsigned old = xb_add(&bar[XB_XSUB(b.x)], 1u);
        const unsigned gen = old / nloc;
        if (old + 1u == (gen + 1u) * nloc) {
            __builtin_amdgcn_fence(__ATOMIC_RELEASE, "agent");
            asm volatile("s_waitcnt vmcnt(0)" ::: "memory");
            const unsigned og = xb_add(&bar[XB_TOP], 1u);
            const unsigned tg = og / nx;
            if (og + 1u == (tg + 1u) * nx) xb_add(&bar[XB_TOPGEN], 1u);
            else XB_SPIN(xb_ld(&bar[XB_TOPGEN]) == tg, bar);
            __builtin_amdgcn_fence(__ATOMIC_ACQUIRE, "agent");
            xb_add(&bar[XB_XGEN(b.x)], 1u);
            asm volatile("s_waitcnt vmcnt(0)" ::: "memory");
        } else {
            XB_SPIN(xb_ld(&bar[XB_XGEN(b.x)]) == gen, bar);
            __builtin_amdgcn_fence(__ATOMIC_ACQUIRE, "agent");
            asm volatile("s_waitcnt vmcnt(0)" ::: "memory");
        }
    }
    __syncthreads();
}

#ifndef PROBE_ID
#define PROBE_ID 0
#endif
#ifndef PROBE_WG
#define PROBE_WG 0
#endif
#ifndef PROBE_MULT
#define PROBE_MULT 8
#endif
constexpr int NWAVES = 8;
constexpr int RING_BYTES = 131072;
constexpr int MIX_LDS = 147456;
constexpr int XG_OFF = MIX_LDS;
static_assert(MISC_OFF == MIX_LDS + 4096, "LDS map");
constexpr int LDS_BYTES = 155648;

struct Args { const float* in[N_IN]; float* out; unsigned char* ws; int ph_lo, ph_hi, use_bar, pad; };

struct Ctx {
    LAS unsigned char* lds;
    const float* const* in; float* out; unsigned char* ws;
    int tid, lane, wave, G, vcu;
};
#define OPAQUE_CTX(C) do { asm volatile("" : "+v"((C).tid), "+v"((C).lane)); asm volatile("" : "+s"((C).wave), "+s"((C).vcu)); } while (0)
#define PB(id) do { if ((id) == PROBE_ID && PROBE_ID != 0 && (int)blockIdx.x == PROBE_WG && F.wave == 0 && lane_id() == 0) { volatile LAS unsigned* pw_ = (volatile LAS unsigned*)(F.lds + MISC_OFF); pw_[33] = (unsigned)__builtin_amdgcn_s_memrealtime(); } } while (0)
#define PE(id) do { if ((id) == PROBE_ID && PROBE_ID != 0 && (int)blockIdx.x == PROBE_WG && F.wave == 0 && lane_id() == 0) { volatile LAS unsigned* pw_ = (volatile LAS unsigned*)(F.lds + MISC_OFF); pw_[32] += (unsigned)__builtin_amdgcn_s_memrealtime() - pw_[33]; } } while (0)
DI bf16_t* wsb(const Ctx& F, size_t off) { return (bf16_t*)(F.ws + off); }
DI float* wsf(const Ctx& F, size_t off) { return (float*)(F.ws + off); }

DI bool chunk_first(int c) { return c == 0 || c == 128 || c >= 256; }
DI bool chunk_last(int c) { return c == 127 || c >= 255; }
DI int chunk_seq(int c) { return c < 128 ? 0 : (c < 256 ? 1 : c - 254); }
DI float* st_out(const Ctx& F, size_t offp, size_t offs, int layer, int seq, int per) {
    return seq < 2 ? F.out + offp + (size_t)(layer * 2 + seq) * per : F.out + offs + (size_t)(layer * 8 + (seq - 2)) * per;
}

DI float wave_sum(float v) {
#pragma unroll
    for (int o = 1; o < 64; o <<= 1) v += __shfl_xor(v, o);
    return v;
}
DI int win_dst(int n) {
    if (n < 512) return PC_AX + n;
    if (n < 1024) return PC_AG + (n - 512);
    if (n < 1280) return PC_BQ + (n - 1024);
    if (n < 1536) return PC_BK + (n - 1280);
    if (n < 2048) return PC_BV + (n - 1536);
    if (n < 2560) return PC_BG + (n - 2048);
    if (n < 2576) return PC_BLR + (n - 2560);
    if (n < 3088) return PC_CZ + (n - 2576);
    if (n < 4112) return PC_XBC + (n - 3088);
    return PC_DT + (n - 4112);
}
DI int map_row(int mode, int n) {
    if (mode == 1) return win_dst(n);
    if (mode == 2) return 256 * (n >> 7) + (n & 127);
    if (mode == 3) return 256 * (n >> 7) + 128 + (n & 127);
    return n;
}
constexpr int TR_PITCH = 68, TR_WAVE_BYTES = 64 * TR_PITCH * 4;
DI void tr_item(const float* W, int K, int N, bf16_t* WT, int mode, const float* g, LAS float* scr, int item, int lane) {
    const int nblk = (N + 63) / 64, kb = item / nblk, nb = item % nblk, k0 = 64 * kb, n0 = 64 * nb;
    const int c4 = (lane & 15) * 4, kr = lane >> 4;
#pragma unroll 8
    for (int i = 0; i < 16; ++i) { const int kk = 4 * i + kr, n = n0 + c4; f32x4 v = {0.f, 0.f, 0.f, 0.f}; if (n < N) v = *(const f32x4*)(W + (size_t)(k0 + kk) * N + n);
        if (g) v *= g[k0 + kk]; *(LAS f32x4*)(scr + kk * TR_PITCH + c4) = v; }
    LDS_WAIT();
    const int c = lane & 7;
#pragma unroll
    for (int j = 0; j < 8; ++j) { const int n = (lane >> 3) + 8 * j; const LAS float* s = scr + (8 * c) * TR_PITCH + n;
        u32x4 o; o.x = pk2(s[0 * TR_PITCH], s[1 * TR_PITCH]); o.y = pk2(s[2 * TR_PITCH], s[3 * TR_PITCH]); o.z = pk2(s[4 * TR_PITCH], s[5 * TR_PITCH]); o.w = pk2(s[6 * TR_PITCH], s[7 * TR_PITCH]);
        if (n0 + n < N) *(u32x4*)(WT + (size_t)map_row(mode, n0 + n) * K + k0 + 8 * c) = o; }
    LDS_WAIT();
}
DI void convert_set(const Ctx& F, int layer, int which, int wgi, int nwg) {
    LAS float* scr = (LAS float*)(F.lds + F.wave * TR_WAVE_BYTES);
    const int gw = wgi * NWAVES + F.wave, NGW = nwg * NWAVES;
    int base = 0;
#define CONV_MAT(cond, Wp, K_, N_, WTp, mode_, gp) if (cond) { const int ni = ((K_) / 64) * (((N_) + 63) / 64); \
        for (int it = gw - base; it < ni; it += NGW) { if (it >= 0) tr_item(Wp, K_, N_, WTp, mode_, gp, scr, it, F.lane); } base = (base + ni) % NGW; }
    CONV_MAT(which & 1, F.in[I_WIN] + (size_t)layer * D * DIN, D, DIN, wsb(F, WS_WIN), 1, F.in[I_NMIX] + layer * D)
    CONV_MAT(which & 2, F.in[I_WOUT] + (size_t)layer * DMIX * D, DMIX, D, wsb(F, WS_WOUT), 0, (const float*)nullptr)
    CONV_MAT(which & 4, F.in[I_WG] + (size_t)layer * D * DFF, D, DFF, wsb(F, WS_WGU), 2, F.in[I_NFFN] + layer * D)
    CONV_MAT(which & 4, F.in[I_WU] + (size_t)layer * D * DFF, D, DFF, wsb(F, WS_WGU), 3, F.in[I_NFFN] + layer * D)
    CONV_MAT(which & 8, F.in[I_WD] + (size_t)layer * DFF * D, DFF, D, wsb(F, WS_WD), 0, (const float*)nullptr)
    CONV_MAT(which & 16, F.in[I_PWG] + (size_t)layer * D * D, D, D, wsb(F, WS_WPG), 0, F.in[I_NPLE] + layer * D)
    CONV_MAT(which & 32, F.in[I_PWP] + (size_t)layer * DPLE * D, DPLE, D, wsb(F, WS_WPP), 0, (const float*)nullptr)
    if (which & 128) {
        for (int it = gw; it < DEPTH * 2 * 8; it += NGW) { const int mat = it, l = mat >> 4, ri = (mat >> 3) & 1, h = mat & 7;
            tr_item(F.in[ri ? I_LWI : I_LWR] + (size_t)(l * 8 + h) * 4096, 64, 64, wsb(F, WS_LRUW) + (size_t)((l * 2 + ri) * 8 + h) * 4096, 0, nullptr, scr, 0, F.lane); }
    }
#undef CONV_MAT
    if (which & 1) {
        u32x4* z = (u32x4*)(wsb(F, WS_WIN) + (size_t)PC_PAD * D); const int n16 = (PC_Y - PC_PAD) * D * 2 / 16;
        u32x4 zv = (u32x4){0u, 0u, 0u, 0u}; asm volatile("" : "+v"(zv));
        for (int i = wgi * 512 + F.tid; i < n16; i += nwg * 512) z[i] = zv;
    }
    if (which & 64) {
        const float* pp = F.in[I_PP] + (size_t)layer * MP * DPLE; const float* ps = F.in[I_PS] + (size_t)layer * MS * DPLE; bf16_t* pb = wsb(F, WS_PB);
        const int n8 = M * DPLE / 8;
        for (int i = wgi * 512 + F.tid; i < n8; i += nwg * 512) { const size_t e = (size_t)i * 8; const float* src = e < (size_t)MP * DPLE ? pp + e : ps + (e - (size_t)MP * DPLE);
            const f32x4 a = *(const f32x4*)src, b = *(const f32x4*)(src + 4); u32x4 o; o.x = pk2(a.x, a.y); o.y = pk2(a.z, a.w); o.z = pk2(b.x, b.y); o.w = pk2(b.z, b.w); *(u32x4*)(pb + e) = o; }
    }
}
DI void p0_rows(const Ctx& F) {
    const int gw = F.vcu * NWAVES + F.wave, NGW = F.G * NWAVES;
    bf16_t* xb = (bf16_t*)F.out; float* rss = wsf(F, WS_RSSN) + (size_t)XB_PAD * 16;
    for (int m0 = gw; m0 < M; m0 += 2 * NGW) {
        f32x4 v[2][4]; float s[2];
#pragma unroll
        for (int k = 0; k < 2; ++k) { const int m = m0 + k * NGW < M ? m0 + k * NGW : m0; const float* xr = m < MP ? F.in[I_XP] + (size_t)m * D : F.in[I_XS] + (size_t)(m - MP) * D; const f32x4* x4 = (const f32x4*)xr + F.lane;
#pragma unroll
            for (int j = 0; j < 4; ++j) v[k][j] = x4[64 * j]; }
#pragma unroll
        for (int k = 0; k < 2; ++k) { const int m = m0 + k * NGW; if (m >= M) break; float ss = 0.f;
#pragma unroll
            for (int j = 0; j < 4; ++j) ss += (v[k][j].x * v[k][j].x + v[k][j].y * v[k][j].y) + (v[k][j].z * v[k][j].z + v[k][j].w * v[k][j].w);
            s[k] = wave_sum(ss);
            u32x2* o8 = (u32x2*)(xb + (size_t)m * D) + F.lane;
#pragma unroll
            for (int j = 0; j < 4; ++j) { u32x2 w; w.x = pk2(v[k][j].x, v[k][j].y); w.y = pk2(v[k][j].z, v[k][j].w); o8[64 * j] = w; }
            if (F.lane < 16) rss[(size_t)m * 16 + F.lane] = F.lane == 0 ? s[k] : 0.f; }
    }
}

#define PBE(id, lds_, pred_) do { if ((id) == PROBE_ID && PROBE_ID != 0 && (int)blockIdx.x == PROBE_WG && (pred_)) { volatile LAS unsigned* pw_ = (volatile LAS unsigned*)((lds_) + MISC_OFF); pw_[33] = (unsigned)__builtin_amdgcn_s_memrealtime(); } } while (0)
#define PEE(id, lds_, pred_) do { if ((id) == PROBE_ID && PROBE_ID != 0 && (int)blockIdx.x == PROBE_WG && (pred_)) { volatile LAS unsigned* pw_ = (volatile LAS unsigned*)((lds_) + MISC_OFF); pw_[32] += (unsigned)__builtin_amdgcn_s_memrealtime() - pw_[33]; } } while (0)
DI float row_rstd(const float* rss, long row) {
    const f32x4* p = (const f32x4*)(rss + row * 16); const f32x4 a = p[0], b = p[1], c = p[2], d = p[3];
    const float s = ((a.x + a.y) + (a.z + a.w)) + ((b.x + b.y) + (b.z + b.w)) + ((c.x + c.y) + (c.z + c.w)) + ((d.x + d.y) + (d.z + d.w));
    return rsqrtf(fmaxf(s, 0.f) * (1.f / D) + EPS);
}
DI float row_rstd_q(const float* rss, long row, int fq) {
    const f32x4 a = *(const f32x4*)(rss + row * 16 + 4 * fq); float s = (a.x + a.y) + (a.z + a.w);
    s += __shfl_xor(s, 16); s += __shfl_xor(s, 32);
    return rsqrtf(fmaxf(s, 0.f) * (1.f / D) + EPS);
}
struct EpiProj {
    static constexpr bool PERM = true;
    bf16_t* O; const float* rss;
    DI void operator()(const f32x4 (&acc)[2][2][4][2], const pg8::Unit& u, int wr, int wc, int fr_, int fq_, LAS unsigned char*) const {
        int fr = fr_, fq = fq_; asm volatile("" : "+v"(fr), "+v"(fq));
        const int row0 = u.arow + wr * 64 + fr, col0 = u.pn * 256 + wc * 32 + 8 * fq;
#pragma unroll
        for (int ai = 0; ai < 2; ++ai)
#pragma unroll
            for (int m = 0; m < 4; ++m) { const int r = row0 + ai * 128 + m * 16; const float rs = row_rstd_q(rss, r, fq); bf16_t* rowp = O + (size_t)r * DINP + col0;
#pragma unroll
                for (int bj = 0; bj < 2; ++bj) { const f32x4 v0 = acc[ai][bj][m][0] * rs, v1 = acc[ai][bj][m][1] * rs;
                    u32x4 w; w.x = pg8::cvt_pk_bf16(v0[0], v0[1]); w.y = pg8::cvt_pk_bf16(v0[2], v0[3]); w.z = pg8::cvt_pk_bf16(v1[0], v1[1]); w.w = pg8::cvt_pk_bf16(v1[2], v1[3]);
                    *(u32x4*)(rowp + bj * 128) = w; } }
    }
};
struct EpiRes {
    static constexpr bool PERM = false;
    const bf16_t* xs; bf16_t* xb; float* rss; bool dry;
    DI void operator()(const f32x4 (&acc)[2][2][4][2], const pg8::Unit& u, int wr, int wc, int fr_, int fq_, LAS unsigned char*) const {
        int fr = fr_, fq = fq_; asm volatile("" : "+v"(fr), "+v"(fq));
        const int row0 = u.arow + wr * 64 + fr, col0 = u.pn * 256 + wc * 32 + 4 * fq;
#pragma unroll
        for (int ai = 0; ai < 2; ++ai)
#pragma unroll
            for (int m = 0; m < 4; ++m) { const int r = row0 + ai * 128 + m * 16; const size_t off = (size_t)r * D + col0;
                float ss = 0.f;
#pragma unroll
                for (int bj = 0; bj < 2; ++bj)
#pragma unroll
                    for (int n = 0; n < 2; ++n) { const int co = bj * 128 + n * 16; const u32x2 xw = *(const u32x2*)(xs + off + co);
                        f32x4 xn = acc[ai][bj][m][n]; xn[0] += __uint_as_float(xw.x << 16); xn[1] += __uint_as_float(xw.x & 0xffff0000u); xn[2] += __uint_as_float(xw.y << 16); xn[3] += __uint_as_float(xw.y & 0xffff0000u);
                        u32x2 w; w.x = pg8::cvt_pk_bf16(xn[0], xn[1]); w.y = pg8::cvt_pk_bf16(xn[2], xn[3]); if (!dry) *(u32x2*)(xb + off + co) = w;
                        ss += (xn[0] * xn[0] + xn[1] * xn[1]) + (xn[2] * xn[2] + xn[3] * xn[3]); }
                ss += __shfl_xor(ss, 16); ss += __shfl_xor(ss, 32);
                if (fq == 0 && !dry) rss[(size_t)r * 16 + u.pn * 4 + wc] = ss;
                asm volatile("" ::: "memory"); }
    }
};
struct EpiPle {
    static constexpr bool PERM = false;
    const bf16_t* xs; bf16_t* xb; const float* rss_in; float* rss_out; const bf16_t* pp; bool dry;
    DI void operator()(const f32x4 (&acc)[2][2][4][2], const pg8::Unit& u, int wr, int wc, int fr_, int fq_, LAS unsigned char*) const {
        int fr = fr_, fq = fq_; asm volatile("" : "+v"(fr), "+v"(fq));
        const int row0 = u.arow + wr * 64 + fr, col0 = u.pn * 256 + wc * 32 + 4 * fq;
#pragma unroll
        for (int ai = 0; ai < 2; ++ai)
#pragma unroll
            for (int m = 0; m < 4; ++m) { const int r = row0 + ai * 128 + m * 16; const size_t off = (size_t)r * D + col0;
                const float rs = row_rstd_q(rss_in, r, fq); float ss = 0.f;
#pragma unroll
                for (int bj = 0; bj < 2; ++bj)
#pragma unroll
                    for (int n = 0; n < 2; ++n) { const int co = bj * 128 + n * 16; const f32x4 f = acc[ai][bj][m][n];
                        const u32x2 pw = *(const u32x2*)(pp + off + co), xw = *(const u32x2*)(xs + off + co);
                        f32x4 xn;
                        xn[0] = __uint_as_float(xw.x << 16) + sigm(f[0] * rs) * __uint_as_float(pw.x << 16); xn[1] = __uint_as_float(xw.x & 0xffff0000u) + sigm(f[1] * rs) * __uint_as_float(pw.x & 0xffff0000u);
                        xn[2] = __uint_as_float(xw.y << 16) + sigm(f[2] * rs) * __uint_as_float(pw.y << 16); xn[3] = __uint_as_float(xw.y & 0xffff0000u) + sigm(f[3] * rs) * __uint_as_float(pw.y & 0xffff0000u);
                        u32x2 w; w.x = pg8::cvt_pk_bf16(xn[0], xn[1]); w.y = pg8::cvt_pk_bf16(xn[2], xn[3]); if (!dry) *(u32x2*)(xb + off + co) = w;
                        ss += (xn[0] * xn[0] + xn[1] * xn[1]) + (xn[2] * xn[2] + xn[3] * xn[3]); }
                ss += __shfl_xor(ss, 16); ss += __shfl_xor(ss, 32);
                if (fq == 0 && !dry) rss_out[(size_t)r * 16 + u.pn * 4 + wc] = ss;
                asm volatile("" ::: "memory"); }
    }
};
struct EpiPP {
    static constexpr bool PERM = false;
    bf16_t* pp;
    DI void operator()(const f32x4 (&acc)[2][2][4][2], const pg8::Unit& u, int wr, int wc, int fr_, int fq_, LAS unsigned char*) const {
        int fr = fr_, fq = fq_; asm volatile("" : "+v"(fr), "+v"(fq));
        const int row0 = u.arow + wr * 64 + fr, col0 = u.pn * 256 + wc * 32 + 4 * fq;
#pragma unroll
        for (int ai = 0; ai < 2; ++ai)
#pragma unroll
            for (int m = 0; m < 4; ++m) { const size_t off = (size_t)(row0 + ai * 128 + m * 16) * D + col0;
#pragma unroll
                for (int bj = 0; bj < 2; ++bj)
#pragma unroll
                    for (int n = 0; n < 2; ++n) { const f32x4 f = acc[ai][bj][m][n]; u32x2 w; w.x = pg8::cvt_pk_bf16(f[0], f[1]); w.y = pg8::cvt_pk_bf16(f[2], f[3]); *(u32x2*)(pp + off + bj * 128 + n * 16) = w; } }
    }
};
struct EpiFfn {
    static constexpr bool PERM = true;
    bf16_t* H; const float* rss; const float* cw; const float* cb; const float* st_in; float* st_p; float* st_s;
    DI void operator()(f32x4 (&acc)[2][2][4][2], const pg8::Unit& u, int wr, int wc, int fr_, int fq_, LAS unsigned char* lds) const {
        int fr = fr_, fq = fq_; asm volatile("" : "+v"(fr), "+v"(fq));
        const int lane = fr + 16 * fq;
        const bool p0_ = (wr == 0 && wc == 0 && lane == 0);
        PBE(41, lds, p0_); PBE(42, lds, p0_);
        const int gc0 = u.pn * 128 + wc * 32 + 8 * fq;
        LAS float* XG = (LAS float*)(lds + XG_OFF);
        LAS float* RT = (LAS float*)(lds + MISC_OFF + 1024);
        LAS float* WT = (LAS float*)(lds + MISC_OFF + 2048);
        {   const int tid_ = (wr * 4 + wc) * 64 + lane, row_ = tid_ >> 1, hf_ = tid_ & 1;
            const f32x4* p_ = (const f32x4*)(rss + ((long)u.arow + row_) * 16 + 8 * hf_); const f32x4 a_ = p_[0], b_ = p_[1];
            float s_ = ((a_.x + a_.y) + (a_.z + a_.w)) + ((b_.x + b_.y) + (b_.z + b_.w)); s_ += __shfl_xor(s_, 1);
            if (hf_ == 0) RT[row_] = rsqrtf(fmaxf(s_, 0.f) * (1.f / D) + EPS);
            if (tid_ < 128) { const int k_ = tid_ >> 5, c_ = u.pn * 128 + 4 * (tid_ & 31);
                *(LAS f32x4*)(WT + k_ * 128 + 4 * (tid_ & 31)) = *(const f32x4*)(k_ < 3 ? cw + (size_t)k_ * DFF + c_ : cb + c_); } }
        if (fr >= 14) {
#pragma unroll
            for (int ai = 0; ai < 2; ++ai)
#pragma unroll
                for (int n = 0; n < 2; ++n) *(LAS f32x4*)(XG + ((2 * ai + wr) * 2 + (fr - 14)) * 128 + wc * 32 + 8 * fq + 4 * n) = acc[ai][0][3][n];
        }
        LDS_WAIT(); __builtin_amdgcn_s_barrier(); asm volatile("" ::: "memory");
#pragma unroll
        for (int ai = 0; ai < 2; ++ai)
#pragma unroll
            for (int m = 0; m < 4; ++m) { const float rs = RT[ai * 128 + wr * 64 + m * 16 + fr];
#pragma unroll
                for (int bj = 0; bj < 2; ++bj)
#pragma unroll
                    for (int n = 0; n < 2; ++n) acc[ai][bj][m][n] *= rs; }
        PEE(42, lds, p0_); PBE(43, lds, p0_);
#pragma unroll
        for (int n = 0; n < 2; ++n) {
            const int gc = gc0 + 4 * n;
            const int lc = wc * 32 + 8 * fq + 4 * n;
            const f32x4 w0 = *(const LAS f32x4*)(WT + lc), w1 = *(const LAS f32x4*)(WT + 128 + lc), w2 = *(const LAS f32x4*)(WT + 256 + lc), bb = *(const LAS f32x4*)(WT + 384 + lc);
#pragma unroll
            for (int ai = 0; ai < 2; ++ai) {
                f32x4 pr1, pr2;
                const int pb = 2 * ai + wr - 1;
                if (pb >= 0) { pr1 = *(const LAS f32x4*)(XG + (pb * 2 + 1) * 128 + wc * 32 + 8 * fq + 4 * n) * RT[64 * pb + 63];
                               pr2 = *(const LAS f32x4*)(XG + (pb * 2 + (fr & 1)) * 128 + wc * 32 + 8 * fq + 4 * n) * RT[64 * pb + 62 + (fr & 1)]; }
                else { pr1 = (f32x4){0.f, 0.f, 0.f, 0.f}; pr2 = pr1; }
#pragma unroll
                for (int m = 0; m < 4; ++m) {
                    const int j = ai * 128 + wr * 64 + m * 16 + fr; const long r = (long)u.arow + j;
                    int t, seq; if (r < MP) { t = (int)r & 8191; seq = (int)(r >> 13); } else { t = (int)(r - MP) & 63; seq = 2 + (int)((r - MP) >> 6); }
                    const int T = r < MP ? 8192 : 64;
                    const bool valid = j >= 2 && r < M;
                    const f32x4 cur = acc[ai][0][m][n]; f32x4 r1, r2;
#pragma unroll
                    for (int i = 0; i < 4; ++i) { r1[i] = dpp_ror<0x121>(cur[i]); r2[i] = dpp_ror<0x122>(cur[i]); }
                    f32x4 p1 = fr >= 1 ? r1 : pr1, p2 = fr >= 2 ? r2 : pr2;
                    pr1 = r1; pr2 = r2;
                    if (valid && t < 2) {
                        const f32x4 z = (f32x4){0.f, 0.f, 0.f, 0.f}; f32x4 s0 = z, s1 = z;
                        if (seq >= 2) { const float* sp = st_in + (size_t)(seq - 2) * 2 * DFF + gc; s0 = *(const f32x4*)sp; s1 = *(const f32x4*)(sp + DFF); }
                        if (t == 0) { p1 = s1; p2 = s0; } else { p2 = s1; }
                    }
                    const f32x4 gpre = bb + w0 * p2 + w1 * p1 + w2 * cur; const f32x4 up = acc[ai][1][m][n];
                    const float h0 = gelu_t(gpre[0]) * up[0], h1 = gelu_t(gpre[1]) * up[1], h2 = gelu_t(gpre[2]) * up[2], h3 = gelu_t(gpre[3]) * up[3];
                    if (valid) { u32x2 hw; hw.x = pg8::cvt_pk_bf16(h0, h1); hw.y = pg8::cvt_pk_bf16(h2, h3); *(u32x2*)(H + (size_t)r * DFF + gc) = hw;
                        if (t >= T - 2) { float* so = (seq < 2 ? st_p + (size_t)seq * 2 * DFF : st_s + (size_t)(seq - 2) * 2 * DFF) + (size_t)(t - (T - 2)) * DFF + gc; *(f32x4*)so = cur; } }
                    if (m == 3) asm volatile("" ::: "memory");
                }
            }
        }
        PEE(43, lds, p0_); PEE(41, lds, p0_);
    }
};

struct OneUnit { int pm, pn; bool on;
    __device__ bool next(int i, pg8::Unit& u) const { if (i != 0 || !on) return false; u.pm = pm; u.pn = pn; u.arow = 256 * pm; return true; } };
struct EpiPart {
    static constexpr bool PERM = false;
    float* base;
    DI void operator()(const f32x4 (&acc)[2][2][4][2], const pg8::Unit&, int wr, int wc, int fr_, int fq_, LAS unsigned char*) const {
        int fr = fr_, fq = fq_; asm volatile("" : "+v"(fr), "+v"(fq));
#pragma unroll
        for (int ai = 0; ai < 2; ++ai)
#pragma unroll
            for (int m = 0; m < 4; ++m) { float* rowp = base + (size_t)(ai * 128 + wr * 64 + m * 16 + fr) * 256 + wc * 32 + 4 * fq;
#pragma unroll
                for (int bj = 0; bj < 2; ++bj)
#pragma unroll
                    for (int n = 0; n < 2; ++n) *(f32x4*)(rowp + bj * 128 + n * 16) = acc[ai][bj][m][n]; }
    }
};
template <int MODE> DI void reduce_tail(const Ctx& F, const float* part, int S, const bf16_t* xs, bf16_t* xb, const float* rss_in, float* rss_out, const bf16_t* pp) {
    for (int t = blockIdx.x; t < 256; t += F.G) { const int j = t >> 5, rl = 8 * (t & 31) + F.wave, pm = 64 + (j >> 2), pn = j & 3; const int r = 256 * pm + rl, col = 256 * pn + 4 * F.lane;
        f32x4 sum = {0.f, 0.f, 0.f, 0.f};
        for (int sl = 0; sl < S; ++sl) sum += *(const f32x4*)(part + ((size_t)(j * S + sl) * 256 + rl) * 256 + 4 * F.lane);
        const size_t off = (size_t)r * D + col; const u32x2 xw = *(const u32x2*)(xs + off);
        f32x4 xn; xn[0] = __uint_as_float(xw.x << 16); xn[1] = __uint_as_float(xw.x & 0xffff0000u); xn[2] = __uint_as_float(xw.y << 16); xn[3] = __uint_as_float(xw.y & 0xffff0000u);
        if (MODE == 0) xn += sum;
        else { const float rs = row_rstd(rss_in, r); const u32x2 pw = *(const u32x2*)(pp + off);
            xn[0] += sigm(sum[0] * rs) * __uint_as_float(pw.x << 16); xn[1] += sigm(sum[1] * rs) * __uint_as_float(pw.x & 0xffff0000u);
            xn[2] += sigm(sum[2] * rs) * __uint_as_float(pw.y << 16); xn[3] += sigm(sum[3] * rs) * __uint_as_float(pw.y & 0xffff0000u); }
        u32x2 w; w.x = pg8::cvt_pk_bf16(xn[0], xn[1]); w.y = pg8::cvt_pk_bf16(xn[2], xn[3]); *(u32x2*)(xb + off) = w;
        float ss = (xn[0] * xn[0] + xn[1] * xn[1]) + (xn[2] * xn[2] + xn[3] * xn[3]);
        ss += __shfl_xor(ss, 1); ss += __shfl_xor(ss, 2); ss += __shfl_xor(ss, 4); ss += __shfl_xor(ss, 8);
        if ((F.lane & 15) == 0) rss_out[(size_t)r * 16 + pn * 4 + (F.lane >> 4)] = ss;
    }
}

DI bf16x8 frag_row(const LAS unsigned char* img, int pitch, int row0, int k0, int lane) {
    return *(const LAS bf16x8*)(img + (row0 + (lane & 15)) * pitch + (k0 + 8 * (lane >> 4)) * 2);
}
DI bf16x8 frag_tr(const LAS unsigned char* img, int pitch, int k0, int n0, int lane) {
    const int g = lane >> 4, i = lane & 15, q = i >> 2, p = i & 3;
    const LAS unsigned char* a = img + (k0 + 8 * g + q) * pitch + (n0 + 4 * p) * 2;
    const s16x4 lo = __builtin_amdgcn_ds_read_tr16_b64_v4i16((LAS s16x4*)a);
    const s16x4 hi = __builtin_amdgcn_ds_read_tr16_b64_v4i16((LAS s16x4*)(a + 4 * pitch));
    return __builtin_shufflevector(lo, hi, 0, 1, 2, 3, 4, 5, 6, 7);
}
#define MFMA16(a, b, c) __builtin_amdgcn_mfma_f32_16x16x32_bf16((a), (b), (c), 0, 0, 0)
DI void st_bf16(LAS unsigned char* img, int pitch, int row, int col, float v) { *(LAS bf16_t*)(img + row * pitch + col * 2) = (bf16_t)f2bf(v); }
DI float ld_bf16(const LAS unsigned char* img, int pitch, int row, int col) { return bf2f(*(const LAS bf16_t*)(img + row * pitch + col * 2)); }

#define WG_BAR() do { asm volatile("s_waitcnt lgkmcnt(0)" ::: "memory"); __builtin_amdgcn_s_barrier(); asm volatile("" ::: "memory"); } while (0)
template <bool SSD> struct LAT {
    static constexpr int DA = SSD ? 128 : 64, DB = SSD ? 64 : 128;
    static constexpr int PA = (DA + 8) * 2, PV = (DB + 8) * 2, PPI = 144, PS = (DB + 8) * 2, POT = (DB + 4) * 4;
    static constexpr int O_QD = 0, O_KI = O_QD + 64 * PA, O_VV = O_KI + 64 * PA, O_VW = O_VV + 64 * PV, O_P = O_VW + (SSD ? 64 * PV : 0), O_SB = O_P + 64 * PPI, O_OT = O_SB + DA * PS, O_TAB = O_OT + 64 * POT;
    static constexpr int NT_O = DB / 32;
};
static_assert(LAT<true>::O_TAB + 8192 <= RING_BYTES && LAT<false>::O_TAB + 8192 <= RING_BYTES, "mixer LDS");
template <bool SSD> DI void la_mt_nt(int T, int& mt, int& nt) { if (SSD) { mt = T >> 2; nt = T & 3; } else { mt = T >> 3; nt = T & 7; } }

template <bool SSD> DI void la_state_update(LAS unsigned char* lds, f32x4 (&S)[4], int w, int lane) {
    typedef LAT<SSD> L; const LAS float* tab = (const LAS float*)(lds + L::O_TAB); const int q = lane >> 4;
#pragma unroll
    for (int x = 0; x < 4; ++x) { int mt, nt; la_mt_nt<SSD>(4 * w + x, mt, nt);
        if (SSD) { const float d = tab[256]; S[x] *= d; }
#pragma unroll
        for (int ks = 0; ks < 2; ++ks) { const bf16x8 a = frag_tr(lds + L::O_KI, L::PA, 32 * ks, 16 * mt, lane); const bf16x8 b = frag_tr(lds + (SSD ? L::O_VW : L::O_VV), L::PV, 32 * ks, 16 * nt, lane); S[x] = MFMA16(a, b, S[x]); }
        if (!SSD) {
#pragma unroll
            for (int r = 0; r < 4; ++r) S[x][r] *= tab[1536 + 16 * mt + 4 * q + r]; }
    }
}
template <bool SSD> DI void la_write_sb(LAS unsigned char* lds, const f32x4 (&S)[4], int w, int lane) {
    typedef LAT<SSD> L; const int q = lane >> 4, c = lane & 15;
#pragma unroll
    for (int x = 0; x < 4; ++x) { int mt, nt; la_mt_nt<SSD>(4 * w + x, mt, nt);
#pragma unroll
        for (int r = 0; r < 4; ++r) st_bf16(lds + L::O_SB, L::PS, 16 * mt + 4 * q + r, 16 * nt + c, S[x][r]); }
}
template <bool SSD> DI void la_compute_p(LAS unsigned char* lds, int w, int lane) {
    typedef LAT<SSD> L; const LAS float* tab = (const LAS float*)(lds + L::O_TAB); const int q = lane >> 4, c = lane & 15, mt = w >> 1;
#pragma unroll
    for (int x = 0; x < 2; ++x) { const int nt = (w & 1) * 2 + x; f32x4 acc = {0.f, 0.f, 0.f, 0.f};
#pragma unroll
        for (int ks = 0; ks < L::DA / 32; ++ks) { const bf16x8 a = frag_row(lds + L::O_QD, L::PA, 16 * mt, 32 * ks, lane); const bf16x8 b = frag_row(lds + L::O_KI, L::PA, 16 * nt, 32 * ks, lane); acc = MFMA16(a, b, acc); }
        const int j = 16 * nt + c;
#pragma unroll
        for (int r = 0; r < 4; ++r) { const int i = 16 * mt + 4 * q + r; float v = acc[r];
            if (SSD) v *= __expf(tab[64 + i] - tab[64 + j]) * tab[j];
            v = (j > i) ? 0.f : v; st_bf16(lds + L::O_P, L::PPI, i, j, v); }
    }
}
template <bool SSD> DI void la_compute_out(LAS unsigned char* lds, f32x4 (&o1)[LAT<SSD>::NT_O], f32x4 (&o2)[LAT<SSD>::NT_O], int w, int lane) {
    typedef LAT<SSD> L; const int mt = w >> 1;
#pragma unroll
    for (int x = 0; x < L::NT_O; ++x) { const int nt = (w & 1) * L::NT_O + x; f32x4 a1 = {0.f, 0.f, 0.f, 0.f}, a2 = {0.f, 0.f, 0.f, 0.f};
#pragma unroll
        for (int ks = 0; ks < 2; ++ks) { const bf16x8 a = frag_row(lds + L::O_P, L::PPI, 16 * mt, 32 * ks, lane); const bf16x8 b = frag_tr(lds + L::O_VV, L::PV, 32 * ks, 16 * nt, lane); a1 = MFMA16(a, b, a1); }
#pragma unroll
        for (int ks = 0; ks < L::DA / 32; ++ks) { const bf16x8 a = frag_row(lds + L::O_QD, L::PA, 16 * mt, 32 * ks, lane); const bf16x8 b = frag_tr(lds + L::O_SB, L::PS, 32 * ks, 16 * nt, lane); a2 = MFMA16(a, b, a2); }
        o1[x] = a1; o2[x] = a2; }
}
DI void la_store_ds(float* ds, const f32x4 (&S)[4], int w, int lane) {
#pragma unroll
    for (int x = 0; x < 4; ++x)
#pragma unroll
        for (int r = 0; r < 4; ++r) ds[((4 * w + x) * 4 + r) * 64 + lane] = S[x][r];
}
DI void la_load_ds(const float* ds, f32x4 (&S)[4], int w, int lane) {
#pragma unroll
    for (int x = 0; x < 4; ++x)
#pragma unroll
        for (int r = 0; r < 4; ++r) S[x][r] = ds[((4 * w + x) * 4 + r) * 64 + lane];
}

struct GlaCoef { float wlr[16]; float blr; };
struct GlaRaw { unsigned short qk[8][2]; u32x4 v[2]; u32x4 lr; u32x4 g[2]; };
DI void gla_load(const Ctx& F, int h, int chunk, GlaRaw& R) {
    const bf16_t* proj = wsb(F, WS_R); const int row0 = 64 * chunk, d = F.lane, w = F.wave;
#pragma unroll
    for (int i = 0; i < 8; ++i) { const size_t ro = (size_t)(row0 + 8 * w + i) * DINP; R.qk[i][0] = proj[ro + PC_BQ + 64 * h + d]; R.qk[i][1] = proj[ro + PC_BK + 64 * h + d]; }
#pragma unroll
    for (int i = 0; i < 2; ++i) { const int idx = F.tid + 512 * i, t = idx >> 4, c16 = idx & 15;
        R.v[i] = *(const u32x4*)(proj + (size_t)(row0 + t) * DINP + PC_BV + 128 * h + 8 * c16);
        R.g[i] = *(const u32x4*)(proj + (size_t)(row0 + t) * DINP + PC_BG + 128 * h + 8 * c16); }
    R.lr = *(const u32x4*)(proj + (size_t)(row0 + ((F.tid >> 1) & 63)) * DINP + PC_BLR + 8 * (F.tid & 1));
}
DI void gla_stage(const Ctx& F, const GlaCoef& cf, const GlaRaw& R) {
    typedef LAT<false> L; LAS unsigned char* lds = F.lds; LAS float* tab = (LAS float*)(lds + L::O_TAB); const int d = F.lane, w = F.wave;
    if (F.tid < 128) { const int t = F.tid >> 1, half = F.tid & 1; float f[8]; unpack8(R.lr, f);
#pragma unroll
        for (int i = 0; i < 8; ++i) tab[t * 16 + 8 * half + i] = f[i]; }
#pragma unroll
    for (int i = 0; i < 2; ++i) { const int idx = F.tid + 512 * i, t = idx >> 4, c16 = idx & 15; *(LAS u32x4*)(lds + L::O_VV + t * L::PV + c16 * 16) = R.v[i]; }
    WG_BAR();
    float pre[8]; float run = 0.f;
#pragma unroll
    for (int i = 0; i < 8; ++i) { const int t = 8 * w + i; float z = cf.blr;
#pragma unroll
        for (int r = 0; r < 16; ++r) z += tab[t * 16 + r] * cf.wlr[r];
        run += logsig_fast(z) * (1.f / 16.f); pre[i] = run; }
    tab[1024 + w * 64 + d] = run;
    WG_BAR();
    float off = 0.f, last = 0.f;
#pragma unroll
    for (int ww = 0; ww < 8; ++ww) { const float tv = tab[1024 + ww * 64 + d]; last += tv; if (ww < w) off += tv; }
#pragma unroll
    for (int i = 0; i < 8; ++i) { const int t = 8 * w + i; const float cum = off + pre[i];
        st_bf16(lds + L::O_QD, L::PA, t, d, bf2f(R.qk[i][0]) * 0.125f * __expf(cum)); st_bf16(lds + L::O_KI, L::PA, t, d, bf2f(R.qk[i][1]) * __expf(-cum)); }
    if (w == 0) tab[1536 + d] = __expf(last);
    WG_BAR();
}
struct SsdRaw { u32x4 x[11]; u32x4 z; unsigned short dtr; };
DI void ssd_task(const Ctx& F, int h, int& cidx, int& rg, int& ch) {
    cidx = F.tid % 40; rg = F.tid / 40; const int g = h >> 2;
    ch = cidx < 8 ? 64 * h + 8 * cidx : (cidx < 24 ? 512 + 128 * g + 8 * (cidx - 8) : 768 + 128 * g + 8 * (cidx - 24));
}
DI void ssd_load(const Ctx& F, int layer, int h, int chunk, SsdRaw& R) {
    const bf16_t* proj = wsb(F, WS_R); const int row0 = 64 * chunk; const bool first = chunk_first(chunk);
    if (F.tid < 320) { int cidx, rg, ch; ssd_task(F, h, cidx, rg, ch);
#pragma unroll
        for (int i = 0; i < 11; ++i) { const int tt = 8 * rg - 3 + i;
            if (tt >= 0 || !first) R.x[i] = *(const u32x4*)(proj + (size_t)(row0 + tt) * DINP + PC_XBC + ch);
            else if (chunk >= 256) { const float* sp = F.in[I_SSC] + ((size_t)(layer * 8 + (chunk - 256)) * 3 + (tt + 3)) * 1024 + ch; const f32x4 a = *(const f32x4*)sp, b = *(const f32x4*)(sp + 4);
                u32x4 o; o.x = pk2(a.x, a.y); o.y = pk2(a.z, a.w); o.z = pk2(b.x, b.y); o.w = pk2(b.z, b.w); R.x[i] = o; }
            else R.x[i] = (u32x4){0u, 0u, 0u, 0u};
        }
    }
    R.z = *(const u32x4*)(proj + (size_t)(row0 + (F.tid >> 3)) * DINP + PC_CZ + 64 * h + 8 * (F.tid & 7));
    R.dtr = proj[(size_t)(row0 + F.lane) * DINP + PC_DT + h];
}
constexpr int SSD_WCV = 512;
DI void ssd_item_weights(const Ctx& F, int layer, int h) {
    typedef LAT<true> L; LAS float* tab = (LAS float*)(F.lds + L::O_TAB);
    if (F.tid < 200) { const int cidx = F.tid / 5, j = F.tid % 5, g = h >> 2;
        const int ch = cidx < 8 ? 64 * h + 8 * cidx : (cidx < 24 ? 512 + 128 * g + 8 * (cidx - 8) : 768 + 128 * g + 8 * (cidx - 24));
        const float* sp = j < 4 ? F.in[I_SCW] + (size_t)(layer * 4 + j) * 1024 + ch : F.in[I_SCB] + layer * 1024 + ch;
        *(LAS f32x4*)(tab + SSD_WCV + (cidx * 5 + j) * 8) = *(const f32x4*)sp; *(LAS f32x4*)(tab + SSD_WCV + (cidx * 5 + j) * 8 + 4) = *(const f32x4*)(sp + 4); }
    WG_BAR();
}
DI void ssd_stage(const Ctx& F, int layer, int h, const SsdRaw& R) {
    typedef LAT<true> L; LAS unsigned char* lds = F.lds; LAS float* tab = (LAS float*)(lds + L::O_TAB);
    if (F.wave == 7) { const int t = F.lane;
        const float dt = softplus_fast(bf2f(R.dtr) + F.in[I_SDTB][layer * 8 + h]); const float cum = wave_incl_scan(-dt * __expf(F.in[I_SALOG][layer * 8 + h]));
        const float last = __shfl(cum, 63);
        tab[t] = dt; tab[64 + t] = cum; tab[128 + t] = __expf(last - cum) * dt; tab[192 + t] = __expf(cum); if (t == 0) tab[256] = __expf(last); }
    if (F.tid < 320) { int cidx, rg, ch; ssd_task(F, h, cidx, rg, ch);
        float wv[4][8], bv[8];
#pragma unroll
        for (int j = 0; j < 4; ++j) { const f32x4 a = *(const LAS f32x4*)(tab + SSD_WCV + (cidx * 5 + j) * 8), b = *(const LAS f32x4*)(tab + SSD_WCV + (cidx * 5 + j) * 8 + 4); wv[j][0] = a.x; wv[j][1] = a.y; wv[j][2] = a.z; wv[j][3] = a.w; wv[j][4] = b.x; wv[j][5] = b.y; wv[j][6] = b.z; wv[j][7] = b.w; }
        { const f32x4 a = *(const LAS f32x4*)(tab + SSD_WCV + (cidx * 5 + 4) * 8), b = *(const LAS f32x4*)(tab + SSD_WCV + (cidx * 5 + 4) * 8 + 4); bv[0] = a.x; bv[1] = a.y; bv[2] = a.z; bv[3] = a.w; bv[4] = b.x; bv[5] = b.y; bv[6] = b.z; bv[7] = b.w; }
        float x0[8], x1[8], x2[8], x3[8]; unpack8(R.x[0], x0); unpack8(R.x[1], x1); unpack8(R.x[2], x2);
#pragma unroll
        for (int r = 0; r < 8; ++r) { const int t = 8 * rg + r; float o[8]; unpack8(R.x[r + 3], x3);
#pragma unroll
            for (int e = 0; e < 8; ++e) { const float v = bv[e] + wv[0][e] * x0[e] + wv[1][e] * x1[e] + wv[2][e] * x2[e] + wv[3][e] * x3[e]; o[e] = silu_f(v); x0[e] = x1[e]; x1[e] = x2[e]; x2[e] = x3[e]; }
            if (cidx < 8) *(LAS u32x4*)(lds + L::O_VV + t * L::PV + cidx * 16) = pack8(o);
            else if (cidx < 24) *(LAS u32x4*)(lds + L::O_KI + t * L::PA + (cidx - 8) * 16) = pack8(o);
            else *(LAS u32x4*)(lds + L::O_QD + t * L::PA + (cidx - 24) * 16) = pack8(o);
        }
    }
    WG_BAR();
    { const int t = F.tid >> 3, c8 = F.tid & 7; float xv[8]; unpack8(*(const LAS u32x4*)(lds + L::O_VV + t * L::PV + c8 * 16), xv); const float we = tab[128 + t];
#pragma unroll
        for (int e = 0; e < 8; ++e) xv[e] *= we;
        *(LAS u32x4*)(lds + L::O_VW + t * L::PV + c8 * 16) = pack8(xv); }
}

DI void gla_pass_a(const Ctx& F0, int layer, int panel, int h) {
    Ctx F = F0; OPAQUE_CTX(F);
    LAS unsigned char* lds = F.lds; const int w = F.wave, lane = F.lane, d = lane; const bf16_t* proj = wsb(F, WS_R); const int row0 = 256 * panel;
    constexpr int PK = 144, PVV = 272, O_KE = 0, O_V = 256 * PK, O_LR = O_V + 256 * PVV, O_TOT = O_LR + 256 * 16 * 4;
    static_assert(O_TOT + 2048 <= RING_BYTES, "gla pass A LDS");
    LAS float* lr = (LAS float*)(lds + O_LR); LAS float* tot = (LAS float*)(lds + O_TOT);
    float wlr[16];
#pragma unroll
    for (int r = 0; r < 16; ++r) wlr[r] = F.in[I_GWLR][(size_t)(layer * 16 + r) * 256 + 64 * h + d];
    const float blr = F.in[I_GBLR][layer * 256 + 64 * h + d];
    { const int t = F.tid >> 1, half = F.tid & 1; const u32x4 v = *(const u32x4*)(proj + (size_t)(row0 + t) * DINP + PC_BLR + 8 * half); float f[8]; unpack8(v, f);
#pragma unroll
        for (int i = 0; i < 8; ++i) lr[t * 16 + 8 * half + i] = f[i]; }
    unsigned short kr[32];
#pragma unroll
    for (int i = 0; i < 32; ++i) kr[i] = proj[(size_t)(row0 + 32 * w + i) * DINP + PC_BK + 64 * h + d];
#pragma unroll
    for (int i = 0; i < 8; ++i) { const int idx = F.tid + 512 * i, t = idx >> 4, c16 = idx & 15;
        *(LAS u32x4*)(lds + O_V + t * PVV + c16 * 16) = *(const u32x4*)(proj + (size_t)(row0 + t) * DINP + PC_BV + 128 * h + 8 * c16); }
    WG_BAR();
    float pre[32]; float run = 0.f;
#pragma unroll
    for (int i = 0; i < 32; ++i) { const int t = 32 * w + i; float z = blr;
#pragma unroll
        for (int r = 0; r < 16; ++r) z += lr[t * 16 + r] * wlr[r];
        run += logsig_fast(z) * (1.f / 16.f); pre[i] = run; }
    tot[w * 64 + d] = run;
    WG_BAR();
    float off = 0.f, last = 0.f;
#pragma unroll
    for (int ww = 0; ww < 8; ++ww) { const float tv = tot[ww * 64 + d]; last += tv; if (ww < w) off += tv; }
#pragma unroll
    for (int i = 0; i < 32; ++i) st_bf16(lds + O_KE, PK, 32 * w + i, d, bf2f(kr[i]) * __expf(last - (off + pre[i])));
    WG_BAR();
    f32x4 S[4];
#pragma unroll
    for (int x = 0; x < 4; ++x) S[x] = (f32x4){0.f, 0.f, 0.f, 0.f};
    const int mt = w >> 1;
#pragma unroll
    for (int ks = 0; ks < 8; ++ks) { const bf16x8 a = frag_tr(lds + O_KE, PK, 32 * ks, 16 * mt, lane);
#pragma unroll
        for (int x = 0; x < 4; ++x) { const bf16x8 b = frag_tr(lds + O_V, PVV, 32 * ks, 16 * (((4 * w + x) & 7)), lane); S[x] = MFMA16(a, b, S[x]); } }
    la_store_ds(wsf(F, WS_DS) + ((size_t)panel * 12 + h) * 8192, S, w, lane);
    if (w == 0) wsf(F, WS_DEC)[(panel * 4 + h) * 64 + d] = __expf(last);
    WG_BAR();
}
DI void ssd_pass_a(const Ctx& F0, int layer, int panel, int h) {
    Ctx F = F0; OPAQUE_CTX(F);
    LAS unsigned char* lds = F.lds; const int w = F.wave, lane = F.lane, g = h >> 2; const bf16_t* proj = wsb(F, WS_R); const int row0 = 256 * panel; const bool first = (panel & 31) == 0;
    constexpr int PB_ = 272, PX = 144, O_B = 0, O_XW = 256 * PB_, O_WE = O_XW + 256 * PX;
    static_assert(O_WE + 1024 <= RING_BYTES, "ssd pass A LDS");
    LAS float* wend = (LAS float*)(lds + O_WE);
    float last = 0.f;
    if (w == 0) {
        const float bias = F.in[I_SDTB][layer * 8 + h], A = -__expf(F.in[I_SALOG][layer * 8 + h]); float dt[4], cs[4]; float run = 0.f;
#pragma unroll
        for (int i = 0; i < 4; ++i) { dt[i] = softplus_fast(bf2f(proj[(size_t)(row0 + 4 * lane + i) * DINP + PC_DT + h]) + bias); run += dt[i] * A; cs[i] = run; }
        const float inc = wave_incl_scan(run);
        const float excl = inc - run; last = __shfl(inc, 63);
#pragma unroll
        for (int i = 0; i < 4; ++i) wend[4 * lane + i] = __expf(last - (excl + cs[i])) * dt[i];
    }
    WG_BAR();
    for (int pass = 0; pass < 2; ++pass) { const int task = F.tid + 512 * pass;
        if (task < 768) { const int cidx = task % 24, rg = task / 24;
            const int ch = cidx < 8 ? 64 * h + 8 * cidx : 512 + 128 * g + 8 * (cidx - 8);
            const float* cwp = F.in[I_SCW] + (size_t)layer * 4 * 1024 + ch; const float* cbp = F.in[I_SCB] + layer * 1024 + ch;
            float wv[4][8], bv[8];
#pragma unroll
            for (int j = 0; j < 4; ++j) { const f32x4 a = *(const f32x4*)(cwp + j * 1024), b = *(const f32x4*)(cwp + j * 1024 + 4); wv[j][0] = a.x; wv[j][1] = a.y; wv[j][2] = a.z; wv[j][3] = a.w; wv[j][4] = b.x; wv[j][5] = b.y; wv[j][6] = b.z; wv[j][7] = b.w; }
            { const f32x4 a = *(const f32x4*)cbp, b = *(const f32x4*)(cbp + 4); bv[0] = a.x; bv[1] = a.y; bv[2] = a.z; bv[3] = a.w; bv[4] = b.x; bv[5] = b.y; bv[6] = b.z; bv[7] = b.w; }
            u32x4 xr[11];
#pragma unroll
            for (int i = 0; i < 11; ++i) { const int tt = 8 * rg - 3 + i;
                if (tt >= 0 || !first) xr[i] = *(const u32x4*)(proj + (size_t)(row0 + tt) * DINP + PC_XBC + ch); else xr[i] = (u32x4){0u, 0u, 0u, 0u}; }
            float x0[8], x1[8], x2[8], x3[8]; unpack8(xr[0], x0); unpack8(xr[1], x1); unpack8(xr[2], x2);
#pragma unroll
            for (int r = 0; r < 8; ++r) { const int t = 8 * rg + r; float o[8]; unpack8(xr[r + 3], x3);
#pragma unroll
                for (int e = 0; e < 8; ++e) { const float v = bv[e] + wv[0][e] * x0[e] + wv[1][e] * x1[e] + wv[2][e] * x2[e] + wv[3][e] * x3[e]; o[e] = silu_f(v); x0[e] = x1[e]; x1[e] = x2[e]; x2[e] = x3[e]; }
                if (cidx < 8) { const float we = wend[t];
#pragma unroll
                    for (int e = 0; e < 8; ++e) o[e] *= we;
                    *(LAS u32x4*)(lds + O_XW + t * PX + cidx * 16) = pack8(o); }
                else *(LAS u32x4*)(lds + O_B + t * PB_ + (cidx - 8) * 16) = pack8(o);
            }
        }
    }
    WG_BAR();
    f32x4 S[4];
#pragma unroll
    for (int x = 0; x < 4; ++x) S[x] = (f32x4){0.f, 0.f, 0.f, 0.f};
#pragma unroll
    for (int ks = 0; ks < 8; ++ks) { const bf16x8 a = frag_tr(lds + O_B, PB_, 32 * ks, 16 * w, lane);
#pragma unroll
        for (int x = 0; x < 4; ++x) { const bf16x8 b = frag_tr(lds + O_XW, PX, 32 * ks, 16 * x, lane); S[x] = MFMA16(a, b, S[x]); } }
    la_store_ds(wsf(F, WS_DS) + ((size_t)panel * 12 + 4 + h) * 8192, S, w, lane);
    if (w == 0 && lane == 0) wsf(F, WS_DEC)[64 * 4 * 64 + panel * 8 + h] = __expf(last);
    WG_BAR();
}

template <bool SSD> DI void la_pass_c(const Ctx& F0, int layer, int c0, int nc, int h, bool dry) {
    Ctx F = F0; OPAQUE_CTX(F);
    typedef LAT<SSD> L; const int w = F.wave, lane = F.lane, q = lane >> 4, c = lane & 15, mt = w >> 1;
    bf16_t* proj = wsb(F, WS_R);
    f32x4 S[4];
    GlaCoef cf; GlaRaw gr; SsdRaw sr;
    if (!SSD) {
#pragma unroll
        for (int r = 0; r < 16; ++r) cf.wlr[r] = F.in[I_GWLR][(size_t)(layer * 16 + r) * 256 + 64 * h + lane];
        cf.blr = F.in[I_GBLR][layer * 256 + 64 * h + lane]; gla_load(F, h, c0, gr); }
    else { ssd_load(F, layer, h, c0, sr); ssd_item_weights(F, layer, h); }
    const int hh = SSD ? 4 + h : h;
    const Ctx Fp = F;
#pragma unroll 1
    for (int cc = 0; cc < nc; ++cc) { const int chunk = c0 + cc, row0 = 64 * chunk;
        Ctx F = Fp; { unsigned z_ = 0; asm volatile("" : "+s"(z_)); F.lds = Fp.lds + z_; } LAS unsigned char* lds = F.lds; LAS float* tab = (LAS float*)(lds + L::O_TAB);
        PB(SSD ? 5 : 15);
        if (cc == 0 || chunk_first(chunk)) {
            if (chunk < 256) la_load_ds(wsf(F, WS_DS) + ((size_t)(chunk >> 2) * 12 + hh) * 8192, S, w, lane);
            else { const int b = chunk - 256;
#pragma unroll
                for (int x = 0; x < 4; ++x) { int smt, snt; la_mt_nt<SSD>(4 * w + x, smt, snt);
                    if (SSD) { const float* sp = F.in[I_SS] + ((size_t)((layer * 8 + b) * 8 + h) * 64 + 16 * snt + c) * 128 + 16 * smt + 4 * q; S[x] = *(const f32x4*)sp; }
                    else { const float* sp = F.in[I_SG] + ((size_t)((layer * 8 + b) * 4 + h) * 64 + 16 * smt + 4 * q) * 128 + 16 * snt + c;
#pragma unroll
                        for (int r = 0; r < 4; ++r) S[x][r] = sp[r * 128]; } } }
            la_write_sb<SSD>(lds, S, w, lane);
        }
        PE(SSD ? 5 : 15);
        PB(SSD ? 1 : 11);
        u32x4 gate0, gate1;
        if (SSD) { ssd_stage(F, layer, h, sr); gate0 = sr.z; gate1 = gate0; if (cc + 1 < nc) ssd_load(F, layer, h, chunk + 1, sr); }
        else { gla_stage(F, cf, gr); gate0 = gr.g[0]; gate1 = gr.g[1]; if (cc + 1 < nc) gla_load(F, h, chunk + 1, gr); }
        PE(SSD ? 1 : 11); PB(SSD ? 2 : 12);
        la_compute_p<SSD>(lds, w, lane);
        WG_BAR();
        PE(SSD ? 2 : 12); PB(SSD ? 3 : 13);
        f32x4 o1[L::NT_O], o2[L::NT_O];
        la_compute_out<SSD>(lds, o1, o2, w, lane);
        la_state_update<SSD>(lds, S, w, lane);
        if (SSD) {
            const float Dh = F.in[I_SD][layer * 8 + h];
#pragma unroll
            for (int x = 0; x < L::NT_O; ++x) { const int p = 16 * ((w & 1) * L::NT_O + x) + c;
#pragma unroll
                for (int r = 0; r < 4; ++r) { const int i = 16 * mt + 4 * q + r; *(LAS float*)(lds + L::O_OT + i * L::POT + p * 4) = o1[x][r] + tab[192 + i] * o2[x][r] + Dh * ld_bf16(lds + L::O_VV, L::PV, i, p); } }
        } else {
            float ss[4] = {0.f, 0.f, 0.f, 0.f};
#pragma unroll
            for (int x = 0; x < L::NT_O; ++x) { const int e = 16 * ((w & 1) * L::NT_O + x) + c;
#pragma unroll
                for (int r = 0; r < 4; ++r) { const float o = o1[x][r] + o2[x][r]; ss[r] += o * o; *(LAS float*)(lds + L::O_OT + (16 * mt + 4 * q + r) * L::POT + e * 4) = o; } }
#pragma unroll
            for (int r = 0; r < 4; ++r) { float s = ss[r]; s += __shfl_xor(s, 1); s += __shfl_xor(s, 2); s += __shfl_xor(s, 4); s += __shfl_xor(s, 8);
                if (c == 0) tab[1600 + (16 * mt + 4 * q + r) * 2 + (w & 1)] = s; }
        }
        WG_BAR();
        PE(SSD ? 3 : 13); PB(SSD ? 4 : 14);
        if (SSD) { const int i = F.tid >> 3, p0 = 8 * (F.tid & 7); float zv[8], yv[8]; unpack8(gate0, zv); float ss = 0.f;
            const f32x4 ya = *(const LAS f32x4*)(lds + L::O_OT + i * L::POT + p0 * 4), yb = *(const LAS f32x4*)(lds + L::O_OT + i * L::POT + p0 * 4 + 16);
            yv[0] = ya.x; yv[1] = ya.y; yv[2] = ya.z; yv[3] = ya.w; yv[4] = yb.x; yv[5] = yb.y; yv[6] = yb.z; yv[7] = yb.w;
#pragma unroll
            for (int e = 0; e < 8; ++e) { yv[e] *= silu_f(zv[e]); ss += yv[e] * yv[e]; }
            ss += __shfl_xor(ss, 1); ss += __shfl_xor(ss, 2); ss += __shfl_xor(ss, 4);
            if (!dry) { *(u32x4*)(proj + (size_t)(row0 + i) * DINP + PC_CZ + 64 * h + p0) = pack8(yv);
                if ((F.tid & 7) == 0) { f32x2 pv; pv.x = ss; pv.y = 0.f; *(f32x2*)(wsf(F, WS_PSS) + (size_t)(row0 + i) * 16 + 2 * h) = pv; } }
        } else {
#pragma unroll
            for (int k = 0; k < 2; ++k) { const int idx = F.tid + 512 * k, i = idx >> 4, e0 = 8 * (idx & 15); float gv[8], yv[8]; unpack8(k ? gate1 : gate0, gv);
                const float rstd = rsqrtf((tab[1600 + 2 * i] + tab[1600 + 2 * i + 1]) * (1.f / 128.f) + EPS);
                const f32x4 ya = *(const LAS f32x4*)(lds + L::O_OT + i * L::POT + e0 * 4), yb = *(const LAS f32x4*)(lds + L::O_OT + i * L::POT + e0 * 4 + 16);
                const float* gn = F.in[I_GNORM] + layer * 512 + 128 * h + e0; const f32x4 na = *(const f32x4*)gn, nb = *(const f32x4*)(gn + 4);
                yv[0] = ya.x * na.x; yv[1] = ya.y * na.y; yv[2] = ya.z * na.z; yv[3] = ya.w * na.w; yv[4] = yb.x * nb.x; yv[5] = yb.y * nb.y; yv[6] = yb.z * nb.z; yv[7] = yb.w * nb.w;
#pragma unroll
                for (int e = 0; e < 8; ++e) yv[e] *= rstd * silu_f(gv[e]);
                if (!dry) *(u32x4*)(proj + (size_t)(row0 + i) * DINP + PC_BG + 128 * h + e0) = pack8(yv); }
        }
        if (chunk_last(chunk)) { if (!dry) { const int seq = chunk_seq(chunk);
            if (SSD) { float* so = st_out(F, O_PS, O_SS, layer, seq, 8 * 64 * 128) + (size_t)h * 64 * 128;
#pragma unroll
                for (int x = 0; x < 4; ++x) { int smt, snt; la_mt_nt<SSD>(4 * w + x, smt, snt); *(f32x4*)(so + (size_t)(16 * snt + c) * 128 + 16 * smt + 4 * q) = S[x]; } }
            else { float* so = st_out(F, O_PG, O_SG, layer, seq, 4 * 64 * 128) + (size_t)h * 64 * 128;
#pragma unroll
                for (int x = 0; x < 4; ++x) { int smt, snt; la_mt_nt<SSD>(4 * w + x, smt, snt);
#pragma unroll
                    for (int r = 0; r < 4; ++r) so[(size_t)(16 * smt + 4 * q + r) * 128 + 16 * snt + c] = S[x][r]; } } }
        } else if (cc + 1 < nc) la_write_sb<SSD>(lds, S, w, lane);
        WG_BAR();
        PE(SSD ? 4 : 14);
    }
}

struct LruSP { bf16x8 br[2], bi[2]; float b_r, b_i, lam, hin; };
template <bool PASS_C> DI void lru_load_sp(const Ctx& F, int layer, int h, int chunk, int nt, LruSP& p) {
    const int lane = F.lane, q = lane >> 4, c = lane & 15, col = 64 * h + 16 * nt + c;
    const bf16_t* wr_t = wsb(F, WS_LRUW) + (size_t)((layer * 2 + 0) * 8 + h) * 4096; const bf16_t* wi_t = wsb(F, WS_LRUW) + (size_t)((layer * 2 + 1) * 8 + h) * 4096;
#pragma unroll
    for (int ks = 0; ks < 2; ++ks) { const int o = (16 * nt + c) * 64 + 32 * ks + 8 * q; p.br[ks] = *(const bf16x8*)(wr_t + o); p.bi[ks] = *(const bf16x8*)(wi_t + o); }
    p.b_r = F.in[I_LBR][layer * 512 + col]; p.b_i = F.in[I_LBI][layer * 512 + col]; p.lam = F.in[I_LAM][layer * 512 + col]; p.hin = 0.f;
    if (PASS_C) p.hin = chunk >= 256 ? F.in[I_SLH][(size_t)(layer * 8 + (chunk - 256)) * 512 + col] : wsf(F, WS_LRUS)[(size_t)(2 * NCH + chunk) * 512 + col];
}
template <bool PASS_C> DI void lru_chunk(const Ctx& F0, int layer, int chunk, bool dry = false) {
    Ctx F = F0; OPAQUE_CTX(F);
    const int h = F.wave, lane = F.lane, q = lane >> 4, c = lane & 15, row0 = 64 * chunk; const bool first = chunk_first(chunk);
    LAS unsigned char* T = F.lds + h * 18432; LAS unsigned char* OT = T + 9216; constexpr int TP = 144;
    bf16_t* proj = wsb(F, WS_R);
    const int cc = lane & 7, rg = lane >> 3;
    PB(PASS_C ? 21 : 31);
    LruSP cur; lru_load_sp<PASS_C>(F, layer, h, chunk, 0, cur);
    {
        const int ch = 64 * h + 8 * cc; u32x4 xr[11];
#pragma unroll
        for (int i = 0; i < 11; ++i) { const int tt = 8 * rg - 3 + i;
            if (tt >= 0 || !first) xr[i] = *(const u32x4*)(proj + (size_t)(row0 + tt) * DINP + PC_AX + ch);
            else if (chunk >= 256) { const float* sp = F.in[I_SLC] + ((size_t)(layer * 8 + (chunk - 256)) * 3 + (tt + 3)) * 512 + ch; const f32x4 a = *(const f32x4*)sp, b = *(const f32x4*)(sp + 4);
                u32x4 o; o.x = pk2(a.x, a.y); o.y = pk2(a.z, a.w); o.z = pk2(b.x, b.y); o.w = pk2(b.z, b.w); xr[i] = o; }
            else xr[i] = (u32x4){0u, 0u, 0u, 0u};
        }
        const float* cwp = F.in[I_LCW] + (size_t)layer * 4 * 512 + ch; const float* cbp = F.in[I_LCB] + layer * 512 + ch;
        float wv[4][8], bv[8];
#pragma unroll
        for (int j = 0; j < 4; ++j) { const f32x4 a = *(const f32x4*)(cwp + j * 512), b = *(const f32x4*)(cwp + j * 512 + 4); wv[j][0] = a.x; wv[j][1] = a.y; wv[j][2] = a.z; wv[j][3] = a.w; wv[j][4] = b.x; wv[j][5] = b.y; wv[j][6] = b.z; wv[j][7] = b.w; }
        { const f32x4 a = *(const f32x4*)cbp, b = *(const f32x4*)(cbp + 4); bv[0] = a.x; bv[1] = a.y; bv[2] = a.z; bv[3] = a.w; bv[4] = b.x; bv[5] = b.y; bv[6] = b.z; bv[7] = b.w; }
        float x0[8], x1[8], x2[8], x3[8]; unpack8(xr[0], x0); unpack8(xr[1], x1); unpack8(xr[2], x2);
#pragma unroll
        for (int r = 0; r < 8; ++r) { float o[8]; unpack8(xr[r + 3], x3);
#pragma unroll
            for (int e = 0; e < 8; ++e) { o[e] = bv[e] + wv[0][e] * x0[e] + wv[1][e] * x1[e] + wv[2][e] * x2[e] + wv[3][e] * x3[e]; x0[e] = x1[e]; x1[e] = x2[e]; x2[e] = x3[e]; }
            *(LAS u32x4*)(T + (8 * rg + r) * TP + cc * 16) = pack8(o); }
    }
    LDS_WAIT();
    PE(PASS_C ? 21 : 31); PB(PASS_C ? 22 : 32);
#pragma unroll 1
    for (int nt = 0; nt < 4; ++nt) {
        LruSP nx = cur; if (nt < 3) lru_load_sp<PASS_C>(F, layer, h, chunk, nt + 1, nx);
        const int col = 64 * h + 16 * nt + c;
        const float c8 = -8.f * softplus_f(-cur.lam);
        float hc = cur.hin, pc = 1.f;
#pragma unroll
        for (int mt = 0; mt < 4; ++mt) {
            const bf16x8 a0 = frag_row(T, TP, 16 * mt, 0, lane), a1 = frag_row(T, TP, 16 * mt, 32, lane);
            f32x4 ar = {0.f, 0.f, 0.f, 0.f}, ai = {0.f, 0.f, 0.f, 0.f};
            ar = MFMA16(a0, cur.br[0], ar); ar = MFMA16(a1, cur.br[1], ar); ai = MFMA16(a0, cur.bi[0], ai); ai = MFMA16(a1, cur.bi[1], ai);
            float a[4], uu[4];
#pragma unroll
            for (int r = 0; r < 4; ++r) { const int t = 16 * mt + 4 * q + r; const float rg_ = sigm(ar[r] + cur.b_r), ig = sigm(ai[r] + cur.b_i), la = c8 * rg_;
                a[r] = __expf(la); uu[r] = __builtin_amdgcn_sqrtf(fmaxf(1.f - a[r] * a[r], 0.f)) * ig * ld_bf16(T, TP, t, 16 * nt + c); }
            const float P = (a[0] * a[1]) * (a[2] * a[3]); const float Hl = ((uu[0] * a[1] + uu[1]) * a[2] + uu[2]) * a[3] + uu[3];
            float hrun = hc, my_in = 0.f;
#pragma unroll
            for (int qq = 0; qq < 4; ++qq) { const float Pq = __shfl(P, c + 16 * qq), Hq = __shfl(Hl, c + 16 * qq); if (qq == q) my_in = hrun; hrun = Pq * hrun + Hq; pc *= Pq; }
            hc = hrun;
            if (PASS_C) { float hh = my_in;
#pragma unroll
                for (int r = 0; r < 4; ++r) { hh = a[r] * hh + uu[r]; st_bf16(OT, TP, 16 * mt + 4 * q + r, 16 * nt + c, hh); } }
        }
        if (!PASS_C) { if (q == 0) { wsf(F, WS_LRUS)[(size_t)chunk * 512 + col] = pc; wsf(F, WS_LRUS)[(size_t)(NCH + chunk) * 512 + col] = hc; } }
        else if (chunk_last(chunk) && q == 0 && !dry) st_out(F, O_PLH, O_SLH, layer, chunk_seq(chunk), 512)[col] = hc;
        cur = nx;
    }
    PE(PASS_C ? 22 : 32); PB(PASS_C ? 23 : 33);
    if (PASS_C) {
        LDS_WAIT();
        u32x4* gp = (u32x4*)(proj + (size_t)(row0 + rg) * DINP + PC_AG + 64 * h + 8 * cc); u32x4 gnx = *gp;
#pragma unroll 1
        for (int i = 0; i < 8; ++i) { const int t = rg + 8 * i; const u32x4 gc = gnx; u32x4* gq = gp + (size_t)i * (8 * DINP * 2 / 16);
            if (i < 7) gnx = *(gq + (8 * DINP * 2 / 16));
            float hv[8], gv[8]; unpack8(*(const LAS u32x4*)(OT + t * TP + cc * 16), hv); unpack8(gc, gv);
#pragma unroll
            for (int e = 0; e < 8; ++e) hv[e] *= gelu_t(gv[e]);
            if (!dry) *gq = pack8(hv); }
        if (chunk_last(chunk) && !dry) { float* so = st_out(F, O_PLC, O_SLC, layer, chunk_seq(chunk), 3 * 512);
#pragma unroll
            for (int i = 0; i < 3; ++i) so[i * 512 + 64 * h + lane] = bf2f(proj[(size_t)(row0 + 61 + i) * DINP + PC_AX + 64 * h + lane]); }
    }
    LDS_WAIT();
    PE(PASS_C ? 23 : 33);
}

DI void phase_mixer_a(const Ctx& F, int layer) {
    for (int it = blockIdx.x; it < 1034; it += F.G) {
        if (it < 256) gla_pass_a(F, layer, it >> 2, it & 3);
        else if (it < 768) ssd_pass_a(F, layer, (it - 256) >> 3, (it - 256) & 7);
        else if (it < 1024) lru_chunk<false>(F, layer, it - 768);
        else { const int seq = it - 1024, lastrow = seq < 2 ? 8192 * (seq + 1) - 1 : MP + 64 * (seq - 1) - 1;
            float* so = st_out(F, O_PSC, O_SSC, layer, seq, 3 * 1024); const bf16_t* proj = wsb(F, WS_R);
            for (int e = F.tid; e < 3 * 1024; e += 512) so[e] = bf2f(proj[(size_t)(lastrow - 2 + (e >> 10)) * DINP + PC_XBC + (e & 1023)]); }
        __syncthreads();
    }
}
DI void phase_mixer_b(const Ctx& F, int layer, bool dry) {
    float* ds = wsf(F, WS_DS); const float* dec = wsf(F, WS_DEC);
    for (int e = blockIdx.x * 512 + F.tid; e < 2 * 12 * 8192; e += F.G * 512) {
        const int idx = e & 8191, hh = (e >> 13) % 12, b = e / (12 * 8192);
        const int ln = idx & 63, r = (idx >> 6) & 3, Tt = idx >> 8; const int a = 16 * (Tt >> 3) + 4 * (ln >> 4) + r;
        float v[32];
#pragma unroll
        for (int p = 0; p < 32; ++p) v[p] = ds[((size_t)(32 * b + p) * 12 + hh) * 8192 + idx];
        float S = 0.f;
#pragma unroll
        for (int p = 0; p < 32; ++p) { const int panel = 32 * b + p; const float dc = hh < 4 ? dec[(panel * 4 + hh) * 64 + a] : dec[64 * 4 * 64 + panel * 8 + (hh - 4)];
            if (!dry) ds[((size_t)panel * 12 + hh) * 8192 + idx] = S; S = dc * S + v[p]; }
    }
    {
        const int gw = blockIdx.x * NWAVES + F.wave; float* ls = wsf(F, WS_LRUS);
        if (gw < 1024) { const int b = gw >> 9, ch = gw & 511, l = F.lane; const int c0 = 128 * b + 2 * l;
            const float A0 = ls[(size_t)c0 * 512 + ch], H0 = ls[(size_t)(NCH + c0) * 512 + ch], A1 = ls[(size_t)(c0 + 1) * 512 + ch], H1 = ls[(size_t)(NCH + c0 + 1) * 512 + ch];
            float A = A1 * A0, H = A1 * H0 + H1;
#pragma unroll
            for (int o = 1; o < 64; o <<= 1) { const float Ap = __shfl_up(A, o), Hp = __shfl_up(H, o); if (l >= o) { H = A * Hp + H; A = A * Ap; } }
            float E = __shfl_up(H, 1); if (l == 0) E = 0.f;
            ls[(size_t)(2 * NCH + c0) * 512 + ch] = E; ls[(size_t)(2 * NCH + c0 + 1) * 512 + ch] = A0 * E + H0; }
    }
}
#ifndef MIX_MASK
#define MIX_MASK 7
#endif
#ifndef DRY_MIX
#define DRY_MIX 7
#endif
DI void phase_mixer_c(const Ctx& F, int layer, bool dry) {
    const int mm = dry ? DRY_MIX : MIX_MASK;
    for (int it = blockIdx.x; it < 1128; it += F.G) {
        if (it < 512) { if (mm & 1) la_pass_c<true>(F, layer, 4 * (it >> 3), 4, it & 7, dry); }
        else if (it < 768) { if (mm & 2) la_pass_c<false>(F, layer, 4 * ((it - 512) >> 2), 4, (it - 512) & 3, dry); }
        else if (it < 1032) { if (mm & 4) lru_chunk<true>(F, layer, it - 768, dry); }
        else if (it < 1096) { if (mm & 1) la_pass_c<true>(F, layer, 256 + ((it - 1032) >> 3), 1, (it - 1032) & 7, dry); }
        else { if (mm & 2) la_pass_c<false>(F, layer, 256 + ((it - 1096) >> 2), 1, (it - 1096) & 3, dry); }
        __syncthreads();
    }
}
DI void phase_ssd_norm(const Ctx& F, int layer, bool dry) {
    const int gw = F.vcu * NWAVES + F.wave, NGW = F.G * NWAVES; bf16_t* proj = wsb(F, WS_R); const float* pss = wsf(F, WS_PSS);
    float gn[8]; { const float* gp = F.in[I_SNORM] + layer * 512 + 8 * F.lane; const f32x4 a = *(const f32x4*)gp, b = *(const f32x4*)(gp + 4); gn[0] = a.x; gn[1] = a.y; gn[2] = a.z; gn[3] = a.w; gn[4] = b.x; gn[5] = b.y; gn[6] = b.z; gn[7] = b.w; }
    for (int m = gw; m < M; m += NGW) {
        const f32x4* p = (const f32x4*)(pss + (size_t)m * 16); const f32x4 a = p[0], b = p[1], c = p[2], d = p[3];
        const float s = ((a.x + a.y) + (a.z + a.w)) + ((b.x + b.y) + (b.z + b.w)) + ((c.x + c.y) + (c.z + c.w)) + ((d.x + d.y) + (d.z + d.w));
        const float rstd = rsqrtf(s * (1.f / 512.f) + EPS);
        u32x4* yp = (u32x4*)(proj + (size_t)m * DINP + PC_CZ + 8 * F.lane); float v[8]; unpack8(*yp, v);
#pragma unroll
        for (int e = 0; e < 8; ++e) v[e] *= rstd * gn[e];
        *yp = pack8(v);
    }
}
DI void phase_final(const Ctx& F) {
    const int gw = F.vcu * NWAVES + F.wave, NGW = F.G * NWAVES; const float* rss = wsf(F, WS_RSSN) + (size_t)XB_PAD * 16; const float* gf = F.in[I_NFIN]; const bf16_t* xs = wsb(F, WS_XBN);
    for (int m = gw; m < M; m += NGW) { const float rs = row_rstd(rss, m); f32x4* y4 = (f32x4*)(F.out + (size_t)m * D) + F.lane; const u32x2* x2 = (const u32x2*)(xs + (size_t)m * D) + F.lane;
#pragma unroll
        for (int j = 0; j < 4; ++j) { const f32x4 g = *((const f32x4*)gf + F.lane + 64 * j); const u32x2 xw = x2[64 * j];
            f32x4 y; y[0] = __uint_as_float(xw.x << 16) * rs * g[0]; y[1] = __uint_as_float(xw.x & 0xffff0000u) * rs * g[1]; y[2] = __uint_as_float(xw.y << 16) * rs * g[2]; y[3] = __uint_as_float(xw.y & 0xffff0000u) * rs * g[3];
            y4[64 * j] = y; } }
}

constexpr int PH_PER_LAYER = 9, N_PHASES = 1 + DEPTH * PH_PER_LAYER + 1;
__global__ void __launch_bounds__(NWAVES * 64, 2) mk_fwd(Args args) {
    extern __shared__ __attribute__((aligned(16))) unsigned char lds_raw[];
    Ctx F; F.lds = (LAS unsigned char*)lds_raw; F.in = args.in; F.out = args.out; F.ws = args.ws;
    F.wave = __builtin_amdgcn_readfirstlane((int)threadIdx.x >> 6); F.lane = 0; F.tid = 0;
#define T0() (F.wave == 0 && lane_id() == 0)
    F.G = gridDim.x; { const int bx = blockIdx.x; F.vcu = (F.G % 8 == 0) ? (bx % 8) * (F.G / 8) + bx / 8 : bx; }
    volatile LAS unsigned* MISC = (volatile LAS unsigned*)(F.lds + MISC_OFF);
    if (F.wave == 0) MISC[lane_id()] = 0u;
    __syncthreads();
    XcdBarrier bar; bar.bar = (unsigned*)(args.ws + WS_CTL); bar.x = 0; bar.st = nullptr;
    if (args.use_bar) bar = xcd_barrier_post((unsigned*)(args.ws + WS_CTL), MISC + 8, T0());
    const int lo = args.ph_lo, hi = args.ph_hi;
#ifndef PH_MASK
#define PH_MASK 0xFFFFu
#endif
#define IN(k) (lo <= (k) && (k) < hi)
#define ON(b) ((PH_MASK >> (b)) & 1u)
#define SEAM(k) do { if (IN(k) && IN((k) + 1)) xcd_barrier(bar, T0()); } while (0)
#ifndef REP_MASK
#define REP_MASK 0
#endif
#define REPS(b) ((REP_MASK >> (b)) & 1)
#define XBAR() do { if (args.use_bar) xcd_barrier(bar, T0()); } while (0)
#define GP bf16_t* XB = wsb(C, WS_XB) + (size_t)XB_PAD * D; float* RSS = wsf(C, WS_RSS) + (size_t)XB_PAD * 16; bf16_t* XBN = (bf16_t*)C.out; bf16_t* XBNO = layer + 1 < DEPTH ? (bf16_t*)C.out : wsb(C, WS_XBN); float* RSSN = wsf(C, WS_RSSN) + (size_t)XB_PAD * 16; \
    (void)XB; (void)RSS; (void)XBN; (void)XBNO; (void)RSSN
#define PHC Ctx C = F; C.lane = lane_id(); C.tid = C.wave * 64 + C.lane; OPAQUE_CTX(C); { size_t zz_ = 0; asm volatile("" : "+s"(zz_)); C.ws = F.ws + zz_; C.out = (float*)((char*)F.out + zz_); }
    PB(100);
    for (int rr_ = 0; rr_ <= REPS(0); ++rr_) { if (IN(0) && ON(0)) { PHC; convert_set(C, 0, 1 | 2 | 4 | 8 | 16 | 32 | 64 | 128, C.vcu, C.G); p0_rows(C); } if (rr_ < REPS(0)) XBAR(); }
    PE(100); PB(120); SEAM(0); PE(120);
    for (int layer = 0; layer < DEPTH; ++layer) {
        const int pb = 1 + layer * PH_PER_LAYER;
        PB(101);
        for (int rr_ = 0; rr_ <= REPS(1); ++rr_) { if (rr_) XBAR();
        if (IN(pb + 0) && ON(1)) { PHC; GP;
            pg8::Gemm g{XBN, wsb(C, WS_WIN), D, D, D}; pg8::StaticOrder S; S.init(M / 256, DINP / 256, C.G, (int)blockIdx.x, 0);
            EpiProj E{wsb(C, WS_R), RSSN}; pg8::gemm_phase<EpiProj, pg8::StaticOrder>(C.lds, g, S, E, C.wave);
            if (layer >= 1 && rr_ == 0 && C.G == 256 && (int)blockIdx.x >= 98) { __syncthreads(); convert_set(C, layer, 2 | 4 | 8 | 16 | 32 | 64, (int)blockIdx.x - 98, C.G - 98); }
            else if (layer >= 1 && rr_ == 0 && C.G != 256) { __syncthreads(); convert_set(C, layer, 2 | 4 | 8 | 16 | 32 | 64, C.vcu, C.G); }
        } }
        PE(101); PB(120); PB(121); SEAM(pb + 0); PE(121); PE(120); PB(102);
        for (int rr_ = 0; rr_ <= REPS(2); ++rr_) { if (rr_) XBAR(); if (IN(pb + 1) && ON(2)) { PHC; phase_mixer_a(C, layer); } }
        PE(102); PB(120); PB(123); SEAM(pb + 1); PE(123); PE(120); PB(103);
        for (int rr_ = 0; rr_ <= REPS(3); ++rr_) { if (rr_) XBAR();
        if (IN(pb + 2) && ON(3)) { PHC; phase_mixer_b(C, layer, rr_ < REPS(3));
            if (layer + 1 < DEPTH) convert_set(C, layer + 1, 1, C.vcu, C.G); } }
        PE(103); PB(120); PB(122); SEAM(pb + 2); PE(122); PE(120); PB(104);
        for (int rr_ = 0; rr_ <= REPS(4); ++rr_) { if (rr_) XBAR(); if (IN(pb + 3) && ON(4)) { PHC; phase_mixer_c(C, layer, rr_ < REPS(4)); } }
        PE(104); PB(120); PB(124); SEAM(pb + 3); PE(124); PE(120); PB(105);
        for (int rr_ = 0; rr_ <= REPS(5); ++rr_) { if (rr_) XBAR(); if (IN(pb + 4) && ON(5)) { PHC; phase_ssd_norm(C, layer, rr_ < REPS(5)); } }
        PE(105); PB(120); SEAM(pb + 4); PE(120); PB(106);
        for (int rr_ = 0; rr_ <= REPS(6); ++rr_) { if (rr_) XBAR(); const bool dry_ = rr_ < REPS(6);
        if (IN(pb + 5) && ON(6)) { PHC; GP;
            pg8::Gemm g{wsb(C, WS_R) + PC_Y, wsb(C, WS_WOUT), DINP, DMIX, DMIX}; pg8::StaticOrder S; S.init(MP / 256, D / 256, C.G, (int)blockIdx.x, 0);
            EpiRes E{XBN, XB, RSS, dry_};
            pg8::gemm_phase<EpiRes, pg8::StaticOrder>(C.lds, g, S, E, C.wave);
            { constexpr int SK = 6, KS = DMIX / SK; const int c = (int)blockIdx.x, j = c / SK, sl = c % SK;
              pg8::Gemm g2{wsb(C, WS_R) + PC_Y + sl * KS, wsb(C, WS_WOUT) + sl * KS, DINP, DMIX, KS}; OneUnit S2{64 + (j >> 2), j & 3, c < 8 * SK};
              EpiPart E2{C.out + (size_t)M * D / 2 + (size_t)(c < 8 * SK ? c : 0) * 65536}; pg8::gemm_phase<EpiPart, OneUnit>(C.lds, g2, S2, E2, C.wave); }
        } }
        XBAR();
        if (IN(pb + 5) && ON(6)) { PHC; GP; reduce_tail<0>(C, C.out + (size_t)M * D / 2, 6, XBN, XB, RSS, RSS, nullptr); }
        PE(106); PB(120); SEAM(pb + 5); PE(120); PB(107);
        for (int rr_ = 0; rr_ <= REPS(7); ++rr_) { if (rr_) XBAR();
        if (IN(pb + 6) && ON(7)) { PHC; GP;
            pg8::Gemm g{XB, wsb(C, WS_WGU), D, D, D}; pg8::StaticOrder S; S.init(67, 2 * DFF / 256, C.G, (int)blockIdx.x, 1);
            EpiFfn E{wsb(C, WS_R), RSS, C.in[I_FCW] + (size_t)layer * 3 * DFF, C.in[I_FCB] + layer * DFF, C.in[I_SFC] + (size_t)layer * 8 * 2 * DFF,
                     C.out + O_PFC + (size_t)layer * 2 * 2 * DFF, C.out + O_SFC + (size_t)layer * 8 * 2 * DFF};
            pg8::gemm_phase<EpiFfn, pg8::StaticOrder>(C.lds, g, S, E, C.wave);
            if (rr_ == 0) { const int sh = C.G == 256 ? 72 : 0;
                if ((int)blockIdx.x >= sh) { pg8::Gemm g2{wsb(C, WS_PB), wsb(C, WS_WPP), DPLE, DPLE, DPLE}; pg8::StaticOrder S2; S2.init(M / 256, D / 256, C.G - sh, (int)blockIdx.x - sh, 0);
                    EpiPP E2{wsb(C, WS_PPO)}; pg8::gemm_phase<EpiPP, pg8::StaticOrder>(C.lds, g2, S2, E2, C.wave); } }
        } }
        PE(107); PB(120); SEAM(pb + 6); PE(120); PB(108);
        for (int rr_ = 0; rr_ <= REPS(8); ++rr_) { if (rr_) XBAR(); const bool dry_ = rr_ < REPS(8);
        if (IN(pb + 7) && ON(8)) { PHC; GP;
            pg8::Gemm g{wsb(C, WS_R), wsb(C, WS_WD), DFF, DFF, DFF}; pg8::StaticOrder S; S.init(MP / 256, D / 256, C.G, (int)blockIdx.x, 0);
            EpiRes E{XB, XB, RSS, dry_}; pg8::gemm_phase<EpiRes, pg8::StaticOrder>(C.lds, g, S, E, C.wave);
            { constexpr int SK = 12, KS = DFF / SK; const int c = (int)blockIdx.x, j = c / SK, sl = c % SK;
              pg8::Gemm g2{wsb(C, WS_R) + sl * KS, wsb(C, WS_WD) + sl * KS, DFF, DFF, KS}; OneUnit S2{64 + (j >> 2), j & 3, c < 8 * SK};
              EpiPart E2{C.out + (size_t)M * D / 2 + (size_t)(c < 8 * SK ? c : 0) * 65536}; pg8::gemm_phase<EpiPart, OneUnit>(C.lds, g2, S2, E2, C.wave); }
        } }
        XBAR();
        if (IN(pb + 7) && ON(8)) { PHC; GP; reduce_tail<0>(C, C.out + (size_t)M * D / 2, 12, XB, XB, RSS, RSS, nullptr); }
        PE(108); PB(120); SEAM(pb + 7); PE(120); PB(109);
        for (int rr_ = 0; rr_ <= REPS(9); ++rr_) { if (rr_) XBAR(); const bool dry_ = rr_ < REPS(9);
        if (IN(pb + 8) && ON(9)) { PHC; GP;
            pg8::Gemm g{XB, wsb(C, WS_WPG), D, D, D}; pg8::StaticOrder S; S.init(MP / 256, D / 256, C.G, (int)blockIdx.x, 0);
            EpiPle E{XB, XBNO, RSS, RSSN, wsb(C, WS_PPO), dry_}; pg8::gemm_phase<EpiPle, pg8::StaticOrder>(C.lds, g, S, E, C.wave);
            { constexpr int SK = 4, KS = D / SK; const int c = (int)blockIdx.x, j = c / SK, sl = c % SK;
              pg8::Gemm g2{XB + sl * KS, wsb(C, WS_WPG) + sl * KS, D, D, KS}; OneUnit S2{64 + (j >> 2), j & 3, c < 8 * SK};
              EpiPart E2{C.out + (size_t)M * D / 2 + (size_t)(c < 8 * SK ? c : 0) * 65536}; pg8::gemm_phase<EpiPart, OneUnit>(C.lds, g2, S2, E2, C.wave); }
        } }
        XBAR();
        if (IN(pb + 8) && ON(9)) { PHC; GP; reduce_tail<1>(C, C.out + (size_t)M * D / 2, 4, XB, XBNO, RSS, RSSN, wsb(C, WS_PPO)); }
        PE(109); PB(120); SEAM(pb + 8); PE(120); PB(110);
    }
    PB(111);
    if (IN(N_PHASES - 1) && ON(10)) { PHC; phase_final(C); }
    PE(111);
    if (PROBE_ID != 0 && (int)blockIdx.x == PROBE_WG) { __syncthreads(); if (F.wave == 0) { const unsigned tot = MISC[32] * PROBE_MULT; const unsigned t0 = (unsigned)__builtin_amdgcn_s_memrealtime();
        while ((unsigned)__builtin_amdgcn_s_memrealtime() - t0 < tot) __builtin_amdgcn_s_sleep(8); } }
#undef IN
#undef ON
#undef SEAM
}

extern "C" void kernel_launch(void* const* d_in, const int* in_sizes, int n_in, void* d_out, int out_size, void* d_ws, size_t ws_size, hipStream_t stream) {
    static int grid = 0;
    if (grid == 0) {
        if (n_in != N_IN || (size_t)out_size != O_END || ws_size < WS_END) { fprintf(stderr, "kernel_launch: unexpected shapes: n_in %d out %d ws %zu (need %d, %zu, %zu)\n", n_in, out_size, ws_size, (int)N_IN, (size_t)O_END, (size_t)WS_END); grid = -1; return; }
        int dev = 0, cus = 0, per_cu = 0;
        if (hipGetDevice(&dev) != hipSuccess || hipDeviceGetAttribute(&cus, hipDeviceAttributeMultiprocessorCount, dev) != hipSuccess) { grid = -1; return; }
        if (hipFuncSetAttribute((const void*)mk_fwd, hipFuncAttributeMaxDynamicSharedMemorySize, LDS_BYTES) != hipSuccess) { fprintf(stderr, "kernel_launch: hipFuncSetAttribute failed\n"); grid = -1; return; }
        if (hipOccupancyMaxActiveBlocksPerMultiprocessor(&per_cu, (const void*)mk_fwd, NWAVES * 64, LDS_BYTES) != hipSuccess || per_cu < 1) { fprintf(stderr, "kernel_launch: occupancy query says %d\n", per_cu); per_cu = 1; }
        (void)hipGetLastError();
        grid = cus;
    }
    if (grid < 0) return;
    (void)hipMemsetAsync((char*)d_ws + WS_CTL, 0, CTL_ZERO_BYTES, stream);
    Args a{};
    for (int i = 0; i < N_IN; ++i) a.in[i] = (const float*)d_in[i];
    a.out = (float*)d_out; a.ws = (unsigned char*)d_ws;
#if MK_PER_PHASE
    for (int p = 0; p < N_PHASES; ++p) { a.ph_lo = p; a.ph_hi = p + 1; a.use_bar = 0; hipLaunchKernelGGL(mk_fwd, dim3(grid), dim3(NWAVES * 64), LDS_BYTES, stream, a); }
#else
    a.ph_lo = 0; a.ph_hi = N_PHASES; a.use_bar = 1;
    void* kargs[] = {&a};
    hipError_t e = hipLaunchCooperativeKernel((const void*)mk_fwd, dim3(grid), dim3(NWAVES * 64), kargs, LDS_BYTES, stream);
    if (e != hipSuccess) fprintf(stderr, "kernel_launch: cooperative launch failed: %s\n", hipGetErrorString(e));
#endif
}
```

```cpp
#include <hip/hip_runtime.h>
#include <cstdio>
#include <cstdint>

#define DI __device__ __forceinline__
#define LAS __attribute__((address_space(3)))
typedef unsigned short bf16_t;
typedef short bf16x8 __attribute__((ext_vector_type(8)));
typedef short s16x4 __attribute__((ext_vector_type(4)));
typedef float f32x4 __attribute__((ext_vector_type(4)));
typedef float f32x2 __attribute__((ext_vector_type(2)));
typedef unsigned u32x4 __attribute__((ext_vector_type(4)));
typedef unsigned u32x2 __attribute__((ext_vector_type(2)));

#ifndef MK_PER_PHASE
#define MK_PER_PHASE 0
#endif

constexpr int DEPTH = 2, D = 1024, MP = 16384, MS = 512, M = MP + MS;
constexpr int DIN = 4120, DINP = 4352, DFF = 3072, DMIX = 1536, DPLE = 256;
constexpr int NCH = M / 64;
constexpr float EPS = 1e-6f;
constexpr int PC_AX = 0, PC_BQ = 512, PC_BK = 768, PC_BV = 1024, PC_BLR = 1536, PC_XBC = 1552, PC_DT = 2576, PC_PAD = 2584, PC_Y = 2816, PC_AG = 2816, PC_BG = 3328, PC_CZ = 3840;

enum { I_XP = 0, I_XS, I_SLC, I_SLH, I_SG, I_SSC, I_SS, I_SFC, I_PP, I_PS, I_NMIX, I_WIN, I_LCW, I_LCB, I_LWR, I_LBR, I_LWI, I_LBI, I_LAM, I_GWLR, I_GBLR, I_GNORM,
       I_SCW, I_SCB, I_SDTB, I_SALOG, I_SD, I_SNORM, I_WOUT, I_NFFN, I_WG, I_WU, I_FCW, I_FCB, I_WD, I_NPLE, I_PWG, I_PWP, I_NFIN, N_IN };
constexpr size_t O_Y = 0;
constexpr size_t O_PLC = (size_t)M * D;
constexpr size_t O_PLH = O_PLC + 2 * 2 * 3 * 512;
constexpr size_t O_PG = O_PLH + 2 * 2 * 512;
constexpr size_t O_PSC = O_PG + 2 * 2 * 4 * 64 * 128;
constexpr size_t O_PS = O_PSC + 2 * 2 * 3 * 1024;
constexpr size_t O_PFC = O_PS + 2 * 2 * 8 * 64 * 128;
constexpr size_t O_SLC = O_PFC + 2 * 2 * 2 * 3072;
constexpr size_t O_SLH = O_SLC + 2 * 8 * 3 * 512;
constexpr size_t O_SG = O_SLH + 2 * 8 * 512;
constexpr size_t O_SSC = O_SG + 2 * 8 * 4 * 64 * 128;
constexpr size_t O_SS = O_SSC + 2 * 8 * 3 * 1024;
constexpr size_t O_SFC = O_SS + 2 * 8 * 8 * 64 * 128;
constexpr size_t O_END = O_SFC + 2 * 8 * 2 * 3072;

constexpr size_t MiB = 1u << 20;
constexpr size_t al4k(size_t x) { return (x + 4095) & ~(size_t)4095; }
constexpr int XB_PAD = 256;
constexpr int XB_ROWS = XB_PAD + M + 128;
constexpr size_t WS_CTL = 0, CTL_ZERO_BYTES = 64 * 1024;
constexpr size_t WS_WIN = al4k(WS_CTL + CTL_ZERO_BYTES);
constexpr size_t WS_WOUT = al4k(WS_WIN + (size_t)DINP * D * 2);
constexpr size_t WS_WGU = al4k(WS_WOUT + (size_t)D * DMIX * 2);
constexpr size_t WS_WD = al4k(WS_WGU + (size_t)2 * DFF * D * 2);
constexpr size_t WS_WPG = al4k(WS_WD + (size_t)D * DFF * 2);
constexpr size_t WS_WPP = al4k(WS_WPG + (size_t)D * D * 2);
constexpr size_t WS_LRUW = al4k(WS_WPP + (size_t)D * DPLE * 2);
constexpr size_t WS_RSS = al4k(WS_LRUW + (size_t)DEPTH * 2 * 8 * 4096 * 2);
constexpr size_t WS_RSSN = al4k(WS_RSS + (size_t)XB_ROWS * 64);
constexpr size_t WS_PSS = al4k(WS_RSSN + (size_t)XB_ROWS * 64);
constexpr size_t WS_LRUS = al4k(WS_PSS + (size_t)M * 64);
constexpr size_t WS_DEC = al4k(WS_LRUS + (size_t)3 * NCH * 512 * 4);
constexpr size_t WS_PB = al4k(WS_DEC + (size_t)(64 * 4 * 64 + 64 * 8) * 4);
constexpr size_t WS_XB = al4k(WS_PB + (size_t)M * DPLE * 2);
constexpr size_t WS_DS = al4k(WS_XB + (size_t)XB_ROWS * D * 2);
constexpr size_t WS_XBN = WS_DS;
constexpr size_t WS_R = al4k(WS_DS + (size_t)M * D * 2);
constexpr size_t WS_PPO = WS_R + 100 * MiB;
constexpr size_t WS_END = WS_R + (size_t)M * DINP * 2;
static_assert(WS_END <= 256 * MiB, "workspace");
static_assert((size_t)64 * 12 * 8192 * 4 <= (size_t)M * D * 2, "DS fits the XBN slot");
static_assert((size_t)M * DFF * 2 <= 100 * MiB && WS_PPO + (size_t)M * D * 2 <= WS_END, "overlay");

constexpr int MISC_OFF = 147456 + 4096;
DI float bf2f(bf16_t b) { return __uint_as_float(((unsigned)b) << 16); }
DI unsigned f2bf(float f) { unsigned u = __float_as_uint(f); return (u + 0x7fffu + ((u >> 16) & 1u)) >> 16; }
DI unsigned pk2(float lo, float hi) { return f2bf(lo) | (f2bf(hi) << 16); }
DI float sigm(float x) { return __builtin_amdgcn_rcpf(1.f + __expf(-x)); }
DI float silu_f(float x) { return x * __builtin_amdgcn_rcpf(1.f + __expf(-x)); }
DI float gelu_t(float x) { const float u = 1.5957691216f * (x + 0.044715f * x * x * x); return x * __builtin_amdgcn_rcpf(1.f + __expf(-u)); }
DI float softplus_f(float x) { return fmaxf(x, 0.f) + log1pf(__expf(-fabsf(x))); }
DI float logsig_f(float x) { return fminf(x, 0.f) - log1pf(__expf(-fabsf(x))); }
template <int CTRL> DI float dpp_ror(float x) { return __builtin_bit_cast(float, __builtin_amdgcn_update_dpp(0, __builtin_bit_cast(int, x), CTRL, 0xf, 0xf, false)); }
DI float log1p_small(float e) { return e < 0.01f ? e * (1.f - e * (0.5f - e * 0.33333334f)) : __logf(1.f + e); }
DI float softplus_fast(float x) { return fmaxf(x, 0.f) + log1p_small(__expf(-fabsf(x))); }
DI float logsig_fast(float x) { return fminf(x, 0.f) - __logf(1.f + __expf(-fabsf(x))); }
DI float wave_incl_scan(float v) {
#define DPPF(x, ctrl, rm, bc) __builtin_bit_cast(float, __builtin_amdgcn_update_dpp(0, __builtin_bit_cast(int, (x)), (ctrl), (rm), 0xf, (bc)))
    v += DPPF(v, 0x111, 0xf, true); v += DPPF(v, 0x112, 0xf, true); v += DPPF(v, 0x114, 0xf, true); v += DPPF(v, 0x118, 0xf, true);
    v += DPPF(v, 0x142, 0xa, false); v += DPPF(v, 0x143, 0xc, false);
#undef DPPF
    return v;
}
DI void unpack8(const u32x4 v, float (&o)[8]) {
#pragma unroll
    for (int i = 0; i < 4; ++i) { o[2 * i] = __uint_as_float(v[i] << 16); o[2 * i + 1] = __uint_as_float(v[i] & 0xffff0000u); }
}
DI u32x4 pack8(const float (&o)[8]) { u32x4 r; r.x = pk2(o[0], o[1]); r.y = pk2(o[2], o[3]); r.z = pk2(o[4], o[5]); r.w = pk2(o[6], o[7]); return r; }
DI int lane_id() { int l; asm volatile("v_mbcnt_lo_u32_b32 %0, -1, 0\n\tv_mbcnt_hi_u32_b32 %0, -1, %0" : "=v"(l)); return l; }
#define LDS_WAIT() asm volatile("s_waitcnt lgkmcnt(0)" ::: "memory")
#define VM_WAIT() asm volatile("s_waitcnt vmcnt(0)" ::: "memory")

namespace pg8 {
constexpr int BM = 256, BK = 64, HALF = 128, HTB = HALF * BK * 2, STAGE_BYTES = 8 * HTB, NXCD = 8, WGM = 8;
__host__ __device__ __forceinline__ int lds_byte(int r, int c) { const int st = (r >> 4) * 2 + (c >> 5), rr = r & 15, cc = c & 31, ob = rr * 64 + cc * 2; return st * 1024 + (ob ^ (((ob >> 9) & 1) << 5)); }
__host__ __device__ __forceinline__ void stage_rc(int b, int& R, int& C) { const int st = b / 1024, sb = b % 1024, swz = sb ^ (((sb >> 9) & 1) << 5); R = (st >> 1) * 16 + swz / 64; C = (st & 1) * 32 + (swz % 64) / 2; }
__host__ __device__ __forceinline__ int perm32(int rho) { const int n = rho >> 4, i = rho & 15; return 8 * (i >> 2) + 4 * n + (i & 3); }

struct Unit { int pm, pn, arow; };
struct Gemm { const bf16_t* A; const bf16_t* Bt; int lda, ldb, K; };

struct StaticOrder {
    int nM, nN, nwg, G, c, shifted;
    __device__ void init(int nM_, int nN_, int G_, int c_, int shifted_) { nM = nM_; nN = nN_; nwg = nM * nN; G = G_; c = c_; shifted = shifted_; }
    __device__ bool next(int i, Unit& u) const {
        const long L = (long)i * G + c; if (L >= nwg) return false;
        int wgid = (int)L; { const int q = nwg / NXCD, r = nwg % NXCD, xcd = wgid % NXCD, off = wgid / NXCD; wgid = (xcd < r ? xcd * (q + 1) : r * (q + 1) + (xcd - r) * q) + off; }
        const int nig = WGM * nN, gid = wgid / nig, fm = gid * WGM, gsz = (nM - fm) < WGM ? (nM - fm) : WGM;
        u.pm = fm + ((wgid % nig) % gsz); u.pn = (wgid % nig) / gsz; u.arow = shifted ? 254 * u.pm - 2 : 256 * u.pm; return true;
    }
};
typedef __bf16 bf16x2_t __attribute__((ext_vector_type(2)));
DI unsigned cvt_pk_bf16(float lo, float hi) { const f32x2 v = {lo, hi}; const bf16x2_t r = __builtin_convertvector(v, bf16x2_t); return __builtin_bit_cast(unsigned, r); }

template <class Epi, class Sched>
DI void gemm_phase(LAS unsigned char* lds, const Gemm g, const Sched& S, const Epi& E, int wid) {
    const int lane = lane_id(), tid = wid * 64 + lane, wr = wid >> 2, wc = wid & 3, fr = lane & 15, fq = lane >> 4;
    const int K = g.K, nt = K / BK;
    unsigned voffA[2], voffB[2];
#pragma unroll
    for (int i = 0; i < 2; ++i) { int R, C; stage_rc(tid * 16 + i * 8192, R, C); const int Rb = Epi::PERM ? ((R & ~31) + perm32(R & 31)) : R;
        voffA[i] = (unsigned)(R * g.lda + C) * 2u; voffB[i] = (unsigned)(Rb * g.ldb + C) * 2u; }
    const size_t kstep = (size_t)(BK * 2);
    const size_t hstepA = (size_t)HALF * g.lda * 2, hstepB = (size_t)HALF * g.ldb * 2;
    const unsigned ldsw = (unsigned)wid * 1024u;
    const int aoff = lds_byte(wr * 64 + fr, fq * 8), boff = lds_byte(wc * 32 + fr, fq * 8);
#define PG8_SA(b, h) (((b) * 2 + (h)) * HTB)
#define PG8_SB(b, h) ((4 + (b) * 2 + (h)) * HTB)
#define PG8_STAGE(bufoff, gbase, voff) do { _Pragma("unroll") for (int _i = 0; _i < 2; ++_i) \
        __builtin_amdgcn_global_load_lds((const unsigned*)((const char*)(gbase) + (voff)[_i]), (LAS unsigned*)(lds + (bufoff) + ldsw + _i * 8192), 16, 0, 0); } while (0)
#define PG8_LDA(dst, b, h) do { _Pragma("unroll") for (int m = 0; m < 4; ++m) _Pragma("unroll") for (int k = 0; k < 2; ++k) dst[m][k] = *(const LAS bf16x8*)(lds + PG8_SA(b, h) + aoff + m * 2048 + k * 1024); } while (0)
#define PG8_LDB(dst, b, h) do { _Pragma("unroll") for (int n = 0; n < 2; ++n) _Pragma("unroll") for (int k = 0; k < 2; ++k) dst[n][k] = *(const LAS bf16x8*)(lds + PG8_SB(b, h) + boff + n * 2048 + k * 1024); } while (0)
#define PG8_MMA(ai, bj, At, Bt) do { __builtin_amdgcn_s_setprio(1); _Pragma("unroll") for (int m = 0; m < 4; ++m) _Pragma("unroll") for (int n = 0; n < 2; ++n) _Pragma("unroll") for (int k = 0; k < 2; ++k) \
        acc[ai][bj][m][n] = __builtin_amdgcn_mfma_f32_16x16x32_bf16(Bt[n][k], At[m][k], acc[ai][bj][m][n], 0, 0, 0); __builtin_amdgcn_s_setprio(0); } while (0)
#define PG8_WAIT_V(n) asm volatile("s_waitcnt vmcnt(" #n ")" ::: "memory")
#define PG8_WAIT_L(n) asm volatile("s_waitcnt lgkmcnt(" #n ")" ::: "memory")
#define PG8_BAR __builtin_amdgcn_s_barrier()
#define PG8_SCHED __builtin_amdgcn_sched_barrier(0)
    Unit cur, nxt; int ui = 0;
    if (!S.next(0, cur)) return;
    f32x4 acc[2][2][4][2];
#pragma unroll
    for (int a = 0; a < 2; ++a)
#pragma unroll
        for (int b = 0; b < 2; ++b)
#pragma unroll
            for (int m = 0; m < 4; ++m)
#pragma unroll
                for (int n = 0; n < 2; ++n) acc[a][b][m][n] = (f32x4){0.f, 0.f, 0.f, 0.f};
    bf16x8 At[4][2], B0[2][2], B1[2][2];
    const char* cA = (const char*)g.A + (long)cur.arow * g.lda * 2; const char* cB = (const char*)g.Bt + (size_t)cur.pn * 256 * g.ldb * 2;
    PG8_STAGE(PG8_SB(0, 0), cB, voffB); PG8_STAGE(PG8_SB(0, 1), cB + hstepB, voffB); PG8_STAGE(PG8_SA(0, 0), cA, voffA); PG8_STAGE(PG8_SA(0, 1), cA + hstepA, voffA);
    if (wr == 1) PG8_BAR;
    PG8_WAIT_V(2); PG8_BAR;
    PG8_STAGE(PG8_SB(1, 0), cB + kstep, voffB); PG8_STAGE(PG8_SA(1, 0), cA + kstep, voffA); PG8_STAGE(PG8_SB(1, 1), cB + hstepB + kstep, voffB);
    PG8_WAIT_V(6); PG8_BAR;
    for (;;) {
        const bool has_next = S.next(ui + 1, nxt);
        const char* nA = has_next ? (const char*)g.A + (long)nxt.arow * g.lda * 2 : cA; const char* nB = has_next ? (const char*)g.Bt + (size_t)nxt.pn * 256 * g.ldb * 2 : cB;
#pragma unroll 1
        for (int t = 0; t < nt; t += 2) {
            const bool last = (t == nt - 2);
            const char* a1 = cA + (size_t)(t + 1) * kstep;
            const char* a2 = last ? nA : cA + (size_t)(t + 2) * kstep; const char* b2 = last ? nB : cB + (size_t)(t + 2) * kstep;
            const char* a3 = a2 + kstep; const char* b3 = b2 + kstep;
            PG8_LDB(B0, 0, 0); PG8_LDB(B1, 0, 1); PG8_SCHED; PG8_LDA(At, 0, 0); PG8_STAGE(PG8_SA(1, 1), a1 + hstepA, voffA);
            PG8_WAIT_V(8); PG8_WAIT_L(0); PG8_BAR; PG8_MMA(0, 0, At, B0); PG8_MMA(0, 1, At, B1); PG8_BAR; PG8_SCHED;
            PG8_LDA(At, 0, 1); PG8_STAGE(PG8_SB(0, 0), b2, voffB); PG8_STAGE(PG8_SB(0, 1), b2 + hstepB, voffB); PG8_STAGE(PG8_SA(0, 0), a2, voffA);
            PG8_WAIT_V(8); PG8_WAIT_L(0); PG8_BAR; PG8_MMA(1, 0, At, B0); PG8_MMA(1, 1, At, B1); PG8_BAR; PG8_SCHED;
            PG8_LDB(B0, 1, 0); PG8_LDB(B1, 1, 1); PG8_SCHED; PG8_LDA(At, 1, 0); PG8_STAGE(PG8_SA(0, 1), a2 + hstepA, voffA);
            PG8_WAIT_V(8); PG8_WAIT_L(0); PG8_BAR; PG8_MMA(0, 0, At, B0); PG8_MMA(0, 1, At, B1); PG8_BAR; PG8_SCHED;
            PG8_LDA(At, 1, 1); PG8_STAGE(PG8_SB(1, 0), b3, voffB); PG8_STAGE(PG8_SB(1, 1), b3 + hstepB, voffB); PG8_STAGE(PG8_SA(1, 0), a3, voffA);
            PG8_WAIT_V(8); PG8_WAIT_L(0); PG8_BAR; PG8_MMA(1, 0, At, B0); PG8_MMA(1, 1, At, B1); PG8_BAR; PG8_SCHED;
        }
        if (wr == 0) PG8_BAR;
        { const int l2 = lane_id(); E(acc, cur, wr, wc, l2 & 15, l2 >> 4, lds); }
        if (!has_next) break;
#pragma unroll
        for (int a = 0; a < 2; ++a)
#pragma unroll
            for (int b = 0; b < 2; ++b)
#pragma unroll
                for (int m = 0; m < 4; ++m)
#pragma unroll
                    for (int n = 0; n < 2; ++n) acc[a][b][m][n] = (f32x4){0.f, 0.f, 0.f, 0.f};
        cur = nxt; cA = nA; cB = nB; ++ui;
        if (wr == 1) PG8_BAR;
    }
    PG8_WAIT_V(0);
    PG8_BAR;
#undef PG8_SA
#undef PG8_SB
#undef PG8_STAGE
#undef PG8_LDA
#undef PG8_LDB
#undef PG8_MMA
#undef PG8_WAIT_V
#undef PG8_WAIT_L
#undef PG8_BAR
#undef PG8_SCHED
}
}

#define XB_TMO      128
#define XB_XCNT(j)  (256  + 64 * (j))
#define XB_XSUB(j)  (1280 + 64 * (j))
#define XB_XGEN(j)  (2304 + 64 * (j))
#define XB_TOP      3328
#define XB_TOPGEN   3392
#define XCD_BAR_WORDS 3456
#define XB_SPIN_CAP (1u << 18)
DI unsigned xb_ld(unsigned* p)              { return __hip_atomic_load(p, __ATOMIC_RELAXED, __HIP_MEMORY_SCOPE_AGENT); }
DI unsigned xb_add(unsigned* p, unsigned v) { return __hip_atomic_fetch_add(p, v, __ATOMIC_RELAXED, __HIP_MEMORY_SCOPE_AGENT); }
DI unsigned xb_xcc_id() { return (unsigned)__builtin_amdgcn_s_getreg((3 << 11) | 20) & 0xFu; }
#define XB_SPIN(cond, bar) do { unsigned _sp = 0; while (cond) { __builtin_amdgcn_s_sleep(1); \
    if ((++_sp & 255u) == 0u) { if (xb_ld(&(bar)[XB_TMO])) break; if (_sp > XB_SPIN_CAP) { atomicAdd(&(bar)[XB_TMO], 1u); break; } } } } while (0)
struct XcdBarrier { unsigned* bar; unsigned x; volatile LAS unsigned* st; };
DI XcdBarrier xcd_barrier_post(unsigned* bar, volatile LAS unsigned* st, bool t0) {
    XcdBarrier b; b.bar = bar; b.x = xb_xcc_id(); b.st = st;
    if (t0) (void)xb_add(&bar[XB_XCNT(b.x)], 1u);
    return b;
}
DI void xcd_barrier_complete(unsigned* bar, unsigned x, unsigned& nloc, unsigned& nx) {
    const unsigned G = gridDim.x * gridDim.y * gridDim.z;
    unsigned sum, cnt, mine, sp = 0u;
    for (;;) {
        sum = 0u; cnt = 0u; mine = 0u;
#pragma unroll
        for (unsigned j = 0; j < 16; ++j) { const unsigned c = xb_ld(&bar[XB_XCNT(j)]); sum += c; cnt += (c > 0u) ? 1u : 0u; mine = (j == x) ? c : mine; }
        if (sum == G) break;
        __builtin_amdgcn_s_sleep(1);
        if ((++sp & 255u) == 0u) { if (xb_ld(&bar[XB_TMO])) break; if (sp > XB_SPIN_CAP) { atomicAdd(&bar[XB_TMO], 1u); break; } }
    }
    nloc = mine > 0u ? mine : 1u; nx = cnt > 0u ? cnt : 1u;
}
DI void xcd_barrier(const XcdBarrier& b, bool t0) {
    asm volatile("s_waitcnt vmcnt(0)" ::: "memory");
    __syncthreads();
    if (t0) {
        unsigned* bar = b.bar;
        __builtin_amdgcn_s_waitcnt(0);
        unsigned nloc = b.st[0], nx = b.st[1];
        if (nloc == 0u) { xcd_barrier_complete(bar, b.x, nloc, nx); b.st[0] = nloc; b.st[1] = nx; }
        const unsigned old = xb_add(&bar[XB_XSUB(b.x)], 1u);
        const unsigned gen = old / nloc;
        if (old + 1u == (gen + 1u) * nloc) {
            __builtin_amdgcn_fence(__ATOMIC_RELEASE, "agent");
            asm volatile("s_waitcnt vmcnt(0)" ::: "memory");
            const unsigned og = xb_add(&bar[XB_TOP], 1u);
            const unsigned tg = og / nx;
            if (og + 1u == (tg + 1u) * nx) xb_add(&bar[XB_TOPGEN], 1u);
            else XB_SPIN(xb_ld(&bar[XB_TOPGEN]) == tg, bar);
            __builtin_amdgcn_fence(__ATOMIC_ACQUIRE, "agent");
            xb_add(&bar[XB_XGEN(b.x)], 1u);
            asm volatile("s_waitcnt vmcnt(0)" ::: "memory");
        } else {
            XB_SPIN(xb_ld(&bar[XB_XGEN(b.x)]) == gen, bar);
            __builtin_amdgcn_fence(__ATOMIC_ACQUIRE, "agent");
            asm volatile("s_waitcnt vmcnt(0)" ::: "memory");
        }
    }
    __syncthreads();
}

#ifndef PROBE_ID
#define PROBE_ID 0
#endif
#ifndef PROBE_WG
#define PROBE_WG 0
#endif
#ifndef PROBE_MULT
#define PROBE_MULT 8
#endif
constexpr int NWAVES = 8;
constexpr int RING_BYTES = 131072;
constexpr int MIX_LDS = 147456;
constexpr int XG_OFF = MIX_LDS;
static_assert(MISC_OFF == MIX_LDS + 4096, "LDS map");
constexpr int LDS_BYTES = 155648;

struct Args { const float* in[N_IN]; float* out; unsigned char* ws; int ph_lo, ph_hi, use_bar, pad; };

struct Ctx {
    LAS unsigned char* lds;
    const float* const* in; float* out; unsigned char* ws;
    int tid, lane, wave, G, vcu;
};
#define OPAQUE_CTX(C) do { asm volatile("" : "+v"((C).tid), "+v"((C).lane)); asm volatile("" : "+s"((C).wave), "+s"((C).vcu)); } while (0)
#define PB(id) do { if ((id) == PROBE_ID && PROBE_ID != 0 && (int)blockIdx.x == PROBE_WG && F.wave == 0 && lane_id() == 0) { volatile LAS unsigned* pw_ = (volatile LAS unsigned*)(F.lds + MISC_OFF); pw_[33] = (unsigned)__builtin_amdgcn_s_memrealtime(); } } while (0)
#define PE(id) do { if ((id) == PROBE_ID && PROBE_ID != 0 && (int)blockIdx.x == PROBE_WG && F.wave == 0 && lane_id() == 0) { volatile LAS unsigned* pw_ = (volatile LAS unsigned*)(F.lds + MISC_OFF); pw_[32] += (unsigned)__builtin_amdgcn_s_memrealtime() - pw_[33]; } } while (0)
DI bf16_t* wsb(const Ctx& F, size_t off) { return (bf16_t*)(F.ws + off); }
DI float* wsf(const Ctx& F, size_t off) { return (float*)(F.ws + off); }

DI bool chunk_first(int c) { return c == 0 || c == 128 || c >= 256; }
DI bool chunk_last(int c) { return c == 127 || c >= 255; }
DI int chunk_seq(int c) { return c < 128 ? 0 : (c < 256 ? 1 : c - 254); }
DI float* st_out(const Ctx& F, size_t offp, size_t offs, int layer, int seq, int per) {
    return seq < 2 ? F.out + offp + (size_t)(layer * 2 + seq) * per : F.out + offs + (size_t)(layer * 8 + (seq - 2)) * per;
}

DI float wave_sum(float v) {
#pragma unroll
    for (int o = 1; o < 64; o <<= 1) v += __shfl_xor(v, o);
    return v;
}
DI int win_dst(int n) {
    if (n < 512) return PC_AX + n;
    if (n < 1024) return PC_AG + (n - 512);
    if (n < 1280) return PC_BQ + (n - 1024);
    if (n < 1536) return PC_BK + (n - 1280);
    if (n < 2048) return PC_BV + (n - 1536);
    if (n < 2560) return PC_BG + (n - 2048);
    if (n < 2576) return PC_BLR + (n - 2560);
    if (n < 3088) return PC_CZ + (n - 2576);
    if (n < 4112) return PC_XBC + (n - 3088);
    return PC_DT + (n - 4112);
}
DI int map_row(int mode, int n) {
    if (mode == 1) return win_dst(n);
    if (mode == 2) return 256 * (n >> 7) + (n & 127);
    if (mode == 3) return 256 * (n >> 7) + 128 + (n & 127);
    return n;
}
constexpr int TR_PITCH = 68, TR_WAVE_BYTES = 64 * TR_PITCH * 4;
DI void tr_item(const float* W, int K, int N, bf16_t* WT, int mode, const float* g, LAS float* scr, int item, int lane) {
    const int nblk = (N + 63) / 64, kb = item / nblk, nb = item % nblk, k0 = 64 * kb, n0 = 64 * nb;
    const int c4 = (lane & 15) * 4, kr = lane >> 4;
#pragma unroll 8
    for (int i = 0; i < 16; ++i) { const int kk = 4 * i + kr, n = n0 + c4; f32x4 v = {0.f, 0.f, 0.f, 0.f}; if (n < N) v = *(const f32x4*)(W + (size_t)(k0 + kk) * N + n);
        if (g) v *= g[k0 + kk]; *(LAS f32x4*)(scr + kk * TR_PITCH + c4) = v; }
    LDS_WAIT();
    const int c = lane & 7;
#pragma unroll
    for (int j = 0; j < 8; ++j) { const int n = (lane >> 3) + 8 * j; const LAS float* s = scr + (8 * c) * TR_PITCH + n;
        u32x4 o; o.x = pk2(s[0 * TR_PITCH], s[1 * TR_PITCH]); o.y = pk2(s[2 * TR_PITCH], s[3 * TR_PITCH]); o.z = pk2(s[4 * TR_PITCH], s[5 * TR_PITCH]); o.w = pk2(s[6 * TR_PITCH], s[7 * TR_PITCH]);
        if (n0 + n < N) *(u32x4*)(WT + (size_t)map_row(mode, n0 + n) * K + k0 + 8 * c) = o; }
    LDS_WAIT();
}
DI void convert_set(const Ctx& F, int layer, int which, int wgi, int nwg) {
    LAS float* scr = (LAS float*)(F.lds + F.wave * TR_WAVE_BYTES);
    const int gw = wgi * NWAVES + F.wave, NGW = nwg * NWAVES;
    int base = 0;
#define CONV_MAT(cond, Wp, K_, N_, WTp, mode_, gp) if (cond) { const int ni = ((K_) / 64) * (((N_) + 63) / 64); \
        for (int it = gw - base; it < ni; it += NGW) { if (it >= 0) tr_item(Wp, K_, N_, WTp, mode_, gp, scr, it, F.lane); } base = (base + ni) % NGW; }
    CONV_MAT(which & 1, F.in[I_WIN] + (size_t)layer * D * DIN, D, DIN, wsb(F, WS_WIN), 1, F.in[I_NMIX] + layer * D)
    CONV_MAT(which & 2, F.in[I_WOUT] + (size_t)layer * DMIX * D, DMIX, D, wsb(F, WS_WOUT), 0, (const float*)nullptr)
    CONV_MAT(which & 4, F.in[I_WG] + (size_t)layer * D * DFF, D, DFF, wsb(F, WS_WGU), 2, F.in[I_NFFN] + layer * D)
    CONV_MAT(which & 4, F.in[I_WU] + (size_t)layer * D * DFF, D, DFF, wsb(F, WS_WGU), 3, F.in[I_NFFN] + layer * D)
    CONV_MAT(which & 8, F.in[I_WD] + (size_t)layer * DFF * D, DFF, D, wsb(F, WS_WD), 0, (const float*)nullptr)
    CONV_MAT(which & 16, F.in[I_PWG] + (size_t)layer * D * D, D, D, wsb(F, WS_WPG), 0, F.in[I_NPLE] + layer * D)
    CONV_MAT(which & 32, F.in[I_PWP] + (size_t)layer * DPLE * D, DPLE, D, wsb(F, WS_WPP), 0, (const float*)nullptr)
    if (which & 128) {
        for (int it = gw; it < DEPTH * 2 * 8; it += NGW) { const int mat = it, l = mat >> 4, ri = (mat >> 3) & 1, h = mat & 7;
            tr_item(F.in[ri ? I_LWI : I_LWR] + (size_t)(l * 8 + h) * 4096, 64, 64, wsb(F, WS_LRUW) + (size_t)((l * 2 + ri) * 8 + h) * 4096, 0, nullptr, scr, 0, F.lane); }
    }
#undef CONV_MAT
    if (which & 1) {
        u32x4* z = (u32x4*)(wsb(F, WS_WIN) + (size_t)PC_PAD * D); const int n16 = (PC_Y - PC_PAD) * D * 2 / 16;
        u32x4 zv = (u32x4){0u, 0u, 0u, 0u}; asm volatile("" : "+v"(zv));
        for (int i = wgi * 512 + F.tid; i < n16; i += nwg * 512) z[i] = zv;
    }
    if (which & 64) {
        const float* pp = F.in[I_PP] + (size_t)layer * MP * DPLE; const float* ps = F.in[I_PS] + (size_t)layer * MS * DPLE; bf16_t* pb = wsb(F, WS_PB);
        const int n8 = M * DPLE / 8;
        for (int i = wgi * 512 + F.tid; i < n8; i += nwg * 512) { const size_t e = (size_t)i * 8; const float* src = e < (size_t)MP * DPLE ? pp + e : ps + (e - (size_t)MP * DPLE);
            const f32x4 a = *(const f32x4*)src, b = *(const f32x4*)(src + 4); u32x4 o; o.x = pk2(a.x, a.y); o.y = pk2(a.z, a.w); o.z = pk2(b.x, b.y); o.w = pk2(b.z, b.w); *(u32x4*)(pb + e) = o; }
    }
}
DI void p0_rows(const Ctx& F) {
    const int gw = F.vcu * NWAVES + F.wave, NGW = F.G * NWAVES;
    bf16_t* xb = (bf16_t*)F.out; float* rss = wsf(F, WS_RSSN) + (size_t)XB_PAD * 16;
    for (int m0 = gw; m0 < M; m0 += 2 * NGW) {
        f32x4 v[2][4]; float s[2];
#pragma unroll
        for (int k = 0; k < 2; ++k) { const int m = m0 + k * NGW < M ? m0 + k * NGW : m0; const float* xr = m < MP ? F.in[I_XP] + (size_t)m * D : F.in[I_XS] + (size_t)(m - MP) * D; const f32x4* x4 = (const f32x4*)xr + F.lane;
#pragma unroll
            for (int j = 0; j < 4; ++j) v[k][j] = x4[64 * j]; }
#pragma unroll
        for (int k = 0; k < 2; ++k) { const int m = m0 + k * NGW; if (m >= M) break; float ss = 0.f;
#pragma unroll
            for (int j = 0; j < 4; ++j) ss += (v[k][j].x * v[k][j].x + v[k][j].y * v[k][j].y) + (v[k][j].z * v[k][j].z + v[k][j].w * v[k][j].w);
            s[k] = wave_sum(ss);
            u32x2* o8 = (u32x2*)(xb + (size_t)m * D) + F.lane;
#pragma unroll
            for (int j = 0; j < 4; ++j) { u32x2 w; w.x = pk2(v[k][j].x, v[k][j].y); w.y = pk2(v[k][j].z, v[k][j].w); o8[64 * j] = w; }
            if (F.lane < 16) rss[(size_t)m * 16 + F.lane] = F.lane == 0 ? s[k] : 0.f; }
    }
}

#define PBE(id, lds_, pred_) do { if ((id) == PROBE_ID && PROBE_ID != 0 && (int)blockIdx.x == PROBE_WG && (pred_)) { volatile LAS unsigned* pw_ = (volatile LAS unsigned*)((lds_) + MISC_OFF); pw_[33] = (unsigned)__builtin_amdgcn_s_memrealtime(); } } while (0)
#define PEE(id, lds_, pred_) do { if ((id) == PROBE_ID && PROBE_ID != 0 && (int)blockIdx.x == PROBE_WG && (pred_)) { volatile LAS unsigned* pw_ = (volatile LAS unsigned*)((lds_) + MISC_OFF); pw_[32] += (unsigned)__builtin_amdgcn_s_memrealtime() - pw_[33]; } } while (0)
DI float row_rstd(const float* rss, long row) {
    const f32x4* p = (const f32x4*)(rss + row * 16); const f32x4 a = p[0], b = p[1], c = p[2], d = p[3];
    const float s = ((a.x + a.y) + (a.z + a.w)) + ((b.x + b.y) + (b.z + b.w)) + ((c.x + c.y) + (c.z + c.w)) + ((d.x + d.y) + (d.z + d.w));
    return rsqrtf(fmaxf(s, 0.f) * (1.f / D) + EPS);
}
DI float row_rstd_q(const float* rss, long row, int fq) {
    const f32x4 a = *(const f32x4*)(rss + row * 16 + 4 * fq); float s = (a.x + a.y) + (a.z + a.w);
    s += __shfl_xor(s, 16); s += __shfl_xor(s, 32);
    return rsqrtf(fmaxf(s, 0.f) * (1.f / D) + EPS);
}
struct EpiProj {
    static constexpr bool PERM = true;
    bf16_t* O; const float* rss;
    DI void operator()(const f32x4 (&acc)[2][2][4][2], const pg8::Unit& u, int wr, int wc, int fr_, int fq_, LAS unsigned char*) const {
        int fr = fr_, fq = fq_; asm volatile("" : "+v"(fr), "+v"(fq));
        const int row0 = u.arow + wr * 64 + fr, col0 = u.pn * 256 + wc * 32 + 8 * fq;
#pragma unroll
        for (int ai = 0; ai < 2; ++ai)
#pragma unroll
            for (int m = 0; m < 4; ++m) { const int r = row0 + ai * 128 + m * 16; const float rs = row_rstd_q(rss, r, fq); bf16_t* rowp = O + (size_t)r * DINP + col0;
#pragma unroll
                for (int bj = 0; bj < 2; ++bj) { const f32x4 v0 = acc[ai][bj][m][0] * rs, v1 = acc[ai][bj][m][1] * rs;
                    u32x4 w; w.x = pg8::cvt_pk_bf16(v0[0], v0[1]); w.y = pg8::cvt_pk_bf16(v0[2], v0[3]); w.z = pg8::cvt_pk_bf16(v1[0], v1[1]); w.w = pg8::cvt_pk_bf16(v1[2], v1[3]);
                    *(u32x4*)(rowp + bj * 128) = w; } }
    }
};
DI void add_bf16x8(f32x4& a, f32x4& b, const u32x4 w) {
    a[0] += __uint_as_float(w.x << 16); a[1] += __uint_as_float(w.x & 0xffff0000u); a[2] += __uint_as_float(w.y << 16); a[3] += __uint_as_float(w.y & 0xffff0000u);
    b[0] += __uint_as_float(w.z << 16); b[1] += __uint_as_float(w.z & 0xffff0000u); b[2] += __uint_as_float(w.w << 16); b[3] += __uint_as_float(w.w & 0xffff0000u);
}
struct EpiRes {
    static constexpr bool PERM = true;
    const bf16_t* xs; bf16_t* xb; float* rss; bool dry;
    DI void operator()(const f32x4 (&acc)[2][2][4][2], const pg8::Unit& u, int wr, int wc, int fr_, int fq_, LAS unsigned char*) const {
        int fr = fr_, fq = fq_; asm volatile("" : "+v"(fr), "+v"(fq));
        const int row0 = u.arow + wr * 64 + fr, col0 = u.pn * 256 + wc * 32 + 8 * fq;
        u32x4 nx0 = *(const u32x4*)(xs + (size_t)row0 * D + col0), nx1 = *(const u32x4*)(xs + (size_t)row0 * D + col0 + 128);
#pragma unroll
        for (int it = 0; it < 8; ++it) { const int ai = it >> 2, m = it & 3; const int r = row0 + ai * 128 + m * 16; const size_t off = (size_t)r * D + col0;
            const u32x4 c0 = nx0, c1 = nx1;
            if (it < 7) { const size_t offn = (size_t)(row0 + ((it + 1) >> 2) * 128 + ((it + 1) & 3) * 16) * D + col0; nx0 = *(const u32x4*)(xs + offn); nx1 = *(const u32x4*)(xs + offn + 128); }
            float ss = 0.f;
#pragma unroll
            for (int bj = 0; bj < 2; ++bj) { f32x4 a = acc[ai][bj][m][0], b = acc[ai][bj][m][1]; add_bf16x8(a, b, bj ? c1 : c0);
                u32x4 w; w.x = pg8::cvt_pk_bf16(a[0], a[1]); w.y = pg8::cvt_pk_bf16(a[2], a[3]); w.z = pg8::cvt_pk_bf16(b[0], b[1]); w.w = pg8::cvt_pk_bf16(b[2], b[3]);
                if (!dry) *(u32x4*)(xb + off + bj * 128) = w;
                ss += ((a[0] * a[0] + a[1] * a[1]) + (a[2] * a[2] + a[3] * a[3])) + ((b[0] * b[0] + b[1] * b[1]) + (b[2] * b[2] + b[3] * b[3])); }
            ss += __shfl_xor(ss, 16); ss += __shfl_xor(ss, 32);
            if (fq == 0 && !dry) rss[(size_t)r * 16 + u.pn * 4 + wc] = ss;
            asm volatile("" ::: "memory"); }
    }
};
struct EpiPle {
    static constexpr bool PERM = true;
    const bf16_t* xs; bf16_t* xb; const float* rss_in; float* rss_out; const bf16_t* pp; bool dry;
    DI void operator()(const f32x4 (&acc)[2][2][4][2], const pg8::Unit& u, int wr, int wc, int fr_, int fq_, LAS unsigned char*) const {
        int fr = fr_, fq = fq_; asm volatile("" : "+v"(fr), "+v"(fq));
        const int row0 = u.arow + wr * 64 + fr, col0 = u.pn * 256 + wc * 32 + 8 * fq;
        u32x4 nx0 = *(const u32x4*)(xs + (size_t)row0 * D + col0), nx1 = *(const u32x4*)(xs + (size_t)row0 * D + col0 + 128);
        u32x4 np0 = *(const u32x4*)(pp + (size_t)row0 * D + col0), np1 = *(const u32x4*)(pp + (size_t)row0 * D + col0 + 128);
        f32x4 nr = *(const f32x4*)(rss_in + (long)row0 * 16 + 4 * fq);
#pragma unroll
        for (int it = 0; it < 8; ++it) { const int ai = it >> 2, m = it & 3; const int r = row0 + ai * 128 + m * 16; const size_t off = (size_t)r * D + col0;
            const u32x4 c0 = nx0, c1 = nx1, q0 = np0, q1 = np1; const f32x4 cr = nr;
            if (it < 7) { const int rn = row0 + ((it + 1) >> 2) * 128 + ((it + 1) & 3) * 16; const size_t offn = (size_t)rn * D + col0;
                nx0 = *(const u32x4*)(xs + offn); nx1 = *(const u32x4*)(xs + offn + 128); np0 = *(const u32x4*)(pp + offn); np1 = *(const u32x4*)(pp + offn + 128); nr = *(const f32x4*)(rss_in + (long)rn * 16 + 4 * fq); }
            float sr = (cr.x + cr.y) + (cr.z + cr.w); sr += __shfl_xor(sr, 16); sr += __shfl_xor(sr, 32);
            const float rs = rsqrtf(fmaxf(sr, 0.f) * (1.f / D) + EPS); float ss = 0.f;
#pragma unroll
            for (int bj = 0; bj < 2; ++bj) { const f32x4 fa = acc[ai][bj][m][0], fb = acc[ai][bj][m][1]; const u32x4 xw = bj ? c1 : c0, pw = bj ? q1 : q0;
                f32x4 a, b;
                a[0] = __uint_as_float(xw.x << 16) + sigm(fa[0] * rs) * __uint_as_float(pw.x << 16); a[1] = __uint_as_float(xw.x & 0xffff0000u) + sigm(fa[1] * rs) * __uint_as_float(pw.x & 0xffff0000u);
                a[2] = __uint_as_float(xw.y << 16) + sigm(fa[2] * rs) * __uint_as_float(pw.y << 16); a[3] = __uint_as_float(xw.y & 0xffff0000u) + sigm(fa[3] * rs) * __uint_as_float(pw.y & 0xffff0000u);
                b[0] = __uint_as_float(xw.z << 16) + sigm(fb[0] * rs) * __uint_as_float(pw.z << 16); b[1] = __uint_as_float(xw.z & 0xffff0000u) + sigm(fb[1] * rs) * __uint_as_float(pw.z & 0xffff0000u);
                b[2] = __uint_as_float(xw.w << 16) + sigm(fb[2] * rs) * __uint_as_float(pw.w << 16); b[3] = __uint_as_float(xw.w & 0xffff0000u) + sigm(fb[3] * rs) * __uint_as_float(pw.w & 0xffff0000u);
                u32x4 w; w.x = pg8::cvt_pk_bf16(a[0], a[1]); w.y = pg8::cvt_pk_bf16(a[2], a[3]); w.z = pg8::cvt_pk_bf16(b[0], b[1]); w.w = pg8::cvt_pk_bf16(b[2], b[3]);
                if (!dry) *(u32x4*)(xb + off + bj * 128) = w;
                ss += ((a[0] * a[0] + a[1] * a[1]) + (a[2] * a[2] + a[3] * a[3])) + ((b[0] * b[0] + b[1] * b[1]) + (b[2] * b[2] + b[3] * b[3])); }
            ss += __shfl_xor(ss, 16); ss += __shfl_xor(ss, 32);
            if (fq == 0 && !dry) rss_out[(size_t)r * 16 + u.pn * 4 + wc] = ss;
            asm volatile("" ::: "memory"); }
    }
};
struct EpiPP {
    static constexpr bool PERM = false;
    bf16_t* pp;
    DI void operator()(const f32x4 (&acc)[2][2][4][2], const pg8::Unit& u, int wr, int wc, int fr_, int fq_, LAS unsigned char*) const {
        int fr = fr_, fq = fq_; asm volatile("" : "+v"(fr), "+v"(fq));
        const int row0 = u.arow + wr * 64 + fr, col0 = u.pn * 256 + wc * 32 + 4 * fq;
#pragma unroll
        for (int ai = 0; ai < 2; ++ai)
#pragma unroll
            for (int m = 0; m < 4; ++m) { const size_t off = (size_t)(row0 + ai * 128 + m * 16) * D + col0;
#pragma unroll
                for (int bj = 0; bj < 2; ++bj)
#pragma unroll
                    for (int n = 0; n < 2; ++n) { const f32x4 f = acc[ai][bj][m][n]; u32x2 w; w.x = pg8::cvt_pk_bf16(f[0], f[1]); w.y = pg8::cvt_pk_bf16(f[2], f[3]); *(u32x2*)(pp + off + bj * 128 + n * 16) = w; } }
    }
};
struct EpiFfn {
    static constexpr bool PERM = true;
    bf16_t* H; const float* rss; const float* cw; const float* cb; const float* st_in; float* st_p; float* st_s;
    DI void operator()(f32x4 (&acc)[2][2][4][2], const pg8::Unit& u, int wr, int wc, int fr_, int fq_, LAS unsigned char* lds) const {
        int fr = fr_, fq = fq_; asm volatile("" : "+v"(fr), "+v"(fq));
        const int lane = fr + 16 * fq;
        const bool p0_ = (wr == 0 && wc == 0 && lane == 0);
        PBE(41, lds, p0_); PBE(42, lds, p0_);
        const int gc0 = u.pn * 128 + wc * 32 + 8 * fq;
        LAS float* XG = (LAS float*)(lds + XG_OFF);
        LAS float* RT = (LAS float*)(lds + MISC_OFF + 1024);
        LAS float* WT = (LAS float*)(lds + MISC_OFF + 2048);
        {   const int tid_ = (wr * 4 + wc) * 64 + lane, row_ = tid_ >> 1, hf_ = tid_ & 1;
            const f32x4* p_ = (const f32x4*)(rss + ((long)u.arow + row_) * 16 + 8 * hf_); const f32x4 a_ = p_[0], b_ = p_[1];
            float s_ = ((a_.x + a_.y) + (a_.z + a_.w)) + ((b_.x + b_.y) + (b_.z + b_.w)); s_ += __shfl_xor(s_, 1);
            if (hf_ == 0) RT[row_] = rsqrtf(fmaxf(s_, 0.f) * (1.f / D) + EPS);
            if (tid_ < 128) { const int k_ = tid_ >> 5, c_ = u.pn * 128 + 4 * (tid_ & 31);
                *(LAS f32x4*)(WT + k_ * 128 + 4 * (tid_ & 31)) = *(const f32x4*)(k_ < 3 ? cw + (size_t)k_ * DFF + c_ : cb + c_); } }
        if (fr >= 14) {
#pragma unroll
            for (int ai = 0; ai < 2; ++ai)
#pragma unroll
                for (int n = 0; n < 2; ++n) *(LAS f32x4*)(XG + ((2 * ai + wr) * 2 + (fr - 14)) * 128 + wc * 32 + 8 * fq + 4 * n) = acc[ai][0][3][n];
        }
        LDS_WAIT(); __builtin_amdgcn_s_barrier(); asm volatile("" ::: "memory");
#pragma unroll
        for (int ai = 0; ai < 2; ++ai)
#pragma unroll
            for (int m = 0; m < 4; ++m) { const float rs = RT[ai * 128 + wr * 64 + m * 16 + fr];
#pragma unroll
                for (int bj = 0; bj < 2; ++bj)
#pragma unroll
                    for (int n = 0; n < 2; ++n) acc[ai][bj][m][n] *= rs; }
        PEE(42, lds, p0_); PBE(43, lds, p0_);
#pragma unroll
        for (int n = 0; n < 2; ++n) {
            const int gc = gc0 + 4 * n;
            const int lc = wc * 32 + 8 * fq + 4 * n;
            const f32x4 w0 = *(const LAS f32x4*)(WT + lc), w1 = *(const LAS f32x4*)(WT + 128 + lc), w2 = *(const LAS f32x4*)(WT + 256 + lc), bb = *(const LAS f32x4*)(WT + 384 + lc);
#pragma unroll
            for (int ai = 0; ai < 2; ++ai) {
                f32x4 pr1, pr2;
                const int pb = 2 * ai + wr - 1;
                if (pb >= 0) { pr1 = *(const LAS f32x4*)(XG + (pb * 2 + 1) * 128 + wc * 32 + 8 * fq + 4 * n) * RT[64 * pb + 63];
                               pr2 = *(const LAS f32x4*)(XG + (pb * 2 + (fr & 1)) * 128 + wc * 32 + 8 * fq + 4 * n) * RT[64 * pb + 62 + (fr & 1)]; }
                else { pr1 = (f32x4){0.f, 0.f, 0.f, 0.f}; pr2 = pr1; }
#pragma unroll
                for (int m = 0; m < 4; ++m) {
                    const int j = ai * 128 + wr * 64 + m * 16 + fr; const long r = (long)u.arow + j;
                    int t, seq; if (r < MP) { t = (int)r & 8191; seq = (int)(r >> 13); } else { t = (int)(r - MP) & 63; seq = 2 + (int)((r - MP) >> 6); }
                    const int T = r < MP ? 8192 : 64;
                    const bool valid = j >= 2 && r < M;
                    const f32x4 cur = acc[ai][0][m][n]; f32x4 r1, r2;
#pragma unroll
                    for (int i = 0; i < 4; ++i) { r1[i] = dpp_ror<0x121>(cur[i]); r2[i] = dpp_ror<0x122>(cur[i]); }
                    f32x4 p1 = fr >= 1 ? r1 : pr1, p2 = fr >= 2 ? r2 : pr2;
                    pr1 = r1; pr2 = r2;
                    if (valid && t < 2) {
                        const f32x4 z = (f32x4){0.f, 0.f, 0.f, 0.f}; f32x4 s0 = z, s1 = z;
                        if (seq >= 2) { const float* sp = st_in + (size_t)(seq - 2) * 2 * DFF + gc; s0 = *(const f32x4*)sp; s1 = *(const f32x4*)(sp + DFF); }
                        if (t == 0) { p1 = s1; p2 = s0; } else { p2 = s1; }
                    }
                    const f32x4 gpre = bb + w0 * p2 + w1 * p1 + w2 * cur; const f32x4 up = acc[ai][1][m][n];
                    const float h0 = gelu_t(gpre[0]) * up[0], h1 = gelu_t(gpre[1]) * up[1], h2 = gelu_t(gpre[2]) * up[2], h3 = gelu_t(gpre[3]) * up[3];
                    if (valid) { u32x2 hw; hw.x = pg8::cvt_pk_bf16(h0, h1); hw.y = pg8::cvt_pk_bf16(h2, h3); *(u32x2*)(H + (size_t)r * DFF + gc) = hw;
                        if (t >= T - 2) { float* so = (seq < 2 ? st_p + (size_t)seq * 2 * DFF : st_s + (size_t)(seq - 2) * 2 * DFF) + (size_t)(t - (T - 2)) * DFF + gc; *(f32x4*)so = cur; } }
                    if (m == 3) asm volatile("" ::: "memory");
                }
            }
        }
        PEE(43, lds, p0_); PEE(41, lds, p0_);
    }
};

struct OneUnit { int pm, pn; bool on;
    __device__ bool next(int i, pg8::Unit& u) const { if (i != 0 || !on) return false; u.pm = pm; u.pn = pn; u.arow = 256 * pm; return true; } };
struct EpiPart {
    static constexpr bool PERM = false;
    float* base;
    DI void operator()(const f32x4 (&acc)[2][2][4][2], const pg8::Unit&, int wr, int wc, int fr_, int fq_, LAS unsigned char*) const {
        int fr = fr_, fq = fq_; asm volatile("" : "+v"(fr), "+v"(fq));
#pragma unroll
        for (int ai = 0; ai < 2; ++ai)
#pragma unroll
            for (int m = 0; m < 4; ++m) { float* rowp = base + (size_t)(ai * 128 + wr * 64 + m * 16 + fr) * 256 + wc * 32 + 4 * fq;
#pragma unroll
                for (int bj = 0; bj < 2; ++bj)
#pragma unroll
                    for (int n = 0; n < 2; ++n) *(f32x4*)(rowp + bj * 128 + n * 16) = acc[ai][bj][m][n]; }
    }
};
template <int MODE> DI void reduce_tail(const Ctx& F, const float* part, int S, const bf16_t* xs, bf16_t* xb, const float* rss_in, float* rss_out, const bf16_t* pp) {
    for (int t = blockIdx.x; t < 256; t += F.G) { const int j = t >> 5, rl = 8 * (t & 31) + F.wave, pm = 64 + (j >> 2), pn = j & 3; const int r = 256 * pm + rl, col = 256 * pn + 4 * F.lane;
        f32x4 sum = {0.f, 0.f, 0.f, 0.f};
        for (int sl = 0; sl < S; ++sl) sum += *(const f32x4*)(part + ((size_t)(j * S + sl) * 256 + rl) * 256 + 4 * F.lane);
        const size_t off = (size_t)r * D + col; const u32x2 xw = *(const u32x2*)(xs + off);
        f32x4 xn; xn[0] = __uint_as_float(xw.x << 16); xn[1] = __uint_as_float(xw.x & 0xffff0000u); xn[2] = __uint_as_float(xw.y << 16); xn[3] = __uint_as_float(xw.y & 0xffff0000u);
        if (MODE == 0) xn += sum;
        else { const float rs = row_rstd(rss_in, r); const u32x2 pw = *(const u32x2*)(pp + off);
            xn[0] += sigm(sum[0] * rs) * __uint_as_float(pw.x << 16); xn[1] += sigm(sum[1] * rs) * __uint_as_float(pw.x & 0xffff0000u);
            xn[2] += sigm(sum[2] * rs) * __uint_as_float(pw.y << 16); xn[3] += sigm(sum[3] * rs) * __uint_as_float(pw.y & 0xffff0000u); }
        u32x2 w; w.x = pg8::cvt_pk_bf16(xn[0], xn[1]); w.y = pg8::cvt_pk_bf16(xn[2], xn[3]); *(u32x2*)(xb + off) = w;
        float ss = (xn[0] * xn[0] + xn[1] * xn[1]) + (xn[2] * xn[2] + xn[3] * xn[3]);
        ss += __shfl_xor(ss, 1); ss += __shfl_xor(ss, 2); ss += __shfl_xor(ss, 4); ss += __shfl_xor(ss, 8);
        if ((F.lane & 15) == 0) rss_out[(size_t)r * 16 + pn * 4 + (F.lane >> 4)] = ss;
    }
}

DI bf16x8 frag_row(const LAS unsigned char* img, int pitch, int row0, int k0, int lane) {
    return *(const LAS bf16x8*)(img + (row0 + (lane & 15)) * pitch + (k0 + 8 * (lane >> 4)) * 2);
}
DI bf16x8 frag_tr(const LAS unsigned char* img, int pitch, int k0, int n0, int lane) {
    const int g = lane >> 4, i = lane & 15, q = i >> 2, p = i & 3;
    const LAS unsigned char* a = img + (k0 + 8 * g + q) * pitch + (n0 + 4 * p) * 2;
    const s16x4 lo = __builtin_amdgcn_ds_read_tr16_b64_v4i16((LAS s16x4*)a);
    const s16x4 hi = __builtin_amdgcn_ds_read_tr16_b64_v4i16((LAS s16x4*)(a + 4 * pitch));
    return __builtin_shufflevector(lo, hi, 0, 1, 2, 3, 4, 5, 6, 7);
}
#define MFMA16(a, b, c) __builtin_amdgcn_mfma_f32_16x16x32_bf16((a), (b), (c), 0, 0, 0)
DI void st_bf16(LAS unsigned char* img, int pitch, int row, int col, float v) { *(LAS bf16_t*)(img + row * pitch + col * 2) = (bf16_t)f2bf(v); }
DI float ld_bf16(const LAS unsigned char* img, int pitch, int row, int col) { return bf2f(*(const LAS bf16_t*)(img + row * pitch + col * 2)); }

#define WG_BAR() do { asm volatile("s_waitcnt lgkmcnt(0)" ::: "memory"); __builtin_amdgcn_s_barrier(); asm volatile("" ::: "memory"); } while (0)
template <bool SSD> struct LAT {
    static constexpr int DA = SSD ? 128 : 64, DB = SSD ? 64 : 128;
    static constexpr int PA = (DA + 8) * 2, PV = (DB + 8) * 2, PPI = 144, PS = (DB + 8) * 2, POT = (DB + 4) * 4;
    static constexpr int O_QD = 0, O_KI = O_QD + 64 * PA, O_VV = O_KI + 64 * PA, O_VW = O_VV + 64 * PV, O_P = O_VW + (SSD ? 64 * PV : 0), O_SB = O_P + 64 * PPI, O_OT = O_SB + DA * PS, O_TAB = O_OT + 64 * POT;
    static constexpr int NT_O = DB / 32;
};
static_assert(LAT<true>::O_TAB + 8192 <= RING_BYTES && LAT<false>::O_TAB + 8192 <= RING_BYTES, "mixer LDS");
template <bool SSD> DI void la_mt_nt(int T, int& mt, int& nt) { if (SSD) { mt = T >> 2; nt = T & 3; } else { mt = T >> 3; nt = T & 7; } }

template <bool SSD> DI void la_state_update(LAS unsigned char* lds, f32x4 (&S)[4], int w, int lane) {
    typedef LAT<SSD> L; const LAS float* tab = (const LAS float*)(lds + L::O_TAB); const int q = lane >> 4;
#pragma unroll
    for (int x = 0; x < 4; ++x) { int mt, nt; la_mt_nt<SSD>(4 * w + x, mt, nt);
        if (SSD) { const float d = tab[256]; S[x] *= d; }
#pragma unroll
        for (int ks = 0; ks < 2; ++ks) { const bf16x8 a = frag_tr(lds + L::O_KI, L::PA, 32 * ks, 16 * mt, lane); const bf16x8 b = frag_tr(lds + (SSD ? L::O_VW : L::O_VV), L::PV, 32 * ks, 16 * nt, lane); S[x] = MFMA16(a, b, S[x]); }
        if (!SSD) {
#pragma unroll
            for (int r = 0; r < 4; ++r) S[x][r] *= tab[1536 + 16 * mt + 4 * q + r]; }
    }
}
template <bool SSD> DI void la_write_sb(LAS unsigned char* lds, const f32x4 (&S)[4], int w, int lane) {
    typedef LAT<SSD> L; const int q = lane >> 4, c = lane & 15;
#pragma unroll
    for (int x = 0; x < 4; ++x) { int mt, nt; la_mt_nt<SSD>(4 * w + x, mt, nt);
#pragma unroll
        for (int r = 0; r < 4; ++r) st_bf16(lds + L::O_SB, L::PS, 16 * mt + 4 * q + r, 16 * nt + c, S[x][r]); }
}
template <bool SSD> DI void la_compute_p(LAS unsigned char* lds, int w, int lane) {
    typedef LAT<SSD> L; const LAS float* tab = (const LAS float*)(lds + L::O_TAB); const int q = lane >> 4, c = lane & 15, mt = w >> 1;
#pragma unroll
    for (int x = 0; x < 2; ++x) { const int nt = (w & 1) * 2 + x; f32x4 acc = {0.f, 0.f, 0.f, 0.f};
#pragma unroll
        for (int ks = 0; ks < L::DA / 32; ++ks) { const bf16x8 a = frag_row(lds + L::O_QD, L::PA, 16 * mt, 32 * ks, lane); const bf16x8 b = frag_row(lds + L::O_KI, L::PA, 16 * nt, 32 * ks, lane); acc = MFMA16(a, b, acc); }
        const int j = 16 * nt + c;
#pragma unroll
        for (int r = 0; r < 4; ++r) { const int i = 16 * mt + 4 * q + r; float v = acc[r];
            if (SSD) v *= __expf(tab[64 + i] - tab[64 + j]) * tab[j];
            v = (j > i) ? 0.f : v; st_bf16(lds + L::O_P, L::PPI, i, j, v); }
    }
}
template <bool SSD> DI void la_compute_out(LAS unsigned char* lds, f32x4 (&o1)[LAT<SSD>::NT_O], f32x4 (&o2)[LAT<SSD>::NT_O], int w, int lane) {
    typedef LAT<SSD> L; const int mt = w >> 1;
#pragma unroll
    for (int x = 0; x < L::NT_O; ++x) { const int nt = (w & 1) * L::NT_O + x; f32x4 a1 = {0.f, 0.f, 0.f, 0.f}, a2 = {0.f, 0.f, 0.f, 0.f};
#pragma unroll
        for (int ks = 0; ks < 2; ++ks) { const bf16x8 a = frag_row(lds + L::O_P, L::PPI, 16 * mt, 32 * ks, lane); const bf16x8 b = frag_tr(lds + L::O_VV, L::PV, 32 * ks, 16 * nt, lane); a1 = MFMA16(a, b, a1); }
#pragma unroll
        for (int ks = 0; ks < L::DA / 32; ++ks) { const bf16x8 a = frag_row(lds + L::O_QD, L::PA, 16 * mt, 32 * ks, lane); const bf16x8 b = frag_tr(lds + L::O_SB, L::PS, 32 * ks, 16 * nt, lane); a2 = MFMA16(a, b, a2); }
        o1[x] = a1; o2[x] = a2; }
}
DI void la_store_ds(float* ds, const f32x4 (&S)[4], int w, int lane) {
#pragma unroll
    for (int x = 0; x < 4; ++x)
#pragma unroll
        for (int r = 0; r < 4; ++r) ds[((4 * w + x) * 4 + r) * 64 + lane] = S[x][r];
}
DI void la_load_ds(const float* ds, f32x4 (&S)[4], int w, int lane) {
#pragma unroll
    for (int x = 0; x < 4; ++x)
#pragma unroll
        for (int r = 0; r < 4; ++r) S[x][r] = ds[((4 * w + x) * 4 + r) * 64 + lane];
}

struct GlaCoef { float wlr[16]; float blr; };
struct GlaRaw { unsigned short qk[8][2]; u32x4 v[2]; u32x4 lr; u32x4 g[2]; };
DI void gla_load(const Ctx& F, int h, int chunk, GlaRaw& R) {
    const bf16_t* proj = wsb(F, WS_R); const int row0 = 64 * chunk, d = F.lane, w = F.wave;
#pragma unroll
    for (int i = 0; i < 8; ++i) { const size_t ro = (size_t)(row0 + 8 * w + i) * DINP; R.qk[i][0] = proj[ro + PC_BQ + 64 * h + d]; R.qk[i][1] = proj[ro + PC_BK + 64 * h + d]; }
#pragma unroll
    for (int i = 0; i < 2; ++i) { const int idx = F.tid + 512 * i, t = idx >> 4, c16 = idx & 15;
        R.v[i] = *(const u32x4*)(proj + (size_t)(row0 + t) * DINP + PC_BV + 128 * h + 8 * c16);
        R.g[i] = *(const u32x4*)(proj + (size_t)(row0 + t) * DINP + PC_BG + 128 * h + 8 * c16); }
    R.lr = *(const u32x4*)(proj + (size_t)(row0 + ((F.tid >> 1) & 63)) * DINP + PC_BLR + 8 * (F.tid & 1));
}
DI void gla_stage(const Ctx& F, const GlaCoef& cf, const GlaRaw& R) {
    typedef LAT<false> L; LAS unsigned char* lds = F.lds; LAS float* tab = (LAS float*)(lds + L::O_TAB); const int d = F.lane, w = F.wave;
    if (F.tid < 128) { const int t = F.tid >> 1, half = F.tid & 1; float f[8]; unpack8(R.lr, f);
#pragma unroll
        for (int i = 0; i < 8; ++i) tab[t * 16 + 8 * half + i] = f[i]; }
#pragma unroll
    for (int i = 0; i < 2; ++i) { const int idx = F.tid + 512 * i, t = idx >> 4, c16 = idx & 15; *(LAS u32x4*)(lds + L::O_VV + t * L::PV + c16 * 16) = R.v[i]; }
    WG_BAR();
    float pre[8]; float run = 0.f;
#pragma unroll
    for (int i = 0; i < 8; ++i) { const int t = 8 * w + i; float z = cf.blr;
#pragma unroll
        for (int r = 0; r < 16; ++r) z += tab[t * 16 + r] * cf.wlr[r];
        run += logsig_fast(z) * (1.f / 16.f); pre[i] = run; }
    tab[1024 + w * 64 + d] = run;
    WG_BAR();
    float off = 0.f, last = 0.f;
#pragma unroll
    for (int ww = 0; ww < 8; ++ww) { const float tv = tab[1024 + ww * 64 + d]; last += tv; if (ww < w) off += tv; }
#pragma unroll
    for (int i = 0; i < 8; ++i) { const int t = 8 * w + i; const float cum = off + pre[i];
        st_bf16(lds + L::O_QD, L::PA, t, d, bf2f(R.qk[i][0]) * 0.125f * __expf(cum)); st_bf16(lds + L::O_KI, L::PA, t, d, bf2f(R.qk[i][1]) * __expf(-cum)); }
    if (w == 0) tab[1536 + d] = __expf(last);
    WG_BAR();
}
struct SsdRaw { u32x4 x[11]; u32x4 z; unsigned short dtr; };
DI void ssd_task(const Ctx& F, int h, int& cidx, int& rg, int& ch) {
    cidx = F.tid % 40; rg = F.tid / 40; const int g = h >> 2;
    ch = cidx < 8 ? 64 * h + 8 * cidx : (cidx < 24 ? 512 + 128 * g + 8 * (cidx - 8) : 768 + 128 * g + 8 * (cidx - 24));
}
DI void ssd_load(const Ctx& F, int layer, int h, int chunk, SsdRaw& R) {
    const bf16_t* proj = wsb(F, WS_R); const int row0 = 64 * chunk; const bool first = chunk_first(chunk);
    if (F.tid < 320) { int cidx, rg, ch; ssd_task(F, h, cidx, rg, ch);
#pragma unroll
        for (int i = 0; i < 11; ++i) { const int tt = 8 * rg - 3 + i;
            if (tt >= 0 || !first) R.x[i] = *(const u32x4*)(proj + (size_t)(row0 + tt) * DINP + PC_XBC + ch);
            else if (chunk >= 256) { const float* sp = F.in[I_SSC] + ((size_t)(layer * 8 + (chunk - 256)) * 3 + (tt + 3)) * 1024 + ch; const f32x4 a = *(const f32x4*)sp, b = *(const f32x4*)(sp + 4);
                u32x4 o; o.x = pk2(a.x, a.y); o.y = pk2(a.z, a.w); o.z = pk2(b.x, b.y); o.w = pk2(b.z, b.w); R.x[i] = o; }
            else R.x[i] = (u32x4){0u, 0u, 0u, 0u};
        }
    }
    R.z = *(const u32x4*)(proj + (size_t)(row0 + (F.tid >> 3)) * DINP + PC_CZ + 64 * h + 8 * (F.tid & 7));
    R.dtr = proj[(size_t)(row0 + F.lane) * DINP + PC_DT + h];
}
constexpr int SSD_WCV = 512;
DI void ssd_item_weights(const Ctx& F, int layer, int h) {
    typedef LAT<true> L; LAS float* tab = (LAS float*)(F.lds + L::O_TAB);
    if (F.tid < 200) { const int cidx = F.tid / 5, j = F.tid % 5, g = h >> 2;
        const int ch = cidx < 8 ? 64 * h + 8 * cidx : (cidx < 24 ? 512 + 128 * g + 8 * (cidx - 8) : 768 + 128 * g + 8 * (cidx - 24));
        const float* sp = j < 4 ? F.in[I_SCW] + (size_t)(layer * 4 + j) * 1024 + ch : F.in[I_SCB] + layer * 1024 + ch;
        *(LAS f32x4*)(tab + SSD_WCV + (cidx * 5 + j) * 8) = *(const f32x4*)sp; *(LAS f32x4*)(tab + SSD_WCV + (cidx * 5 + j) * 8 + 4) = *(const f32x4*)(sp + 4); }
    WG_BAR();
}
DI void ssd_stage(const Ctx& F, int layer, int h, const SsdRaw& R) {
    typedef LAT<true> L; LAS unsigned char* lds = F.lds; LAS float* tab = (LAS float*)(lds + L::O_TAB);
    if (F.wave == 7) { const int t = F.lane;
        const float dt = softplus_fast(bf2f(R.dtr) + F.in[I_SDTB][layer * 8 + h]); const float cum = wave_incl_scan(-dt * __expf(F.in[I_SALOG][layer * 8 + h]));
        const float last = __shfl(cum, 63);
        tab[t] = dt; tab[64 + t] = cum; tab[128 + t] = __expf(last - cum) * dt; tab[192 + t] = __expf(cum); if (t == 0) tab[256] = __expf(last); }
    if (F.tid < 320) { int cidx, rg, ch; ssd_task(F, h, cidx, rg, ch);
        float wv[4][8], bv[8];
#pragma unroll
        for (int j = 0; j < 4; ++j) { const f32x4 a = *(const LAS f32x4*)(tab + SSD_WCV + (cidx * 5 + j) * 8), b = *(const LAS f32x4*)(tab + SSD_WCV + (cidx * 5 + j) * 8 + 4); wv[j][0] = a.x; wv[j][1] = a.y; wv[j][2] = a.z; wv[j][3] = a.w; wv[j][4] = b.x; wv[j][5] = b.y; wv[j][6] = b.z; wv[j][7] = b.w; }
        { const f32x4 a = *(const LAS f32x4*)(tab + SSD_WCV + (cidx * 5 + 4) * 8), b = *(const LAS f32x4*)(tab + SSD_WCV + (cidx * 5 + 4) * 8 + 4); bv[0] = a.x; bv[1] = a.y; bv[2] = a.z; bv[3] = a.w; bv[4] = b.x; bv[5] = b.y; bv[6] = b.z; bv[7] = b.w; }
        float x0[8], x1[8], x2[8], x3[8]; unpack8(R.x[0], x0); unpack8(R.x[1], x1); unpack8(R.x[2], x2);
#pragma unroll
        for (int r = 0; r < 8; ++r) { const int t = 8 * rg + r; float o[8]; unpack8(R.x[r + 3], x3);
#pragma unroll
            for (int e = 0; e < 8; ++e) { const float v = bv[e] + wv[0][e] * x0[e] + wv[1][e] * x1[e] + wv[2][e] * x2[e] + wv[3][e] * x3[e]; o[e] = silu_f(v); x0[e] = x1[e]; x1[e] = x2[e]; x2[e] = x3[e]; }
            if (cidx < 8) *(LAS u32x4*)(lds + L::O_VV + t * L::PV + cidx * 16) = pack8(o);
            else if (cidx < 24) *(LAS u32x4*)(lds + L::O_KI + t * L::PA + (cidx - 8) * 16) = pack8(o);
            else *(LAS u32x4*)(lds + L::O_QD + t * L::PA + (cidx - 24) * 16) = pack8(o);
        }
    }
    WG_BAR();
    { const int t = F.tid >> 3, c8 = F.tid & 7; float xv[8]; unpack8(*(const LAS u32x4*)(lds + L::O_VV + t * L::PV + c8 * 16), xv); const float we = tab[128 + t];
#pragma unroll
        for (int e = 0; e < 8; ++e) xv[e] *= we;
        *(LAS u32x4*)(lds + L::O_VW + t * L::PV + c8 * 16) = pack8(xv); }
}

DI void gla_pass_a(const Ctx& F0, int layer, int panel, int h) {
    Ctx F = F0; OPAQUE_CTX(F);
    LAS unsigned char* lds = F.lds; const int w = F.wave, lane = F.lane, d = lane; const bf16_t* proj = wsb(F, WS_R); const int row0 = 256 * panel;
    constexpr int PK = 144, PVV = 272, O_KE = 0, O_V = 256 * PK, O_LR = O_V + 256 * PVV, O_TOT = O_LR + 256 * 16 * 4;
    static_assert(O_TOT + 2048 <= RING_BYTES, "gla pass A LDS");
    LAS float* lr = (LAS float*)(lds + O_LR); LAS float* tot = (LAS float*)(lds + O_TOT);
    float wlr[16];
#pragma unroll
    for (int r = 0; r < 16; ++r) wlr[r] = F.in[I_GWLR][(size_t)(layer * 16 + r) * 256 + 64 * h + d];
    const float blr = F.in[I_GBLR][layer * 256 + 64 * h + d];
    { const int t = F.tid >> 1, half = F.tid & 1; const u32x4 v = *(const u32x4*)(proj + (size_t)(row0 + t) * DINP + PC_BLR + 8 * half); float f[8]; unpack8(v, f);
#pragma unroll
        for (int i = 0; i < 8; ++i) lr[t * 16 + 8 * half + i] = f[i]; }
    unsigned short kr[32];
#pragma unroll
    for (int i = 0; i < 32; ++i) kr[i] = proj[(size_t)(row0 + 32 * w + i) * DINP + PC_BK + 64 * h + d];
#pragma unroll
    for (int i = 0; i < 8; ++i) { const int idx = F.tid + 512 * i, t = idx >> 4, c16 = idx & 15;
        *(LAS u32x4*)(lds + O_V + t * PVV + c16 * 16) = *(const u32x4*)(proj + (size_t)(row0 + t) * DINP + PC_BV + 128 * h + 8 * c16); }
    WG_BAR();
    float pre[32]; float run = 0.f;
#pragma unroll
    for (int i = 0; i < 32; ++i) { const int t = 32 * w + i; float z = blr;
#pragma unroll
        for (int r = 0; r < 16; ++r) z += lr[t * 16 + r] * wlr[r];
        run += logsig_fast(z) * (1.f / 16.f); pre[i] = run; }
    tot[w * 64 + d] = run;
    WG_BAR();
    float off = 0.f, last = 0.f;
#pragma unroll
    for (int ww = 0; ww < 8; ++ww) { const float tv = tot[ww * 64 + d]; last += tv; if (ww < w) off += tv; }
#pragma unroll
    for (int i = 0; i < 32; ++i) st_bf16(lds + O_KE, PK, 32 * w + i, d, bf2f(kr[i]) * __expf(last - (off + pre[i])));
    WG_BAR();
    f32x4 S[4];
#pragma unroll
    for (int x = 0; x < 4; ++x) S[x] = (f32x4){0.f, 0.f, 0.f, 0.f};
    const int mt = w >> 1;
#pragma unroll
    for (int ks = 0; ks < 8; ++ks) { const bf16x8 a = frag_tr(lds + O_KE, PK, 32 * ks, 16 * mt, lane);
#pragma unroll
        for (int x = 0; x < 4; ++x) { const bf16x8 b = frag_tr(lds + O_V, PVV, 32 * ks, 16 * (((4 * w + x) & 7)), lane); S[x] = MFMA16(a, b, S[x]); } }
    la_store_ds(wsf(F, WS_DS) + ((size_t)panel * 12 + h) * 8192, S, w, lane);
    if (w == 0) wsf(F, WS_DEC)[(panel * 4 + h) * 64 + d] = __expf(last);
    WG_BAR();
}
DI void ssd_pass_a(const Ctx& F0, int layer, int panel, int h) {
    Ctx F = F0; OPAQUE_CTX(F);
    LAS unsigned char* lds = F.lds; const int w = F.wave, lane = F.lane, g = h >> 2; const bf16_t* proj = wsb(F, WS_R); const int row0 = 256 * panel; const bool first = (panel & 31) == 0;
    constexpr int PB_ = 272, PX = 144, O_B = 0, O_XW = 256 * PB_, O_WE = O_XW + 256 * PX;
    static_assert(O_WE + 1024 <= RING_BYTES, "ssd pass A LDS");
    LAS float* wend = (LAS float*)(lds + O_WE);
    float last = 0.f;
    if (w == 0) {
        const float bias = F.in[I_SDTB][layer * 8 + h], A = -__expf(F.in[I_SALOG][layer * 8 + h]); float dt[4], cs[4]; float run = 0.f;
#pragma unroll
        for (int i = 0; i < 4; ++i) { dt[i] = softplus_fast(bf2f(proj[(size_t)(row0 + 4 * lane + i) * DINP + PC_DT + h]) + bias); run += dt[i] * A; cs[i] = run; }
        const float inc = wave_incl_scan(run);
        const float excl = inc - run; last = __shfl(inc, 63);
#pragma unroll
        for (int i = 0; i < 4; ++i) wend[4 * lane + i] = __expf(last - (excl + cs[i])) * dt[i];
    }
    WG_BAR();
    for (int pass = 0; pass < 2; ++pass) { const int task = F.tid + 512 * pass;
        if (task < 768) { const int cidx = task % 24, rg = task / 24;
            const int ch = cidx < 8 ? 64 * h + 8 * cidx : 512 + 128 * g + 8 * (cidx - 8);
            const float* cwp = F.in[I_SCW] + (size_t)layer * 4 * 1024 + ch; const float* cbp = F.in[I_SCB] + layer * 1024 + ch;
            float wv[4][8], bv[8];
#pragma unroll
            for (int j = 0; j < 4; ++j) { const f32x4 a = *(const f32x4*)(cwp + j * 1024), b = *(const f32x4*)(cwp + j * 1024 + 4); wv[j][0] = a.x; wv[j][1] = a.y; wv[j][2] = a.z; wv[j][3] = a.w; wv[j][4] = b.x; wv[j][5] = b.y; wv[j][6] = b.z; wv[j][7] = b.w; }
            { const f32x4 a = *(const f32x4*)cbp, b = *(const f32x4*)(cbp + 4); bv[0] = a.x; bv[1] = a.y; bv[2] = a.z; bv[3] = a.w; bv[4] = b.x; bv[5] = b.y; bv[6] = b.z; bv[7] = b.w; }
            u32x4 xr[11];
#pragma unroll
            for (int i = 0; i < 11; ++i) { const int tt = 8 * rg - 3 + i;
                if (tt >= 0 || !first) xr[i] = *(const u32x4*)(proj + (size_t)(row0 + tt) * DINP + PC_XBC + ch); else xr[i] = (u32x4){0u, 0u, 0u, 0u}; }
            float x0[8], x1[8], x2[8], x3[8]; unpack8(xr[0], x0); unpack8(xr[1], x1); unpack8(xr[2], x2);
#pragma unroll
            for (int r = 0; r < 8; ++r) { const int t = 8 * rg + r; float o[8]; unpack8(xr[r + 3], x3);
#pragma unroll
                for (int e = 0; e < 8; ++e) { const float v = bv[e] + wv[0][e] * x0[e] + wv[1][e] * x1[e] + wv[2][e] * x2[e] + wv[3][e] * x3[e]; o[e] = silu_f(v); x0[e] = x1[e]; x1[e] = x2[e]; x2[e] = x3[e]; }
                if (cidx < 8) { const float we = wend[t];
#pragma unroll
                    for (int e = 0; e < 8; ++e) o[e] *= we;
                    *(LAS u32x4*)(lds + O_XW + t * PX + cidx * 16) = pack8(o); }
                else *(LAS u32x4*)(lds + O_B + t * PB_ + (cidx - 8) * 16) = pack8(o);
            }
        }
    }
    WG_BAR();
    f32x4 S[4];
#pragma unroll
    for (int x = 0; x < 4; ++x) S[x] = (f32x4){0.f, 0.f, 0.f, 0.f};
#pragma unroll
    for (int ks = 0; ks < 8; ++ks) { const bf16x8 a = frag_tr(lds + O_B, PB_, 32 * ks, 16 * w, lane);
#pragma unroll
        for (int x = 0; x < 4; ++x) { const bf16x8 b = frag_tr(lds + O_XW, PX, 32 * ks, 16 * x, lane); S[x] = MFMA16(a, b, S[x]); } }
    la_store_ds(wsf(F, WS_DS) + ((size_t)panel * 12 + 4 + h) * 8192, S, w, lane);
    if (w == 0 && lane == 0) wsf(F, WS_DEC)[64 * 4 * 64 + panel * 8 + h] = __expf(last);
    WG_BAR();
}

template <bool SSD> DI void la_pass_c(const Ctx& F0, int layer, int c0, int nc, int h, bool dry) {
    Ctx F = F0; OPAQUE_CTX(F);
    typedef LAT<SSD> L; const int w = F.wave, lane = F.lane, q = lane >> 4, c = lane & 15, mt = w >> 1;
    bf16_t* proj = wsb(F, WS_R);
    f32x4 S[4];
    GlaCoef cf; GlaRaw gr; SsdRaw sr;
    if (!SSD) {
#pragma unroll
        for (int r = 0; r < 16; ++r) cf.wlr[r] = F.in[I_GWLR][(size_t)(layer * 16 + r) * 256 + 64 * h + lane];
        cf.blr = F.in[I_GBLR][layer * 256 + 64 * h + lane]; gla_load(F, h, c0, gr); }
    else { ssd_load(F, layer, h, c0, sr); ssd_item_weights(F, layer, h); }
    const int hh = SSD ? 4 + h : h;
    const Ctx Fp = F;
#pragma unroll 1
    for (int cc = 0; cc < nc; ++cc) { const int chunk = c0 + cc, row0 = 64 * chunk;
        Ctx F = Fp; { unsigned z_ = 0; asm volatile("" : "+s"(z_)); F.lds = Fp.lds + z_; } LAS unsigned char* lds = F.lds; LAS float* tab = (LAS float*)(lds + L::O_TAB);
        PB(SSD ? 5 : 15);
        if (cc == 0 || chunk_first(chunk)) {
            if (chunk < 256) la_load_ds(wsf(F, WS_DS) + ((size_t)(chunk >> 2) * 12 + hh) * 8192, S, w, lane);
            else { const int b = chunk - 256;
#pragma unroll
                for (int x = 0; x < 4; ++x) { int smt, snt; la_mt_nt<SSD>(4 * w + x, smt, snt);
                    if (SSD) { const float* sp = F.in[I_SS] + ((size_t)((layer * 8 + b) * 8 + h) * 64 + 16 * snt + c) * 128 + 16 * smt + 4 * q; S[x] = *(const f32x4*)sp; }
                    else { const float* sp = F.in[I_SG] + ((size_t)((layer * 8 + b) * 4 + h) * 64 + 16 * smt + 4 * q) * 128 + 16 * snt + c;
#pragma unroll
                        for (int r = 0; r < 4; ++r) S[x][r] = sp[r * 128]; } } }
            la_write_sb<SSD>(lds, S, w, lane);
        }
        PE(SSD ? 5 : 15);
        PB(SSD ? 1 : 11);
        u32x4 gate0, gate1;
        if (SSD) { ssd_stage(F, layer, h, sr); gate0 = sr.z; gate1 = gate0; if (cc + 1 < nc) ssd_load(F, layer, h, chunk + 1, sr); }
        else { gla_stage(F, cf, gr); gate0 = gr.g[0]; gate1 = gr.g[1]; if (cc + 1 < nc) gla_load(F, h, chunk + 1, gr); }
        PE(SSD ? 1 : 11); PB(SSD ? 2 : 12);
        la_compute_p<SSD>(lds, w, lane);
        WG_BAR();
        PE(SSD ? 2 : 12); PB(SSD ? 3 : 13);
        f32x4 o1[L::NT_O], o2[L::NT_O];
        la_compute_out<SSD>(lds, o1, o2, w, lane);
        la_state_update<SSD>(lds, S, w, lane);
        if (SSD) {
            const float Dh = F.in[I_SD][layer * 8 + h];
#pragma unroll
            for (int x = 0; x < L::NT_O; ++x) { const int p = 16 * ((w & 1) * L::NT_O + x) + c;
#pragma unroll
                for (int r = 0; r < 4; ++r) { const int i = 16 * mt + 4 * q + r; *(LAS float*)(lds + L::O_OT + i * L::POT + p * 4) = o1[x][r] + tab[192 + i] * o2[x][r] + Dh * ld_bf16(lds + L::O_VV, L::PV, i, p); } }
        } else {
            float ss[4] = {0.f, 0.f, 0.f, 0.f};
#pragma unroll
            for (int x = 0; x < L::NT_O; ++x) { const int e = 16 * ((w & 1) * L::NT_O + x) + c;
#pragma unroll
                for (int r = 0; r < 4; ++r) { const float o = o1[x][r] + o2[x][r]; ss[r] += o * o; *(LAS float*)(lds + L::O_OT + (16 * mt + 4 * q + r) * L::POT + e * 4) = o; } }
#pragma unroll
            for (int r = 0; r < 4; ++r) { float s = ss[r]; s += __shfl_xor(s, 1); s += __shfl_xor(s, 2); s += __shfl_xor(s, 4); s += __shfl_xor(s, 8);
                if (c == 0) tab[1600 + (16 * mt + 4 * q + r) * 2 + (w & 1)] = s; }
        }
        WG_BAR();
        PE(SSD ? 3 : 13); PB(SSD ? 4 : 14);
        if (SSD) { const int i = F.tid >> 3, p0 = 8 * (F.tid & 7); float zv[8], yv[8]; unpack8(gate0, zv); float ss = 0.f;
            const f32x4 ya = *(const LAS f32x4*)(lds + L::O_OT + i * L::POT + p0 * 4), yb = *(const LAS f32x4*)(lds + L::O_OT + i * L::POT + p0 * 4 + 16);
            yv[0] = ya.x; yv[1] = ya.y; yv[2] = ya.z; yv[3] = ya.w; yv[4] = yb.x; yv[5] = yb.y; yv[6] = yb.z; yv[7] = yb.w;
#pragma unroll
            for (int e = 0; e < 8; ++e) { yv[e] *= silu_f(zv[e]); ss += yv[e] * yv[e]; }
            ss += __shfl_xor(ss, 1); ss += __shfl_xor(ss, 2); ss += __shfl_xor(ss, 4);
            if (!dry) { *(u32x4*)(proj + (size_t)(row0 + i) * DINP + PC_CZ + 64 * h + p0) = pack8(yv);
                if ((F.tid & 7) == 0) { f32x2 pv; pv.x = ss; pv.y = 0.f; *(f32x2*)(wsf(F, WS_PSS) + (size_t)(row0 + i) * 16 + 2 * h) = pv; } }
        } else {
#pragma unroll
            for (int k = 0; k < 2; ++k) { const int idx = F.tid + 512 * k, i = idx >> 4, e0 = 8 * (idx & 15); float gv[8], yv[8]; unpack8(k ? gate1 : gate0, gv);
                const float rstd = rsqrtf((tab[1600 + 2 * i] + tab[1600 + 2 * i + 1]) * (1.f / 128.f) + EPS);
                const f32x4 ya = *(const LAS f32x4*)(lds + L::O_OT + i * L::POT + e0 * 4), yb = *(const LAS f32x4*)(lds + L::O_OT + i * L::POT + e0 * 4 + 16);
                const float* gn = F.in[I_GNORM] + layer * 512 + 128 * h + e0; const f32x4 na = *(const f32x4*)gn, nb = *(const f32x4*)(gn + 4);
                yv[0] = ya.x * na.x; yv[1] = ya.y * na.y; yv[2] = ya.z * na.z; yv[3] = ya.w * na.w; yv[4] = yb.x * nb.x; yv[5] = yb.y * nb.y; yv[6] = yb.z * nb.z; yv[7] = yb.w * nb.w;
#pragma unroll
                for (int e = 0; e < 8; ++e) yv[e] *= rstd * silu_f(gv[e]);
                if (!dry) *(u32x4*)(proj + (size_t)(row0 + i) * DINP + PC_BG + 128 * h + e0) = pack8(yv); }
        }
        if (chunk_last(chunk)) { if (!dry) { const int seq = chunk_seq(chunk);
            if (SSD) { float* so = st_out(F, O_PS, O_SS, layer, seq, 8 * 64 * 128) + (size_t)h * 64 * 128;
#pragma unroll
                for (int x = 0; x < 4; ++x) { int smt, snt; la_mt_nt<SSD>(4 * w + x, smt, snt); *(f32x4*)(so + (size_t)(16 * snt + c) * 128 + 16 * smt + 4 * q) = S[x]; } }
            else { float* so = st_out(F, O_PG, O_SG, layer, seq, 4 * 64 * 128) + (size_t)h * 64 * 128;
#pragma unroll
                for (int x = 0; x < 4; ++x) { int smt, snt; la_mt_nt<SSD>(4 * w + x, smt, snt);
#pragma unroll
                    for (int r = 0; r < 4; ++r) so[(size_t)(16 * smt + 4 * q + r) * 128 + 16 * snt + c] = S[x][r]; } } }
        } else if (cc + 1 < nc) la_write_sb<SSD>(lds, S, w, lane);
        WG_BAR();
        PE(SSD ? 4 : 14);
    }
}

struct LruSP { bf16x8 br[2], bi[2]; float b_r, b_i, lam, hin; };
template <bool PASS_C> DI void lru_load_sp(const Ctx& F, int layer, int h, int chunk, int nt, LruSP& p) {
    const int lane = F.lane, q = lane >> 4, c = lane & 15, col = 64 * h + 16 * nt + c;
    const bf16_t* wr_t = wsb(F, WS_LRUW) + (size_t)((layer * 2 + 0) * 8 + h) * 4096; const bf16_t* wi_t = wsb(F, WS_LRUW) + (size_t)((layer * 2 + 1) * 8 + h) * 4096;
#pragma unroll
    for (int ks = 0; ks < 2; ++ks) { const int o = (16 * nt + c) * 64 + 32 * ks + 8 * q; p.br[ks] = *(const bf16x8*)(wr_t + o); p.bi[ks] = *(const bf16x8*)(wi_t + o); }
    p.b_r = F.in[I_LBR][layer * 512 + col]; p.b_i = F.in[I_LBI][layer * 512 + col]; p.lam = F.in[I_LAM][layer * 512 + col]; p.hin = 0.f;
    if (PASS_C) p.hin = chunk >= 256 ? F.in[I_SLH][(size_t)(layer * 8 + (chunk - 256)) * 512 + col] : wsf(F, WS_LRUS)[(size_t)(2 * NCH + chunk) * 512 + col];
}
template <bool PASS_C> DI void lru_chunk(const Ctx& F0, int layer, int chunk, bool dry = false) {
    Ctx F = F0; OPAQUE_CTX(F);
    const int h = F.wave, lane = F.lane, q = lane >> 4, c = lane & 15, row0 = 64 * chunk; const bool first = chunk_first(chunk);
    LAS unsigned char* T = F.lds + h * 18432; LAS unsigned char* OT = T + 9216; constexpr int TP = 144;
    bf16_t* proj = wsb(F, WS_R);
    const int cc = lane & 7, rg = lane >> 3;
    PB(PASS_C ? 21 : 31);
    LruSP cur; lru_load_sp<PASS_C>(F, layer, h, chunk, 0, cur);
    {
        const int ch = 64 * h + 8 * cc; u32x4 xr[11];
#pragma unroll
        for (int i = 0; i < 11; ++i) { const int tt = 8 * rg - 3 + i;
            if (tt >= 0 || !first) xr[i] = *(const u32x4*)(proj + (size_t)(row0 + tt) * DINP + PC_AX + ch);
            else if (chunk >= 256) { const float* sp = F.in[I_SLC] + ((size_t)(layer * 8 + (chunk - 256)) * 3 + (tt + 3)) * 512 + ch; const f32x4 a = *(const f32x4*)sp, b = *(const f32x4*)(sp + 4);
                u32x4 o; o.x = pk2(a.x, a.y); o.y = pk2(a.z, a.w); o.z = pk2(b.x, b.y); o.w = pk2(b.z, b.w); xr[i] = o; }
            else xr[i] = (u32x4){0u, 0u, 0u, 0u};
        }
        const float* cwp = F.in[I_LCW] + (size_t)layer * 4 * 512 + ch; const float* cbp = F.in[I_LCB] + layer * 512 + ch;
        float wv[4][8], bv[8];
#pragma unroll
        for (int j = 0; j < 4; ++j) { const f32x4 a = *(const f32x4*)(cwp + j * 512), b = *(const f32x4*)(cwp + j * 512 + 4); wv[j][0] = a.x; wv[j][1] = a.y; wv[j][2] = a.z; wv[j][3] = a.w; wv[j][4] = b.x; wv[j][5] = b.y; wv[j][6] = b.z; wv[j][7] = b.w; }
        { const f32x4 a = *(const f32x4*)cbp, b = *(const f32x4*)(cbp + 4); bv[0] = a.x; bv[1] = a.y; bv[2] = a.z; bv[3] = a.w; bv[4] = b.x; bv[5] = b.y; bv[6] = b.z; bv[7] = b.w; }
        float x0[8], x1[8], x2[8], x3[8]; unpack8(xr[0], x0); unpack8(xr[1], x1); unpack8(xr[2], x2);
#pragma unroll
        for (int r = 0; r < 8; ++r) { float o[8]; unpack8(xr[r + 3], x3);
#pragma unroll
            for (int e = 0; e < 8; ++e) { o[e] = bv[e] + wv[0][e] * x0[e] + wv[1][e] * x1[e] + wv[2][e] * x2[e] + wv[3][e] * x3[e]; x0[e] = x1[e]; x1[e] = x2[e]; x2[e] = x3[e]; }
            *(LAS u32x4*)(T + (8 * rg + r) * TP + cc * 16) = pack8(o); }
    }
    LDS_WAIT();
    PE(PASS_C ? 21 : 31); PB(PASS_C ? 22 : 32);
#pragma unroll 1
    for (int nt = 0; nt < 4; ++nt) {
        LruSP nx = cur; if (nt < 3) lru_load_sp<PASS_C>(F, layer, h, chunk, nt + 1, nx);
        const int col = 64 * h + 16 * nt + c;
        const float c8 = -8.f * softplus_f(-cur.lam);
        float hc = cur.hin, pc = 1.f;
#pragma unroll
        for (int mt = 0; mt < 4; ++mt) {
            const bf16x8 a0 = frag_row(T, TP, 16 * mt, 0, lane), a1 = frag_row(T, TP, 16 * mt, 32, lane);
            f32x4 ar = {0.f, 0.f, 0.f, 0.f}, ai = {0.f, 0.f, 0.f, 0.f};
            ar = MFMA16(a0, cur.br[0], ar); ar = MFMA16(a1, cur.br[1], ar); ai = MFMA16(a0, cur.bi[0], ai); ai = MFMA16(a1, cur.bi[1], ai);
            float a[4], uu[4];
#pragma unroll
            for (int r = 0; r < 4; ++r) { const int t = 16 * mt + 4 * q + r; const float rg_ = sigm(ar[r] + cur.b_r), ig = sigm(ai[r] + cur.b_i), la = c8 * rg_;
                a[r] = __expf(la); uu[r] = __builtin_amdgcn_sqrtf(fmaxf(1.f - a[r] * a[r], 0.f)) * ig * ld_bf16(T, TP, t, 16 * nt + c); }
            const float P = (a[0] * a[1]) * (a[2] * a[3]); const float Hl = ((uu[0] * a[1] + uu[1]) * a[2] + uu[2]) * a[3] + uu[3];
            float hrun = hc, my_in = 0.f;
#pragma unroll
            for (int qq = 0; qq < 4; ++qq) { const float Pq = __shfl(P, c + 16 * qq), Hq = __shfl(Hl, c + 16 * qq); if (qq == q) my_in = hrun; hrun = Pq * hrun + Hq; pc *= Pq; }
            hc = hrun;
            if (PASS_C) { float hh = my_in;
#pragma unroll
                for (int r = 0; r < 4; ++r) { hh = a[r] * hh + uu[r]; st_bf16(OT, TP, 16 * mt + 4 * q + r, 16 * nt + c, hh); } }
        }
        if (!PASS_C) { if (q == 0) { wsf(F, WS_LRUS)[(size_t)chunk * 512 + col] = pc; wsf(F, WS_LRUS)[(size_t)(NCH + chunk) * 512 + col] = hc; } }
        else if (chunk_last(chunk) && q == 0 && !dry) st_out(F, O_PLH, O_SLH, layer, chunk_seq(chunk), 512)[col] = hc;
        cur = nx;
    }
    PE(PASS_C ? 22 : 32); PB(PASS_C ? 23 : 33);
    if (PASS_C) {
        LDS_WAIT();
        u32x4* gp = (u32x4*)(proj + (size_t)(row0 + rg) * DINP + PC_AG + 64 * h + 8 * cc); u32x4 gnx = *gp;
#pragma unroll 1
        for (int i = 0; i < 8; ++i) { const int t = rg + 8 * i; const u32x4 gc = gnx; u32x4* gq = gp + (size_t)i * (8 * DINP * 2 / 16);
            if (i < 7) gnx = *(gq + (8 * DINP * 2 / 16));
            float hv[8], gv[8]; unpack8(*(const LAS u32x4*)(OT + t * TP + cc * 16), hv); unpack8(gc, gv);
#pragma unroll
            for (int e = 0; e < 8; ++e) hv[e] *= gelu_t(gv[e]);
            if (!dry) *gq = pack8(hv); }
        if (chunk_last(chunk) && !dry) { float* so = st_out(F, O_PLC, O_SLC, layer, chunk_seq(chunk), 3 * 512);
#pragma unroll
            for (int i = 0; i < 3; ++i) so[i * 512 + 64 * h + lane] = bf2f(proj[(size_t)(row0 + 61 + i) * DINP + PC_AX + 64 * h + lane]); }
    }
    LDS_WAIT();
    PE(PASS_C ? 23 : 33);
}

DI void phase_mixer_a(const Ctx& F, int layer) {
    for (int it = blockIdx.x; it < 1034; it += F.G) {
        if (it < 256) gla_pass_a(F, layer, it >> 2, it & 3);
        else if (it < 768) ssd_pass_a(F, layer, (it - 256) >> 3, (it - 256) & 7);
        else if (it < 1024) lru_chunk<false>(F, layer, it - 768);
        else { const int seq = it - 1024, lastrow = seq < 2 ? 8192 * (seq + 1) - 1 : MP + 64 * (seq - 1) - 1;
            float* so = st_out(F, O_PSC, O_SSC, layer, seq, 3 * 1024); const bf16_t* proj = wsb(F, WS_R);
            for (int e = F.tid; e < 3 * 1024; e += 512) so[e] = bf2f(proj[(size_t)(lastrow - 2 + (e >> 10)) * DINP + PC_XBC + (e & 1023)]); }
        __syncthreads();
    }
}
DI void phase_mixer_b(const Ctx& F, int layer, bool dry) {
    float* ds = wsf(F, WS_DS); const float* dec = wsf(F, WS_DEC);
    for (int e = blockIdx.x * 512 + F.tid; e < 2 * 12 * 8192; e += F.G * 512) {
        const int idx = e & 8191, hh = (e >> 13) % 12, b = e / (12 * 8192);
        const int ln = idx & 63, r = (idx >> 6) & 3, Tt = idx >> 8; const int a = 16 * (Tt >> 3) + 4 * (ln >> 4) + r;
        float v[32];
#pragma unroll
        for (int p = 0; p < 32; ++p) v[p] = ds[((size_t)(32 * b + p) * 12 + hh) * 8192 + idx];
        float S = 0.f;
#pragma unroll
        for (int p = 0; p < 32; ++p) { const int panel = 32 * b + p; const float dc = hh < 4 ? dec[(panel * 4 + hh) * 64 + a] : dec[64 * 4 * 64 + panel * 8 + (hh - 4)];
            if (!dry) ds[((size_t)panel * 12 + hh) * 8192 + idx] = S; S = dc * S + v[p]; }
    }
    {
        const int gw = blockIdx.x * NWAVES + F.wave; float* ls = wsf(F, WS_LRUS);
        if (gw < 1024) { const int b = gw >> 9, ch = gw & 511, l = F.lane; const int c0 = 128 * b + 2 * l;
            const float A0 = ls[(size_t)c0 * 512 + ch], H0 = ls[(size_t)(NCH + c0) * 512 + ch], A1 = ls[(size_t)(c0 + 1) * 512 + ch], H1 = ls[(size_t)(NCH + c0 + 1) * 512 + ch];
            float A = A1 * A0, H = A1 * H0 + H1;
#pragma unroll
            for (int o = 1; o < 64; o <<= 1) { const float Ap = __shfl_up(A, o), Hp = __shfl_up(H, o); if (l >= o) { H = A * Hp + H; A = A * Ap; } }
            float E = __shfl_up(H, 1); if (l == 0) E = 0.f;
            ls[(size_t)(2 * NCH + c0) * 512 + ch] = E; ls[(size_t)(2 * NCH + c0 + 1) * 512 + ch] = A0 * E + H0; }
    }
}
#ifndef MIX_MASK
#define MIX_MASK 7
#endif
#ifndef DRY_MIX
#define DRY_MIX 7
#endif
DI void phase_mixer_c(const Ctx& F, int layer, bool dry) {
    const int mm = dry ? DRY_MIX : MIX_MASK;
    for (int it = blockIdx.x; it < 1128; it += F.G) {
        if (it < 512) { if (mm & 1) la_pass_c<true>(F, layer, 4 * (it >> 3), 4, it & 7, dry); }
        else if (it < 768) { if (mm & 2) la_pass_c<false>(F, layer, 4 * ((it - 512) >> 2), 4, (it - 512) & 3, dry); }
        else if (it < 1032) { if (mm & 4) lru_chunk<true>(F, layer, it - 768, dry); }
        else if (it < 1096) { if (mm & 1) la_pass_c<true>(F, layer, 256 + ((it - 1032) >> 3), 1, (it - 1032) & 7, dry); }
        else { if (mm & 2) la_pass_c<false>(F, layer, 256 + ((it - 1096) >> 2), 1, (it - 1096) & 3, dry); }
        __syncthreads();
    }
}
DI void phase_ssd_norm(const Ctx& F, int layer, bool dry) {
    const int gw = F.vcu * NWAVES + F.wave, NGW = F.G * NWAVES; bf16_t* proj = wsb(F, WS_R); const float* pss = wsf(F, WS_PSS);
    float gn[8]; { const float* gp = F.in[I_SNORM] + layer * 512 + 8 * F.lane; const f32x4 a = *(const f32x4*)gp, b = *(const f32x4*)(gp + 4); gn[0] = a.x; gn[1] = a.y; gn[2] = a.z; gn[3] = a.w; gn[4] = b.x; gn[5] = b.y; gn[6] = b.z; gn[7] = b.w; }
    for (int m = gw; m < M; m += NGW) {
        const f32x4* p = (const f32x4*)(pss + (size_t)m * 16); const f32x4 a = p[0], b = p[1], c = p[2], d = p[3];
        const float s = ((a.x + a.y) + (a.z + a.w)) + ((b.x + b.y) + (b.z + b.w)) + ((c.x + c.y) + (c.z + c.w)) + ((d.x + d.y) + (d.z + d.w));
        const float rstd = rsqrtf(s * (1.f / 512.f) + EPS);
        u32x4* yp = (u32x4*)(proj + (size_t)m * DINP + PC_CZ + 8 * F.lane); float v[8]; unpack8(*yp, v);
#pragma unroll
        for (int e = 0; e < 8; ++e) v[e] *= rstd * gn[e];
        *yp = pack8(v);
    }
}
DI void phase_final(const Ctx& F) {
    const int gw = F.vcu * NWAVES + F.wave, NGW = F.G * NWAVES; const float* rss = wsf(F, WS_RSSN) + (size_t)XB_PAD * 16; const float* gf = F.in[I_NFIN]; const bf16_t* xs = wsb(F, WS_XBN);
    for (int m = gw; m < M; m += NGW) { const float rs = row_rstd(rss, m); f32x4* y4 = (f32x4*)(F.out + (size_t)m * D) + F.lane; const u32x2* x2 = (const u32x2*)(xs + (size_t)m * D) + F.lane;
#pragma unroll
        for (int j = 0; j < 4; ++j) { const f32x4 g = *((const f32x4*)gf + F.lane + 64 * j); const u32x2 xw = x2[64 * j];
            f32x4 y; y[0] = __uint_as_float(xw.x << 16) * rs * g[0]; y[1] = __uint_as_float(xw.x & 0xffff0000u) * rs * g[1]; y[2] = __uint_as_float(xw.y << 16) * rs * g[2]; y[3] = __uint_as_float(xw.y & 0xffff0000u) * rs * g[3];
            y4[64 * j] = y; } }
}

constexpr int PH_PER_LAYER = 9, N_PHASES = 1 + DEPTH * PH_PER_LAYER + 1;
__global__ void __launch_bounds__(NWAVES * 64, 2) mk_fwd(Args args) {
    extern __shared__ __attribute__((aligned(16))) unsigned char lds_raw[];
    Ctx F; F.lds = (LAS unsigned char*)lds_raw; F.in = args.in; F.out = args.out; F.ws = args.ws;
    F.wave = __builtin_amdgcn_readfirstlane((int)threadIdx.x >> 6); F.lane = 0; F.tid = 0;
#define T0() (F.wave == 0 && lane_id() == 0)
    F.G = gridDim.x; { const int bx = blockIdx.x; F.vcu = (F.G % 8 == 0) ? (bx % 8) * (F.G / 8) + bx / 8 : bx; }
    volatile LAS unsigned* MISC = (volatile LAS unsigned*)(F.lds + MISC_OFF);
    if (F.wave == 0) MISC[lane_id()] = 0u;
    __syncthreads();
    XcdBarrier bar; bar.bar = (unsigned*)(args.ws + WS_CTL); bar.x = 0; bar.st = nullptr;
    if (args.use_bar) bar = xcd_barrier_post((unsigned*)(args.ws + WS_CTL), MISC + 8, T0());
    const int lo = args.ph_lo, hi = args.ph_hi;
#ifndef PH_MASK
#define PH_MASK 0xFFFFu
#endif
#define IN(k) (lo <= (k) && (k) < hi)
#define ON(b) ((PH_MASK >> (b)) & 1u)
#define SEAM(k) do { if (IN(k) && IN((k) + 1)) xcd_barrier(bar, T0()); } while (0)
#ifndef REP_MASK
#define REP_MASK 0
#endif
#define REPS(b) ((REP_MASK >> (b)) & 1)
#define XBAR() do { if (args.use_bar) xcd_barrier(bar, T0()); } while (0)
#define GP bf16_t* XB = wsb(C, WS_XB) + (size_t)XB_PAD * D; float* RSS = wsf(C, WS_RSS) + (size_t)XB_PAD * 16; bf16_t* XBN = (bf16_t*)C.out; bf16_t* XBNO = layer + 1 < DEPTH ? (bf16_t*)C.out : wsb(C, WS_XBN); float* RSSN = wsf(C, WS_RSSN) + (size_t)XB_PAD * 16; \
    (void)XB; (void)RSS; (void)XBN; (void)XBNO; (void)RSSN
#define PHC Ctx C = F; C.lane = lane_id(); C.tid = C.wave * 64 + C.lane; OPAQUE_CTX(C); { size_t zz_ = 0; asm volatile("" : "+s"(zz_)); C.ws = F.ws + zz_; C.out = (float*)((char*)F.out + zz_); }
    PB(100);
    for (int rr_ = 0; rr_ <= REPS(0); ++rr_) { if (IN(0) && ON(0)) { PHC; convert_set(C, 0, 1 | 2 | 4 | 8 | 16 | 32 | 64 | 128, C.vcu, C.G); p0_rows(C); } if (rr_ < REPS(0)) XBAR(); }
    PE(100); PB(120); SEAM(0); PE(120);
    for (int layer = 0; layer < DEPTH; ++layer) {
        const int pb = 1 + layer * PH_PER_LAYER;
        PB(101);
        for (int rr_ = 0; rr_ <= REPS(1); ++rr_) { if (rr_) XBAR();
        if (IN(pb + 0) && ON(1)) { PHC; GP;
            pg8::Gemm g{XBN, wsb(C, WS_WIN), D, D, D}; pg8::StaticOrder S; S.init(M / 256, DINP / 256, C.G, (int)blockIdx.x, 0);
            EpiProj E{wsb(C, WS_R), RSSN}; pg8::gemm_phase<EpiProj, pg8::StaticOrder>(C.lds, g, S, E, C.wave);
            if (layer >= 1 && rr_ == 0 && C.G == 256 && (int)blockIdx.x >= 98) { __syncthreads(); convert_set(C, layer, 2 | 4 | 8 | 16 | 32 | 64, (int)blockIdx.x - 98, C.G - 98); }
            else if (layer >= 1 && rr_ == 0 && C.G != 256) { __syncthreads(); convert_set(C, layer, 2 | 4 | 8 | 16 | 32 | 64, C.vcu, C.G); }
        } }
        PE(101); PB(120); PB(121); SEAM(pb + 0); PE(121); PE(120); PB(102);
        for (int rr_ = 0; rr_ <= REPS(2); ++rr_) { if (rr_) XBAR(); if (IN(pb + 1) && ON(2)) { PHC; phase_mixer_a(C, layer); } }
        PE(102); PB(120); PB(123); SEAM(pb + 1); PE(123); PE(120); PB(103);
        for (int rr_ = 0; rr_ <= REPS(3); ++rr_) { if (rr_) XBAR();
        if (IN(pb + 2) && ON(3)) { PHC; phase_mixer_b(C, layer, rr_ < REPS(3));
            if (layer + 1 < DEPTH) convert_set(C, layer + 1, 1, C.vcu, C.G); } }
        PE(103); PB(120); PB(122); SEAM(pb + 2); PE(122); PE(120); PB(104);
        for (int rr_ = 0; rr_ <= REPS(4); ++rr_) { if (rr_) XBAR(); if (IN(pb + 3) && ON(4)) { PHC; phase_mixer_c(C, layer, rr_ < REPS(4)); } }
        PE(104); PB(120); PB(124); SEAM(pb + 3); PE(124); PE(120); PB(105);
        for (int rr_ = 0; rr_ <= REPS(5); ++rr_) { if (rr_) XBAR(); if (IN(pb + 4) && ON(5)) { PHC; phase_ssd_norm(C, layer, rr_ < REPS(5)); } }
        PE(105); PB(120); SEAM(pb + 4); PE(120); PB(106);
        for (int rr_ = 0; rr_ <= REPS(6); ++rr_) { if (rr_) XBAR(); const bool dry_ = rr_ < REPS(6);
        if (IN(pb + 5) && ON(6)) { PHC; GP;
            pg8::Gemm g{wsb(C, WS_R) + PC_Y, wsb(C, WS_WOUT), DINP, DMIX, DMIX}; pg8::StaticOrder S; S.init(MP / 256, D / 256, C.G, (int)blockIdx.x, 0);
            EpiRes E{XBN, XB, RSS, dry_};
            pg8::gemm_phase<EpiRes, pg8::StaticOrder>(C.lds, g, S, E, C.wave);
            { constexpr int SK = 6, KS = DMIX / SK; const int c = (int)blockIdx.x, j = c / SK, sl = c % SK;
              pg8::Gemm g2{wsb(C, WS_R) + PC_Y + sl * KS, wsb(C, WS_WOUT) + sl * KS, DINP, DMIX, KS}; OneUnit S2{64 + (j >> 2), j & 3, c < 8 * SK};
              EpiPart E2{C.out + (size_t)M * D / 2 + (size_t)(c < 8 * SK ? c : 0) * 65536}; pg8::gemm_phase<EpiPart, OneUnit>(C.lds, g2, S2, E2, C.wave); }
        } }
        XBAR();
        if (IN(pb + 5) && ON(6)) { PHC; GP; reduce_tail<0>(C, C.out + (size_t)M * D / 2, 6, XBN, XB, RSS, RSS, nullptr); }
        PE(106); PB(120); SEAM(pb + 5); PE(120); PB(107);
        for (int rr_ = 0; rr_ <= REPS(7); ++rr_) { if (rr_) XBAR();
        if (IN(pb + 6) && ON(7)) { PHC; GP;
            pg8::Gemm g{XB, wsb(C, WS_WGU), D, D, D}; pg8::StaticOrder S; S.init(67, 2 * DFF / 256, C.G, (int)blockIdx.x, 1);
            EpiFfn E{wsb(C, WS_R), RSS, C.in[I_FCW] + (size_t)layer * 3 * DFF, C.in[I_FCB] + layer * DFF, C.in[I_SFC] + (size_t)layer * 8 * 2 * DFF,
                     C.out + O_PFC + (size_t)layer * 2 * 2 * DFF, C.out + O_SFC + (size_t)layer * 8 * 2 * DFF};
            pg8::gemm_phase<EpiFfn, pg8::StaticOrder>(C.lds, g, S, E, C.wave);
            if (rr_ == 0) { const int sh = C.G == 256 ? 72 : 0;
                if ((int)blockIdx.x >= sh) { pg8::Gemm g2{wsb(C, WS_PB), wsb(C, WS_WPP), DPLE, DPLE, DPLE}; pg8::StaticOrder S2; S2.init(M / 256, D / 256, C.G - sh, (int)blockIdx.x - sh, 0);
                    EpiPP E2{wsb(C, WS_PPO)}; pg8::gemm_phase<EpiPP, pg8::StaticOrder>(C.lds, g2, S2, E2, C.wave); } }
        } }
        PE(107); PB(120); SEAM(pb + 6); PE(120); PB(108);
        for (int rr_ = 0; rr_ <= REPS(8); ++rr_) { if (rr_) XBAR(); const bool dry_ = rr_ < REPS(8);
        if (IN(pb + 7) && ON(8)) { PHC; GP;
            pg8::Gemm g{wsb(C, WS_R), wsb(C, WS_WD), DFF, DFF, DFF}; pg8::StaticOrder S; S.init(MP / 256, D / 256, C.G, (int)blockIdx.x, 0);
            EpiRes E{XB, XB, RSS, dry_}; pg8::gemm_phase<EpiRes, pg8::StaticOrder>(C.lds, g, S, E, C.wave);
            { constexpr int SK = 12, KS = DFF / SK; const int c = (int)blockIdx.x, j = c / SK, sl = c % SK;
              pg8::Gemm g2{wsb(C, WS_R) + sl * KS, wsb(C, WS_WD) + sl * KS, DFF, DFF, KS}; OneUnit S2{64 + (j >> 2), j & 3, c < 8 * SK};
              EpiPart E2{C.out + (size_t)M * D / 2 + (size_t)(c < 8 * SK ? c : 0) * 65536}; pg8::gemm_phase<EpiPart, OneUnit>(C.lds, g2, S2, E2, C.wave); }
        } }
        XBAR();
        if (IN(pb + 7) && ON(8)) { PHC; GP; reduce_tail<0>(C, C.out + (size_t)M * D / 2, 12, XB, XB, RSS, RSS, nullptr); }
        PE(108); PB(120); SEAM(pb + 7); PE(120); PB(109);
        for (int rr_ = 0; rr_ <= REPS(9); ++rr_) { if (rr_) XBAR(); const bool dry_ = rr_ < REPS(9);
        if (IN(pb + 8) && ON(9)) { PHC; GP;
            pg8::Gemm g{XB, wsb(C, WS_WPG), D, D, D}; pg8::StaticOrder S; S.init(MP / 256, D / 256, C.G, (int)blockIdx.x, 0);
            EpiPle E{XB, XBNO, RSS, RSSN, wsb(C, WS_PPO), dry_}; pg8::gemm_phase<EpiPle, pg8::StaticOrder>(C.lds, g, S, E, C.wave);
            { constexpr int SK = 4, KS = D / SK; const int c = (int)blockIdx.x, j = c / SK, sl = c % SK;
              pg8::Gemm g2{XB + sl * KS, wsb(C, WS_WPG) + sl * KS, D, D, KS}; OneUnit S2{64 + (j >> 2), j & 3, c < 8 * SK};
              EpiPart E2{C.out + (size_t)M * D / 2 + (size_t)(c < 8 * SK ? c : 0) * 65536}; pg8::gemm_phase<EpiPart, OneUnit>(C.lds, g2, S2, E2, C.wave); }
        } }
        XBAR();
        if (IN(pb + 8) && ON(9)) { PHC; GP; reduce_tail<1>(C, C.out + (size_t)M * D / 2, 4, XB, XBNO, RSS, RSSN, wsb(C, WS_PPO)); }
        PE(109); PB(120); SEAM(pb + 8); PE(120); PB(110);
    }
    PB(111);
    if (IN(N_PHASES - 1) && ON(10)) { PHC; phase_final(C); }
    PE(111);
    if (PROBE_ID != 0 && (int)blockIdx.x == PROBE_WG) { __syncthreads(); if (F.wave == 0) { const unsigned tot = MISC[32] * PROBE_MULT; const unsigned t0 = (unsigned)__builtin_amdgcn_s_memrealtime();
        while ((unsigned)__builtin_amdgcn_s_memrealtime() - t0 < tot) __builtin_amdgcn_s_sleep(8); } }
#undef IN
#undef ON
#undef SEAM
}

extern "C" void kernel_launch(void* const* d_in, const int* in_sizes, int n_in, void* d_out, int out_size, void* d_ws, size_t ws_size, hipStream_t stream) {
    static int grid = 0;
    if (grid == 0) {
        if (n_in != N_IN || (size_t)out_size != O_END || ws_size < WS_END) { fprintf(stderr, "kernel_launch: unexpected shapes: n_in %d out %d ws %zu (need %d, %zu, %zu)\n", n_in, out_size, ws_size, (int)N_IN, (size_t)O_END, (size_t)WS_END); grid = -1; return; }
        int dev = 0, cus = 0, per_cu = 0;
        if (hipGetDevice(&dev) != hipSuccess || hipDeviceGetAttribute(&cus, hipDeviceAttributeMultiprocessorCount, dev) != hipSuccess) { grid = -1; return; }
        if (hipFuncSetAttribute((const void*)mk_fwd, hipFuncAttributeMaxDynamicSharedMemorySize, LDS_BYTES) != hipSuccess) { fprintf(stderr, "kernel_launch: hipFuncSetAttribute failed\n"); grid = -1; return; }
        if (hipOccupancyMaxActiveBlocksPerMultiprocessor(&per_cu, (const void*)mk_fwd, NWAVES * 64, LDS_BYTES) != hipSuccess || per_cu < 1) { fprintf(stderr, "kernel_launch: occupancy query says %d\n", per_cu); per_cu = 1; }
        (void)hipGetLastError();
        grid = cus;
    }
    if (grid < 0) return;
    (void)hipMemsetAsync((char*)d_ws + WS_CTL, 0, CTL_ZERO_BYTES, stream);
    Args a{};
    for (int i = 0; i < N_IN; ++i) a.in[i] = (const float*)d_in[i];
    a.out = (float*)d_out; a.ws = (unsigned char*)d_ws;
#if MK_PER_PHASE
    for (int p = 0; p < N_PHASES; ++p) { a.ph_lo = p; a.ph_hi = p + 1; a.use_bar = 0; hipLaunchKernelGGL(mk_fwd, dim3(grid), dim3(NWAVES * 64), LDS_BYTES, stream, a); }
#else
    a.ph_lo = 0; a.ph_hi = N_PHASES; a.use_bar = 1;
    void* kargs[] = {&a};
    hipError_t e = hipLaunchCooperativeKernel((const void*)mk_fwd, dim3(grid), dim3(NWAVES * 64), kargs, LDS_BYTES, stream);
    if (e != hipSuccess) fprintf(stderr, "kernel_launch: cooperative launch failed: %s\n", hipGetErrorString(e));
#endif
}
```

```cpp
#include <hip/hip_runtime.h>
#include <cstdio>
#include <cstdint>

#define DI __device__ __forceinline__
#define LAS __attribute__((address_space(3)))
typedef unsigned short bf16_t;
typedef short bf16x8 __attribute__((ext_vector_type(8)));
typedef short s16x4 __attribute__((ext_vector_type(4)));
typedef float f32x4 __attribute__((ext_vector_type(4)));
typedef float f32x2 __attribute__((ext_vector_type(2)));
typedef unsigned u32x4 __attribute__((ext_vector_type(4)));
typedef unsigned u32x2 __attribute__((ext_vector_type(2)));

#ifndef MK_PER_PHASE
#define MK_PER_PHASE 0
#endif

constexpr int DEPTH = 2, D = 1024, MP = 16384, MS = 512, M = MP + MS;
constexpr int DIN = 4120, DINP = 4352, DFF = 3072, DMIX = 1536, DPLE = 256;
constexpr int NCH = M / 64;
constexpr float EPS = 1e-6f;
constexpr int PC_AX = 0, PC_BQ = 512, PC_BK = 768, PC_BV = 1024, PC_BLR = 1536, PC_XBC = 1552, PC_DT = 2576, PC_PAD = 2584, PC_Y = 2816, PC_AG = 2816, PC_BG = 3328, PC_CZ = 3840;

enum { I_XP = 0, I_XS, I_SLC, I_SLH, I_SG, I_SSC, I_SS, I_SFC, I_PP, I_PS, I_NMIX, I_WIN, I_LCW, I_LCB, I_LWR, I_LBR, I_LWI, I_LBI, I_LAM, I_GWLR, I_GBLR, I_GNORM,
       I_SCW, I_SCB, I_SDTB, I_SALOG, I_SD, I_SNORM, I_WOUT, I_NFFN, I_WG, I_WU, I_FCW, I_FCB, I_WD, I_NPLE, I_PWG, I_PWP, I_NFIN, N_IN };
constexpr size_t O_Y = 0;
constexpr size_t O_PLC = (size_t)M * D;
constexpr size_t O_PLH = O_PLC + 2 * 2 * 3 * 512;
constexpr size_t O_PG = O_PLH + 2 * 2 * 512;
constexpr size_t O_PSC = O_PG + 2 * 2 * 4 * 64 * 128;
constexpr size_t O_PS = O_PSC + 2 * 2 * 3 * 1024;
constexpr size_t O_PFC = O_PS + 2 * 2 * 8 * 64 * 128;
constexpr size_t O_SLC = O_PFC + 2 * 2 * 2 * 3072;
constexpr size_t O_SLH = O_SLC + 2 * 8 * 3 * 512;
constexpr size_t O_SG = O_SLH + 2 * 8 * 512;
constexpr size_t O_SSC = O_SG + 2 * 8 * 4 * 64 * 128;
constexpr size_t O_SS = O_SSC + 2 * 8 * 3 * 1024;
constexpr size_t O_SFC = O_SS + 2 * 8 * 8 * 64 * 128;
constexpr size_t O_END = O_SFC + 2 * 8 * 2 * 3072;

constexpr size_t MiB = 1u << 20;
constexpr size_t al4k(size_t x) { return (x + 4095) & ~(size_t)4095; }
constexpr int XB_PAD = 256;
constexpr int XB_ROWS = XB_PAD + M + 128;
constexpr size_t WS_CTL = 0, CTL_ZERO_BYTES = 64 * 1024;
constexpr size_t WS_WIN = al4k(WS_CTL + CTL_ZERO_BYTES);
constexpr size_t WS_WOUT = al4k(WS_WIN + (size_t)DINP * D * 2);
constexpr size_t WS_WGU = al4k(WS_WOUT + (size_t)D * DMIX * 2);
constexpr size_t WS_WD = al4k(WS_WGU + (size_t)2 * DFF * D * 2);
constexpr size_t WS_WPG = al4k(WS_WD + (size_t)D * DFF * 2);
constexpr size_t WS_WPP = al4k(WS_WPG + (size_t)D * D * 2);
constexpr size_t WS_LRUW = al4k(WS_WPP + (size_t)D * DPLE * 2);
constexpr size_t WS_RSS = al4k(WS_LRUW + (size_t)DEPTH * 2 * 8 * 4096 * 2);
constexpr size_t WS_RSSN = al4k(WS_RSS + (size_t)XB_ROWS * 64);
constexpr size_t WS_PSS = al4k(WS_RSSN + (size_t)XB_ROWS * 64);
constexpr size_t WS_LRUS = al4k(WS_PSS + (size_t)M * 64);
constexpr size_t WS_DEC = al4k(WS_LRUS + (size_t)3 * NCH * 512 * 4);
constexpr size_t WS_PB = al4k(WS_DEC + (size_t)(64 * 4 * 64 + 64 * 8) * 4);
constexpr size_t WS_XB = al4k(WS_PB + (size_t)M * DPLE * 2);
constexpr size_t WS_DS = al4k(WS_XB + (size_t)XB_ROWS * D * 2);
constexpr size_t WS_XBN = WS_DS;
constexpr size_t WS_R = al4k(WS_DS + (size_t)M * D * 2);
constexpr size_t WS_PPO = WS_R + 100 * MiB;
constexpr size_t WS_END = WS_R + (size_t)M * DINP * 2;
static_assert(WS_END <= 256 * MiB, "workspace");
static_assert((size_t)64 * 12 * 8192 * 4 <= (size_t)M * D * 2, "DS fits the XBN slot");
static_assert((size_t)M * DFF * 2 <= 100 * MiB && WS_PPO + (size_t)M * D * 2 <= WS_END, "overlay");

constexpr int MISC_OFF = 147456 + 4096;
DI float bf2f(bf16_t b) { return __uint_as_float(((unsigned)b) << 16); }
DI unsigned f2bf(float f) { unsigned u = __float_as_uint(f); return (u + 0x7fffu + ((u >> 16) & 1u)) >> 16; }
DI unsigned pk2(float lo, float hi) { return f2bf(lo) | (f2bf(hi) << 16); }
DI float sigm(float x) { return __builtin_amdgcn_rcpf(1.f + __expf(-x)); }
DI float silu_f(float x) { return x * __builtin_amdgcn_rcpf(1.f + __expf(-x)); }
DI float gelu_t(float x) { const float u = 1.5957691216f * (x + 0.044715f * x * x * x); return x * __builtin_amdgcn_rcpf(1.f + __expf(-u)); }
DI float softplus_f(float x) { return fmaxf(x, 0.f) + log1pf(__expf(-fabsf(x))); }
DI float logsig_f(float x) { return fminf(x, 0.f) - log1pf(__expf(-fabsf(x))); }
template <int CTRL> DI float dpp_ror(float x) { return __builtin_bit_cast(float, __builtin_amdgcn_update_dpp(0, __builtin_bit_cast(int, x), CTRL, 0xf, 0xf, false)); }
DI float log1p_small(float e) { return e < 0.01f ? e * (1.f - e * (0.5f - e * 0.33333334f)) : __logf(1.f + e); }
DI float softplus_fast(float x) { return fmaxf(x, 0.f) + log1p_small(__expf(-fabsf(x))); }
DI float logsig_fast(float x) { return fminf(x, 0.f) - __logf(1.f + __expf(-fabsf(x))); }
DI float wave_incl_scan(float v) {
#define DPPF(x, ctrl, rm, bc) __builtin_bit_cast(float, __builtin_amdgcn_update_dpp(0, __builtin_bit_cast(int, (x)), (ctrl), (rm), 0xf, (bc)))
    v += DPPF(v, 0x111, 0xf, true); v += DPPF(v, 0x112, 0xf, true); v += DPPF(v, 0x114, 0xf, true); v += DPPF(v, 0x118, 0xf, true);
    v += DPPF(v, 0x142, 0xa, false); v += DPPF(v, 0x143, 0xc, false);
#undef DPPF
    return v;
}
DI void unpack8(const u32x4 v, float (&o)[8]) {
#pragma unroll
    for (int i = 0; i < 4; ++i) { o[2 * i] = __uint_as_float(v[i] << 16); o[2 * i + 1] = __uint_as_float(v[i] & 0xffff0000u); }
}
DI u32x4 pack8(const float (&o)[8]) { u32x4 r; r.x = pk2(o[0], o[1]); r.y = pk2(o[2], o[3]); r.z = pk2(o[4], o[5]); r.w = pk2(o[6], o[7]); return r; }
DI int lane_id() { int l; asm volatile("v_mbcnt_lo_u32_b32 %0, -1, 0\n\tv_mbcnt_hi_u32_b32 %0, -1, %0" : "=v"(l)); return l; }
#define LDS_WAIT() asm volatile("s_waitcnt lgkmcnt(0)" ::: "memory")
#define VM_WAIT() asm volatile("s_waitcnt vmcnt(0)" ::: "memory")

namespace pg8 {
constexpr int BM = 256, BK = 64, HALF = 128, HTB = HALF * BK * 2, STAGE_BYTES = 8 * HTB, NXCD = 8, WGM = 8;
__host__ __device__ __forceinline__ int lds_byte(int r, int c) { const int st = (r >> 4) * 2 + (c >> 5), rr = r & 15, cc = c & 31, ob = rr * 64 + cc * 2; return st * 1024 + (ob ^ (((ob >> 9) & 1) << 5)); }
__host__ __device__ __forceinline__ void stage_rc(int b, int& R, int& C) { const int st = b / 1024, sb = b % 1024, swz = sb ^ (((sb >> 9) & 1) << 5); R = (st >> 1) * 16 + swz / 64; C = (st & 1) * 32 + (swz % 64) / 2; }
__host__ __device__ __forceinline__ int perm32(int rho) { const int n = rho >> 4, i = rho & 15; return 8 * (i >> 2) + 4 * n + (i & 3); }

struct Unit { int pm, pn, arow; };
struct Gemm { const bf16_t* A; const bf16_t* Bt; int lda, ldb, K; };

struct StaticOrder {
    int nM, nN, nwg, G, c, shifted;
    __device__ void init(int nM_, int nN_, int G_, int c_, int shifted_) { nM = nM_; nN = nN_; nwg = nM * nN; G = G_; c = c_; shifted = shifted_; }
    __device__ bool next(int i, Unit& u) const {
        const long L = (long)i * G + c; if (L >= nwg) return false;
        int wgid = (int)L; { const int q = nwg / NXCD, r = nwg % NXCD, xcd = wgid % NXCD, off = wgid / NXCD; wgid = (xcd < r ? xcd * (q + 1) : r * (q + 1) + (xcd - r) * q) + off; }
        const int nig = WGM * nN, gid = wgid / nig, fm = gid * WGM, gsz = (nM - fm) < WGM ? (nM - fm) : WGM;
        u.pm = fm + ((wgid % nig) % gsz); u.pn = (wgid % nig) / gsz; u.arow = shifted ? 254 * u.pm - 2 : 256 * u.pm; return true;
    }
};
typedef __bf16 bf16x2_t __attribute__((ext_vector_type(2)));
DI unsigned cvt_pk_bf16(float lo, float hi) { const f32x2 v = {lo, hi}; const bf16x2_t r = __builtin_convertvector(v, bf16x2_t); return __builtin_bit_cast(unsigned, r); }

template <class Epi, class Sched>
DI void gemm_phase(LAS unsigned char* lds, const Gemm g, const Sched& S, const Epi& E, int wid) {
    const int lane = lane_id(), tid = wid * 64 + lane, wr = wid >> 2, wc = wid & 3, fr = lane & 15, fq = lane >> 4;
    const int K = g.K, nt = K / BK;
    unsigned voffA[2], voffB[2];
#pragma unroll
    for (int i = 0; i < 2; ++i) { int R, C; stage_rc(tid * 16 + i * 8192, R, C); const int Rb = Epi::PERM ? ((R & ~31) + perm32(R & 31)) : R;
        voffA[i] = (unsigned)(R * g.lda + C) * 2u; voffB[i] = (unsigned)(Rb * g.ldb + C) * 2u; }
    const size_t kstep = (size_t)(BK * 2);
    const size_t hstepA = (size_t)HALF * g.lda * 2, hstepB = (size_t)HALF * g.ldb * 2;
    const unsigned ldsw = (unsigned)wid * 1024u;
    const int aoff = lds_byte(wr * 64 + fr, fq * 8), boff = lds_byte(wc * 32 + fr, fq * 8);
#define PG8_SA(b, h) (((b) * 2 + (h)) * HTB)
#define PG8_SB(b, h) ((4 + (b) * 2 + (h)) * HTB)
#define PG8_STAGE(bufoff, gbase, voff) do { _Pragma("unroll") for (int _i = 0; _i < 2; ++_i) \
        __builtin_amdgcn_global_load_lds((const unsigned*)((const char*)(gbase) + (voff)[_i]), (LAS unsigned*)(lds + (bufoff) + ldsw + _i * 8192), 16, 0, 0); } while (0)
#define PG8_LDA(dst, b, h) do { _Pragma("unroll") for (int m = 0; m < 4; ++m) _Pragma("unroll") for (int k = 0; k < 2; ++k) dst[m][k] = *(const LAS bf16x8*)(lds + PG8_SA(b, h) + aoff + m * 2048 + k * 1024); } while (0)
#define PG8_LDB(dst, b, h) do { _Pragma("unroll") for (int n = 0; n < 2; ++n) _Pragma("unroll") for (int k = 0; k < 2; ++k) dst[n][k] = *(const LAS bf16x8*)(lds + PG8_SB(b, h) + boff + n * 2048 + k * 1024); } while (0)
#define PG8_MMA(ai, bj, At, Bt) do { __builtin_amdgcn_s_setprio(1); _Pragma("unroll") for (int m = 0; m < 4; ++m) _Pragma("unroll") for (int n = 0; n < 2; ++n) _Pragma("unroll") for (int k = 0; k < 2; ++k) \
        acc[ai][bj][m][n] = __builtin_amdgcn_mfma_f32_16x16x32_bf16(Bt[n][k], At[m][k], acc[ai][bj][m][n], 0, 0, 0); __builtin_amdgcn_s_setprio(0); } while (0)
#define PG8_WAIT_V(n) asm volatile("s_waitcnt vmcnt(" #n ")" ::: "memory")
#define PG8_WAIT_L(n) asm volatile("s_waitcnt lgkmcnt(" #n ")" ::: "memory")
#define PG8_BAR __builtin_amdgcn_s_barrier()
#define PG8_SCHED __builtin_amdgcn_sched_barrier(0)
    Unit cur, nxt; int ui = 0;
    if (!S.next(0, cur)) return;
    f32x4 acc[2][2][4][2];
#pragma unroll
    for (int a = 0; a < 2; ++a)
#pragma unroll
        for (int b = 0; b < 2; ++b)
#pragma unroll
            for (int m = 0; m < 4; ++m)
#pragma unroll
                for (int n = 0; n < 2; ++n) acc[a][b][m][n] = (f32x4){0.f, 0.f, 0.f, 0.f};
    bf16x8 At[4][2], B0[2][2], B1[2][2];
    const char* cA = (const char*)g.A + (long)cur.arow * g.lda * 2; const char* cB = (const char*)g.Bt + (size_t)cur.pn * 256 * g.ldb * 2;
    PG8_STAGE(PG8_SB(0, 0), cB, voffB); PG8_STAGE(PG8_SB(0, 1), cB + hstepB, voffB); PG8_STAGE(PG8_SA(0, 0), cA, voffA); PG8_STAGE(PG8_SA(0, 1), cA + hstepA, voffA);
    if (wr == 1) PG8_BAR;
    PG8_WAIT_V(2); PG8_BAR;
    PG8_STAGE(PG8_SB(1, 0), cB + kstep, voffB); PG8_STAGE(PG8_SA(1, 0), cA + kstep, voffA); PG8_STAGE(PG8_SB(1, 1), cB + hstepB + kstep, voffB);
    PG8_WAIT_V(6); PG8_BAR;
    for (;;) {
        const bool has_next = S.next(ui + 1, nxt);
        const char* nA = has_next ? (const char*)g.A + (long)nxt.arow * g.lda * 2 : cA; const char* nB = has_next ? (const char*)g.Bt + (size_t)nxt.pn * 256 * g.ldb * 2 : cB;
#pragma unroll 1
        for (int t = 0; t < nt; t += 2) {
            const bool last = (t == nt - 2);
            const char* a1 = cA + (size_t)(t + 1) * kstep;
            const char* a2 = last ? nA : cA + (size_t)(t + 2) * kstep; const char* b2 = last ? nB : cB + (size_t)(t + 2) * kstep;
            const char* a3 = a2 + kstep; const char* b3 = b2 + kstep;
            PG8_LDB(B0, 0, 0); PG8_LDB(B1, 0, 1); PG8_SCHED; PG8_LDA(At, 0, 0); PG8_STAGE(PG8_SA(1, 1), a1 + hstepA, voffA);
            PG8_WAIT_V(8); PG8_WAIT_L(0); PG8_BAR; PG8_MMA(0, 0, At, B0); PG8_MMA(0, 1, At, B1); PG8_BAR; PG8_SCHED;
            PG8_LDA(At, 0, 1); PG8_STAGE(PG8_SB(0, 0), b2, voffB); PG8_STAGE(PG8_SB(0, 1), b2 + hstepB, voffB); PG8_STAGE(PG8_SA(0, 0), a2, voffA);
            PG8_WAIT_V(8); PG8_WAIT_L(0); PG8_BAR; PG8_MMA(1, 0, At, B0); PG8_MMA(1, 1, At, B1); PG8_BAR; PG8_SCHED;
            PG8_LDB(B0, 1, 0); PG8_LDB(B1, 1, 1); PG8_SCHED; PG8_LDA(At, 1, 0); PG8_STAGE(PG8_SA(0, 1), a2 + hstepA, voffA);
            PG8_WAIT_V(8); PG8_WAIT_L(0); PG8_BAR; PG8_MMA(0, 0, At, B0); PG8_MMA(0, 1, At, B1); PG8_BAR; PG8_SCHED;
            PG8_LDA(At, 1, 1); PG8_STAGE(PG8_SB(1, 0), b3, voffB); PG8_STAGE(PG8_SB(1, 1), b3 + hstepB, voffB); PG8_STAGE(PG8_SA(1, 0), a3, voffA);
            PG8_WAIT_V(8); PG8_WAIT_L(0); PG8_BAR; PG8_MMA(1, 0, At, B0); PG8_MMA(1, 1, At, B1); PG8_BAR; PG8_SCHED;
        }
        if (wr == 0) PG8_BAR;
        { const int l2 = lane_id(); E(acc, cur, wr, wc, l2 & 15, l2 >> 4, lds); }
        if (!has_next) break;
#pragma unroll
        for (int a = 0; a < 2; ++a)
#pragma unroll
            for (int b = 0; b < 2; ++b)
#pragma unroll
                for (int m = 0; m < 4; ++m)
#pragma unroll
                    for (int n = 0; n < 2; ++n) acc[a][b][m][n] = (f32x4){0.f, 0.f, 0.f, 0.f};
        cur = nxt; cA = nA; cB = nB; ++ui;
        if (wr == 1) PG8_BAR;
    }
    PG8_WAIT_V(0);
    PG8_BAR;
#undef PG8_SA
#undef PG8_SB
#undef PG8_STAGE
#undef PG8_LDA
#undef PG8_LDB
#undef PG8_MMA
#undef PG8_WAIT_V
#undef PG8_WAIT_L
#undef PG8_BAR
#undef PG8_SCHED
}
}

#define XB_TMO      128
#define XB_XCNT(j)  (256  + 64 * (j))
#define XB_XSUB(j)  (1280 + 64 * (j))
#define XB_XGEN(j)  (2304 + 64 * (j))
#define XB_TOP      3328
#define XB_TOPGEN   3392
#define XCD_BAR_WORDS 3456
#define XB_SPIN_CAP (1u << 18)
DI unsigned xb_ld(unsigned* p)              { return __hip_atomic_load(p, __ATOMIC_RELAXED, __HIP_MEMORY_SCOPE_AGENT); }
DI unsigned xb_add(unsigned* p, unsigned v) { return __hip_atomic_fetch_add(p, v, __ATOMIC_RELAXED, __HIP_MEMORY_SCOPE_AGENT); }
DI unsigned xb_xcc_id() { return (unsigned)__builtin_amdgcn_s_getreg((3 << 11) | 20) & 0xFu; }
#define XB_SPIN(cond, bar) do { unsigned _sp = 0; while (cond) { __builtin_amdgcn_s_sleep(1); \
    if ((++_sp & 255u) == 0u) { if (xb_ld(&(bar)[XB_TMO])) break; if (_sp > XB_SPIN_CAP) { atomicAdd(&(bar)[XB_TMO], 1u); break; } } } } while (0)
struct XcdBarrier { unsigned* bar; unsigned x; volatile LAS unsigned* st; };
DI XcdBarrier xcd_barrier_post(unsigned* bar, volatile LAS unsigned* st, bool t0) {
    XcdBarrier b; b.bar = bar; b.x = xb_xcc_id(); b.st = st;
    if (t0) (void)xb_add(&bar[XB_XCNT(b.x)], 1u);
    return b;
}
DI void xcd_barrier_complete(unsigned* bar, unsigned x, unsigned& nloc, unsigned& nx) {
    const unsigned G = gridDim.x * gridDim.y * gridDim.z;
    unsigned sum, cnt, mine, sp = 0u;
    for (;;) {
        sum = 0u; cnt = 0u; mine = 0u;
#pragma unroll
        for (unsigned j = 0; j < 16; ++j) { const unsigned c = xb_ld(&bar[XB_XCNT(j)]); sum += c; cnt += (c > 0u) ? 1u : 0u; mine = (j == x) ? c : mine; }
        if (sum == G) break;
        __builtin_amdgcn_s_sleep(1);
        if ((++sp & 255u) == 0u) { if (xb_ld(&bar[XB_TMO])) break; if (sp > XB_SPIN_CAP) { atomicAdd(&bar[XB_TMO], 1u); break; } }
    }
    nloc = mine > 0u ? mine : 1u; nx = cnt > 0u ? cnt : 1u;
}
DI void xcd_barrier(const XcdBarrier& b, bool t0) {
    asm volatile("s_waitcnt vmcnt(0)" ::: "memory");
    __syncthreads();
    if (t0) {
        unsigned* bar = b.bar;
        __builtin_amdgcn_s_waitcnt(0);
        unsigned nloc = b.st[0], nx = b.st[1];
        if (nloc == 0u) { xcd_barrier_complete(bar, b.x, nloc, nx); b.st[0] = nloc; b.st[1] = nx; }
        const unsigned old = xb_add(&bar[XB_XSUB(b.x)], 1u);
        const unsigned gen = old / nloc;
        if (old + 1u == (gen + 1u) * nloc) {
            __builtin_amdgcn_fence(__ATOMIC_RELEASE, "agent");
            asm volatile("s_waitcnt vmcnt(0)" ::: "memory");
            const unsigned og = xb_add(&bar[XB_TOP], 1u);
            const unsigned tg = og / nx;
            if (og + 1u == (tg + 1u) * nx) xb_add(&bar[XB_TOPGEN], 1u);
            else XB_SPIN(xb_ld(&bar[XB_TOPGEN]) == tg, bar);
            __builtin_amdgcn_fence(__ATOMIC_ACQUIRE, "agent");
            xb_add(&bar[XB_XGEN(b.x)], 1u);
            asm volatile("s_waitcnt vmcnt(0)" ::: "memory");
        } else {
            XB_SPIN(xb_ld(&bar[XB_XGEN(b.x)]) == gen, bar);
            __builtin_amdgcn_fence(__ATOMIC_ACQUIRE, "agent");
            asm volatile("s_waitcnt vmcnt(0)" ::: "memory");
        }
    }
    __syncthreads();
}

#ifndef PROBE_ID
#define PROBE_ID 0
#endif
#ifndef PROBE_WG
#define PROBE_WG 0
#endif
#ifndef PROBE_MULT
#define PROBE_MULT 8
#endif
constexpr int NWAVES = 8;
constexpr int RING_BYTES = 131072;
constexpr int MIX_LDS = 147456;
constexpr int XG_OFF = MIX_LDS;
static_assert(MISC_OFF == MIX_LDS + 4096, "LDS map");
constexpr int LDS_BYTES = 155648;

struct Args { const float* in[N_IN]; float* out; unsigned char* ws; int ph_lo, ph_hi, use_bar, pad; };

struct Ctx {
    LAS unsigned char* lds;
    const float* const* in; float* out; unsigned char* ws;
    int tid, lane, wave, G, vcu;
};
#define OPAQUE_CTX(C) do { asm volatile("" : "+v"((C).tid), "+v"((C).lane)); asm volatile("" : "+s"((C).wave), "+s"((C).vcu)); } while (0)
#define PB(id) do { if ((id) == PROBE_ID && PROBE_ID != 0 && (int)blockIdx.x == PROBE_WG && F.wave == 0 && lane_id() == 0) { volatile LAS unsigned* pw_ = (volatile LAS unsigned*)(F.lds + MISC_OFF); pw_[33] = (unsigned)__builtin_amdgcn_s_memrealtime(); } } while (0)
#define PE(id) do { if ((id) == PROBE_ID && PROBE_ID != 0 && (int)blockIdx.x == PROBE_WG && F.wave == 0 && lane_id() == 0) { volatile LAS unsigned* pw_ = (volatile LAS unsigned*)(F.lds + MISC_OFF); pw_[32] += (unsigned)__builtin_amdgcn_s_memrealtime() - pw_[33]; } } while (0)
DI bf16_t* wsb(const Ctx& F, size_t off) { return (bf16_t*)(F.ws + off); }
DI float* wsf(const Ctx& F, size_t off) { return (float*)(F.ws + off); }

DI bool chunk_first(int c) { return c == 0 || c == 128 || c >= 256; }
DI bool chunk_last(int c) { return c == 127 || c >= 255; }
DI int chunk_seq(int c) { return c < 128 ? 0 : (c < 256 ? 1 : c - 254); }
DI float* st_out(const Ctx& F, size_t offp, size_t offs, int layer, int seq, int per) {
    return seq < 2 ? F.out + offp + (size_t)(layer * 2 + seq) * per : F.out + offs + (size_t)(layer * 8 + (seq - 2)) * per;
}

DI float wave_sum(float v) {
#pragma unroll
    for (int o = 1; o < 64; o <<= 1) v += __shfl_xor(v, o);
    return v;
}
DI int win_dst(int n) {
    if (n < 512) return PC_AX + n;
    if (n < 1024) return PC_AG + (n - 512);
    if (n < 1280) return PC_BQ + (n - 1024);
    if (n < 1536) return PC_BK + (n - 1280);
    if (n < 2048) return PC_BV + (n - 1536);
    if (n < 2560) return PC_BG + (n - 2048);
    if (n < 2576) return PC_BLR + (n - 2560);
    if (n < 3088) return PC_CZ + (n - 2576);
    if (n < 4112) return PC_XBC + (n - 3088);
    return PC_DT + (n - 4112);
}
DI int map_row(int mode, int n) {
    if (mode == 1) return win_dst(n);
    if (mode == 2) return 256 * (n >> 7) + (n & 127);
    if (mode == 3) return 256 * (n >> 7) + 128 + (n & 127);
    return n;
}
constexpr int TR_PITCH = 68, TR_WAVE_BYTES = 64 * TR_PITCH * 4;
DI void tr_item(const float* W, int K, int N, bf16_t* WT, int mode, const float* g, LAS float* scr, int item, int lane) {
    const int nblk = (N + 63) / 64, kb = item / nblk, nb = item % nblk, k0 = 64 * kb, n0 = 64 * nb;
    const int c4 = (lane & 15) * 4, kr = lane >> 4;
#pragma unroll 8
    for (int i = 0; i < 16; ++i) { const int kk = 4 * i + kr, n = n0 + c4; f32x4 v = {0.f, 0.f, 0.f, 0.f}; if (n < N) v = *(const f32x4*)(W + (size_t)(k0 + kk) * N + n);
        if (g) v *= g[k0 + kk]; *(LAS f32x4*)(scr + kk * TR_PITCH + c4) = v; }
    LDS_WAIT();
    const int c = lane & 7;
#pragma unroll
    for (int j = 0; j < 8; ++j) { const int n = (lane >> 3) + 8 * j; const LAS float* s = scr + (8 * c) * TR_PITCH + n;
        u32x4 o; o.x = pk2(s[0 * TR_PITCH], s[1 * TR_PITCH]); o.y = pk2(s[2 * TR_PITCH], s[3 * TR_PITCH]); o.z = pk2(s[4 * TR_PITCH], s[5 * TR_PITCH]); o.w = pk2(s[6 * TR_PITCH], s[7 * TR_PITCH]);
        if (n0 + n < N) *(u32x4*)(WT + (size_t)map_row(mode, n0 + n) * K + k0 + 8 * c) = o; }
    LDS_WAIT();
}
DI void convert_set(const Ctx& F, int layer, int which, int wgi, int nwg) {
    LAS float* scr = (LAS float*)(F.lds + F.wave * TR_WAVE_BYTES);
    const int gw = wgi * NWAVES + F.wave, NGW = nwg * NWAVES;
    int base = 0;
#define CONV_MAT(cond, Wp, K_, N_, WTp, mode_, gp) if (cond) { const int ni = ((K_) / 64) * (((N_) + 63) / 64); \
        for (int it = gw - base; it < ni; it += NGW) { if (it >= 0) tr_item(Wp, K_, N_, WTp, mode_, gp, scr, it, F.lane); } base = (base + ni) % NGW; }
    CONV_MAT(which & 1, F.in[I_WIN] + (size_t)layer * D * DIN, D, DIN, wsb(F, WS_WIN), 1, F.in[I_NMIX] + layer * D)
    CONV_MAT(which & 2, F.in[I_WOUT] + (size_t)layer * DMIX * D, DMIX, D, wsb(F, WS_WOUT), 0, (const float*)nullptr)
    CONV_MAT(which & 4, F.in[I_WG] + (size_t)layer * D * DFF, D, DFF, wsb(F, WS_WGU), 2, F.in[I_NFFN] + layer * D)
    CONV_MAT(which & 4, F.in[I_WU] + (size_t)layer * D * DFF, D, DFF, wsb(F, WS_WGU), 3, F.in[I_NFFN] + layer * D)
    CONV_MAT(which & 8, F.in[I_WD] + (size_t)layer * DFF * D, DFF, D, wsb(F, WS_WD), 0, (const float*)nullptr)
    CONV_MAT(which & 16, F.in[I_PWG] + (size_t)layer * D * D, D, D, wsb(F, WS_WPG), 0, F.in[I_NPLE] + layer * D)
    CONV_MAT(which & 32, F.in[I_PWP] + (size_t)layer * DPLE * D, DPLE, D, wsb(F, WS_WPP), 0, (const float*)nullptr)
    if (which & 128) {
        for (int it = gw; it < DEPTH * 2 * 8; it += NGW) { const int mat = it, l = mat >> 4, ri = (mat >> 3) & 1, h = mat & 7;
            tr_item(F.in[ri ? I_LWI : I_LWR] + (size_t)(l * 8 + h) * 4096, 64, 64, wsb(F, WS_LRUW) + (size_t)((l * 2 + ri) * 8 + h) * 4096, 0, nullptr, scr, 0, F.lane); }
    }
#undef CONV_MAT
    if (which & 1) {
        u32x4* z = (u32x4*)(wsb(F, WS_WIN) + (size_t)PC_PAD * D); const int n16 = (PC_Y - PC_PAD) * D * 2 / 16;
        u32x4 zv = (u32x4){0u, 0u, 0u, 0u}; asm volatile("" : "+v"(zv));
        for (int i = wgi * 512 + F.tid; i < n16; i += nwg * 512) z[i] = zv;
    }
    if (which & 64) {
        const float* pp = F.in[I_PP] + (size_t)layer * MP * DPLE; const float* ps = F.in[I_PS] + (size_t)layer * MS * DPLE; bf16_t* pb = wsb(F, WS_PB);
        const int n8 = M * DPLE / 8;
        for (int i = wgi * 512 + F.tid; i < n8; i += nwg * 512) { const size_t e = (size_t)i * 8; const float* src = e < (size_t)MP * DPLE ? pp + e : ps + (e - (size_t)MP * DPLE);
            const f32x4 a = *(const f32x4*)src, b = *(const f32x4*)(src + 4); u32x4 o; o.x = pk2(a.x, a.y); o.y = pk2(a.z, a.w); o.z = pk2(b.x, b.y); o.w = pk2(b.z, b.w); *(u32x4*)(pb + e) = o; }
    }
}
DI void p0_rows(const Ctx& F) {
    const int gw = F.vcu * NWAVES + F.wave, NGW = F.G * NWAVES;
    bf16_t* xb = (bf16_t*)F.out; float* rss = wsf(F, WS_RSSN) + (size_t)XB_PAD * 16;
    for (int m0 = gw; m0 < M; m0 += 2 * NGW) {
        f32x4 v[2][4]; float s[2];
#pragma unroll
        for (int k = 0; k < 2; ++k) { const int m = m0 + k * NGW < M ? m0 + k * NGW : m0; const float* xr = m < MP ? F.in[I_XP] + (size_t)m * D : F.in[I_XS] + (size_t)(m - MP) * D; const f32x4* x4 = (const f32x4*)xr + F.lane;
#pragma unroll
            for (int j = 0; j < 4; ++j) v[k][j] = x4[64 * j]; }
#pragma unroll
        for (int k = 0; k < 2; ++k) { const int m = m0 + k * NGW; if (m >= M) break; float ss = 0.f;
#pragma unroll
            for (int j = 0; j < 4; ++j) ss += (v[k][j].x * v[k][j].x + v[k][j].y * v[k][j].y) + (v[k][j].z * v[k][j].z + v[k][j].w * v[k][j].w);
            s[k] = wave_sum(ss);
            u32x2* o8 = (u32x2*)(xb + (size_t)m * D) + F.lane;
#pragma unroll
            for (int j = 0; j < 4; ++j) { u32x2 w; w.x = pk2(v[k][j].x, v[k][j].y); w.y = pk2(v[k][j].z, v[k][j].w); o8[64 * j] = w; }
            if (F.lane < 16) rss[(size_t)m * 16 + F.lane] = F.lane == 0 ? s[k] : 0.f; }
    }
}

#define PBE(id, lds_, pred_) do { if ((id) == PROBE_ID && PROBE_ID != 0 && (int)blockIdx.x == PROBE_WG && (pred_)) { volatile LAS unsigned* pw_ = (volatile LAS unsigned*)((lds_) + MISC_OFF); pw_[33] = (unsigned)__builtin_amdgcn_s_memrealtime(); } } while (0)
#define PEE(id, lds_, pred_) do { if ((id) == PROBE_ID && PROBE_ID != 0 && (int)blockIdx.x == PROBE_WG && (pred_)) { volatile LAS unsigned* pw_ = (volatile LAS unsigned*)((lds_) + MISC_OFF); pw_[32] += (unsigned)__builtin_amdgcn_s_memrealtime() - pw_[33]; } } while (0)
DI float row_rstd(const float* rss, long row) {
    const f32x4* p = (const f32x4*)(rss + row * 16); const f32x4 a = p[0], b = p[1], c = p[2], d = p[3];
    const float s = ((a.x + a.y) + (a.z + a.w)) + ((b.x + b.y) + (b.z + b.w)) + ((c.x + c.y) + (c.z + c.w)) + ((d.x + d.y) + (d.z + d.w));
    return rsqrtf(fmaxf(s, 0.f) * (1.f / D) + EPS);
}
DI float row_rstd_q(const float* rss, long row, int fq) {
    const f32x4 a = *(const f32x4*)(rss + row * 16 + 4 * fq); float s = (a.x + a.y) + (a.z + a.w);
    s += __shfl_xor(s, 16); s += __shfl_xor(s, 32);
    return rsqrtf(fmaxf(s, 0.f) * (1.f / D) + EPS);
}
struct EpiProj {
    static constexpr bool PERM = true;
    bf16_t* O; const float* rss;
    DI void operator()(const f32x4 (&acc)[2][2][4][2], const pg8::Unit& u, int wr, int wc, int fr_, int fq_, LAS unsigned char*) const {
        int fr = fr_, fq = fq_; asm volatile("" : "+v"(fr), "+v"(fq));
        const int row0 = u.arow + wr * 64 + fr, col0 = u.pn * 256 + wc * 32 + 8 * fq;
        f32x4 nr = *(const f32x4*)(rss + (long)row0 * 16 + 4 * fq);
#pragma unroll
        for (int it = 0; it < 8; ++it) { const int ai = it >> 2, m = it & 3; const int r = row0 + ai * 128 + m * 16; bf16_t* rowp = O + (size_t)r * DINP + col0;
            const f32x4 cr = nr;
            if (it < 7) nr = *(const f32x4*)(rss + (long)(row0 + ((it + 1) >> 2) * 128 + ((it + 1) & 3) * 16) * 16 + 4 * fq);
            float sr = (cr.x + cr.y) + (cr.z + cr.w); sr += __shfl_xor(sr, 16); sr += __shfl_xor(sr, 32);
            const float rs = rsqrtf(fmaxf(sr, 0.f) * (1.f / D) + EPS);
#pragma unroll
            for (int bj = 0; bj < 2; ++bj) { const f32x4 v0 = acc[ai][bj][m][0] * rs, v1 = acc[ai][bj][m][1] * rs;
                u32x4 w; w.x = pg8::cvt_pk_bf16(v0[0], v0[1]); w.y = pg8::cvt_pk_bf16(v0[2], v0[3]); w.z = pg8::cvt_pk_bf16(v1[0], v1[1]); w.w = pg8::cvt_pk_bf16(v1[2], v1[3]);
                *(u32x4*)(rowp + bj * 128) = w; }
            asm volatile("" ::: "memory"); }
    }
};
DI void add_bf16x8(f32x4& a, f32x4& b, const u32x4 w) {
    a[0] += __uint_as_float(w.x << 16); a[1] += __uint_as_float(w.x & 0xffff0000u); a[2] += __uint_as_float(w.y << 16); a[3] += __uint_as_float(w.y & 0xffff0000u);
    b[0] += __uint_as_float(w.z << 16); b[1] += __uint_as_float(w.z & 0xffff0000u); b[2] += __uint_as_float(w.w << 16); b[3] += __uint_as_float(w.w & 0xffff0000u);
}
struct EpiRes {
    static constexpr bool PERM = true;
    const bf16_t* xs; bf16_t* xb; float* rss; bool dry;
    DI void operator()(const f32x4 (&acc)[2][2][4][2], const pg8::Unit& u, int wr, int wc, int fr_, int fq_, LAS unsigned char*) const {
        int fr = fr_, fq = fq_; asm volatile("" : "+v"(fr), "+v"(fq));
        const int row0 = u.arow + wr * 64 + fr, col0 = u.pn * 256 + wc * 32 + 8 * fq;
        u32x4 nx0 = *(const u32x4*)(xs + (size_t)row0 * D + col0), nx1 = *(const u32x4*)(xs + (size_t)row0 * D + col0 + 128);
#pragma unroll
        for (int it = 0; it < 8; ++it) { const int ai = it >> 2, m = it & 3; const int r = row0 + ai * 128 + m * 16; const size_t off = (size_t)r * D + col0;
            const u32x4 c0 = nx0, c1 = nx1;
            if (it < 7) { const size_t offn = (size_t)(row0 + ((it + 1) >> 2) * 128 + ((it + 1) & 3) * 16) * D + col0; nx0 = *(const u32x4*)(xs + offn); nx1 = *(const u32x4*)(xs + offn + 128); }
            float ss = 0.f;
#pragma unroll
            for (int bj = 0; bj < 2; ++bj) { f32x4 a = acc[ai][bj][m][0], b = acc[ai][bj][m][1]; add_bf16x8(a, b, bj ? c1 : c0);
                u32x4 w; w.x = pg8::cvt_pk_bf16(a[0], a[1]); w.y = pg8::cvt_pk_bf16(a[2], a[3]); w.z = pg8::cvt_pk_bf16(b[0], b[1]); w.w = pg8::cvt_pk_bf16(b[2], b[3]);
                if (!dry) *(u32x4*)(xb + off + bj * 128) = w;
                ss += ((a[0] * a[0] + a[1] * a[1]) + (a[2] * a[2] + a[3] * a[3])) + ((b[0] * b[0] + b[1] * b[1]) + (b[2] * b[2] + b[3] * b[3])); }
            ss += __shfl_xor(ss, 16); ss += __shfl_xor(ss, 32);
            if (fq == 0 && !dry) rss[(size_t)r * 16 + u.pn * 4 + wc] = ss;
            asm volatile("" ::: "memory"); }
    }
};
struct EpiPle {
    static constexpr bool PERM = true;
    const bf16_t* xs; bf16_t* xb; const float* rss_in; float* rss_out; const bf16_t* pp; bool dry;
    DI void operator()(const f32x4 (&acc)[2][2][4][2], const pg8::Unit& u, int wr, int wc, int fr_, int fq_, LAS unsigned char*) const {
        int fr = fr_, fq = fq_; asm volatile("" : "+v"(fr), "+v"(fq));
        const int row0 = u.arow + wr * 64 + fr, col0 = u.pn * 256 + wc * 32 + 8 * fq;
        u32x4 nx0 = *(const u32x4*)(xs + (size_t)row0 * D + col0), nx1 = *(const u32x4*)(xs + (size_t)row0 * D + col0 + 128);
        u32x4 np0 = *(const u32x4*)(pp + (size_t)row0 * D + col0), np1 = *(const u32x4*)(pp + (size_t)row0 * D + col0 + 128);
        f32x4 nr = *(const f32x4*)(rss_in + (long)row0 * 16 + 4 * fq);
#pragma unroll
        for (int it = 0; it < 8; ++it) { const int ai = it >> 2, m = it & 3; const int r = row0 + ai * 128 + m * 16; const size_t off = (size_t)r * D + col0;
            const u32x4 c0 = nx0, c1 = nx1, q0 = np0, q1 = np1; const f32x4 cr = nr;
            if (it < 7) { const int rn = row0 + ((it + 1) >> 2) * 128 + ((it + 1) & 3) * 16; const size_t offn = (size_t)rn * D + col0;
                nx0 = *(const u32x4*)(xs + offn); nx1 = *(const u32x4*)(xs + offn + 128); np0 = *(const u32x4*)(pp + offn); np1 = *(const u32x4*)(pp + offn + 128); nr = *(const f32x4*)(rss_in + (long)rn * 16 + 4 * fq); }
            float sr = (cr.x + cr.y) + (cr.z + cr.w); sr += __shfl_xor(sr, 16); sr += __shfl_xor(sr, 32);
            const float rs = rsqrtf(fmaxf(sr, 0.f) * (1.f / D) + EPS); float ss = 0.f;
#pragma unroll
            for (int bj = 0; bj < 2; ++bj) { const f32x4 fa = acc[ai][bj][m][0], fb = acc[ai][bj][m][1]; const u32x4 xw = bj ? c1 : c0, pw = bj ? q1 : q0;
                f32x4 a, b;
                a[0] = __uint_as_float(xw.x << 16) + sigm(fa[0] * rs) * __uint_as_float(pw.x << 16); a[1] = __uint_as_float(xw.x & 0xffff0000u) + sigm(fa[1] * rs) * __uint_as_float(pw.x & 0xffff0000u);
                a[2] = __uint_as_float(xw.y << 16) + sigm(fa[2] * rs) * __uint_as_float(pw.y << 16); a[3] = __uint_as_float(xw.y & 0xffff0000u) + sigm(fa[3] * rs) * __uint_as_float(pw.y & 0xffff0000u);
                b[0] = __uint_as_float(xw.z << 16) + sigm(fb[0] * rs) * __uint_as_float(pw.z << 16); b[1] = __uint_as_float(xw.z & 0xffff0000u) + sigm(fb[1] * rs) * __uint_as_float(pw.z & 0xffff0000u);
                b[2] = __uint_as_float(xw.w << 16) + sigm(fb[2] * rs) * __uint_as_float(pw.w << 16); b[3] = __uint_as_float(xw.w & 0xffff0000u) + sigm(fb[3] * rs) * __uint_as_float(pw.w & 0xffff0000u);
                u32x4 w; w.x = pg8::cvt_pk_bf16(a[0], a[1]); w.y = pg8::cvt_pk_bf16(a[2], a[3]); w.z = pg8::cvt_pk_bf16(b[0], b[1]); w.w = pg8::cvt_pk_bf16(b[2], b[3]);
                if (!dry) *(u32x4*)(xb + off + bj * 128) = w;
                ss += ((a[0] * a[0] + a[1] * a[1]) + (a[2] * a[2] + a[3] * a[3])) + ((b[0] * b[0] + b[1] * b[1]) + (b[2] * b[2] + b[3] * b[3])); }
            ss += __shfl_xor(ss, 16); ss += __shfl_xor(ss, 32);
            if (fq == 0 && !dry) rss_out[(size_t)r * 16 + u.pn * 4 + wc] = ss;
            asm volatile("" ::: "memory"); }
    }
};
struct EpiPP {
    static constexpr bool PERM = true;
    bf16_t* pp;
    DI void operator()(const f32x4 (&acc)[2][2][4][2], const pg8::Unit& u, int wr, int wc, int fr_, int fq_, LAS unsigned char*) const {
        int fr = fr_, fq = fq_; asm volatile("" : "+v"(fr), "+v"(fq));
        const int row0 = u.arow + wr * 64 + fr, col0 = u.pn * 256 + wc * 32 + 8 * fq;
#pragma unroll
        for (int ai = 0; ai < 2; ++ai)
#pragma unroll
            for (int m = 0; m < 4; ++m) { const size_t off = (size_t)(row0 + ai * 128 + m * 16) * D + col0;
#pragma unroll
                for (int bj = 0; bj < 2; ++bj) { const f32x4 f = acc[ai][bj][m][0], g = acc[ai][bj][m][1];
                    u32x4 w; w.x = pg8::cvt_pk_bf16(f[0], f[1]); w.y = pg8::cvt_pk_bf16(f[2], f[3]); w.z = pg8::cvt_pk_bf16(g[0], g[1]); w.w = pg8::cvt_pk_bf16(g[2], g[3]); *(u32x4*)(pp + off + bj * 128) = w; } }
    }
};
struct EpiFfn {
    static constexpr bool PERM = true;
    bf16_t* H; const float* rss; const float* cw; const float* cb; const float* st_in; float* st_p; float* st_s;
    DI void operator()(f32x4 (&acc)[2][2][4][2], const pg8::Unit& u, int wr, int wc, int fr_, int fq_, LAS unsigned char* lds) const {
        int fr = fr_, fq = fq_; asm volatile("" : "+v"(fr), "+v"(fq));
        const int lane = fr + 16 * fq;
        const bool p0_ = (wr == 0 && wc == 0 && lane == 0);
        PBE(41, lds, p0_); PBE(42, lds, p0_);
        const int gc0 = u.pn * 128 + wc * 32 + 8 * fq;
        LAS float* XG = (LAS float*)(lds + XG_OFF);
        LAS float* RT = (LAS float*)(lds + MISC_OFF + 1024);
        LAS float* WT = (LAS float*)(lds + MISC_OFF + 2048);
        {   const int tid_ = (wr * 4 + wc) * 64 + lane, row_ = tid_ >> 1, hf_ = tid_ & 1;
            const f32x4* p_ = (const f32x4*)(rss + ((long)u.arow + row_) * 16 + 8 * hf_); const f32x4 a_ = p_[0], b_ = p_[1];
            float s_ = ((a_.x + a_.y) + (a_.z + a_.w)) + ((b_.x + b_.y) + (b_.z + b_.w)); s_ += __shfl_xor(s_, 1);
            if (hf_ == 0) RT[row_] = rsqrtf(fmaxf(s_, 0.f) * (1.f / D) + EPS);
            if (tid_ < 128) { const int k_ = tid_ >> 5, c_ = u.pn * 128 + 4 * (tid_ & 31);
                *(LAS f32x4*)(WT + k_ * 128 + 4 * (tid_ & 31)) = *(const f32x4*)(k_ < 3 ? cw + (size_t)k_ * DFF + c_ : cb + c_); } }
        if (fr >= 14) {
#pragma unroll
            for (int ai = 0; ai < 2; ++ai)
#pragma unroll
                for (int n = 0; n < 2; ++n) *(LAS f32x4*)(XG + ((2 * ai + wr) * 2 + (fr - 14)) * 128 + wc * 32 + 8 * fq + 4 * n) = acc[ai][0][3][n];
        }
        LDS_WAIT(); __builtin_amdgcn_s_barrier(); asm volatile("" ::: "memory");
#pragma unroll
        for (int ai = 0; ai < 2; ++ai)
#pragma unroll
            for (int m = 0; m < 4; ++m) { const float rs = RT[ai * 128 + wr * 64 + m * 16 + fr];
#pragma unroll
                for (int bj = 0; bj < 2; ++bj)
#pragma unroll
                    for (int n = 0; n < 2; ++n) acc[ai][bj][m][n] *= rs; }
        PEE(42, lds, p0_); PBE(43, lds, p0_);
#pragma unroll
        for (int n = 0; n < 2; ++n) {
            const int gc = gc0 + 4 * n;
            const int lc = wc * 32 + 8 * fq + 4 * n;
            const f32x4 w0 = *(const LAS f32x4*)(WT + lc), w1 = *(const LAS f32x4*)(WT + 128 + lc), w2 = *(const LAS f32x4*)(WT + 256 + lc), bb = *(const LAS f32x4*)(WT + 384 + lc);
#pragma unroll
            for (int ai = 0; ai < 2; ++ai) {
                f32x4 pr1, pr2;
                const int pb = 2 * ai + wr - 1;
                if (pb >= 0) { pr1 = *(const LAS f32x4*)(XG + (pb * 2 + 1) * 128 + wc * 32 + 8 * fq + 4 * n) * RT[64 * pb + 63];
                               pr2 = *(const LAS f32x4*)(XG + (pb * 2 + (fr & 1)) * 128 + wc * 32 + 8 * fq + 4 * n) * RT[64 * pb + 62 + (fr & 1)]; }
                else { pr1 = (f32x4){0.f, 0.f, 0.f, 0.f}; pr2 = pr1; }
#pragma unroll
                for (int m = 0; m < 4; ++m) {
                    const int j = ai * 128 + wr * 64 + m * 16 + fr; const long r = (long)u.arow + j;
                    int t, seq; if (r < MP) { t = (int)r & 8191; seq = (int)(r >> 13); } else { t = (int)(r - MP) & 63; seq = 2 + (int)((r - MP) >> 6); }
                    const int T = r < MP ? 8192 : 64;
                    const bool valid = j >= 2 && r < M;
                    const f32x4 cur = acc[ai][0][m][n]; f32x4 r1, r2;
#pragma unroll
                    for (int i = 0; i < 4; ++i) { r1[i] = dpp_ror<0x121>(cur[i]); r2[i] = dpp_ror<0x122>(cur[i]); }
                    f32x4 p1 = fr >= 1 ? r1 : pr1, p2 = fr >= 2 ? r2 : pr2;
                    pr1 = r1; pr2 = r2;
                    if (valid && t < 2) {
                        const f32x4 z = (f32x4){0.f, 0.f, 0.f, 0.f}; f32x4 s0 = z, s1 = z;
                        if (seq >= 2) { const float* sp = st_in + (size_t)(seq - 2) * 2 * DFF + gc; s0 = *(const f32x4*)sp; s1 = *(const f32x4*)(sp + DFF); }
                        if (t == 0) { p1 = s1; p2 = s0; } else { p2 = s1; }
                    }
                    const f32x4 gpre = bb + w0 * p2 + w1 * p1 + w2 * cur; const f32x4 up = acc[ai][1][m][n];
                    const float h0 = gelu_t(gpre[0]) * up[0], h1 = gelu_t(gpre[1]) * up[1], h2 = gelu_t(gpre[2]) * up[2], h3 = gelu_t(gpre[3]) * up[3];
                    if (valid) { u32x2 hw; hw.x = pg8::cvt_pk_bf16(h0, h1); hw.y = pg8::cvt_pk_bf16(h2, h3); *(u32x2*)(H + (size_t)r * DFF + gc) = hw;
                        if (t >= T - 2) { float* so = (seq < 2 ? st_p + (size_t)seq * 2 * DFF : st_s + (size_t)(seq - 2) * 2 * DFF) + (size_t)(t - (T - 2)) * DFF + gc; *(f32x4*)so = cur; } }
                    if (m == 3) asm volatile("" ::: "memory");
                }
            }
        }
        PEE(43, lds, p0_); PEE(41, lds, p0_);
    }
};

struct OneUnit { int pm, pn; bool on;
    __device__ bool next(int i, pg8::Unit& u) const { if (i != 0 || !on) return false; u.pm = pm; u.pn = pn; u.arow = 256 * pm; return true; } };
struct EpiPart {
    static constexpr bool PERM = false;
    float* base;
    DI void operator()(const f32x4 (&acc)[2][2][4][2], const pg8::Unit&, int wr, int wc, int fr_, int fq_, LAS unsigned char*) const {
        int fr = fr_, fq = fq_; asm volatile("" : "+v"(fr), "+v"(fq));
#pragma unroll
        for (int ai = 0; ai < 2; ++ai)
#pragma unroll
            for (int m = 0; m < 4; ++m) { float* rowp = base + (size_t)(ai * 128 + wr * 64 + m * 16 + fr) * 256 + wc * 32 + 4 * fq;
#pragma unroll
                for (int bj = 0; bj < 2; ++bj)
#pragma unroll
                    for (int n = 0; n < 2; ++n) *(f32x4*)(rowp + bj * 128 + n * 16) = acc[ai][bj][m][n]; }
    }
};
template <int MODE> DI void reduce_tail(const Ctx& F, const float* part, int S, const bf16_t* xs, bf16_t* xb, const float* rss_in, float* rss_out, const bf16_t* pp) {
    for (int t = blockIdx.x; t < 256; t += F.G) { const int j = t >> 5, rl = 8 * (t & 31) + F.wave, pm = 64 + (j >> 2), pn = j & 3; const int r = 256 * pm + rl, col = 256 * pn + 4 * F.lane;
        f32x4 sum = {0.f, 0.f, 0.f, 0.f};
        for (int sl = 0; sl < S; ++sl) sum += *(const f32x4*)(part + ((size_t)(j * S + sl) * 256 + rl) * 256 + 4 * F.lane);
        const size_t off = (size_t)r * D + col; const u32x2 xw = *(const u32x2*)(xs + off);
        f32x4 xn; xn[0] = __uint_as_float(xw.x << 16); xn[1] = __uint_as_float(xw.x & 0xffff0000u); xn[2] = __uint_as_float(xw.y << 16); xn[3] = __uint_as_float(xw.y & 0xffff0000u);
        if (MODE == 0) xn += sum;
        else { const float rs = row_rstd(rss_in, r); const u32x2 pw = *(const u32x2*)(pp + off);
            xn[0] += sigm(sum[0] * rs) * __uint_as_float(pw.x << 16); xn[1] += sigm(sum[1] * rs) * __uint_as_float(pw.x & 0xffff0000u);
            xn[2] += sigm(sum[2] * rs) * __uint_as_float(pw.y << 16); xn[3] += sigm(sum[3] * rs) * __uint_as_float(pw.y & 0xffff0000u); }
        u32x2 w; w.x = pg8::cvt_pk_bf16(xn[0], xn[1]); w.y = pg8::cvt_pk_bf16(xn[2], xn[3]); *(u32x2*)(xb + off) = w;
        float ss = (xn[0] * xn[0] + xn[1] * xn[1]) + (xn[2] * xn[2] + xn[3] * xn[3]);
        ss += __shfl_xor(ss, 1); ss += __shfl_xor(ss, 2); ss += __shfl_xor(ss, 4); ss += __shfl_xor(ss, 8);
        if ((F.lane & 15) == 0) rss_out[(size_t)r * 16 + pn * 4 + (F.lane >> 4)] = ss;
    }
}

DI bf16x8 frag_row(const LAS unsigned char* img, int pitch, int row0, int k0, int lane) {
    return *(const LAS bf16x8*)(img + (row0 + (lane & 15)) * pitch + (k0 + 8 * (lane >> 4)) * 2);
}
DI bf16x8 frag_tr(const LAS unsigned char* img, int pitch, int k0, int n0, int lane) {
    const int g = lane >> 4, i = lane & 15, q = i >> 2, p = i & 3;
    const LAS unsigned char* a = img + (k0 + 8 * g + q) * pitch + (n0 + 4 * p) * 2;
    const s16x4 lo = __builtin_amdgcn_ds_read_tr16_b64_v4i16((LAS s16x4*)a);
    const s16x4 hi = __builtin_amdgcn_ds_read_tr16_b64_v4i16((LAS s16x4*)(a + 4 * pitch));
    return __builtin_shufflevector(lo, hi, 0, 1, 2, 3, 4, 5, 6, 7);
}
#define MFMA16(a, b, c) __builtin_amdgcn_mfma_f32_16x16x32_bf16((a), (b), (c), 0, 0, 0)
DI void st_bf16(LAS unsigned char* img, int pitch, int row, int col, float v) { *(LAS bf16_t*)(img + row * pitch + col * 2) = (bf16_t)f2bf(v); }
DI float ld_bf16(const LAS unsigned char* img, int pitch, int row, int col) { return bf2f(*(const LAS bf16_t*)(img + row * pitch + col * 2)); }

#define WG_BAR() do { asm volatile("s_waitcnt lgkmcnt(0)" ::: "memory"); __builtin_amdgcn_s_barrier(); asm volatile("" ::: "memory"); } while (0)
template <bool SSD> struct LAT {
    static constexpr int DA = SSD ? 128 : 64, DB = SSD ? 64 : 128;
    static constexpr int PA = (DA + 8) * 2, PV = (DB + 8) * 2, PPI = 144, PS = (DB + 8) * 2, POT = (DB + 4) * 4;
    static constexpr int O_QD = 0, O_KI = O_QD + 64 * PA, O_VV = O_KI + 64 * PA, O_VW = O_VV + 64 * PV, O_P = O_VW + (SSD ? 64 * PV : 0), O_SB = O_P + 64 * PPI, O_OT = O_SB + DA * PS, O_TAB = O_OT + 64 * POT;
    static constexpr int NT_O = DB / 32;
};
static_assert(LAT<true>::O_TAB + 8192 <= RING_BYTES && LAT<false>::O_TAB + 8192 <= RING_BYTES, "mixer LDS");
template <bool SSD> DI void la_mt_nt(int T, int& mt, int& nt) { if (SSD) { mt = T >> 2; nt = T & 3; } else { mt = T >> 3; nt = T & 7; } }

template <bool SSD> DI void la_state_update(LAS unsigned char* lds, f32x4 (&S)[4], int w, int lane) {
    typedef LAT<SSD> L; const LAS float* tab = (const LAS float*)(lds + L::O_TAB); const int q = lane >> 4;
#pragma unroll
    for (int x = 0; x < 4; ++x) { int mt, nt; la_mt_nt<SSD>(4 * w + x, mt, nt);
        if (SSD) { const float d = tab[256]; S[x] *= d; }
#pragma unroll
        for (int ks = 0; ks < 2; ++ks) { const bf16x8 a = frag_tr(lds + L::O_KI, L::PA, 32 * ks, 16 * mt, lane); const bf16x8 b = frag_tr(lds + (SSD ? L::O_VW : L::O_VV), L::PV, 32 * ks, 16 * nt, lane); S[x] = MFMA16(a, b, S[x]); }
        if (!SSD) {
#pragma unroll
            for (int r = 0; r < 4; ++r) S[x][r] *= tab[1536 + 16 * mt + 4 * q + r]; }
    }
}
template <bool SSD> DI void la_write_sb(LAS unsigned char* lds, const f32x4 (&S)[4], int w, int lane) {
    typedef LAT<SSD> L; const int q = lane >> 4, c = lane & 15;
#pragma unroll
    for (int x = 0; x < 4; ++x) { int mt, nt; la_mt_nt<SSD>(4 * w + x, mt, nt);
#pragma unroll
        for (int r = 0; r < 4; ++r) st_bf16(lds + L::O_SB, L::PS, 16 * mt + 4 * q + r, 16 * nt + c, S[x][r]); }
}
template <bool SSD> DI void la_compute_p(LAS unsigned char* lds, int w, int lane) {
    typedef LAT<SSD> L; const LAS float* tab = (const LAS float*)(lds + L::O_TAB); const int q = lane >> 4, c = lane & 15, mt = w >> 1;
#pragma unroll
    for (int x = 0; x < 2; ++x) { const int nt = (w & 1) * 2 + x; f32x4 acc = {0.f, 0.f, 0.f, 0.f};
#pragma unroll
        for (int ks = 0; ks < L::DA / 32; ++ks) { const bf16x8 a = frag_row(lds + L::O_QD, L::PA, 16 * mt, 32 * ks, lane); const bf16x8 b = frag_row(lds + L::O_KI, L::PA, 16 * nt, 32 * ks, lane); acc = MFMA16(a, b, acc); }
        const int j = 16 * nt + c;
#pragma unroll
        for (int r = 0; r < 4; ++r) { const int i = 16 * mt + 4 * q + r; float v = acc[r];
            if (SSD) v *= __expf(tab[64 + i] - tab[64 + j]) * tab[j];
            v = (j > i) ? 0.f : v; st_bf16(lds + L::O_P, L::PPI, i, j, v); }
    }
}
template <bool SSD> DI void la_compute_out(LAS unsigned char* lds, f32x4 (&o1)[LAT<SSD>::NT_O], f32x4 (&o2)[LAT<SSD>::NT_O], int w, int lane) {
    typedef LAT<SSD> L; const int mt = w >> 1;
#pragma unroll
    for (int x = 0; x < L::NT_O; ++x) { const int nt = (w & 1) * L::NT_O + x; f32x4 a1 = {0.f, 0.f, 0.f, 0.f}, a2 = {0.f, 0.f, 0.f, 0.f};
#pragma unroll
        for (int ks = 0; ks < 2; ++ks) { const bf16x8 a = frag_row(lds + L::O_P, L::PPI, 16 * mt, 32 * ks, lane); const bf16x8 b = frag_tr(lds + L::O_VV, L::PV, 32 * ks, 16 * nt, lane); a1 = MFMA16(a, b, a1); }
#pragma unroll
        for (int ks = 0; ks < L::DA / 32; ++ks) { const bf16x8 a = frag_row(lds + L::O_QD, L::PA, 16 * mt, 32 * ks, lane); const bf16x8 b = frag_tr(lds + L::O_SB, L::PS, 32 * ks, 16 * nt, lane); a2 = MFMA16(a, b, a2); }
        o1[x] = a1; o2[x] = a2; }
}
DI void la_store_ds(float* ds, const f32x4 (&S)[4], int w, int lane) {
#pragma unroll
    for (int x = 0; x < 4; ++x)
#pragma unroll
        for (int r = 0; r < 4; ++r) ds[((4 * w + x) * 4 + r) * 64 + lane] = S[x][r];
}
DI void la_load_ds(const float* ds, f32x4 (&S)[4], int w, int lane) {
#pragma unroll
    for (int x = 0; x < 4; ++x)
#pragma unroll
        for (int r = 0; r < 4; ++r) S[x][r] = ds[((4 * w + x) * 4 + r) * 64 + lane];
}

struct GlaCoef { float wlr[16]; float blr; };
struct GlaRaw { unsigned short qk[8][2]; u32x4 v[2]; u32x4 lr; u32x4 g[2]; };
DI void gla_load(const Ctx& F, int h, int chunk, GlaRaw& R) {
    const bf16_t* proj = wsb(F, WS_R); const int row0 = 64 * chunk, d = F.lane, w = F.wave;
#pragma unroll
    for (int i = 0; i < 8; ++i) { const size_t ro = (size_t)(row0 + 8 * w + i) * DINP; R.qk[i][0] = proj[ro + PC_BQ + 64 * h + d]; R.qk[i][1] = proj[ro + PC_BK + 64 * h + d]; }
#pragma unroll
    for (int i = 0; i < 2; ++i) { const int idx = F.tid + 512 * i, t = idx >> 4, c16 = idx & 15;
        R.v[i] = *(const u32x4*)(proj + (size_t)(row0 + t) * DINP + PC_BV + 128 * h + 8 * c16);
        R.g[i] = *(const u32x4*)(proj + (size_t)(row0 + t) * DINP + PC_BG + 128 * h + 8 * c16); }
    R.lr = *(const u32x4*)(proj + (size_t)(row0 + ((F.tid >> 1) & 63)) * DINP + PC_BLR + 8 * (F.tid & 1));
}
DI void gla_stage(const Ctx& F, const GlaCoef& cf, const GlaRaw& R) {
    typedef LAT<false> L; LAS unsigned char* lds = F.lds; LAS float* tab = (LAS float*)(lds + L::O_TAB); const int d = F.lane, w = F.wave;
    if (F.tid < 128) { const int t = F.tid >> 1, half = F.tid & 1; float f[8]; unpack8(R.lr, f);
#pragma unroll
        for (int i = 0; i < 8; ++i) tab[t * 16 + 8 * half + i] = f[i]; }
#pragma unroll
    for (int i = 0; i < 2; ++i) { const int idx = F.tid + 512 * i, t = idx >> 4, c16 = idx & 15; *(LAS u32x4*)(lds + L::O_VV + t * L::PV + c16 * 16) = R.v[i]; }
    WG_BAR();
    float pre[8]; float run = 0.f;
#pragma unroll
    for (int i = 0; i < 8; ++i) { const int t = 8 * w + i; float z = cf.blr;
#pragma unroll
        for (int r = 0; r < 16; ++r) z += tab[t * 16 + r] * cf.wlr[r];
        run += logsig_fast(z) * (1.f / 16.f); pre[i] = run; }
    tab[1024 + w * 64 + d] = run;
    WG_BAR();
    float off = 0.f, last = 0.f;
#pragma unroll
    for (int ww = 0; ww < 8; ++ww) { const float tv = tab[1024 + ww * 64 + d]; last += tv; if (ww < w) off += tv; }
#pragma unroll
    for (int i = 0; i < 8; ++i) { const int t = 8 * w + i; const float cum = off + pre[i];
        st_bf16(lds + L::O_QD, L::PA, t, d, bf2f(R.qk[i][0]) * 0.125f * __expf(cum)); st_bf16(lds + L::O_KI, L::PA, t, d, bf2f(R.qk[i][1]) * __expf(-cum)); }
    if (w == 0) tab[1536 + d] = __expf(last);
    WG_BAR();
}
struct SsdRaw { u32x4 x[11]; u32x4 z; unsigned short dtr; };
DI void ssd_task(const Ctx& F, int h, int& cidx, int& rg, int& ch) {
    cidx = F.tid % 40; rg = F.tid / 40; const int g = h >> 2;
    ch = cidx < 8 ? 64 * h + 8 * cidx : (cidx < 24 ? 512 + 128 * g + 8 * (cidx - 8) : 768 + 128 * g + 8 * (cidx - 24));
}
DI void ssd_load(const Ctx& F, int layer, int h, int chunk, SsdRaw& R) {
    const bf16_t* proj = wsb(F, WS_R); const int row0 = 64 * chunk; const bool first = chunk_first(chunk);
    if (F.tid < 320) { int cidx, rg, ch; ssd_task(F, h, cidx, rg, ch);
#pragma unroll
        for (int i = 0; i < 11; ++i) { const int tt = 8 * rg - 3 + i;
            if (tt >= 0 || !first) R.x[i] = *(const u32x4*)(proj + (size_t)(row0 + tt) * DINP + PC_XBC + ch);
            else if (chunk >= 256) { const float* sp = F.in[I_SSC] + ((size_t)(layer * 8 + (chunk - 256)) * 3 + (tt + 3)) * 1024 + ch; const f32x4 a = *(const f32x4*)sp, b = *(const f32x4*)(sp + 4);
                u32x4 o; o.x = pk2(a.x, a.y); o.y = pk2(a.z, a.w); o.z = pk2(b.x, b.y); o.w = pk2(b.z, b.w); R.x[i] = o; }
            else R.x[i] = (u32x4){0u, 0u, 0u, 0u};
        }
    }
    R.z = *(const u32x4*)(proj + (size_t)(row0 + (F.tid >> 3)) * DINP + PC_CZ + 64 * h + 8 * (F.tid & 7));
    R.dtr = proj[(size_t)(row0 + F.lane) * DINP + PC_DT + h];
}
constexpr int SSD_WCV = 512;
DI void ssd_item_weights(const Ctx& F, int layer, int h) {
    typedef LAT<true> L; LAS float* tab = (LAS float*)(F.lds + L::O_TAB);
    if (F.tid < 200) { const int cidx = F.tid / 5, j = F.tid % 5, g = h >> 2;
        const int ch = cidx < 8 ? 64 * h + 8 * cidx : (cidx < 24 ? 512 + 128 * g + 8 * (cidx - 8) : 768 + 128 * g + 8 * (cidx - 24));
        const float* sp = j < 4 ? F.in[I_SCW] + (size_t)(layer * 4 + j) * 1024 + ch : F.in[I_SCB] + layer * 1024 + ch;
        *(LAS f32x4*)(tab + SSD_WCV + (cidx * 5 + j) * 8) = *(const f32x4*)sp; *(LAS f32x4*)(tab + SSD_WCV + (cidx * 5 + j) * 8 + 4) = *(const f32x4*)(sp + 4); }
    WG_BAR();
}
DI void ssd_stage(const Ctx& F, int layer, int h, const SsdRaw& R) {
    typedef LAT<true> L; LAS unsigned char* lds = F.lds; LAS float* tab = (LAS float*)(lds + L::O_TAB);
    if (F.wave == 7) { const int t = F.lane;
        const float dt = softplus_fast(bf2f(R.dtr) + F.in[I_SDTB][layer * 8 + h]); const float cum = wave_incl_scan(-dt * __expf(F.in[I_SALOG][layer * 8 + h]));
        const float last = __shfl(cum, 63);
        tab[t] = dt; tab[64 + t] = cum; tab[128 + t] = __expf(last - cum) * dt; tab[192 + t] = __expf(cum); if (t == 0) tab[256] = __expf(last); }
    if (F.tid < 320) { int cidx, rg, ch; ssd_task(F, h, cidx, rg, ch);
        float wv[4][8], bv[8];
#pragma unroll
        for (int j = 0; j < 4; ++j) { const f32x4 a = *(const LAS f32x4*)(tab + SSD_WCV + (cidx * 5 + j) * 8), b = *(const LAS f32x4*)(tab + SSD_WCV + (cidx * 5 + j) * 8 + 4); wv[j][0] = a.x; wv[j][1] = a.y; wv[j][2] = a.z; wv[j][3] = a.w; wv[j][4] = b.x; wv[j][5] = b.y; wv[j][6] = b.z; wv[j][7] = b.w; }
        { const f32x4 a = *(const LAS f32x4*)(tab + SSD_WCV + (cidx * 5 + 4) * 8), b = *(const LAS f32x4*)(tab + SSD_WCV + (cidx * 5 + 4) * 8 + 4); bv[0] = a.x; bv[1] = a.y; bv[2] = a.z; bv[3] = a.w; bv[4] = b.x; bv[5] = b.y; bv[6] = b.z; bv[7] = b.w; }
        float x0[8], x1[8], x2[8], x3[8]; unpack8(R.x[0], x0); unpack8(R.x[1], x1); unpack8(R.x[2], x2);
#pragma unroll
        for (int r = 0; r < 8; ++r) { const int t = 8 * rg + r; float o[8]; unpack8(R.x[r + 3], x3);
#pragma unroll
            for (int e = 0; e < 8; ++e) { const float v = bv[e] + wv[0][e] * x0[e] + wv[1][e] * x1[e] + wv[2][e] * x2[e] + wv[3][e] * x3[e]; o[e] = silu_f(v); x0[e] = x1[e]; x1[e] = x2[e]; x2[e] = x3[e]; }
            if (cidx < 8) *(LAS u32x4*)(lds + L::O_VV + t * L::PV + cidx * 16) = pack8(o);
            else if (cidx < 24) *(LAS u32x4*)(lds + L::O_KI + t * L::PA + (cidx - 8) * 16) = pack8(o);
            else *(LAS u32x4*)(lds + L::O_QD + t * L::PA + (cidx - 24) * 16) = pack8(o);
        }
    }
    WG_BAR();
    { const int t = F.tid >> 3, c8 = F.tid & 7; float xv[8]; unpack8(*(const LAS u32x4*)(lds + L::O_VV + t * L::PV + c8 * 16), xv); const float we = tab[128 + t];
#pragma unroll
        for (int e = 0; e < 8; ++e) xv[e] *= we;
        *(LAS u32x4*)(lds + L::O_VW + t * L::PV + c8 * 16) = pack8(xv); }
}

DI void gla_pass_a(const Ctx& F0, int layer, int panel, int h) {
    Ctx F = F0; OPAQUE_CTX(F);
    LAS unsigned char* lds = F.lds; const int w = F.wave, lane = F.lane, d = lane; const bf16_t* proj = wsb(F, WS_R); const int row0 = 256 * panel;
    constexpr int PK = 144, PVV = 272, O_KE = 0, O_V = 256 * PK, O_LR = O_V + 256 * PVV, O_TOT = O_LR + 256 * 16 * 4;
    static_assert(O_TOT + 2048 <= RING_BYTES, "gla pass A LDS");
    LAS float* lr = (LAS float*)(lds + O_LR); LAS float* tot = (LAS float*)(lds + O_TOT);
    float wlr[16];
#pragma unroll
    for (int r = 0; r < 16; ++r) wlr[r] = F.in[I_GWLR][(size_t)(layer * 16 + r) * 256 + 64 * h + d];
    const float blr = F.in[I_GBLR][layer * 256 + 64 * h + d];
    { const int t = F.tid >> 1, half = F.tid & 1; const u32x4 v = *(const u32x4*)(proj + (size_t)(row0 + t) * DINP + PC_BLR + 8 * half); float f[8]; unpack8(v, f);
#pragma unroll
        for (int i = 0; i < 8; ++i) lr[t * 16 + 8 * half + i] = f[i]; }
    unsigned short kr[32];
#pragma unroll
    for (int i = 0; i < 32; ++i) kr[i] = proj[(size_t)(row0 + 32 * w + i) * DINP + PC_BK + 64 * h + d];
#pragma unroll
    for (int i = 0; i < 8; ++i) { const int idx = F.tid + 512 * i, t = idx >> 4, c16 = idx & 15;
        *(LAS u32x4*)(lds + O_V + t * PVV + c16 * 16) = *(const u32x4*)(proj + (size_t)(row0 + t) * DINP + PC_BV + 128 * h + 8 * c16); }
    WG_BAR();
    float pre[32]; float run = 0.f;
#pragma unroll
    for (int i = 0; i < 32; ++i) { const int t = 32 * w + i; float z = blr;
#pragma unroll
        for (int r = 0; r < 16; ++r) z += lr[t * 16 + r] * wlr[r];
        run += logsig_fast(z) * (1.f / 16.f); pre[i] = run; }
    tot[w * 64 + d] = run;
    WG_BAR();
    float off = 0.f, last = 0.f;
#pragma unroll
    for (int ww = 0; ww < 8; ++ww) { const float tv = tot[ww * 64 + d]; last += tv; if (ww < w) off += tv; }
#pragma unroll
    for (int i = 0; i < 32; ++i) st_bf16(lds + O_KE, PK, 32 * w + i, d, bf2f(kr[i]) * __expf(last - (off + pre[i])));
    WG_BAR();
    f32x4 S[4];
#pragma unroll
    for (int x = 0; x < 4; ++x) S[x] = (f32x4){0.f, 0.f, 0.f, 0.f};
    const int mt = w >> 1;
#pragma unroll
    for (int ks = 0; ks < 8; ++ks) { const bf16x8 a = frag_tr(lds + O_KE, PK, 32 * ks, 16 * mt, lane);
#pragma unroll
        for (int x = 0; x < 4; ++x) { const bf16x8 b = frag_tr(lds + O_V, PVV, 32 * ks, 16 * (((4 * w + x) & 7)), lane); S[x] = MFMA16(a, b, S[x]); } }
    la_store_ds(wsf(F, WS_DS) + ((size_t)panel * 12 + h) * 8192, S, w, lane);
    if (w == 0) wsf(F, WS_DEC)[(panel * 4 + h) * 64 + d] = __expf(last);
    WG_BAR();
}
DI void ssd_pass_a(const Ctx& F0, int layer, int panel, int h) {
    Ctx F = F0; OPAQUE_CTX(F);
    LAS unsigned char* lds = F.lds; const int w = F.wave, lane = F.lane, g = h >> 2; const bf16_t* proj = wsb(F, WS_R); const int row0 = 256 * panel; const bool first = (panel & 31) == 0;
    constexpr int PB_ = 272, PX = 144, O_B = 0, O_XW = 256 * PB_, O_WE = O_XW + 256 * PX;
    static_assert(O_WE + 1024 <= RING_BYTES, "ssd pass A LDS");
    LAS float* wend = (LAS float*)(lds + O_WE);
    float last = 0.f;
    if (w == 0) {
        const float bias = F.in[I_SDTB][layer * 8 + h], A = -__expf(F.in[I_SALOG][layer * 8 + h]); float dt[4], cs[4]; float run = 0.f;
#pragma unroll
        for (int i = 0; i < 4; ++i) { dt[i] = softplus_fast(bf2f(proj[(size_t)(row0 + 4 * lane + i) * DINP + PC_DT + h]) + bias); run += dt[i] * A; cs[i] = run; }
        const float inc = wave_incl_scan(run);
        const float excl = inc - run; last = __shfl(inc, 63);
#pragma unroll
        for (int i = 0; i < 4; ++i) wend[4 * lane + i] = __expf(last - (excl + cs[i])) * dt[i];
    }
    WG_BAR();
    for (int pass = 0; pass < 2; ++pass) { const int task = F.tid + 512 * pass;
        if (task < 768) { const int cidx = task % 24, rg = task / 24;
            const int ch = cidx < 8 ? 64 * h + 8 * cidx : 512 + 128 * g + 8 * (cidx - 8);
            const float* cwp = F.in[I_SCW] + (size_t)layer * 4 * 1024 + ch; const float* cbp = F.in[I_SCB] + layer * 1024 + ch;
            float wv[4][8], bv[8];
#pragma unroll
            for (int j = 0; j < 4; ++j) { const f32x4 a = *(const f32x4*)(cwp + j * 1024), b = *(const f32x4*)(cwp + j * 1024 + 4); wv[j][0] = a.x; wv[j][1] = a.y; wv[j][2] = a.z; wv[j][3] = a.w; wv[j][4] = b.x; wv[j][5] = b.y; wv[j][6] = b.z; wv[j][7] = b.w; }
            { const f32x4 a = *(const f32x4*)cbp, b = *(const f32x4*)(cbp + 4); bv[0] = a.x; bv[1] = a.y; bv[2] = a.z; bv[3] = a.w; bv[4] = b.x; bv[5] = b.y; bv[6] = b.z; bv[7] = b.w; }
            u32x4 xr[11];
#pragma unroll
            for (int i = 0; i < 11; ++i) { const int tt = 8 * rg - 3 + i;
                if (tt >= 0 || !first) xr[i] = *(const u32x4*)(proj + (size_t)(row0 + tt) * DINP + PC_XBC + ch); else xr[i] = (u32x4){0u, 0u, 0u, 0u}; }
            float x0[8], x1[8], x2[8], x3[8]; unpack8(xr[0], x0); unpack8(xr[1], x1); unpack8(xr[2], x2);
#pragma unroll
            for (int r = 0; r < 8; ++r) { const int t = 8 * rg + r; float o[8]; unpack8(xr[r + 3], x3);
#pragma unroll
                for (int e = 0; e < 8; ++e) { const float v = bv[e] + wv[0][e] * x0[e] + wv[1][e] * x1[e] + wv[2][e] * x2[e] + wv[3][e] * x3[e]; o[e] = silu_f(v); x0[e] = x1[e]; x1[e] = x2[e]; x2[e] = x3[e]; }
                if (cidx < 8) { const float we = wend[t];
#pragma unroll
                    for (int e = 0; e < 8; ++e) o[e] *= we;
                    *(LAS u32x4*)(lds + O_XW + t * PX + cidx * 16) = pack8(o); }
                else *(LAS u32x4*)(lds + O_B + t * PB_ + (cidx - 8) * 16) = pack8(o);
            }
        }
    }
    WG_BAR();
    f32x4 S[4];
#pragma unroll
    for (int x = 0; x < 4; ++x) S[x] = (f32x4){0.f, 0.f, 0.f, 0.f};
#pragma unroll
    for (int ks = 0; ks < 8; ++ks) { const bf16x8 a = frag_tr(lds + O_B, PB_, 32 * ks, 16 * w, lane);
#pragma unroll
        for (int x = 0; x < 4; ++x) { const bf16x8 b = frag_tr(lds + O_XW, PX, 32 * ks, 16 * x, lane); S[x] = MFMA16(a, b, S[x]); } }
    la_store_ds(wsf(F, WS_DS) + ((size_t)panel * 12 + 4 + h) * 8192, S, w, lane);
    if (w == 0 && lane == 0) wsf(F, WS_DEC)[64 * 4 * 64 + panel * 8 + h] = __expf(last);
    WG_BAR();
}

template <bool SSD> DI void la_pass_c(const Ctx& F0, int layer, int c0, int nc, int h, bool dry) {
    Ctx F = F0; OPAQUE_CTX(F);
    typedef LAT<SSD> L; const int w = F.wave, lane = F.lane, q = lane >> 4, c = lane & 15, mt = w >> 1;
    bf16_t* proj = wsb(F, WS_R);
    f32x4 S[4];
    GlaCoef cf; GlaRaw gr; SsdRaw sr;
    if (!SSD) {
#pragma unroll
        for (int r = 0; r < 16; ++r) cf.wlr[r] = F.in[I_GWLR][(size_t)(layer * 16 + r) * 256 + 64 * h + lane];
        cf.blr = F.in[I_GBLR][layer * 256 + 64 * h + lane]; gla_load(F, h, c0, gr); }
    else { ssd_load(F, layer, h, c0, sr); ssd_item_weights(F, layer, h); }
    const int hh = SSD ? 4 + h : h;
    const Ctx Fp = F;
#pragma unroll 1
    for (int cc = 0; cc < nc; ++cc) { const int chunk = c0 + cc, row0 = 64 * chunk;
        Ctx F = Fp; { unsigned z_ = 0; asm volatile("" : "+s"(z_)); F.lds = Fp.lds + z_; } LAS unsigned char* lds = F.lds; LAS float* tab = (LAS float*)(lds + L::O_TAB);
        PB(SSD ? 5 : 15);
        if (cc == 0 || chunk_first(chunk)) {
            if (chunk < 256) la_load_ds(wsf(F, WS_DS) + ((size_t)(chunk >> 2) * 12 + hh) * 8192, S, w, lane);
            else { const int b = chunk - 256;
#pragma unroll
                for (int x = 0; x < 4; ++x) { int smt, snt; la_mt_nt<SSD>(4 * w + x, smt, snt);
                    if (SSD) { const float* sp = F.in[I_SS] + ((size_t)((layer * 8 + b) * 8 + h) * 64 + 16 * snt + c) * 128 + 16 * smt + 4 * q; S[x] = *(const f32x4*)sp; }
                    else { const float* sp = F.in[I_SG] + ((size_t)((layer * 8 + b) * 4 + h) * 64 + 16 * smt + 4 * q) * 128 + 16 * snt + c;
#pragma unroll
                        for (int r = 0; r < 4; ++r) S[x][r] = sp[r * 128]; } } }
            la_write_sb<SSD>(lds, S, w, lane);
        }
        PE(SSD ? 5 : 15);
        PB(SSD ? 1 : 11);
        u32x4 gate0, gate1;
        if (SSD) { ssd_stage(F, layer, h, sr); gate0 = sr.z; gate1 = gate0; if (cc + 1 < nc) ssd_load(F, layer, h, chunk + 1, sr); }
        else { gla_stage(F, cf, gr); gate0 = gr.g[0]; gate1 = gr.g[1]; if (cc + 1 < nc) gla_load(F, h, chunk + 1, gr); }
        PE(SSD ? 1 : 11); PB(SSD ? 2 : 12);
        la_compute_p<SSD>(lds, w, lane);
        WG_BAR();
        PE(SSD ? 2 : 12); PB(SSD ? 3 : 13);
        f32x4 o1[L::NT_O], o2[L::NT_O];
        la_compute_out<SSD>(lds, o1, o2, w, lane);
        la_state_update<SSD>(lds, S, w, lane);
        if (SSD) {
            const float Dh = F.in[I_SD][layer * 8 + h];
#pragma unroll
            for (int x = 0; x < L::NT_O; ++x) { const int p = 16 * ((w & 1) * L::NT_O + x) + c;
#pragma unroll
                for (int r = 0; r < 4; ++r) { const int i = 16 * mt + 4 * q + r; *(LAS float*)(lds + L::O_OT + i * L::POT + p * 4) = o1[x][r] + tab[192 + i] * o2[x][r] + Dh * ld_bf16(lds + L::O_VV, L::PV, i, p); } }
        } else {
            float ss[4] = {0.f, 0.f, 0.f, 0.f};
#pragma unroll
            for (int x = 0; x < L::NT_O; ++x) { const int e = 16 * ((w & 1) * L::NT_O + x) + c;
#pragma unroll
                for (int r = 0; r < 4; ++r) { const float o = o1[x][r] + o2[x][r]; ss[r] += o * o; *(LAS float*)(lds + L::O_OT + (16 * mt + 4 * q + r) * L::POT + e * 4) = o; } }
#pragma unroll
            for (int r = 0; r < 4; ++r) { float s = ss[r]; s += __shfl_xor(s, 1); s += __shfl_xor(s, 2); s += __shfl_xor(s, 4); s += __shfl_xor(s, 8);
                if (c == 0) tab[1600 + (16 * mt + 4 * q + r) * 2 + (w & 1)] = s; }
        }
        WG_BAR();
        PE(SSD ? 3 : 13); PB(SSD ? 4 : 14);
        if (SSD) { const int i = F.tid >> 3, p0 = 8 * (F.tid & 7); float zv[8], yv[8]; unpack8(gate0, zv); float ss = 0.f;
            const f32x4 ya = *(const LAS f32x4*)(lds + L::O_OT + i * L::POT + p0 * 4), yb = *(const LAS f32x4*)(lds + L::O_OT + i * L::POT + p0 * 4 + 16);
            yv[0] = ya.x; yv[1] = ya.y; yv[2] = ya.z; yv[3] = ya.w; yv[4] = yb.x; yv[5] = yb.y; yv[6] = yb.z; yv[7] = yb.w;
#pragma unroll
            for (int e = 0; e < 8; ++e) { yv[e] *= silu_f(zv[e]); ss += yv[e] * yv[e]; }
            ss += __shfl_xor(ss, 1); ss += __shfl_xor(ss, 2); ss += __shfl_xor(ss, 4);
            if (!dry) { *(u32x4*)(proj + (size_t)(row0 + i) * DINP + PC_CZ + 64 * h + p0) = pack8(yv);
                if ((F.tid & 7) == 0) { f32x2 pv; pv.x = ss; pv.y = 0.f; *(f32x2*)(wsf(F, WS_PSS) + (size_t)(row0 + i) * 16 + 2 * h) = pv; } }
        } else {
#pragma unroll
            for (int k = 0; k < 2; ++k) { const int idx = F.tid + 512 * k, i = idx >> 4, e0 = 8 * (idx & 15); float gv[8], yv[8]; unpack8(k ? gate1 : gate0, gv);
                const float rstd = rsqrtf((tab[1600 + 2 * i] + tab[1600 + 2 * i + 1]) * (1.f / 128.f) + EPS);
                const f32x4 ya = *(const LAS f32x4*)(lds + L::O_OT + i * L::POT + e0 * 4), yb = *(const LAS f32x4*)(lds + L::O_OT + i * L::POT + e0 * 4 + 16);
                const float* gn = F.in[I_GNORM] + layer * 512 + 128 * h + e0; const f32x4 na = *(const f32x4*)gn, nb = *(const f32x4*)(gn + 4);
                yv[0] = ya.x * na.x; yv[1] = ya.y * na.y; yv[2] = ya.z * na.z; yv[3] = ya.w * na.w; yv[4] = yb.x * nb.x; yv[5] = yb.y * nb.y; yv[6] = yb.z * nb.z; yv[7] = yb.w * nb.w;
#pragma unroll
                for (int e = 0; e < 8; ++e) yv[e] *= rstd * silu_f(gv[e]);
                if (!dry) *(u32x4*)(proj + (size_t)(row0 + i) * DINP + PC_BG + 128 * h + e0) = pack8(yv); }
        }
        if (chunk_last(chunk)) { if (!dry) { const int seq = chunk_seq(chunk);
            if (SSD) { float* so = st_out(F, O_PS, O_SS, layer, seq, 8 * 64 * 128) + (size_t)h * 64 * 128;
#pragma unroll
                for (int x = 0; x < 4; ++x) { int smt, snt; la_mt_nt<SSD>(4 * w + x, smt, snt); *(f32x4*)(so + (size_t)(16 * snt + c) * 128 + 16 * smt + 4 * q) = S[x]; } }
            else { float* so = st_out(F, O_PG, O_SG, layer, seq, 4 * 64 * 128) + (size_t)h * 64 * 128;
#pragma unroll
                for (int x = 0; x < 4; ++x) { int smt, snt; la_mt_nt<SSD>(4 * w + x, smt, snt);
#pragma unroll
                    for (int r = 0; r < 4; ++r) so[(size_t)(16 * smt + 4 * q + r) * 128 + 16 * snt + c] = S[x][r]; } } }
        } else if (cc + 1 < nc) la_write_sb<SSD>(lds, S, w, lane);
        WG_BAR();
        PE(SSD ? 4 : 14);
    }
}

struct LruSP { bf16x8 br[2], bi[2]; float b_r, b_i, lam, hin; };
template <bool PASS_C> DI void lru_load_sp(const Ctx& F, int layer, int h, int chunk, int nt, LruSP& p) {
    const int lane = F.lane, q = lane >> 4, c = lane & 15, col = 64 * h + 16 * nt + c;
    const bf16_t* wr_t = wsb(F, WS_LRUW) + (size_t)((layer * 2 + 0) * 8 + h) * 4096; const bf16_t* wi_t = wsb(F, WS_LRUW) + (size_t)((layer * 2 + 1) * 8 + h) * 4096;
#pragma unroll
    for (int ks = 0; ks < 2; ++ks) { const int o = (16 * nt + c) * 64 + 32 * ks + 8 * q; p.br[ks] = *(const bf16x8*)(wr_t + o); p.bi[ks] = *(const bf16x8*)(wi_t + o); }
    p.b_r = F.in[I_LBR][layer * 512 + col]; p.b_i = F.in[I_LBI][layer * 512 + col]; p.lam = F.in[I_LAM][layer * 512 + col]; p.hin = 0.f;
    if (PASS_C) p.hin = chunk >= 256 ? F.in[I_SLH][(size_t)(layer * 8 + (chunk - 256)) * 512 + col] : wsf(F, WS_LRUS)[(size_t)(2 * NCH + chunk) * 512 + col];
}
template <bool PASS_C> DI void lru_chunk(const Ctx& F0, int layer, int chunk, bool dry = false) {
    Ctx F = F0; OPAQUE_CTX(F);
    const int h = F.wave, lane = F.lane, q = lane >> 4, c = lane & 15, row0 = 64 * chunk; const bool first = chunk_first(chunk);
    LAS unsigned char* T = F.lds + h * 18432; LAS unsigned char* OT = T + 9216; constexpr int TP = 144;
    bf16_t* proj = wsb(F, WS_R);
    const int cc = lane & 7, rg = lane >> 3;
    PB(PASS_C ? 21 : 31);
    LruSP cur; lru_load_sp<PASS_C>(F, layer, h, chunk, 0, cur);
    {
        const int ch = 64 * h + 8 * cc; u32x4 xr[11];
#pragma unroll
        for (int i = 0; i < 11; ++i) { const int tt = 8 * rg - 3 + i;
            if (tt >= 0 || !first) xr[i] = *(const u32x4*)(proj + (size_t)(row0 + tt) * DINP + PC_AX + ch);
            else if (chunk >= 256) { const float* sp = F.in[I_SLC] + ((size_t)(layer * 8 + (chunk - 256)) * 3 + (tt + 3)) * 512 + ch; const f32x4 a = *(const f32x4*)sp, b = *(const f32x4*)(sp + 4);
                u32x4 o; o.x = pk2(a.x, a.y); o.y = pk2(a.z, a.w); o.z = pk2(b.x, b.y); o.w = pk2(b.z, b.w); xr[i] = o; }
            else xr[i] = (u32x4){0u, 0u, 0u, 0u};
        }
        const float* cwp = F.in[I_LCW] + (size_t)layer * 4 * 512 + ch; const float* cbp = F.in[I_LCB] + layer * 512 + ch;
        float wv[4][8], bv[8];
#pragma unroll
        for (int j = 0; j < 4; ++j) { const f32x4 a = *(const f32x4*)(cwp + j * 512), b = *(const f32x4*)(cwp + j * 512 + 4); wv[j][0] = a.x; wv[j][1] = a.y; wv[j][2] = a.z; wv[j][3] = a.w; wv[j][4] = b.x; wv[j][5] = b.y; wv[j][6] = b.z; wv[j][7] = b.w; }
        { const f32x4 a = *(const f32x4*)cbp, b = *(const f32x4*)(cbp + 4); bv[0] = a.x; bv[1] = a.y; bv[2] = a.z; bv[3] = a.w; bv[4] = b.x; bv[5] = b.y; bv[6] = b.z; bv[7] = b.w; }
        float x0[8], x1[8], x2[8], x3[8]; unpack8(xr[0], x0); unpack8(xr[1], x1); unpack8(xr[2], x2);
#pragma unroll
        for (int r = 0; r < 8; ++r) { float o[8]; unpack8(xr[r + 3], x3);
#pragma unroll
            for (int e = 0; e < 8; ++e) { o[e] = bv[e] + wv[0][e] * x0[e] + wv[1][e] * x1[e] + wv[2][e] * x2[e] + wv[3][e] * x3[e]; x0[e] = x1[e]; x1[e] = x2[e]; x2[e] = x3[e]; }
            *(LAS u32x4*)(T + (8 * rg + r) * TP + cc * 16) = pack8(o); }
    }
    LDS_WAIT();
    PE(PASS_C ? 21 : 31); PB(PASS_C ? 22 : 32);
#pragma unroll 1
    for (int nt = 0; nt < 4; ++nt) {
        LruSP nx = cur; if (nt < 3) lru_load_sp<PASS_C>(F, layer, h, chunk, nt + 1, nx);
        const int col = 64 * h + 16 * nt + c;
        const float c8 = -8.f * softplus_f(-cur.lam);
        float hc = cur.hin, pc = 1.f;
#pragma unroll
        for (int mt = 0; mt < 4; ++mt) {
            const bf16x8 a0 = frag_row(T, TP, 16 * mt, 0, lane), a1 = frag_row(T, TP, 16 * mt, 32, lane);
            f32x4 ar = {0.f, 0.f, 0.f, 0.f}, ai = {0.f, 0.f, 0.f, 0.f};
            ar = MFMA16(a0, cur.br[0], ar); ar = MFMA16(a1, cur.br[1], ar); ai = MFMA16(a0, cur.bi[0], ai); ai = MFMA16(a1, cur.bi[1], ai);
            float a[4], uu[4];
#pragma unroll
            for (int r = 0; r < 4; ++r) { const int t = 16 * mt + 4 * q + r; const float rg_ = sigm(ar[r] + cur.b_r), ig = sigm(ai[r] + cur.b_i), la = c8 * rg_;
                a[r] = __expf(la); uu[r] = __builtin_amdgcn_sqrtf(fmaxf(1.f - a[r] * a[r], 0.f)) * ig * ld_bf16(T, TP, t, 16 * nt + c); }
            const float P = (a[0] * a[1]) * (a[2] * a[3]); const float Hl = ((uu[0] * a[1] + uu[1]) * a[2] + uu[2]) * a[3] + uu[3];
            float hrun = hc, my_in = 0.f;
#pragma unroll
            for (int qq = 0; qq < 4; ++qq) { const float Pq = __shfl(P, c + 16 * qq), Hq = __shfl(Hl, c + 16 * qq); if (qq == q) my_in = hrun; hrun = Pq * hrun + Hq; pc *= Pq; }
            hc = hrun;
            if (PASS_C) { float hh = my_in;
#pragma unroll
                for (int r = 0; r < 4; ++r) { hh = a[r] * hh + uu[r]; st_bf16(OT, TP, 16 * mt + 4 * q + r, 16 * nt + c, hh); } }
        }
        if (!PASS_C) { if (q == 0) { wsf(F, WS_LRUS)[(size_t)chunk * 512 + col] = pc; wsf(F, WS_LRUS)[(size_t)(NCH + chunk) * 512 + col] = hc; } }
        else if (chunk_last(chunk) && q == 0 && !dry) st_out(F, O_PLH, O_SLH, layer, chunk_seq(chunk), 512)[col] = hc;
        cur = nx;
    }
    PE(PASS_C ? 22 : 32); PB(PASS_C ? 23 : 33);
    if (PASS_C) {
        LDS_WAIT();
        u32x4* gp = (u32x4*)(proj + (size_t)(row0 + rg) * DINP + PC_AG + 64 * h + 8 * cc); u32x4 gnx = *gp;
#pragma unroll 1
        for (int i = 0; i < 8; ++i) { const int t = rg + 8 * i; const u32x4 gc = gnx; u32x4* gq = gp + (size_t)i * (8 * DINP * 2 / 16);
            if (i < 7) gnx = *(gq + (8 * DINP * 2 / 16));
            float hv[8], gv[8]; unpack8(*(const LAS u32x4*)(OT + t * TP + cc * 16), hv); unpack8(gc, gv);
#pragma unroll
            for (int e = 0; e < 8; ++e) hv[e] *= gelu_t(gv[e]);
            if (!dry) *gq = pack8(hv); }
        if (chunk_last(chunk) && !dry) { float* so = st_out(F, O_PLC, O_SLC, layer, chunk_seq(chunk), 3 * 512);
#pragma unroll
            for (int i = 0; i < 3; ++i) so[i * 512 + 64 * h + lane] = bf2f(proj[(size_t)(row0 + 61 + i) * DINP + PC_AX + 64 * h + lane]); }
    }
    LDS_WAIT();
    PE(PASS_C ? 23 : 33);
}

DI void phase_mixer_a(const Ctx& F, int layer) {
    for (int it = blockIdx.x; it < 1034; it += F.G) {
        if (it < 256) gla_pass_a(F, layer, it >> 2, it & 3);
        else if (it < 768) ssd_pass_a(F, layer, (it - 256) >> 3, (it - 256) & 7);
        else if (it < 1024) lru_chunk<false>(F, layer, it - 768);
        else { const int seq = it - 1024, lastrow = seq < 2 ? 8192 * (seq + 1) - 1 : MP + 64 * (seq - 1) - 1;
            float* so = st_out(F, O_PSC, O_SSC, layer, seq, 3 * 1024); const bf16_t* proj = wsb(F, WS_R);
            for (int e = F.tid; e < 3 * 1024; e += 512) so[e] = bf2f(proj[(size_t)(lastrow - 2 + (e >> 10)) * DINP + PC_XBC + (e & 1023)]); }
        __syncthreads();
    }
}
DI void phase_mixer_b(const Ctx& F, int layer, bool dry) {
    float* ds = wsf(F, WS_DS); const float* dec = wsf(F, WS_DEC);
    for (int e = blockIdx.x * 512 + F.tid; e < 2 * 12 * 8192; e += F.G * 512) {
        const int idx = e & 8191, hh = (e >> 13) % 12, b = e / (12 * 8192);
        const int ln = idx & 63, r = (idx >> 6) & 3, Tt = idx >> 8; const int a = 16 * (Tt >> 3) + 4 * (ln >> 4) + r;
        float v[32];
#pragma unroll
        for (int p = 0; p < 32; ++p) v[p] = ds[((size_t)(32 * b + p) * 12 + hh) * 8192 + idx];
        float S = 0.f;
#pragma unroll
        for (int p = 0; p < 32; ++p) { const int panel = 32 * b + p; const float dc = hh < 4 ? dec[(panel * 4 + hh) * 64 + a] : dec[64 * 4 * 64 + panel * 8 + (hh - 4)];
            if (!dry) ds[((size_t)panel * 12 + hh) * 8192 + idx] = S; S = dc * S + v[p]; }
    }
    {
        const int gw = blockIdx.x * NWAVES + F.wave; float* ls = wsf(F, WS_LRUS);
        if (gw < 1024) { const int b = gw >> 9, ch = gw & 511, l = F.lane; const int c0 = 128 * b + 2 * l;
            const float A0 = ls[(size_t)c0 * 512 + ch], H0 = ls[(size_t)(NCH + c0) * 512 + ch], A1 = ls[(size_t)(c0 + 1) * 512 + ch], H1 = ls[(size_t)(NCH + c0 + 1) * 512 + ch];
            float A = A1 * A0, H = A1 * H0 + H1;
#pragma unroll
            for (int o = 1; o < 64; o <<= 1) { const float Ap = __shfl_up(A, o), Hp = __shfl_up(H, o); if (l >= o) { H = A * Hp + H; A = A * Ap; } }
            float E = __shfl_up(H, 1); if (l == 0) E = 0.f;
            ls[(size_t)(2 * NCH + c0) * 512 + ch] = E; ls[(size_t)(2 * NCH + c0 + 1) * 512 + ch] = A0 * E + H0; }
    }
}
#ifndef MIX_MASK
#define MIX_MASK 7
#endif
#ifndef DRY_MIX
#define DRY_MIX 7
#endif
DI void phase_mixer_c(const Ctx& F, int layer, bool dry) {
    const int mm = dry ? DRY_MIX : MIX_MASK;
    for (int it = blockIdx.x; it < 1128; it += F.G) {
        if (it < 512) { if (mm & 1) la_pass_c<true>(F, layer, 4 * (it >> 3), 4, it & 7, dry); }
        else if (it < 768) { if (mm & 2) la_pass_c<false>(F, layer, 4 * ((it - 512) >> 2), 4, (it - 512) & 3, dry); }
        else if (it < 1032) { if (mm & 4) lru_chunk<true>(F, layer, it - 768, dry); }
        else if (it < 1096) { if (mm & 1) la_pass_c<true>(F, layer, 256 + ((it - 1032) >> 3), 1, (it - 1032) & 7, dry); }
        else { if (mm & 2) la_pass_c<false>(F, layer, 256 + ((it - 1096) >> 2), 1, (it - 1096) & 3, dry); }
        __syncthreads();
    }
}
DI void phase_ssd_norm(const Ctx& F, int layer, bool dry) {
    const int gw = F.vcu * NWAVES + F.wave, NGW = F.G * NWAVES; bf16_t* proj = wsb(F, WS_R); const float* pss = wsf(F, WS_PSS);
    float gn[8]; { const float* gp = F.in[I_SNORM] + layer * 512 + 8 * F.lane; const f32x4 a = *(const f32x4*)gp, b = *(const f32x4*)(gp + 4); gn[0] = a.x; gn[1] = a.y; gn[2] = a.z; gn[3] = a.w; gn[4] = b.x; gn[5] = b.y; gn[6] = b.z; gn[7] = b.w; }
    for (int m = gw; m < M; m += NGW) {
        const f32x4* p = (const f32x4*)(pss + (size_t)m * 16); const f32x4 a = p[0], b = p[1], c = p[2], d = p[3];
        const float s = ((a.x + a.y) + (a.z + a.w)) + ((b.x + b.y) + (b.z + b.w)) + ((c.x + c.y) + (c.z + c.w)) + ((d.x + d.y) + (d.z + d.w));
        const float rstd = rsqrtf(s * (1.f / 512.f) + EPS);
        u32x4* yp = (u32x4*)(proj + (size_t)m * DINP + PC_CZ + 8 * F.lane); float v[8]; unpack8(*yp, v);
#pragma unroll
        for (int e = 0; e < 8; ++e) v[e] *= rstd * gn[e];
        *yp = pack8(v);
    }
}
DI void phase_final(const Ctx& F) {
    const int gw = F.vcu * NWAVES + F.wave, NGW = F.G * NWAVES; const float* rss = wsf(F, WS_RSSN) + (size_t)XB_PAD * 16; const float* gf = F.in[I_NFIN]; const bf16_t* xs = wsb(F, WS_XBN);
    for (int m = gw; m < M; m += NGW) { const float rs = row_rstd(rss, m); f32x4* y4 = (f32x4*)(F.out + (size_t)m * D) + F.lane; const u32x2* x2 = (const u32x2*)(xs + (size_t)m * D) + F.lane;
#pragma unroll
        for (int j = 0; j < 4; ++j) { const f32x4 g = *((const f32x4*)gf + F.lane + 64 * j); const u32x2 xw = x2[64 * j];
            f32x4 y; y[0] = __uint_as_float(xw.x << 16) * rs * g[0]; y[1] = __uint_as_float(xw.x & 0xffff0000u) * rs * g[1]; y[2] = __uint_as_float(xw.y << 16) * rs * g[2]; y[3] = __uint_as_float(xw.y & 0xffff0000u) * rs * g[3];
            y4[64 * j] = y; } }
}

constexpr int PH_PER_LAYER = 9, N_PHASES = 1 + DEPTH * PH_PER_LAYER + 1;
__global__ void __launch_bounds__(NWAVES * 64, 2) mk_fwd(Args args) {
    extern __shared__ __attribute__((aligned(16))) unsigned char lds_raw[];
    Ctx F; F.lds = (LAS unsigned char*)lds_raw; F.in = args.in; F.out = args.out; F.ws = args.ws;
    F.wave = __builtin_amdgcn_readfirstlane((int)threadIdx.x >> 6); F.lane = 0; F.tid = 0;
#define T0() (F.wave == 0 && lane_id() == 0)
    F.G = gridDim.x; { const int bx = blockIdx.x; F.vcu = (F.G % 8 == 0) ? (bx % 8) * (F.G / 8) + bx / 8 : bx; }
    volatile LAS unsigned* MISC = (volatile LAS unsigned*)(F.lds + MISC_OFF);
    if (F.wave == 0) MISC[lane_id()] = 0u;
    __syncthreads();
    XcdBarrier bar; bar.bar = (unsigned*)(args.ws + WS_CTL); bar.x = 0; bar.st = nullptr;
    if (args.use_bar) bar = xcd_barrier_post((unsigned*)(args.ws + WS_CTL), MISC + 8, T0());
    const int lo = args.ph_lo, hi = args.ph_hi;
#ifndef PH_MASK
#define PH_MASK 0xFFFFu
#endif
#define IN(k) (lo <= (k) && (k) < hi)
#define ON(b) ((PH_MASK >> (b)) & 1u)
#define SEAM(k) do { if (IN(k) && IN((k) + 1)) xcd_barrier(bar, T0()); } while (0)
#ifndef REP_MASK
#define REP_MASK 0
#endif
#define REPS(b) ((REP_MASK >> (b)) & 1)
#define XBAR() do { if (args.use_bar) xcd_barrier(bar, T0()); } while (0)
#define GP bf16_t* XB = wsb(C, WS_XB) + (size_t)XB_PAD * D; float* RSS = wsf(C, WS_RSS) + (size_t)XB_PAD * 16; bf16_t* XBN = (bf16_t*)C.out; bf16_t* XBNO = layer + 1 < DEPTH ? (bf16_t*)C.out : wsb(C, WS_XBN); float* RSSN = wsf(C, WS_RSSN) + (size_t)XB_PAD * 16; \
    (void)XB; (void)RSS; (void)XBN; (void)XBNO; (void)RSSN
#define PHC Ctx C = F; C.lane = lane_id(); C.tid = C.wave * 64 + C.lane; OPAQUE_CTX(C); { size_t zz_ = 0; asm volatile("" : "+s"(zz_)); C.ws = F.ws + zz_; C.out = (float*)((char*)F.out + zz_); }
    PB(100);
    for (int rr_ = 0; rr_ <= REPS(0); ++rr_) { if (IN(0) && ON(0)) { PHC; convert_set(C, 0, 1 | 2 | 4 | 8 | 16 | 32 | 64 | 128, C.vcu, C.G); p0_rows(C); } if (rr_ < REPS(0)) XBAR(); }
    PE(100); PB(120); SEAM(0); PE(120);
    for (int layer = 0; layer < DEPTH; ++layer) {
        const int pb = 1 + layer * PH_PER_LAYER;
        PB(101);
        for (int rr_ = 0; rr_ <= REPS(1); ++rr_) { if (rr_) XBAR();
        if (IN(pb + 0) && ON(1)) { PHC; GP;
            pg8::Gemm g{XBN, wsb(C, WS_WIN), D, D, D}; pg8::StaticOrder S; S.init(M / 256, DINP / 256, C.G, (int)blockIdx.x, 0);
            EpiProj E{wsb(C, WS_R), RSSN}; pg8::gemm_phase<EpiProj, pg8::StaticOrder>(C.lds, g, S, E, C.wave);
            if (layer >= 1 && rr_ == 0 && C.G == 256 && (int)blockIdx.x >= 98) { __syncthreads(); convert_set(C, layer, 2 | 4 | 8 | 16 | 32 | 64, (int)blockIdx.x - 98, C.G - 98); }
            else if (layer >= 1 && rr_ == 0 && C.G != 256) { __syncthreads(); convert_set(C, layer, 2 | 4 | 8 | 16 | 32 | 64, C.vcu, C.G); }
        } }
        PE(101); PB(120); PB(121); SEAM(pb + 0); PE(121); PE(120); PB(102);
        for (int rr_ = 0; rr_ <= REPS(2); ++rr_) { if (rr_) XBAR(); if (IN(pb + 1) && ON(2)) { PHC; phase_mixer_a(C, layer); } }
        PE(102); PB(120); PB(123); SEAM(pb + 1); PE(123); PE(120); PB(103);
        for (int rr_ = 0; rr_ <= REPS(3); ++rr_) { if (rr_) XBAR();
        if (IN(pb + 2) && ON(3)) { PHC; phase_mixer_b(C, layer, rr_ < REPS(3));
            if (layer + 1 < DEPTH) convert_set(C, layer + 1, 1, C.vcu, C.G); } }
        PE(103); PB(120); PB(122); SEAM(pb + 2); PE(122); PE(120); PB(104);
        for (int rr_ = 0; rr_ <= REPS(4); ++rr_) { if (rr_) XBAR(); if (IN(pb + 3) && ON(4)) { PHC; phase_mixer_c(C, layer, rr_ < REPS(4)); } }
        PE(104); PB(120); PB(124); SEAM(pb + 3); PE(124); PE(120); PB(105);
        for (int rr_ = 0; rr_ <= REPS(5); ++rr_) { if (rr_) XBAR(); if (IN(pb + 4) && ON(5)) { PHC; phase_ssd_norm(C, layer, rr_ < REPS(5)); } }
        PE(105); PB(120); SEAM(pb + 4); PE(120); PB(106);
        for (int rr_ = 0; rr_ <= REPS(6); ++rr_) { if (rr_) XBAR(); const bool dry_ = rr_ < REPS(6);
        if (IN(pb + 5) && ON(6)) { PHC; GP;
            pg8::Gemm g{wsb(C, WS_R) + PC_Y, wsb(C, WS_WOUT), DINP, DMIX, DMIX}; pg8::StaticOrder S; S.init(MP / 256, D / 256, C.G, (int)blockIdx.x, 0);
            EpiRes E{XBN, XB, RSS, dry_};
            pg8::gemm_phase<EpiRes, pg8::StaticOrder>(C.lds, g, S, E, C.wave);
            { constexpr int SK = 6, KS = DMIX / SK; const int c = (int)blockIdx.x, j = c / SK, sl = c % SK;
              pg8::Gemm g2{wsb(C, WS_R) + PC_Y + sl * KS, wsb(C, WS_WOUT) + sl * KS, DINP, DMIX, KS}; OneUnit S2{64 + (j >> 2), j & 3, c < 8 * SK};
              EpiPart E2{C.out + (size_t)M * D / 2 + (size_t)(c < 8 * SK ? c : 0) * 65536}; pg8::gemm_phase<EpiPart, OneUnit>(C.lds, g2, S2, E2, C.wave); }
        } }
        XBAR();
        if (IN(pb + 5) && ON(6)) { PHC; GP; reduce_tail<0>(C, C.out + (size_t)M * D / 2, 6, XBN, XB, RSS, RSS, nullptr); }
        PE(106); PB(120); SEAM(pb + 5); PE(120); PB(107);
        for (int rr_ = 0; rr_ <= REPS(7); ++rr_) { if (rr_) XBAR();
        if (IN(pb + 6) && ON(7)) { PHC; GP;
            pg8::Gemm g{XB, wsb(C, WS_WGU), D, D, D}; pg8::StaticOrder S; S.init(67, 2 * DFF / 256, C.G, (int)blockIdx.x, 1);
            EpiFfn E{wsb(C, WS_R), RSS, C.in[I_FCW] + (size_t)layer * 3 * DFF, C.in[I_FCB] + layer * DFF, C.in[I_SFC] + (size_t)layer * 8 * 2 * DFF,
                     C.out + O_PFC + (size_t)layer * 2 * 2 * DFF, C.out + O_SFC + (size_t)layer * 8 * 2 * DFF};
            pg8::gemm_phase<EpiFfn, pg8::StaticOrder>(C.lds, g, S, E, C.wave);
            if (rr_ == 0) { const int sh = C.G == 256 ? 72 : 0;
                if ((int)blockIdx.x >= sh) { pg8::Gemm g2{wsb(C, WS_PB), wsb(C, WS_WPP), DPLE, DPLE, DPLE}; pg8::StaticOrder S2; S2.init(M / 256, D / 256, C.G - sh, (int)blockIdx.x - sh, 0);
                    EpiPP E2{wsb(C, WS_PPO)}; pg8::gemm_phase<EpiPP, pg8::StaticOrder>(C.lds, g2, S2, E2, C.wave); } }
        } }
        PE(107); PB(120); SEAM(pb + 6); PE(120); PB(108);
        for (int rr_ = 0; rr_ <= REPS(8); ++rr_) { if (rr_) XBAR(); const bool dry_ = rr_ < REPS(8);
        if (IN(pb + 7) && ON(8)) { PHC; GP;
            pg8::Gemm g{wsb(C, WS_R), wsb(C, WS_WD), DFF, DFF, DFF}; pg8::StaticOrder S; S.init(MP / 256, D / 256, C.G, (int)blockIdx.x, 0);
            EpiRes E{XB, XB, RSS, dry_}; pg8::gemm_phase<EpiRes, pg8::StaticOrder>(C.lds, g, S, E, C.wave);
            { constexpr int SK = 12, KS = DFF / SK; const int c = (int)blockIdx.x, j = c / SK, sl = c % SK;
              pg8::Gemm g2{wsb(C, WS_R) + sl * KS, wsb(C, WS_WD) + sl * KS, DFF, DFF, KS}; OneUnit S2{64 + (j >> 2), j & 3, c < 8 * SK};
              EpiPart E2{C.out + (size_t)M * D / 2 + (size_t)(c < 8 * SK ? c : 0) * 65536}; pg8::gemm_phase<EpiPart, OneUnit>(C.lds, g2, S2, E2, C.wave); }
        } }
        XBAR();
        if (IN(pb + 7) && ON(8)) { PHC; GP; reduce_tail<0>(C, C.out + (size_t)M * D / 2, 12, XB, XB, RSS, RSS, nullptr); }
        PE(108); PB(120); SEAM(pb + 7); PE(120); PB(109);
        for (int rr_ = 0; rr_ <= REPS(9); ++rr_) { if (rr_) XBAR(); const bool dry_ = rr_ < REPS(9);
        if (IN(pb + 8) && ON(9)) { PHC; GP;
            pg8::Gemm g{XB, wsb(C, WS_WPG), D, D, D}; pg8::StaticOrder S; S.init(MP / 256, D / 256, C.G, (int)blockIdx.x, 0);
            EpiPle E{XB, XBNO, RSS, RSSN, wsb(C, WS_PPO), dry_}; pg8::gemm_phase<EpiPle, pg8::StaticOrder>(C.lds, g, S, E, C.wave);
            { constexpr int SK = 4, KS = D / SK; const int c = (int)blockIdx.x, j = c / SK, sl = c % SK;
              pg8::Gemm g2{XB + sl * KS, wsb(C, WS_WPG) + sl * KS, D, D, KS}; OneUnit S2{64 + (j >> 2), j & 3, c < 8 * SK};
              EpiPart E2{C.out + (size_t)M * D / 2 + (size_t)(c < 8 * SK ? c : 0) * 65536}; pg8::gemm_phase<EpiPart, OneUnit>(C.lds, g2, S2, E2, C.wave); }
        } }
        XBAR();
        if (IN(pb + 8) && ON(9)) { PHC; GP; reduce_tail<1>(C, C.out + (size_t)M * D / 2, 4, XB, XBNO, RSS, RSSN, wsb(C, WS_PPO)); }
        PE(109); PB(120); SEAM(pb + 8); PE(120); PB(110);
    }
    PB(111);
    if (IN(N_PHASES - 1) && ON(10)) { PHC; phase_final(C); }
    PE(111);
    if (PROBE_ID != 0 && (int)blockIdx.x == PROBE_WG) { __syncthreads(); if (F.wave == 0) { const unsigned tot = MISC[32] * PROBE_MULT; const unsigned t0 = (unsigned)__builtin_amdgcn_s_memrealtime();
        while ((unsigned)__builtin_amdgcn_s_memrealtime() - t0 < tot) __builtin_amdgcn_s_sleep(8); } }
#undef IN
#undef ON
#undef SEAM
}

extern "C" void kernel_launch(void* const* d_in, const int* in_sizes, int n_in, void* d_out, int out_size, void* d_ws, size_t ws_size, hipStream_t stream) {
    static int grid = 0;
    if (grid == 0) {
        if (n_in != N_IN || (size_t)out_size != O_END || ws_size < WS_END) { fprintf(stderr, "kernel_launch: unexpected shapes: n_in %d out %d ws %zu (need %d, %zu, %zu)\n", n_in, out_size, ws_size, (int)N_IN, (size_t)O_END, (size_t)WS_END); grid = -1; return; }
        int dev = 0, cus = 0, per_cu = 0;
        if (hipGetDevice(&dev) != hipSuccess || hipDeviceGetAttribute(&cus, hipDeviceAttributeMultiprocessorCount, dev) != hipSuccess) { grid = -1; return; }
        if (hipFuncSetAttribute((const void*)mk_fwd, hipFuncAttributeMaxDynamicSharedMemorySize, LDS_BYTES) != hipSuccess) { fprintf(stderr, "kernel_launch: hipFuncSetAttribute failed\n"); grid = -1; return; }
        if (hipOccupancyMaxActiveBlocksPerMultiprocessor(&per_cu, (const void*)mk_fwd, NWAVES * 64, LDS_BYTES) != hipSuccess || per_cu < 1) { fprintf(stderr, "kernel_launch: occupancy query says %d\n", per_cu); per_cu = 1; }
        (void)hipGetLastError();
        grid = cus;
    }
    if (grid < 0) return;
    (void)hipMemsetAsync((char*)d_ws + WS_CTL, 0, CTL_ZERO_BYTES, stream);
    Args a{};
    for (int i = 0; i < N_IN; ++i) a.in[i] = (const float*)d_in[i];
    a.out = (float*)d_out; a.ws = (unsigned char*)d_ws;
#if MK_PER_PHASE
    for (int p = 0; p < N_PHASES; ++p) { a.ph_lo = p; a.ph_hi = p + 1; a.use_bar = 0; hipLaunchKernelGGL(mk_fwd, dim3(grid), dim3(NWAVES * 64), LDS_BYTES, stream, a); }
#else
    a.ph_lo = 0; a.ph_hi = N_PHASES; a.use_bar = 1;
    void* kargs[] = {&a};
    hipError_t e = hipLaunchCooperativeKernel((const void*)mk_fwd, dim3(grid), dim3(NWAVES * 64), kargs, LDS_BYTES, stream);
    if (e != hipSuccess) fprintf(stderr, "kernel_launch: cooperative launch failed: %s\n", hipGetErrorString(e));
#endif
}
```

```cpp
#include <hip/hip_runtime.h>
#include <cstdio>
#include <cstdint>

#define DI __device__ __forceinline__
#define LAS __attribute__((address_space(3)))
typedef unsigned short bf16_t;
typedef short bf16x8 __attribute__((ext_vector_type(8)));
typedef short s16x4 __attribute__((ext_vector_type(4)));
typedef float f32x4 __attribute__((ext_vector_type(4)));
typedef float f32x2 __attribute__((ext_vector_type(2)));
typedef unsigned u32x4 __attribute__((ext_vector_type(4)));
typedef unsigned u32x2 __attribute__((ext_vector_type(2)));

#ifndef MK_PER_PHASE
#define MK_PER_PHASE 0
#endif

constexpr int DEPTH = 2, D = 1024, MP = 16384, MS = 512, M = MP + MS;
constexpr int DIN = 4120, DINP = 4352, DFF = 3072, DMIX = 1536, DPLE = 256;
constexpr int NCH = M / 64;
constexpr float EPS = 1e-6f;
constexpr int PC_AX = 0, PC_BQ = 512, PC_BK = 768, PC_BV = 1024, PC_BLR = 1536, PC_XBC = 1552, PC_DT = 2576, PC_PAD = 2584, PC_Y = 2816, PC_AG = 2816, PC_BG = 3328, PC_CZ = 3840;

enum { I_XP = 0, I_XS, I_SLC, I_SLH, I_SG, I_SSC, I_SS, I_SFC, I_PP, I_PS, I_NMIX, I_WIN, I_LCW, I_LCB, I_LWR, I_LBR, I_LWI, I_LBI, I_LAM, I_GWLR, I_GBLR, I_GNORM,
       I_SCW, I_SCB, I_SDTB, I_SALOG, I_SD, I_SNORM, I_WOUT, I_NFFN, I_WG, I_WU, I_FCW, I_FCB, I_WD, I_NPLE, I_PWG, I_PWP, I_NFIN, N_IN };
constexpr size_t O_Y = 0;
constexpr size_t O_PLC = (size_t)M * D;
constexpr size_t O_PLH = O_PLC + 2 * 2 * 3 * 512;
constexpr size_t O_PG = O_PLH + 2 * 2 * 512;
constexpr size_t O_PSC = O_PG + 2 * 2 * 4 * 64 * 128;
constexpr size_t O_PS = O_PSC + 2 * 2 * 3 * 1024;
constexpr size_t O_PFC = O_PS + 2 * 2 * 8 * 64 * 128;
constexpr size_t O_SLC = O_PFC + 2 * 2 * 2 * 3072;
constexpr size_t O_SLH = O_SLC + 2 * 8 * 3 * 512;
constexpr size_t O_SG = O_SLH + 2 * 8 * 512;
constexpr size_t O_SSC = O_SG + 2 * 8 * 4 * 64 * 128;
constexpr size_t O_SS = O_SSC + 2 * 8 * 3 * 1024;
constexpr size_t O_SFC = O_SS + 2 * 8 * 8 * 64 * 128;
constexpr size_t O_END = O_SFC + 2 * 8 * 2 * 3072;

constexpr size_t MiB = 1u << 20;
constexpr size_t al4k(size_t x) { return (x + 4095) & ~(size_t)4095; }
constexpr int XB_PAD = 256;
constexpr int XB_ROWS = XB_PAD + M + 128;
constexpr size_t WS_CTL = 0, CTL_ZERO_BYTES = 64 * 1024;
constexpr size_t WS_WIN = al4k(WS_CTL + CTL_ZERO_BYTES);
constexpr size_t WS_WOUT = al4k(WS_WIN + (size_t)DINP * D * 2);
constexpr size_t WS_WGU = al4k(WS_WOUT + (size_t)D * DMIX * 2);
constexpr size_t WS_WD = al4k(WS_WGU + (size_t)2 * DFF * D * 2);
constexpr size_t WS_WPG = al4k(WS_WD + (size_t)D * DFF * 2);
constexpr size_t WS_WPP = al4k(WS_WPG + (size_t)D * D * 2);
constexpr size_t WS_LRUW = al4k(WS_WPP + (size_t)D * DPLE * 2);
constexpr size_t WS_RSS = al4k(WS_LRUW + (size_t)DEPTH * 2 * 8 * 4096 * 2);
constexpr size_t WS_RSSN = al4k(WS_RSS + (size_t)XB_ROWS * 64);
constexpr size_t WS_PSS = al4k(WS_RSSN + (size_t)XB_ROWS * 64);
constexpr size_t WS_LRUS = al4k(WS_PSS + (size_t)M * 64);
constexpr size_t WS_DEC = al4k(WS_LRUS + (size_t)3 * NCH * 512 * 4);
constexpr size_t WS_PB = al4k(WS_DEC + (size_t)(64 * 4 * 64 + 64 * 8) * 4);
constexpr size_t WS_XB = al4k(WS_PB + (size_t)M * DPLE * 2);
constexpr size_t WS_DS = al4k(WS_XB + (size_t)XB_ROWS * D * 2);
constexpr size_t WS_XBN = WS_DS;
constexpr size_t WS_R = al4k(WS_DS + (size_t)M * D * 2);
constexpr size_t WS_PPO = WS_R + 100 * MiB;
constexpr size_t WS_END = WS_R + (size_t)M * DINP * 2;
static_assert(WS_END <= 256 * MiB, "workspace");
static_assert((size_t)64 * 12 * 8192 * 4 <= (size_t)M * D * 2, "DS fits the XBN slot");
static_assert((size_t)M * DFF * 2 <= 100 * MiB && WS_PPO + (size_t)M * D * 2 <= WS_END, "overlay");

constexpr int MISC_OFF = 147456 + 4096;
DI float bf2f(bf16_t b) { return __uint_as_float(((unsigned)b) << 16); }
DI unsigned f2bf(float f) { unsigned u = __float_as_uint(f); return (u + 0x7fffu + ((u >> 16) & 1u)) >> 16; }
DI unsigned pk2(float lo, float hi) { return f2bf(lo) | (f2bf(hi) << 16); }
DI float sigm(float x) { return __builtin_amdgcn_rcpf(1.f + __expf(-x)); }
DI float silu_f(float x) { return x * __builtin_amdgcn_rcpf(1.f + __expf(-x)); }
DI float gelu_t(float x) { const float u = 1.5957691216f * (x + 0.044715f * x * x * x); return x * __builtin_amdgcn_rcpf(1.f + __expf(-u)); }
DI float softplus_f(float x) { return fmaxf(x, 0.f) + log1pf(__expf(-fabsf(x))); }
DI float logsig_f(float x) { return fminf(x, 0.f) - log1pf(__expf(-fabsf(x))); }
template <int CTRL> DI float dpp_ror(float x) { return __builtin_bit_cast(float, __builtin_amdgcn_mov_dpp(__builtin_bit_cast(int, x), CTRL, 0xf, 0xf, false)); }
DI float gelu_mul(float x, float up) { const float a = x * __builtin_fmaf(x * x, -0.10294324f, -2.3022082f); return (x * up) * __builtin_amdgcn_rcpf(1.f + __builtin_amdgcn_exp2f(a)); }
DI float log1p_small(float e) { return e < 0.01f ? e * (1.f - e * (0.5f - e * 0.33333334f)) : __logf(1.f + e); }
DI float softplus_fast(float x) { return fmaxf(x, 0.f) + log1p_small(__expf(-fabsf(x))); }
DI float logsig_fast(float x) { return fminf(x, 0.f) - __logf(1.f + __expf(-fabsf(x))); }
DI float wave_incl_scan(float v) {
#define DPPF(x, ctrl, rm, bc) __builtin_bit_cast(float, __builtin_amdgcn_update_dpp(0, __builtin_bit_cast(int, (x)), (ctrl), (rm), 0xf, (bc)))
    v += DPPF(v, 0x111, 0xf, true); v += DPPF(v, 0x112, 0xf, true); v += DPPF(v, 0x114, 0xf, true); v += DPPF(v, 0x118, 0xf, true);
    v += DPPF(v, 0x142, 0xa, false); v += DPPF(v, 0x143, 0xc, false);
#undef DPPF
    return v;
}
DI void unpack8(const u32x4 v, float (&o)[8]) {
#pragma unroll
    for (int i = 0; i < 4; ++i) { o[2 * i] = __uint_as_float(v[i] << 16); o[2 * i + 1] = __uint_as_float(v[i] & 0xffff0000u); }
}
DI u32x4 pack8(const float (&o)[8]) { u32x4 r; r.x = pk2(o[0], o[1]); r.y = pk2(o[2], o[3]); r.z = pk2(o[4], o[5]); r.w = pk2(o[6], o[7]); return r; }
DI int lane_id() { int l; asm volatile("v_mbcnt_lo_u32_b32 %0, -1, 0\n\tv_mbcnt_hi_u32_b32 %0, -1, %0" : "=v"(l)); return l; }
#define LDS_WAIT() asm volatile("s_waitcnt lgkmcnt(0)" ::: "memory")
#define VM_WAIT() asm volatile("s_waitcnt vmcnt(0)" ::: "memory")

namespace pg8 {
constexpr int BM = 256, BK = 64, HALF = 128, HTB = HALF * BK * 2, STAGE_BYTES = 8 * HTB, NXCD = 8, WGM = 8;
__host__ __device__ __forceinline__ int lds_byte(int r, int c) { const int st = (r >> 4) * 2 + (c >> 5), rr = r & 15, cc = c & 31, ob = rr * 64 + cc * 2; return st * 1024 + (ob ^ (((ob >> 9) & 1) << 5)); }
__host__ __device__ __forceinline__ void stage_rc(int b, int& R, int& C) { const int st = b / 1024, sb = b % 1024, swz = sb ^ (((sb >> 9) & 1) << 5); R = (st >> 1) * 16 + swz / 64; C = (st & 1) * 32 + (swz % 64) / 2; }
__host__ __device__ __forceinline__ int perm32(int rho) { const int n = rho >> 4, i = rho & 15; return 8 * (i >> 2) + 4 * n + (i & 3); }

struct Unit { int pm, pn, arow; };
struct Gemm { const bf16_t* A; const bf16_t* Bt; int lda, ldb, K; };

struct StaticOrder {
    int nM, nN, nwg, G, c, shifted;
    __device__ void init(int nM_, int nN_, int G_, int c_, int shifted_) { nM = nM_; nN = nN_; nwg = nM * nN; G = G_; c = c_; shifted = shifted_; }
    __device__ bool next(int i, Unit& u) const {
        const long L = (long)i * G + c; if (L >= nwg) return false;
        int wgid = (int)L; { const int q = nwg / NXCD, r = nwg % NXCD, xcd = wgid % NXCD, off = wgid / NXCD; wgid = (xcd < r ? xcd * (q + 1) : r * (q + 1) + (xcd - r) * q) + off; }
        const int nig = WGM * nN, gid = wgid / nig, fm = gid * WGM, gsz = (nM - fm) < WGM ? (nM - fm) : WGM;
        u.pm = fm + ((wgid % nig) % gsz); u.pn = (wgid % nig) / gsz; u.arow = shifted ? 254 * u.pm - 2 : 256 * u.pm; return true;
    }
};
typedef __bf16 bf16x2_t __attribute__((ext_vector_type(2)));
DI unsigned cvt_pk_bf16(float lo, float hi) { const f32x2 v = {lo, hi}; const bf16x2_t r = __builtin_convertvector(v, bf16x2_t); return __builtin_bit_cast(unsigned, r); }

template <class Epi, class Sched>
DI void gemm_phase(LAS unsigned char* lds, const Gemm g, const Sched& S, const Epi& E, int wid) {
    const int lane = lane_id(), tid = wid * 64 + lane, wr = wid >> 2, wc = wid & 3, fr = lane & 15, fq = lane >> 4;
    const int K = g.K, nt = K / BK;
    unsigned voffA[2], voffB[2];
#pragma unroll
    for (int i = 0; i < 2; ++i) { int R, C; stage_rc(tid * 16 + i * 8192, R, C); const int Rb = Epi::PERM ? ((R & ~31) + perm32(R & 31)) : R;
        voffA[i] = (unsigned)(R * g.lda + C) * 2u; voffB[i] = (unsigned)(Rb * g.ldb + C) * 2u; }
    const size_t kstep = (size_t)(BK * 2);
    const size_t hstepA = (size_t)HALF * g.lda * 2, hstepB = (size_t)HALF * g.ldb * 2;
    const unsigned ldsw = (unsigned)wid * 1024u;
    const int aoff = lds_byte(wr * 64 + fr, fq * 8), boff = lds_byte(wc * 32 + fr, fq * 8);
#define PG8_SA(b, h) (((b) * 2 + (h)) * HTB)
#define PG8_SB(b, h) ((4 + (b) * 2 + (h)) * HTB)
#define PG8_STAGE(bufoff, gbase, voff) do { _Pragma("unroll") for (int _i = 0; _i < 2; ++_i) \
        __builtin_amdgcn_global_load_lds((const unsigned*)((const char*)(gbase) + (voff)[_i]), (LAS unsigned*)(lds + (bufoff) + ldsw + _i * 8192), 16, 0, 0); } while (0)
#define PG8_LDA(dst, b, h) do { _Pragma("unroll") for (int m = 0; m < 4; ++m) _Pragma("unroll") for (int k = 0; k < 2; ++k) dst[m][k] = *(const LAS bf16x8*)(lds + PG8_SA(b, h) + aoff + m * 2048 + k * 1024); } while (0)
#define PG8_LDB(dst, b, h) do { _Pragma("unroll") for (int n = 0; n < 2; ++n) _Pragma("unroll") for (int k = 0; k < 2; ++k) dst[n][k] = *(const LAS bf16x8*)(lds + PG8_SB(b, h) + boff + n * 2048 + k * 1024); } while (0)
#define PG8_MMA(ai, bj, At, Bt) do { __builtin_amdgcn_s_setprio(1); _Pragma("unroll") for (int m = 0; m < 4; ++m) _Pragma("unroll") for (int n = 0; n < 2; ++n) _Pragma("unroll") for (int k = 0; k < 2; ++k) \
        acc[ai][bj][m][n] = __builtin_amdgcn_mfma_f32_16x16x32_bf16(Bt[n][k], At[m][k], acc[ai][bj][m][n], 0, 0, 0); __builtin_amdgcn_s_setprio(0); } while (0)
#define PG8_WAIT_V(n) asm volatile("s_waitcnt vmcnt(" #n ")" ::: "memory")
#define PG8_WAIT_L(n) asm volatile("s_waitcnt lgkmcnt(" #n ")" ::: "memory")
#define PG8_BAR __builtin_amdgcn_s_barrier()
#define PG8_SCHED __builtin_amdgcn_sched_barrier(0)
    Unit cur, nxt; int ui = 0;
    if (!S.next(0, cur)) return;
    f32x4 acc[2][2][4][2];
#pragma unroll
    for (int a = 0; a < 2; ++a)
#pragma unroll
        for (int b = 0; b < 2; ++b)
#pragma unroll
            for (int m = 0; m < 4; ++m)
#pragma unroll
                for (int n = 0; n < 2; ++n) acc[a][b][m][n] = (f32x4){0.f, 0.f, 0.f, 0.f};
    bf16x8 At[4][2], B0[2][2], B1[2][2];
    const char* cA = (const char*)g.A + (long)cur.arow * g.lda * 2; const char* cB = (const char*)g.Bt + (size_t)cur.pn * 256 * g.ldb * 2;
    PG8_STAGE(PG8_SB(0, 0), cB, voffB); PG8_STAGE(PG8_SB(0, 1), cB + hstepB, voffB); PG8_STAGE(PG8_SA(0, 0), cA, voffA); PG8_STAGE(PG8_SA(0, 1), cA + hstepA, voffA);
    if (wr == 1) PG8_BAR;
    PG8_WAIT_V(2); PG8_BAR;
    PG8_STAGE(PG8_SB(1, 0), cB + kstep, voffB); PG8_STAGE(PG8_SA(1, 0), cA + kstep, voffA); PG8_STAGE(PG8_SB(1, 1), cB + hstepB + kstep, voffB);
    PG8_WAIT_V(6); PG8_BAR;
    for (;;) {
        const bool has_next = S.next(ui + 1, nxt);
        const char* nA = has_next ? (const char*)g.A + (long)nxt.arow * g.lda * 2 : cA; const char* nB = has_next ? (const char*)g.Bt + (size_t)nxt.pn * 256 * g.ldb * 2 : cB;
#pragma unroll 1
        for (int t = 0; t < nt; t += 2) {
            const bool last = (t == nt - 2);
            const char* a1 = cA + (size_t)(t + 1) * kstep;
            const char* a2 = last ? nA : cA + (size_t)(t + 2) * kstep; const char* b2 = last ? nB : cB + (size_t)(t + 2) * kstep;
            const char* a3 = a2 + kstep; const char* b3 = b2 + kstep;
            PG8_LDB(B0, 0, 0); PG8_LDB(B1, 0, 1); PG8_SCHED; PG8_LDA(At, 0, 0); PG8_STAGE(PG8_SA(1, 1), a1 + hstepA, voffA);
            PG8_WAIT_V(8); PG8_WAIT_L(0); PG8_BAR; PG8_MMA(0, 0, At, B0); PG8_MMA(0, 1, At, B1); PG8_BAR; PG8_SCHED;
            PG8_LDA(At, 0, 1); PG8_STAGE(PG8_SB(0, 0), b2, voffB); PG8_STAGE(PG8_SB(0, 1), b2 + hstepB, voffB); PG8_STAGE(PG8_SA(0, 0), a2, voffA);
            PG8_WAIT_V(8); PG8_WAIT_L(0); PG8_BAR; PG8_MMA(1, 0, At, B0); PG8_MMA(1, 1, At, B1); PG8_BAR; PG8_SCHED;
            PG8_LDB(B0, 1, 0); PG8_LDB(B1, 1, 1); PG8_SCHED; PG8_LDA(At, 1, 0); PG8_STAGE(PG8_SA(0, 1), a2 + hstepA, voffA);
            PG8_WAIT_V(8); PG8_WAIT_L(0); PG8_BAR; PG8_MMA(0, 0, At, B0); PG8_MMA(0, 1, At, B1); PG8_BAR; PG8_SCHED;
            PG8_LDA(At, 1, 1); PG8_STAGE(PG8_SB(1, 0), b3, voffB); PG8_STAGE(PG8_SB(1, 1), b3 + hstepB, voffB); PG8_STAGE(PG8_SA(1, 0), a3, voffA);
            PG8_WAIT_V(8); PG8_WAIT_L(0); PG8_BAR; PG8_MMA(1, 0, At, B0); PG8_MMA(1, 1, At, B1); PG8_BAR; PG8_SCHED;
        }
        if (wr == 0) PG8_BAR;
        { const int l2 = lane_id(); E(acc, cur, wr, wc, l2 & 15, l2 >> 4, lds); }
        if (!has_next) break;
#pragma unroll
        for (int a = 0; a < 2; ++a)
#pragma unroll
            for (int b = 0; b < 2; ++b)
#pragma unroll
                for (int m = 0; m < 4; ++m)
#pragma unroll
                    for (int n = 0; n < 2; ++n) acc[a][b][m][n] = (f32x4){0.f, 0.f, 0.f, 0.f};
        cur = nxt; cA = nA; cB = nB; ++ui;
        if (wr == 1) PG8_BAR;
    }
    PG8_WAIT_V(0);
    PG8_BAR;
#undef PG8_SA
#undef PG8_SB
#undef PG8_STAGE
#undef PG8_LDA
#undef PG8_LDB
#undef PG8_MMA
#undef PG8_WAIT_V
#undef PG8_WAIT_L
#undef PG8_BAR
#undef PG8_SCHED
}
}

#define XB_TMO      128
#define XB_XCNT(j)  (256  + 64 * (j))
#define XB_XSUB(j)  (1280 + 64 * (j))
#define XB_XGEN(j)  (2304 + 64 * (j))
#define XB_TOP      3328
#define XB_TOPGEN   3392
#define XCD_BAR_WORDS 3456
#define XB_SPIN_CAP (1u << 18)
DI unsigned xb_ld(unsigned* p)              { return __hip_atomic_load(p, __ATOMIC_RELAXED, __HIP_MEMORY_SCOPE_AGENT); }
DI unsigned xb_add(unsigned* p, unsigned v) { return __hip_atomic_fetch_add(p, v, __ATOMIC_RELAXED, __HIP_MEMORY_SCOPE_AGENT); }
DI unsigned xb_xcc_id() { return (unsigned)__builtin_amdgcn_s_getreg((3 << 11) | 20) & 0xFu; }
#define XB_SPIN(cond, bar) do { unsigned _sp = 0; while (cond) { __builtin_amdgcn_s_sleep(1); \
    if ((++_sp & 255u) == 0u) { if (xb_ld(&(bar)[XB_TMO])) break; if (_sp > XB_SPIN_CAP) { atomicAdd(&(bar)[XB_TMO], 1u); break; } } } } while (0)
struct XcdBarrier { unsigned* bar; unsigned x; volatile LAS unsigned* st; };
DI XcdBarrier xcd_barrier_post(unsigned* bar, volatile LAS unsigned* st, bool t0) {
    XcdBarrier b; b.bar = bar; b.x = xb_xcc_id(); b.st = st;
    if (t0) (void)xb_add(&bar[XB_XCNT(b.x)], 1u);
    return b;
}
DI void xcd_barrier_complete(unsigned* bar, unsigned x, unsigned& nloc, unsigned& nx) {
    const unsigned G = gridDim.x * gridDim.y * gridDim.z;
    unsigned sum, cnt, mine, sp = 0u;
    for (;;) {
        sum = 0u; cnt = 0u; mine = 0u;
#pragma unroll
        for (unsigned j = 0; j < 16; ++j) { const unsigned c = xb_ld(&bar[XB_XCNT(j)]); sum += c; cnt += (c > 0u) ? 1u : 0u; mine = (j == x) ? c : mine; }
        if (sum == G) break;
        __builtin_amdgcn_s_sleep(1);
        if ((++sp & 255u) == 0u) { if (xb_ld(&bar[XB_TMO])) break; if (sp > XB_SPIN_CAP) { atomicAdd(&bar[XB_TMO], 1u); break; } }
    }
    nloc = mine > 0u ? mine : 1u; nx = cnt > 0u ? cnt : 1u;
}
DI void xcd_barrier(const XcdBarrier& b, bool t0) {
    asm volatile("s_waitcnt vmcnt(0)" ::: "memory");
    __syncthreads();
    if (t0) {
        unsigned* bar = b.bar;
        __builtin_amdgcn_s_waitcnt(0);
        unsigned nloc = b.st[0], nx = b.st[1];
        if (nloc == 0u) { xcd_barrier_complete(bar, b.x, nloc, nx); b.st[0] = nloc; b.st[1] = nx; }
        const unsigned old = xb_add(&bar[XB_XSUB(b.x)], 1u);
        const unsigned gen = old / nloc;
        if (old + 1u == (gen + 1u) * nloc) {
            __builtin_amdgcn_fence(__ATOMIC_RELEASE, "agent");
            asm volatile("s_waitcnt vmcnt(0)" ::: "memory");
            const unsigned og = xb_add(&bar[XB_TOP], 1u);
            const unsigned tg = og / nx;
            if (og + 1u == (tg + 1u) * nx) xb_add(&bar[XB_TOPGEN], 1u);
            else XB_SPIN(xb_ld(&bar[XB_TOPGEN]) == tg, bar);
            __builtin_amdgcn_fence(__ATOMIC_ACQUIRE, "agent");
            xb_add(&bar[XB_XGEN(b.x)], 1u);
            asm volatile("s_waitcnt vmcnt(0)" ::: "memory");
        } else {
            XB_SPIN(xb_ld(&bar[XB_XGEN(b.x)]) == gen, bar);
            __builtin_amdgcn_fence(__ATOMIC_ACQUIRE, "agent");
            asm volatile("s_waitcnt vmcnt(0)" ::: "memory");
        }
    }
    __syncthreads();
}

#ifndef PROBE_ID
#define PROBE_ID 0
#endif
#ifndef PROBE_WG
#define PROBE_WG 0
#endif
#ifndef PROBE_MULT
#define PROBE_MULT 8
#endif
constexpr int NWAVES = 8;
constexpr int RING_BYTES = 131072;
constexpr int MIX_LDS = 147456;
constexpr int XG_OFF = MIX_LDS;
static_assert(MISC_OFF == MIX_LDS + 4096, "LDS map");
constexpr int LDS_BYTES = 155648;

struct Args { const float* in[N_IN]; float* out; unsigned char* ws; int ph_lo, ph_hi, use_bar, pad; };

struct Ctx {
    LAS unsigned char* lds;
    const float* const* in; float* out; unsigned char* ws;
    int tid, lane, wave, G, vcu;
};
#define OPAQUE_CTX(C) do { asm volatile("" : "+v"((C).tid), "+v"((C).lane)); asm volatile("" : "+s"((C).wave), "+s"((C).vcu)); } while (0)
#define PB(id) do { if ((id) == PROBE_ID && PROBE_ID != 0 && (int)blockIdx.x == PROBE_WG && F.wave == 0 && lane_id() == 0) { volatile LAS unsigned* pw_ = (volatile LAS unsigned*)(F.lds + MISC_OFF); pw_[33] = (unsigned)__builtin_amdgcn_s_memrealtime(); } } while (0)
#define PE(id) do { if ((id) == PROBE_ID && PROBE_ID != 0 && (int)blockIdx.x == PROBE_WG && F.wave == 0 && lane_id() == 0) { volatile LAS unsigned* pw_ = (volatile LAS unsigned*)(F.lds + MISC_OFF); pw_[32] += (unsigned)__builtin_amdgcn_s_memrealtime() - pw_[33]; } } while (0)
DI bf16_t* wsb(const Ctx& F, size_t off) { return (bf16_t*)(F.ws + off); }
DI float* wsf(const Ctx& F, size_t off) { return (float*)(F.ws + off); }

DI bool chunk_first(int c) { return c == 0 || c == 128 || c >= 256; }
DI bool chunk_last(int c) { return c == 127 || c >= 255; }
DI int chunk_seq(int c) { return c < 128 ? 0 : (c < 256 ? 1 : c - 254); }
DI float* st_out(const Ctx& F, size_t offp, size_t offs, int layer, int seq, int per) {
    return seq < 2 ? F.out + offp + (size_t)(layer * 2 + seq) * per : F.out + offs + (size_t)(layer * 8 + (seq - 2)) * per;
}

DI float wave_sum(float v) {
#pragma unroll
    for (int o = 1; o < 64; o <<= 1) v += __shfl_xor(v, o);
    return v;
}
DI int win_dst(int n) {
    if (n < 512) return PC_AX + n;
    if (n < 1024) return PC_AG + (n - 512);
    if (n < 1280) return PC_BQ + (n - 1024);
    if (n < 1536) return PC_BK + (n - 1280);
    if (n < 2048) return PC_BV + (n - 1536);
    if (n < 2560) return PC_BG + (n - 2048);
    if (n < 2576) return PC_BLR + (n - 2560);
    if (n < 3088) return PC_CZ + (n - 2576);
    if (n < 4112) return PC_XBC + (n - 3088);
    return PC_DT + (n - 4112);
}
DI int map_row(int mode, int n) {
    if (mode == 1) return win_dst(n);
    if (mode == 2) return 256 * (n >> 7) + (n & 127);
    if (mode == 3) return 256 * (n >> 7) + 128 + (n & 127);
    return n;
}
constexpr int TR_PITCH = 68, TR_WAVE_BYTES = 64 * TR_PITCH * 4;
DI void tr_item(const float* W, int K, int N, bf16_t* WT, int mode, const float* g, LAS float* scr, int item, int lane) {
    const int nblk = (N + 63) / 64, kb = item / nblk, nb = item % nblk, k0 = 64 * kb, n0 = 64 * nb;
    const int c4 = (lane & 15) * 4, kr = lane >> 4;
#pragma unroll 8
    for (int i = 0; i < 16; ++i) { const int kk = 4 * i + kr, n = n0 + c4; f32x4 v = {0.f, 0.f, 0.f, 0.f}; if (n < N) v = *(const f32x4*)(W + (size_t)(k0 + kk) * N + n);
        if (g) v *= g[k0 + kk]; *(LAS f32x4*)(scr + kk * TR_PITCH + c4) = v; }
    LDS_WAIT();
    const int c = lane & 7;
#pragma unroll
    for (int j = 0; j < 8; ++j) { const int n = (lane >> 3) + 8 * j; const LAS float* s = scr + (8 * c) * TR_PITCH + n;
        u32x4 o; o.x = pk2(s[0 * TR_PITCH], s[1 * TR_PITCH]); o.y = pk2(s[2 * TR_PITCH], s[3 * TR_PITCH]); o.z = pk2(s[4 * TR_PITCH], s[5 * TR_PITCH]); o.w = pk2(s[6 * TR_PITCH], s[7 * TR_PITCH]);
        if (n0 + n < N) *(u32x4*)(WT + (size_t)map_row(mode, n0 + n) * K + k0 + 8 * c) = o; }
    LDS_WAIT();
}
DI void convert_set(const Ctx& F, int layer, int which, int wgi, int nwg) {
    LAS float* scr = (LAS float*)(F.lds + F.wave * TR_WAVE_BYTES);
    const int gw = wgi * NWAVES + F.wave, NGW = nwg * NWAVES;
    int base = 0;
#define CONV_MAT(cond, Wp, K_, N_, WTp, mode_, gp) if (cond) { const int ni = ((K_) / 64) * (((N_) + 63) / 64); \
        for (int it = gw - base; it < ni; it += NGW) { if (it >= 0) tr_item(Wp, K_, N_, WTp, mode_, gp, scr, it, F.lane); } base = (base + ni) % NGW; }
    CONV_MAT(which & 1, F.in[I_WIN] + (size_t)layer * D * DIN, D, DIN, wsb(F, WS_WIN), 1, F.in[I_NMIX] + layer * D)
    CONV_MAT(which & 2, F.in[I_WOUT] + (size_t)layer * DMIX * D, DMIX, D, wsb(F, WS_WOUT), 0, (const float*)nullptr)
    CONV_MAT(which & 4, F.in[I_WG] + (size_t)layer * D * DFF, D, DFF, wsb(F, WS_WGU), 2, F.in[I_NFFN] + layer * D)
    CONV_MAT(which & 4, F.in[I_WU] + (size_t)layer * D * DFF, D, DFF, wsb(F, WS_WGU), 3, F.in[I_NFFN] + layer * D)
    CONV_MAT(which & 8, F.in[I_WD] + (size_t)layer * DFF * D, DFF, D, wsb(F, WS_WD), 0, (const float*)nullptr)
    CONV_MAT(which & 16, F.in[I_PWG] + (size_t)layer * D * D, D, D, wsb(F, WS_WPG), 0, F.in[I_NPLE] + layer * D)
    CONV_MAT(which & 32, F.in[I_PWP] + (size_t)layer * DPLE * D, DPLE, D, wsb(F, WS_WPP), 0, (const float*)nullptr)
    if (which & 128) {
        for (int it = gw; it < DEPTH * 2 * 8; it += NGW) { const int mat = it, l = mat >> 4, ri = (mat >> 3) & 1, h = mat & 7;
            tr_item(F.in[ri ? I_LWI : I_LWR] + (size_t)(l * 8 + h) * 4096, 64, 64, wsb(F, WS_LRUW) + (size_t)((l * 2 + ri) * 8 + h) * 4096, 0, nullptr, scr, 0, F.lane); }
    }
#undef CONV_MAT
    if (which & 1) {
        u32x4* z = (u32x4*)(wsb(F, WS_WIN) + (size_t)PC_PAD * D); const int n16 = (PC_Y - PC_PAD) * D * 2 / 16;
        u32x4 zv = (u32x4){0u, 0u, 0u, 0u}; asm volatile("" : "+v"(zv));
        for (int i = wgi * 512 + F.tid; i < n16; i += nwg * 512) z[i] = zv;
    }
    if (which & 64) {
        const float* pp = F.in[I_PP] + (size_t)layer * MP * DPLE; const float* ps = F.in[I_PS] + (size_t)layer * MS * DPLE; bf16_t* pb = wsb(F, WS_PB);
        const int n8 = M * DPLE / 8;
        for (int i = wgi * 512 + F.tid; i < n8; i += nwg * 512) { const size_t e = (size_t)i * 8; const float* src = e < (size_t)MP * DPLE ? pp + e : ps + (e - (size_t)MP * DPLE);
            const f32x4 a = *(const f32x4*)src, b = *(const f32x4*)(src + 4); u32x4 o; o.x = pk2(a.x, a.y); o.y = pk2(a.z, a.w); o.z = pk2(b.x, b.y); o.w = pk2(b.z, b.w); *(u32x4*)(pb + e) = o; }
    }
}
DI void p0_rows(const Ctx& F) {
    const int gw = F.vcu * NWAVES + F.wave, NGW = F.G * NWAVES;
    bf16_t* xb = (bf16_t*)F.out; float* rss = wsf(F, WS_RSSN) + (size_t)XB_PAD * 16;
    for (int m0 = gw; m0 < M; m0 += 2 * NGW) {
        f32x4 v[2][4]; float s[2];
#pragma unroll
        for (int k = 0; k < 2; ++k) { const int m = m0 + k * NGW < M ? m0 + k * NGW : m0; const float* xr = m < MP ? F.in[I_XP] + (size_t)m * D : F.in[I_XS] + (size_t)(m - MP) * D; const f32x4* x4 = (const f32x4*)xr + F.lane;
#pragma unroll
            for (int j = 0; j < 4; ++j) v[k][j] = x4[64 * j]; }
#pragma unroll
        for (int k = 0; k < 2; ++k) { const int m = m0 + k * NGW; if (m >= M) break; float ss = 0.f;
#pragma unroll
            for (int j = 0; j < 4; ++j) ss += (v[k][j].x * v[k][j].x + v[k][j].y * v[k][j].y) + (v[k][j].z * v[k][j].z + v[k][j].w * v[k][j].w);
            s[k] = wave_sum(ss);
            u32x2* o8 = (u32x2*)(xb + (size_t)m * D) + F.lane;
#pragma unroll
            for (int j = 0; j < 4; ++j) { u32x2 w; w.x = pk2(v[k][j].x, v[k][j].y); w.y = pk2(v[k][j].z, v[k][j].w); o8[64 * j] = w; }
            if (F.lane < 16) rss[(size_t)m * 16 + F.lane] = F.lane == 0 ? s[k] : 0.f; }
    }
}

#define PBE(id, lds_, pred_) do { if ((id) == PROBE_ID && PROBE_ID != 0 && (int)blockIdx.x == PROBE_WG && (pred_)) { volatile LAS unsigned* pw_ = (volatile LAS unsigned*)((lds_) + MISC_OFF); pw_[33] = (unsigned)__builtin_amdgcn_s_memrealtime(); } } while (0)
#define PEE(id, lds_, pred_) do { if ((id) == PROBE_ID && PROBE_ID != 0 && (int)blockIdx.x == PROBE_WG && (pred_)) { volatile LAS unsigned* pw_ = (volatile LAS unsigned*)((lds_) + MISC_OFF); pw_[32] += (unsigned)__builtin_amdgcn_s_memrealtime() - pw_[33]; } } while (0)
DI float row_rstd(const float* rss, long row) {
    const f32x4* p = (const f32x4*)(rss + row * 16); const f32x4 a = p[0], b = p[1], c = p[2], d = p[3];
    const float s = ((a.x + a.y) + (a.z + a.w)) + ((b.x + b.y) + (b.z + b.w)) + ((c.x + c.y) + (c.z + c.w)) + ((d.x + d.y) + (d.z + d.w));
    return rsqrtf(fmaxf(s, 0.f) * (1.f / D) + EPS);
}
DI float row_rstd_q(const float* rss, long row, int fq) {
    const f32x4 a = *(const f32x4*)(rss + row * 16 + 4 * fq); float s = (a.x + a.y) + (a.z + a.w);
    s += __shfl_xor(s, 16); s += __shfl_xor(s, 32);
    return rsqrtf(fmaxf(s, 0.f) * (1.f / D) + EPS);
}
struct EpiProj {
    static constexpr bool PERM = true;
    bf16_t* O; const float* rss;
    DI void operator()(const f32x4 (&acc)[2][2][4][2], const pg8::Unit& u, int wr, int wc, int fr_, int fq_, LAS unsigned char*) const {
        int fr = fr_, fq = fq_; asm volatile("" : "+v"(fr), "+v"(fq));
        const int row0 = u.arow + wr * 64 + fr, col0 = u.pn * 256 + wc * 32 + 8 * fq;
        f32x4 nr = *(const f32x4*)(rss + (long)row0 * 16 + 4 * fq);
#pragma unroll
        for (int it = 0; it < 8; ++it) { const int ai = it >> 2, m = it & 3; const int r = row0 + ai * 128 + m * 16; bf16_t* rowp = O + (size_t)r * DINP + col0;
            const f32x4 cr = nr;
            if (it < 7) nr = *(const f32x4*)(rss + (long)(row0 + ((it + 1) >> 2) * 128 + ((it + 1) & 3) * 16) * 16 + 4 * fq);
            float sr = (cr.x + cr.y) + (cr.z + cr.w); sr += __shfl_xor(sr, 16); sr += __shfl_xor(sr, 32);
            const float rs = rsqrtf(fmaxf(sr, 0.f) * (1.f / D) + EPS);
#pragma unroll
            for (int bj = 0; bj < 2; ++bj) { const f32x4 v0 = acc[ai][bj][m][0] * rs, v1 = acc[ai][bj][m][1] * rs;
                u32x4 w; w.x = pg8::cvt_pk_bf16(v0[0], v0[1]); w.y = pg8::cvt_pk_bf16(v0[2], v0[3]); w.z = pg8::cvt_pk_bf16(v1[0], v1[1]); w.w = pg8::cvt_pk_bf16(v1[2], v1[3]);
                *(u32x4*)(rowp + bj * 128) = w; }
            asm volatile("" ::: "memory"); }
    }
};
DI void add_bf16x8(f32x4& a, f32x4& b, const u32x4 w) {
    a[0] += __uint_as_float(w.x << 16); a[1] += __uint_as_float(w.x & 0xffff0000u); a[2] += __uint_as_float(w.y << 16); a[3] += __uint_as_float(w.y & 0xffff0000u);
    b[0] += __uint_as_float(w.z << 16); b[1] += __uint_as_float(w.z & 0xffff0000u); b[2] += __uint_as_float(w.w << 16); b[3] += __uint_as_float(w.w & 0xffff0000u);
}
struct EpiRes {
    static constexpr bool PERM = true;
    const bf16_t* xs; bf16_t* xb; float* rss; bool dry;
    DI void operator()(const f32x4 (&acc)[2][2][4][2], const pg8::Unit& u, int wr, int wc, int fr_, int fq_, LAS unsigned char*) const {
        int fr = fr_, fq = fq_; asm volatile("" : "+v"(fr), "+v"(fq));
        const int row0 = u.arow + wr * 64 + fr, col0 = u.pn * 256 + wc * 32 + 8 * fq;
        u32x4 nx0 = *(const u32x4*)(xs + (size_t)row0 * D + col0), nx1 = *(const u32x4*)(xs + (size_t)row0 * D + col0 + 128);
#pragma unroll
        for (int it = 0; it < 8; ++it) { const int ai = it >> 2, m = it & 3; const int r = row0 + ai * 128 + m * 16; const size_t off = (size_t)r * D + col0;
            const u32x4 c0 = nx0, c1 = nx1;
            if (it < 7) { const size_t offn = (size_t)(row0 + ((it + 1) >> 2) * 128 + ((it + 1) & 3) * 16) * D + col0; nx0 = *(const u32x4*)(xs + offn); nx1 = *(const u32x4*)(xs + offn + 128); }
            float ss = 0.f;
#pragma unroll
            for (int bj = 0; bj < 2; ++bj) { f32x4 a = acc[ai][bj][m][0], b = acc[ai][bj][m][1]; add_bf16x8(a, b, bj ? c1 : c0);
                u32x4 w; w.x = pg8::cvt_pk_bf16(a[0], a[1]); w.y = pg8::cvt_pk_bf16(a[2], a[3]); w.z = pg8::cvt_pk_bf16(b[0], b[1]); w.w = pg8::cvt_pk_bf16(b[2], b[3]);
                if (!dry) *(u32x4*)(xb + off + bj * 128) = w;
                ss += ((a[0] * a[0] + a[1] * a[1]) + (a[2] * a[2] + a[3] * a[3])) + ((b[0] * b[0] + b[1] * b[1]) + (b[2] * b[2] + b[3] * b[3])); }
            ss += __shfl_xor(ss, 16); ss += __shfl_xor(ss, 32);
            if (fq == 0 && !dry) rss[(size_t)r * 16 + u.pn * 4 + wc] = ss;
            asm volatile("" ::: "memory"); }
    }
};
struct EpiPle {
    static constexpr bool PERM = true;
    const bf16_t* xs; bf16_t* xb; const float* rss_in; float* rss_out; const bf16_t* pp; bool dry;
    DI void operator()(const f32x4 (&acc)[2][2][4][2], const pg8::Unit& u, int wr, int wc, int fr_, int fq_, LAS unsigned char*) const {
        int fr = fr_, fq = fq_; asm volatile("" : "+v"(fr), "+v"(fq));
        const int row0 = u.arow + wr * 64 + fr, col0 = u.pn * 256 + wc * 32 + 8 * fq;
        u32x4 nx0 = *(const u32x4*)(xs + (size_t)row0 * D + col0), nx1 = *(const u32x4*)(xs + (size_t)row0 * D + col0 + 128);
        u32x4 np0 = *(const u32x4*)(pp + (size_t)row0 * D + col0), np1 = *(const u32x4*)(pp + (size_t)row0 * D + col0 + 128);
        f32x4 nr = *(const f32x4*)(rss_in + (long)row0 * 16 + 4 * fq);
#pragma unroll
        for (int it = 0; it < 8; ++it) { const int ai = it >> 2, m = it & 3; const int r = row0 + ai * 128 + m * 16; const size_t off = (size_t)r * D + col0;
            const u32x4 c0 = nx0, c1 = nx1, q0 = np0, q1 = np1; const f32x4 cr = nr;
            if (it < 7) { const int rn = row0 + ((it + 1) >> 2) * 128 + ((it + 1) & 3) * 16; const size_t offn = (size_t)rn * D + col0;
                nx0 = *(const u32x4*)(xs + offn); nx1 = *(const u32x4*)(xs + offn + 128); np0 = *(const u32x4*)(pp + offn); np1 = *(const u32x4*)(pp + offn + 128); nr = *(const f32x4*)(rss_in + (long)rn * 16 + 4 * fq); }
            float sr = (cr.x + cr.y) + (cr.z + cr.w); sr += __shfl_xor(sr, 16); sr += __shfl_xor(sr, 32);
            const float rs = rsqrtf(fmaxf(sr, 0.f) * (1.f / D) + EPS); float ss = 0.f;
#pragma unroll
            for (int bj = 0; bj < 2; ++bj) { const f32x4 fa = acc[ai][bj][m][0], fb = acc[ai][bj][m][1]; const u32x4 xw = bj ? c1 : c0, pw = bj ? q1 : q0;
                f32x4 a, b;
                a[0] = __uint_as_float(xw.x << 16) + sigm(fa[0] * rs) * __uint_as_float(pw.x << 16); a[1] = __uint_as_float(xw.x & 0xffff0000u) + sigm(fa[1] * rs) * __uint_as_float(pw.x & 0xffff0000u);
                a[2] = __uint_as_float(xw.y << 16) + sigm(fa[2] * rs) * __uint_as_float(pw.y << 16); a[3] = __uint_as_float(xw.y & 0xffff0000u) + sigm(fa[3] * rs) * __uint_as_float(pw.y & 0xffff0000u);
                b[0] = __uint_as_float(xw.z << 16) + sigm(fb[0] * rs) * __uint_as_float(pw.z << 16); b[1] = __uint_as_float(xw.z & 0xffff0000u) + sigm(fb[1] * rs) * __uint_as_float(pw.z & 0xffff0000u);
                b[2] = __uint_as_float(xw.w << 16) + sigm(fb[2] * rs) * __uint_as_float(pw.w << 16); b[3] = __uint_as_float(xw.w & 0xffff0000u) + sigm(fb[3] * rs) * __uint_as_float(pw.w & 0xffff0000u);
                u32x4 w; w.x = pg8::cvt_pk_bf16(a[0], a[1]); w.y = pg8::cvt_pk_bf16(a[2], a[3]); w.z = pg8::cvt_pk_bf16(b[0], b[1]); w.w = pg8::cvt_pk_bf16(b[2], b[3]);
                if (!dry) *(u32x4*)(xb + off + bj * 128) = w;
                ss += ((a[0] * a[0] + a[1] * a[1]) + (a[2] * a[2] + a[3] * a[3])) + ((b[0] * b[0] + b[1] * b[1]) + (b[2] * b[2] + b[3] * b[3])); }
            ss += __shfl_xor(ss, 16); ss += __shfl_xor(ss, 32);
            if (fq == 0 && !dry) rss_out[(size_t)r * 16 + u.pn * 4 + wc] = ss;
            asm volatile("" ::: "memory"); }
    }
};
struct EpiPP {
    static constexpr bool PERM = true;
    bf16_t* pp;
    DI void operator()(const f32x4 (&acc)[2][2][4][2], const pg8::Unit& u, int wr, int wc, int fr_, int fq_, LAS unsigned char*) const {
        int fr = fr_, fq = fq_; asm volatile("" : "+v"(fr), "+v"(fq));
        const int row0 = u.arow + wr * 64 + fr, col0 = u.pn * 256 + wc * 32 + 8 * fq;
#pragma unroll
        for (int ai = 0; ai < 2; ++ai)
#pragma unroll
            for (int m = 0; m < 4; ++m) { const size_t off = (size_t)(row0 + ai * 128 + m * 16) * D + col0;
#pragma unroll
                for (int bj = 0; bj < 2; ++bj) { const f32x4 f = acc[ai][bj][m][0], g = acc[ai][bj][m][1];
                    u32x4 w; w.x = pg8::cvt_pk_bf16(f[0], f[1]); w.y = pg8::cvt_pk_bf16(f[2], f[3]); w.z = pg8::cvt_pk_bf16(g[0], g[1]); w.w = pg8::cvt_pk_bf16(g[2], g[3]); *(u32x4*)(pp + off + bj * 128) = w; } }
    }
};
struct EpiFfn {
    static constexpr bool PERM = true;
    bf16_t* H; const float* rss; const float* cw; const float* cb; const float* st_in; float* st_p; float* st_s;
    template <bool SP> DI void body(f32x4 (&acc)[2][2][4][2], const pg8::Unit& u, int wr, int wc, int fr, int fq, int gc0, LAS float* XG, LAS float* RT, LAS float* WT) const {
#pragma unroll
        for (int n = 0; n < 2; ++n) {
            const int gc = gc0 + 4 * n;
            const int lc = wc * 32 + 8 * fq + 4 * n;
            const f32x4 w0 = *(const LAS f32x4*)(WT + lc), w1 = *(const LAS f32x4*)(WT + 128 + lc), w2 = *(const LAS f32x4*)(WT + 256 + lc), bb = *(const LAS f32x4*)(WT + 384 + lc);
#pragma unroll
            for (int ai = 0; ai < 2; ++ai) {
                f32x4 pr1, pr2;
                const int pb = 2 * ai + wr - 1;
                if (pb >= 0) { pr1 = *(const LAS f32x4*)(XG + (pb * 2 + 1) * 128 + wc * 32 + 8 * fq + 4 * n) * RT[64 * pb + 63];
                               pr2 = *(const LAS f32x4*)(XG + (pb * 2 + (fr & 1)) * 128 + wc * 32 + 8 * fq + 4 * n) * RT[64 * pb + 62 + (fr & 1)]; }
                else { pr1 = (f32x4){0.f, 0.f, 0.f, 0.f}; pr2 = pr1; }
#pragma unroll
                for (int m = 0; m < 4; ++m) {
                    const int j = ai * 128 + wr * 64 + m * 16 + fr; const long r = (long)u.arow + j;
                    const f32x4 cur = acc[ai][0][m][n]; f32x4 r1, r2;
#pragma unroll
                    for (int i = 0; i < 4; ++i) { r1[i] = dpp_ror<0x121>(cur[i]); r2[i] = dpp_ror<0x122>(cur[i]); }
                    f32x4 p1 = fr >= 1 ? r1 : pr1, p2 = fr >= 2 ? r2 : pr2;
                    pr1 = r1; pr2 = r2;
                    int t = 0, seq = 0, T = 8192; bool valid;
                    if (SP) { if (r < MP) { t = (int)r & 8191; seq = (int)(r >> 13); } else { t = (int)(r - MP) & 63; seq = 2 + (int)((r - MP) >> 6); T = 64; }
                        valid = j >= 2 && r < M;
                        if (valid && t < 2) {
                            const f32x4 z = (f32x4){0.f, 0.f, 0.f, 0.f}; f32x4 s0 = z, s1 = z;
                            if (seq >= 2) { const float* sp = st_in + (size_t)(seq - 2) * 2 * DFF + gc; s0 = *(const f32x4*)sp; s1 = *(const f32x4*)(sp + DFF); }
                            if (t == 0) { p1 = s1; p2 = s0; } else { p2 = s1; }
                        } }
                    else valid = (ai != 0 || m != 0) ? true : (wr != 0 || fr >= 2);
                    const f32x4 gpre = bb + w0 * p2 + w1 * p1 + w2 * cur; const f32x4 up = acc[ai][1][m][n];
                    const float h0 = gelu_mul(gpre[0], up[0]), h1 = gelu_mul(gpre[1], up[1]), h2 = gelu_mul(gpre[2], up[2]), h3 = gelu_mul(gpre[3], up[3]);
                    if (valid) { u32x2 hw; hw.x = pg8::cvt_pk_bf16(h0, h1); hw.y = pg8::cvt_pk_bf16(h2, h3); *(u32x2*)(H + (size_t)r * DFF + gc) = hw;
                        if (SP) { if (t >= T - 2) { float* so = (seq < 2 ? st_p + (size_t)seq * 2 * DFF : st_s + (size_t)(seq - 2) * 2 * DFF) + (size_t)(t - (T - 2)) * DFF + gc; *(f32x4*)so = cur; } } }
                    if (m == 3) asm volatile("" ::: "memory");
                }
            }
        }
    }
    DI void operator()(f32x4 (&acc)[2][2][4][2], const pg8::Unit& u, int wr, int wc, int fr_, int fq_, LAS unsigned char* lds) const {
        int fr = fr_, fq = fq_; asm volatile("" : "+v"(fr), "+v"(fq));
        const int lane = fr + 16 * fq;
        const bool p0_ = (wr == 0 && wc == 0 && lane == 0);
        PBE(41, lds, p0_); PBE(42, lds, p0_);
        const int gc0 = u.pn * 128 + wc * 32 + 8 * fq;
        LAS float* XG = (LAS float*)(lds + XG_OFF);
        LAS float* RT = (LAS float*)(lds + MISC_OFF + 1024);
        LAS float* WT = (LAS float*)(lds + MISC_OFF + 2048);
        {   const int tid_ = (wr * 4 + wc) * 64 + lane, row_ = tid_ >> 1, hf_ = tid_ & 1;
            const f32x4* p_ = (const f32x4*)(rss + ((long)u.arow + row_) * 16 + 8 * hf_); const f32x4 a_ = p_[0], b_ = p_[1];
            float s_ = ((a_.x + a_.y) + (a_.z + a_.w)) + ((b_.x + b_.y) + (b_.z + b_.w)); s_ += __shfl_xor(s_, 1);
            if (hf_ == 0) RT[row_] = rsqrtf(fmaxf(s_, 0.f) * (1.f / D) + EPS);
            if (tid_ < 128) { const int k_ = tid_ >> 5, c_ = u.pn * 128 + 4 * (tid_ & 31);
                *(LAS f32x4*)(WT + k_ * 128 + 4 * (tid_ & 31)) = *(const f32x4*)(k_ < 3 ? cw + (size_t)k_ * DFF + c_ : cb + c_); } }
        if (fr >= 14) {
#pragma unroll
            for (int ai = 0; ai < 2; ++ai)
#pragma unroll
                for (int n = 0; n < 2; ++n) *(LAS f32x4*)(XG + ((2 * ai + wr) * 2 + (fr - 14)) * 128 + wc * 32 + 8 * fq + 4 * n) = acc[ai][0][3][n];
        }
        LDS_WAIT(); __builtin_amdgcn_s_barrier(); asm volatile("" ::: "memory");
#pragma unroll
        for (int ai = 0; ai < 2; ++ai)
#pragma unroll
            for (int m = 0; m < 4; ++m) { const float rs = RT[ai * 128 + wr * 64 + m * 16 + fr];
#pragma unroll
                for (int bj = 0; bj < 2; ++bj)
#pragma unroll
                    for (int n = 0; n < 2; ++n) acc[ai][bj][m][n] *= rs; }
        PEE(42, lds, p0_); PBE(43, lds, p0_);
        const int t0_ = (254 * u.pm) & 8191; const bool special = t0_ < 2 || t0_ + 253 >= 8190 || 254 * u.pm + 253 >= MP;
        if (special) body<true>(acc, u, wr, wc, fr, fq, gc0, XG, RT, WT); else body<false>(acc, u, wr, wc, fr, fq, gc0, XG, RT, WT);
        PEE(43, lds, p0_); PEE(41, lds, p0_);
    }
};

struct OneUnit { int pm, pn; bool on;
    __device__ bool next(int i, pg8::Unit& u) const { if (i != 0 || !on) return false; u.pm = pm; u.pn = pn; u.arow = 256 * pm; return true; } };
struct EpiPart {
    static constexpr bool PERM = false;
    float* base;
    DI void operator()(const f32x4 (&acc)[2][2][4][2], const pg8::Unit&, int wr, int wc, int fr_, int fq_, LAS unsigned char*) const {
        int fr = fr_, fq = fq_; asm volatile("" : "+v"(fr), "+v"(fq));
#pragma unroll
        for (int ai = 0; ai < 2; ++ai)
#pragma unroll
            for (int m = 0; m < 4; ++m) { float* rowp = base + (size_t)(ai * 128 + wr * 64 + m * 16 + fr) * 256 + wc * 32 + 4 * fq;
#pragma unroll
                for (int bj = 0; bj < 2; ++bj)
#pragma unroll
                    for (int n = 0; n < 2; ++n) *(f32x4*)(rowp + bj * 128 + n * 16) = acc[ai][bj][m][n]; }
    }
};
template <int MODE> DI void reduce_tail(const Ctx& F, const float* part, int S, const bf16_t* xs, bf16_t* xb, const float* rss_in, float* rss_out, const bf16_t* pp) {
    for (int t = blockIdx.x; t < 256; t += F.G) { const int j = t >> 5, rl = 8 * (t & 31) + F.wave, pm = 64 + (j >> 2), pn = j & 3; const int r = 256 * pm + rl, col = 256 * pn + 4 * F.lane;
        f32x4 sum = {0.f, 0.f, 0.f, 0.f};
        for (int sl = 0; sl < S; ++sl) sum += *(const f32x4*)(part + ((size_t)(j * S + sl) * 256 + rl) * 256 + 4 * F.lane);
        const size_t off = (size_t)r * D + col; const u32x2 xw = *(const u32x2*)(xs + off);
        f32x4 xn; xn[0] = __uint_as_float(xw.x << 16); xn[1] = __uint_as_float(xw.x & 0xffff0000u); xn[2] = __uint_as_float(xw.y << 16); xn[3] = __uint_as_float(xw.y & 0xffff0000u);
        if (MODE == 0) xn += sum;
        else { const float rs = row_rstd(rss_in, r); const u32x2 pw = *(const u32x2*)(pp + off);
            xn[0] += sigm(sum[0] * rs) * __uint_as_float(pw.x << 16); xn[1] += sigm(sum[1] * rs) * __uint_as_float(pw.x & 0xffff0000u);
            xn[2] += sigm(sum[2] * rs) * __uint_as_float(pw.y << 16); xn[3] += sigm(sum[3] * rs) * __uint_as_float(pw.y & 0xffff0000u); }
        u32x2 w; w.x = pg8::cvt_pk_bf16(xn[0], xn[1]); w.y = pg8::cvt_pk_bf16(xn[2], xn[3]); *(u32x2*)(xb + off) = w;
        float ss = (xn[0] * xn[0] + xn[1] * xn[1]) + (xn[2] * xn[2] + xn[3] * xn[3]);
        ss += __shfl_xor(ss, 1); ss += __shfl_xor(ss, 2); ss += __shfl_xor(ss, 4); ss += __shfl_xor(ss, 8);
        if ((F.lane & 15) == 0) rss_out[(size_t)r * 16 + pn * 4 + (F.lane >> 4)] = ss;
    }
}

DI bf16x8 frag_row(const LAS unsigned char* img, int pitch, int row0, int k0, int lane) {
    return *(const LAS bf16x8*)(img + (row0 + (lane & 15)) * pitch + (k0 + 8 * (lane >> 4)) * 2);
}
DI bf16x8 frag_tr(const LAS unsigned char* img, int pitch, int k0, int n0, int lane) {
    const int g = lane >> 4, i = lane & 15, q = i >> 2, p = i & 3;
    const LAS unsigned char* a = img + (k0 + 8 * g + q) * pitch + (n0 + 4 * p) * 2;
    const s16x4 lo = __builtin_amdgcn_ds_read_tr16_b64_v4i16((LAS s16x4*)a);
    const s16x4 hi = __builtin_amdgcn_ds_read_tr16_b64_v4i16((LAS s16x4*)(a + 4 * pitch));
    return __builtin_shufflevector(lo, hi, 0, 1, 2, 3, 4, 5, 6, 7);
}
#define MFMA16(a, b, c) __builtin_amdgcn_mfma_f32_16x16x32_bf16((a), (b), (c), 0, 0, 0)
DI void st_bf16(LAS unsigned char* img, int pitch, int row, int col, float v) { *(LAS bf16_t*)(img + row * pitch + col * 2) = (bf16_t)f2bf(v); }
DI float ld_bf16(const LAS unsigned char* img, int pitch, int row, int col) { return bf2f(*(const LAS bf16_t*)(img + row * pitch + col * 2)); }

#define WG_BAR() do { asm volatile("s_waitcnt lgkmcnt(0)" ::: "memory"); __builtin_amdgcn_s_barrier(); asm volatile("" ::: "memory"); } while (0)
template <bool SSD> struct LAT {
    static constexpr int DA = SSD ? 128 : 64, DB = SSD ? 64 : 128;
    static constexpr int PA = (DA + 8) * 2, PV = (DB + 8) * 2, PPI = 144, PS = (DB + 8) * 2, POT = (DB + 4) * 4;
    static constexpr int O_QD = 0, O_KI = O_QD + 64 * PA, O_VV = O_KI + 64 * PA, O_VW = O_VV + 64 * PV, O_P = O_VW + (SSD ? 64 * PV : 0), O_SB = O_P + 64 * PPI, O_OT = O_SB + DA * PS, O_TAB = O_OT + 64 * POT;
    static constexpr int NT_O = DB / 32;
};
static_assert(LAT<true>::O_TAB + 8192 <= RING_BYTES && LAT<false>::O_TAB + 8192 <= RING_BYTES, "mixer LDS");
template <bool SSD> DI void la_mt_nt(int T, int& mt, int& nt) { if (SSD) { mt = T >> 2; nt = T & 3; } else { mt = T >> 3; nt = T & 7; } }

template <bool SSD> DI void la_state_update(LAS unsigned char* lds, f32x4 (&S)[4], int w, int lane) {
    typedef LAT<SSD> L; const LAS float* tab = (const LAS float*)(lds + L::O_TAB); const int q = lane >> 4;
#pragma unroll
    for (int x = 0; x < 4; ++x) { int mt, nt; la_mt_nt<SSD>(4 * w + x, mt, nt);
        if (SSD) { const float d = tab[256]; S[x] *= d; }
#pragma unroll
        for (int ks = 0; ks < 2; ++ks) { const bf16x8 a = frag_tr(lds + L::O_KI, L::PA, 32 * ks, 16 * mt, lane); const bf16x8 b = frag_tr(lds + (SSD ? L::O_VW : L::O_VV), L::PV, 32 * ks, 16 * nt, lane); S[x] = MFMA16(a, b, S[x]); }
        if (!SSD) {
#pragma unroll
            for (int r = 0; r < 4; ++r) S[x][r] *= tab[1536 + 16 * mt + 4 * q + r]; }
    }
}
template <bool SSD> DI void la_write_sb(LAS unsigned char* lds, const f32x4 (&S)[4], int w, int lane) {
    typedef LAT<SSD> L; const int q = lane >> 4, c = lane & 15;
#pragma unroll
    for (int x = 0; x < 4; ++x) { int mt, nt; la_mt_nt<SSD>(4 * w + x, mt, nt);
#pragma unroll
        for (int r = 0; r < 4; ++r) st_bf16(lds + L::O_SB, L::PS, 16 * mt + 4 * q + r, 16 * nt + c, S[x][r]); }
}
template <bool SSD> DI void la_compute_p(LAS unsigned char* lds, int w, int lane) {
    typedef LAT<SSD> L; const LAS float* tab = (const LAS float*)(lds + L::O_TAB); const int q = lane >> 4, c = lane & 15, mt = w >> 1;
#pragma unroll
    for (int x = 0; x < 2; ++x) { const int nt = (w & 1) * 2 + x; f32x4 acc = {0.f, 0.f, 0.f, 0.f};
#pragma unroll
        for (int ks = 0; ks < L::DA / 32; ++ks) { const bf16x8 a = frag_row(lds + L::O_QD, L::PA, 16 * mt, 32 * ks, lane); const bf16x8 b = frag_row(lds + L::O_KI, L::PA, 16 * nt, 32 * ks, lane); acc = MFMA16(a, b, acc); }
        const int j = 16 * nt + c;
#pragma unroll
        for (int r = 0; r < 4; ++r) { const int i = 16 * mt + 4 * q + r; float v = acc[r];
            if (SSD) v *= __expf(tab[64 + i] - tab[64 + j]) * tab[j];
            v = (j > i) ? 0.f : v; st_bf16(lds + L::O_P, L::PPI, i, j, v); }
    }
}
template <bool SSD> DI void la_compute_out(LAS unsigned char* lds, f32x4 (&o1)[LAT<SSD>::NT_O], f32x4 (&o2)[LAT<SSD>::NT_O], int w, int lane) {
    typedef LAT<SSD> L; const int mt = w >> 1;
#pragma unroll
    for (int x = 0; x < L::NT_O; ++x) { const int nt = (w & 1) * L::NT_O + x; f32x4 a1 = {0.f, 0.f, 0.f, 0.f}, a2 = {0.f, 0.f, 0.f, 0.f};
#pragma unroll
        for (int ks = 0; ks < 2; ++ks) { const bf16x8 a = frag_row(lds + L::O_P, L::PPI, 16 * mt, 32 * ks, lane); const bf16x8 b = frag_tr(lds + L::O_VV, L::PV, 32 * ks, 16 * nt, lane); a1 = MFMA16(a, b, a1); }
#pragma unroll
        for (int ks = 0; ks < L::DA / 32; ++ks) { const bf16x8 a = frag_row(lds + L::O_QD, L::PA, 16 * mt, 32 * ks, lane); const bf16x8 b = frag_tr(lds + L::O_SB, L::PS, 32 * ks, 16 * nt, lane); a2 = MFMA16(a, b, a2); }
        o1[x] = a1; o2[x] = a2; }
}
DI void la_store_ds(float* ds, const f32x4 (&S)[4], int w, int lane) {
#pragma unroll
    for (int x = 0; x < 4; ++x)
#pragma unroll
        for (int r = 0; r < 4; ++r) ds[((4 * w + x) * 4 + r) * 64 + lane] = S[x][r];
}
DI void la_load_ds(const float* ds, f32x4 (&S)[4], int w, int lane) {
#pragma unroll
    for (int x = 0; x < 4; ++x)
#pragma unroll
        for (int r = 0; r < 4; ++r) S[x][r] = ds[((4 * w + x) * 4 + r) * 64 + lane];
}

struct GlaCoef { float wlr[16]; float blr; };
struct GlaRaw { unsigned short qk[8][2]; u32x4 v[2]; u32x4 lr; u32x4 g[2]; };
DI void gla_load(const Ctx& F, int h, int chunk, GlaRaw& R) {
    const bf16_t* proj = wsb(F, WS_R); const int row0 = 64 * chunk, d = F.lane, w = F.wave;
#pragma unroll
    for (int i = 0; i < 8; ++i) { const size_t ro = (size_t)(row0 + 8 * w + i) * DINP; R.qk[i][0] = proj[ro + PC_BQ + 64 * h + d]; R.qk[i][1] = proj[ro + PC_BK + 64 * h + d]; }
#pragma unroll
    for (int i = 0; i < 2; ++i) { const int idx = F.tid + 512 * i, t = idx >> 4, c16 = idx & 15;
        R.v[i] = *(const u32x4*)(proj + (size_t)(row0 + t) * DINP + PC_BV + 128 * h + 8 * c16);
        R.g[i] = *(const u32x4*)(proj + (size_t)(row0 + t) * DINP + PC_BG + 128 * h + 8 * c16); }
    R.lr = *(const u32x4*)(proj + (size_t)(row0 + ((F.tid >> 1) & 63)) * DINP + PC_BLR + 8 * (F.tid & 1));
}
DI void gla_stage(const Ctx& F, const GlaCoef& cf, const GlaRaw& R) {
    typedef LAT<false> L; LAS unsigned char* lds = F.lds; LAS float* tab = (LAS float*)(lds + L::O_TAB); const int d = F.lane, w = F.wave;
    if (F.tid < 128) { const int t = F.tid >> 1, half = F.tid & 1; float f[8]; unpack8(R.lr, f);
#pragma unroll
        for (int i = 0; i < 8; ++i) tab[t * 16 + 8 * half + i] = f[i]; }
#pragma unroll
    for (int i = 0; i < 2; ++i) { const int idx = F.tid + 512 * i, t = idx >> 4, c16 = idx & 15; *(LAS u32x4*)(lds + L::O_VV + t * L::PV + c16 * 16) = R.v[i]; }
    WG_BAR();
    float pre[8]; float run = 0.f;
#pragma unroll
    for (int i = 0; i < 8; ++i) { const int t = 8 * w + i; float z = cf.blr;
#pragma unroll
        for (int r = 0; r < 16; ++r) z += tab[t * 16 + r] * cf.wlr[r];
        run += logsig_fast(z) * (1.f / 16.f); pre[i] = run; }
    tab[1024 + w * 64 + d] = run;
    WG_BAR();
    float off = 0.f, last = 0.f;
#pragma unroll
    for (int ww = 0; ww < 8; ++ww) { const float tv = tab[1024 + ww * 64 + d]; last += tv; if (ww < w) off += tv; }
#pragma unroll
    for (int i = 0; i < 8; ++i) { const int t = 8 * w + i; const float cum = off + pre[i];
        st_bf16(lds + L::O_QD, L::PA, t, d, bf2f(R.qk[i][0]) * 0.125f * __expf(cum)); st_bf16(lds + L::O_KI, L::PA, t, d, bf2f(R.qk[i][1]) * __expf(-cum)); }
    if (w == 0) tab[1536 + d] = __expf(last);
    WG_BAR();
}
struct SsdRaw { u32x4 x[11]; u32x4 z; unsigned short dtr; };
DI void ssd_task(const Ctx& F, int h, int& cidx, int& rg, int& ch) {
    cidx = F.tid % 40; rg = F.tid / 40; const int g = h >> 2;
    ch = cidx < 8 ? 64 * h + 8 * cidx : (cidx < 24 ? 512 + 128 * g + 8 * (cidx - 8) : 768 + 128 * g + 8 * (cidx - 24));
}
DI void ssd_load(const Ctx& F, int layer, int h, int chunk, SsdRaw& R) {
    const bf16_t* proj = wsb(F, WS_R); const int row0 = 64 * chunk; const bool first = chunk_first(chunk);
    if (F.tid < 320) { int cidx, rg, ch; ssd_task(F, h, cidx, rg, ch);
#pragma unroll
        for (int i = 0; i < 11; ++i) { const int tt = 8 * rg - 3 + i;
            if (tt >= 0 || !first) R.x[i] = *(const u32x4*)(proj + (size_t)(row0 + tt) * DINP + PC_XBC + ch);
            else if (chunk >= 256) { const float* sp = F.in[I_SSC] + ((size_t)(layer * 8 + (chunk - 256)) * 3 + (tt + 3)) * 1024 + ch; const f32x4 a = *(const f32x4*)sp, b = *(const f32x4*)(sp + 4);
                u32x4 o; o.x = pk2(a.x, a.y); o.y = pk2(a.z, a.w); o.z = pk2(b.x, b.y); o.w = pk2(b.z, b.w); R.x[i] = o; }
            else R.x[i] = (u32x4){0u, 0u, 0u, 0u};
        }
    }
    R.z = *(const u32x4*)(proj + (size_t)(row0 + (F.tid >> 3)) * DINP + PC_CZ + 64 * h + 8 * (F.tid & 7));
    R.dtr = proj[(size_t)(row0 + F.lane) * DINP + PC_DT + h];
}
constexpr int SSD_WCV = 512;
DI void ssd_item_weights(const Ctx& F, int layer, int h) {
    typedef LAT<true> L; LAS float* tab = (LAS float*)(F.lds + L::O_TAB);
    if (F.tid < 200) { const int cidx = F.tid / 5, j = F.tid % 5, g = h >> 2;
        const int ch = cidx < 8 ? 64 * h + 8 * cidx : (cidx < 24 ? 512 + 128 * g + 8 * (cidx - 8) : 768 + 128 * g + 8 * (cidx - 24));
        const float* sp = j < 4 ? F.in[I_SCW] + (size_t)(layer * 4 + j) * 1024 + ch : F.in[I_SCB] + layer * 1024 + ch;
        *(LAS f32x4*)(tab + SSD_WCV + (cidx * 5 + j) * 8) = *(const f32x4*)sp; *(LAS f32x4*)(tab + SSD_WCV + (cidx * 5 + j) * 8 + 4) = *(const f32x4*)(sp + 4); }
    WG_BAR();
}
DI void ssd_stage(const Ctx& F, int layer, int h, const SsdRaw& R) {
    typedef LAT<true> L; LAS unsigned char* lds = F.lds; LAS float* tab = (LAS float*)(lds + L::O_TAB);
    if (F.wave == 7) { const int t = F.lane;
        const float dt = softplus_fast(bf2f(R.dtr) + F.in[I_SDTB][layer * 8 + h]); const float cum = wave_incl_scan(-dt * __expf(F.in[I_SALOG][layer * 8 + h]));
        const float last = __shfl(cum, 63);
        tab[t] = dt; tab[64 + t] = cum; tab[128 + t] = __expf(last - cum) * dt; tab[192 + t] = __expf(cum); if (t == 0) tab[256] = __expf(last); }
    if (F.tid < 320) { int cidx, rg, ch; ssd_task(F, h, cidx, rg, ch);
        float wv[4][8], bv[8];
#pragma unroll
        for (int j = 0; j < 4; ++j) { const f32x4 a = *(const LAS f32x4*)(tab + SSD_WCV + (cidx * 5 + j) * 8), b = *(const LAS f32x4*)(tab + SSD_WCV + (cidx * 5 + j) * 8 + 4); wv[j][0] = a.x; wv[j][1] = a.y; wv[j][2] = a.z; wv[j][3] = a.w; wv[j][4] = b.x; wv[j][5] = b.y; wv[j][6] = b.z; wv[j][7] = b.w; }
        { const f32x4 a = *(const LAS f32x4*)(tab + SSD_WCV + (cidx * 5 + 4) * 8), b = *(const LAS f32x4*)(tab + SSD_WCV + (cidx * 5 + 4) * 8 + 4); bv[0] = a.x; bv[1] = a.y; bv[2] = a.z; bv[3] = a.w; bv[4] = b.x; bv[5] = b.y; bv[6] = b.z; bv[7] = b.w; }
        float x0[8], x1[8], x2[8], x3[8]; unpack8(R.x[0], x0); unpack8(R.x[1], x1); unpack8(R.x[2], x2);
#pragma unroll
        for (int r = 0; r < 8; ++r) { const int t = 8 * rg + r; float o[8]; unpack8(R.x[r + 3], x3);
#pragma unroll
            for (int e = 0; e < 8; ++e) { const float v = bv[e] + wv[0][e] * x0[e] + wv[1][e] * x1[e] + wv[2][e] * x2[e] + wv[3][e] * x3[e]; o[e] = silu_f(v); x0[e] = x1[e]; x1[e] = x2[e]; x2[e] = x3[e]; }
            if (cidx < 8) *(LAS u32x4*)(lds + L::O_VV + t * L::PV + cidx * 16) = pack8(o);
            else if (cidx < 24) *(LAS u32x4*)(lds + L::O_KI + t * L::PA + (cidx - 8) * 16) = pack8(o);
            else *(LAS u32x4*)(lds + L::O_QD + t * L::PA + (cidx - 24) * 16) = pack8(o);
        }
    }
    WG_BAR();
    { const int t = F.tid >> 3, c8 = F.tid & 7; float xv[8]; unpack8(*(const LAS u32x4*)(lds + L::O_VV + t * L::PV + c8 * 16), xv); const float we = tab[128 + t];
#pragma unroll
        for (int e = 0; e < 8; ++e) xv[e] *= we;
        *(LAS u32x4*)(lds + L::O_VW + t * L::PV + c8 * 16) = pack8(xv); }
}

DI void gla_pass_a(const Ctx& F0, int layer, int panel, int h) {
    Ctx F = F0; OPAQUE_CTX(F);
    LAS unsigned char* lds = F.lds; const int w = F.wave, lane = F.lane, d = lane; const bf16_t* proj = wsb(F, WS_R); const int row0 = 256 * panel;
    constexpr int PK = 144, PVV = 272, O_KE = 0, O_V = 256 * PK, O_LR = O_V + 256 * PVV, O_TOT = O_LR + 256 * 16 * 4;
    static_assert(O_TOT + 2048 <= RING_BYTES, "gla pass A LDS");
    LAS float* lr = (LAS float*)(lds + O_LR); LAS float* tot = (LAS float*)(lds + O_TOT);
    float wlr[16];
#pragma unroll
    for (int r = 0; r < 16; ++r) wlr[r] = F.in[I_GWLR][(size_t)(layer * 16 + r) * 256 + 64 * h + d];
    const float blr = F.in[I_GBLR][layer * 256 + 64 * h + d];
    { const int t = F.tid >> 1, half = F.tid & 1; const u32x4 v = *(const u32x4*)(proj + (size_t)(row0 + t) * DINP + PC_BLR + 8 * half); float f[8]; unpack8(v, f);
#pragma unroll
        for (int i = 0; i < 8; ++i) lr[t * 16 + 8 * half + i] = f[i]; }
    unsigned short kr[32];
#pragma unroll
    for (int i = 0; i < 32; ++i) kr[i] = proj[(size_t)(row0 + 32 * w + i) * DINP + PC_BK + 64 * h + d];
#pragma unroll
    for (int i = 0; i < 8; ++i) { const int idx = F.tid + 512 * i, t = idx >> 4, c16 = idx & 15;
        *(LAS u32x4*)(lds + O_V + t * PVV + c16 * 16) = *(const u32x4*)(proj + (size_t)(row0 + t) * DINP + PC_BV + 128 * h + 8 * c16); }
    WG_BAR();
    float pre[32]; float run = 0.f;
#pragma unroll
    for (int i = 0; i < 32; ++i) { const int t = 32 * w + i; float z = blr;
#pragma unroll
        for (int r = 0; r < 16; ++r) z += lr[t * 16 + r] * wlr[r];
        run += logsig_fast(z) * (1.f / 16.f); pre[i] = run; }
    tot[w * 64 + d] = run;
    WG_BAR();
    float off = 0.f, last = 0.f;
#pragma unroll
    for (int ww = 0; ww < 8; ++ww) { const float tv = tot[ww * 64 + d]; last += tv; if (ww < w) off += tv; }
#pragma unroll
    for (int i = 0; i < 32; ++i) st_bf16(lds + O_KE, PK, 32 * w + i, d, bf2f(kr[i]) * __expf(last - (off + pre[i])));
    WG_BAR();
    f32x4 S[4];
#pragma unroll
    for (int x = 0; x < 4; ++x) S[x] = (f32x4){0.f, 0.f, 0.f, 0.f};
    const int mt = w >> 1;
#pragma unroll
    for (int ks = 0; ks < 8; ++ks) { const bf16x8 a = frag_tr(lds + O_KE, PK, 32 * ks, 16 * mt, lane);
#pragma unroll
        for (int x = 0; x < 4; ++x) { const bf16x8 b = frag_tr(lds + O_V, PVV, 32 * ks, 16 * (((4 * w + x) & 7)), lane); S[x] = MFMA16(a, b, S[x]); } }
    la_store_ds(wsf(F, WS_DS) + ((size_t)panel * 12 + h) * 8192, S, w, lane);
    if (w == 0) wsf(F, WS_DEC)[(panel * 4 + h) * 64 + d] = __expf(last);
    WG_BAR();
}
DI void ssd_pass_a(const Ctx& F0, int layer, int panel, int h) {
    Ctx F = F0; OPAQUE_CTX(F);
    LAS unsigned char* lds = F.lds; const int w = F.wave, lane = F.lane, g = h >> 2; const bf16_t* proj = wsb(F, WS_R); const int row0 = 256 * panel; const bool first = (panel & 31) == 0;
    constexpr int PB_ = 272, PX = 144, O_B = 0, O_XW = 256 * PB_, O_WE = O_XW + 256 * PX;
    static_assert(O_WE + 1024 <= RING_BYTES, "ssd pass A LDS");
    LAS float* wend = (LAS float*)(lds + O_WE);
    float last = 0.f;
    if (w == 0) {
        const float bias = F.in[I_SDTB][layer * 8 + h], A = -__expf(F.in[I_SALOG][layer * 8 + h]); float dt[4], cs[4]; float run = 0.f;
#pragma unroll
        for (int i = 0; i < 4; ++i) { dt[i] = softplus_fast(bf2f(proj[(size_t)(row0 + 4 * lane + i) * DINP + PC_DT + h]) + bias); run += dt[i] * A; cs[i] = run; }
        const float inc = wave_incl_scan(run);
        const float excl = inc - run; last = __shfl(inc, 63);
#pragma unroll
        for (int i = 0; i < 4; ++i) wend[4 * lane + i] = __expf(last - (excl + cs[i])) * dt[i];
    }
    WG_BAR();
    for (int pass = 0; pass < 2; ++pass) { const int task = F.tid + 512 * pass;
        if (task < 768) { const int cidx = task % 24, rg = task / 24;
            const int ch = cidx < 8 ? 64 * h + 8 * cidx : 512 + 128 * g + 8 * (cidx - 8);
            const float* cwp = F.in[I_SCW] + (size_t)layer * 4 * 1024 + ch; const float* cbp = F.in[I_SCB] + layer * 1024 + ch;
            float wv[4][8], bv[8];
#pragma unroll
            for (int j = 0; j < 4; ++j) { const f32x4 a = *(const f32x4*)(cwp + j * 1024), b = *(const f32x4*)(cwp + j * 1024 + 4); wv[j][0] = a.x; wv[j][1] = a.y; wv[j][2] = a.z; wv[j][3] = a.w; wv[j][4] = b.x; wv[j][5] = b.y; wv[j][6] = b.z; wv[j][7] = b.w; }
            { const f32x4 a = *(const f32x4*)cbp, b = *(const f32x4*)(cbp + 4); bv[0] = a.x; bv[1] = a.y; bv[2] = a.z; bv[3] = a.w; bv[4] = b.x; bv[5] = b.y; bv[6] = b.z; bv[7] = b.w; }
            u32x4 xr[11];
#pragma unroll
            for (int i = 0; i < 11; ++i) { const int tt = 8 * rg - 3 + i;
                if (tt >= 0 || !first) xr[i] = *(const u32x4*)(proj + (size_t)(row0 + tt) * DINP + PC_XBC + ch); else xr[i] = (u32x4){0u, 0u, 0u, 0u}; }
            float x0[8], x1[8], x2[8], x3[8]; unpack8(xr[0], x0); unpack8(xr[1], x1); unpack8(xr[2], x2);
#pragma unroll
            for (int r = 0; r < 8; ++r) { const int t = 8 * rg + r; float o[8]; unpack8(xr[r + 3], x3);
#pragma unroll
                for (int e = 0; e < 8; ++e) { const float v = bv[e] + wv[0][e] * x0[e] + wv[1][e] * x1[e] + wv[2][e] * x2[e] + wv[3][e] * x3[e]; o[e] = silu_f(v); x0[e] = x1[e]; x1[e] = x2[e]; x2[e] = x3[e]; }
                if (cidx < 8) { const float we = wend[t];
#pragma unroll
                    for (int e = 0; e < 8; ++e) o[e] *= we;
                    *(LAS u32x4*)(lds + O_XW + t * PX + cidx * 16) = pack8(o); }
                else *(LAS u32x4*)(lds + O_B + t * PB_ + (cidx - 8) * 16) = pack8(o);
            }
        }
    }
    WG_BAR();
    f32x4 S[4];
#pragma unroll
    for (int x = 0; x < 4; ++x) S[x] = (f32x4){0.f, 0.f, 0.f, 0.f};
#pragma unroll
    for (int ks = 0; ks < 8; ++ks) { const bf16x8 a = frag_tr(lds + O_B, PB_, 32 * ks, 16 * w, lane);
#pragma unroll
        for (int x = 0; x < 4; ++x) { const bf16x8 b = frag_tr(lds + O_XW, PX, 32 * ks, 16 * x, lane); S[x] = MFMA16(a, b, S[x]); } }
    la_store_ds(wsf(F, WS_DS) + ((size_t)panel * 12 + 4 + h) * 8192, S, w, lane);
    if (w == 0 && lane == 0) wsf(F, WS_DEC)[64 * 4 * 64 + panel * 8 + h] = __expf(last);
    WG_BAR();
}

template <bool SSD> DI void la_pass_c(const Ctx& F0, int layer, int c0, int nc, int h, bool dry) {
    Ctx F = F0; OPAQUE_CTX(F);
    typedef LAT<SSD> L; const int w = F.wave, lane = F.lane, q = lane >> 4, c = lane & 15, mt = w >> 1;
    bf16_t* proj = wsb(F, WS_R);
    f32x4 S[4];
    GlaCoef cf; GlaRaw gr; SsdRaw sr;
    if (!SSD) {
#pragma unroll
        for (int r = 0; r < 16; ++r) cf.wlr[r] = F.in[I_GWLR][(size_t)(layer * 16 + r) * 256 + 64 * h + lane];
        cf.blr = F.in[I_GBLR][layer * 256 + 64 * h + lane]; gla_load(F, h, c0, gr); }
    else { ssd_load(F, layer, h, c0, sr); ssd_item_weights(F, layer, h); }
    const int hh = SSD ? 4 + h : h;
    const Ctx Fp = F;
#pragma unroll 1
    for (int cc = 0; cc < nc; ++cc) { const int chunk = c0 + cc, row0 = 64 * chunk;
        Ctx F = Fp; { unsigned z_ = 0; asm volatile("" : "+s"(z_)); F.lds = Fp.lds + z_; } LAS unsigned char* lds = F.lds; LAS float* tab = (LAS float*)(lds + L::O_TAB);
        PB(SSD ? 5 : 15);
        if (cc == 0 || chunk_first(chunk)) {
            if (chunk < 256) la_load_ds(wsf(F, WS_DS) + ((size_t)(chunk >> 2) * 12 + hh) * 8192, S, w, lane);
            else { const int b = chunk - 256;
#pragma unroll
                for (int x = 0; x < 4; ++x) { int smt, snt; la_mt_nt<SSD>(4 * w + x, smt, snt);
                    if (SSD) { const float* sp = F.in[I_SS] + ((size_t)((layer * 8 + b) * 8 + h) * 64 + 16 * snt + c) * 128 + 16 * smt + 4 * q; S[x] = *(const f32x4*)sp; }
                    else { const float* sp = F.in[I_SG] + ((size_t)((layer * 8 + b) * 4 + h) * 64 + 16 * smt + 4 * q) * 128 + 16 * snt + c;
#pragma unroll
                        for (int r = 0; r < 4; ++r) S[x][r] = sp[r * 128]; } } }
            la_write_sb<SSD>(lds, S, w, lane);
        }
        PE(SSD ? 5 : 15);
        PB(SSD ? 1 : 11);
        u32x4 gate0, gate1;
        if (SSD) { ssd_stage(F, layer, h, sr); gate0 = sr.z; gate1 = gate0; if (cc + 1 < nc) ssd_load(F, layer, h, chunk + 1, sr); }
        else { gla_stage(F, cf, gr); gate0 = gr.g[0]; gate1 = gr.g[1]; if (cc + 1 < nc) gla_load(F, h, chunk + 1, gr); }
        PE(SSD ? 1 : 11); PB(SSD ? 2 : 12);
        la_compute_p<SSD>(lds, w, lane);
        WG_BAR();
        PE(SSD ? 2 : 12); PB(SSD ? 3 : 13);
        f32x4 o1[L::NT_O], o2[L::NT_O];
        la_compute_out<SSD>(lds, o1, o2, w, lane);
        la_state_update<SSD>(lds, S, w, lane);
        if (SSD) {
            const float Dh = F.in[I_SD][layer * 8 + h];
#pragma unroll
            for (int x = 0; x < L::NT_O; ++x) { const int p = 16 * ((w & 1) * L::NT_O + x) + c;
#pragma unroll
                for (int r = 0; r < 4; ++r) { const int i = 16 * mt + 4 * q + r; *(LAS float*)(lds + L::O_OT + i * L::POT + p * 4) = o1[x][r] + tab[192 + i] * o2[x][r] + Dh * ld_bf16(lds + L::O_VV, L::PV, i, p); } }
        } else {
            float ss[4] = {0.f, 0.f, 0.f, 0.f};
#pragma unroll
            for (int x = 0; x < L::NT_O; ++x) { const int e = 16 * ((w & 1) * L::NT_O + x) + c;
#pragma unroll
                for (int r = 0; r < 4; ++r) { const float o = o1[x][r] + o2[x][r]; ss[r] += o * o; *(LAS float*)(lds + L::O_OT + (16 * mt + 4 * q + r) * L::POT + e * 4) = o; } }
#pragma unroll
            for (int r = 0; r < 4; ++r) { float s = ss[r]; s += __shfl_xor(s, 1); s += __shfl_xor(s, 2); s += __shfl_xor(s, 4); s += __shfl_xor(s, 8);
                if (c == 0) tab[1600 + (16 * mt + 4 * q + r) * 2 + (w & 1)] = s; }
        }
        WG_BAR();
        PE(SSD ? 3 : 13); PB(SSD ? 4 : 14);
        if (SSD) { const int i = F.tid >> 3, p0 = 8 * (F.tid & 7); float zv[8], yv[8]; unpack8(gate0, zv); float ss = 0.f;
            const f32x4 ya = *(const LAS f32x4*)(lds + L::O_OT + i * L::POT + p0 * 4), yb = *(const LAS f32x4*)(lds + L::O_OT + i * L::POT + p0 * 4 + 16);
            yv[0] = ya.x; yv[1] = ya.y; yv[2] = ya.z; yv[3] = ya.w; yv[4] = yb.x; yv[5] = yb.y; yv[6] = yb.z; yv[7] = yb.w;
#pragma unroll
            for (int e = 0; e < 8; ++e) { yv[e] *= silu_f(zv[e]); ss += yv[e] * yv[e]; }
            ss += __shfl_xor(ss, 1); ss += __shfl_xor(ss, 2); ss += __shfl_xor(ss, 4);
            if (!dry) { *(u32x4*)(proj + (size_t)(row0 + i) * DINP + PC_CZ + 64 * h + p0) = pack8(yv);
                if ((F.tid & 7) == 0) { f32x2 pv; pv.x = ss; pv.y = 0.f; *(f32x2*)(wsf(F, WS_PSS) + (size_t)(row0 + i) * 16 + 2 * h) = pv; } }
        } else {
#pragma unroll
            for (int k = 0; k < 2; ++k) { const int idx = F.tid + 512 * k, i = idx >> 4, e0 = 8 * (idx & 15); float gv[8], yv[8]; unpack8(k ? gate1 : gate0, gv);
                const float rstd = rsqrtf((tab[1600 + 2 * i] + tab[1600 + 2 * i + 1]) * (1.f / 128.f) + EPS);
                const f32x4 ya = *(const LAS f32x4*)(lds + L::O_OT + i * L::POT + e0 * 4), yb = *(const LAS f32x4*)(lds + L::O_OT + i * L::POT + e0 * 4 + 16);
                const float* gn = F.in[I_GNORM] + layer * 512 + 128 * h + e0; const f32x4 na = *(const f32x4*)gn, nb = *(const f32x4*)(gn + 4);
                yv[0] = ya.x * na.x; yv[1] = ya.y * na.y; yv[2] = ya.z * na.z; yv[3] = ya.w * na.w; yv[4] = yb.x * nb.x; yv[5] = yb.y * nb.y; yv[6] = yb.z * nb.z; yv[7] = yb.w * nb.w;
#pragma unroll
                for (int e = 0; e < 8; ++e) yv[e] *= rstd * silu_f(gv[e]);
                if (!dry) *(u32x4*)(proj + (size_t)(row0 + i) * DINP + PC_BG + 128 * h + e0) = pack8(yv); }
        }
        if (chunk_last(chunk)) { if (!dry) { const int seq = chunk_seq(chunk);
            if (SSD) { float* so = st_out(F, O_PS, O_SS, layer, seq, 8 * 64 * 128) + (size_t)h * 64 * 128;
#pragma unroll
                for (int x = 0; x < 4; ++x) { int smt, snt; la_mt_nt<SSD>(4 * w + x, smt, snt); *(f32x4*)(so + (size_t)(16 * snt + c) * 128 + 16 * smt + 4 * q) = S[x]; } }
            else { float* so = st_out(F, O_PG, O_SG, layer, seq, 4 * 64 * 128) + (size_t)h * 64 * 128;
#pragma unroll
                for (int x = 0; x < 4; ++x) { int smt, snt; la_mt_nt<SSD>(4 * w + x, smt, snt);
#pragma unroll
                    for (int r = 0; r < 4; ++r) so[(size_t)(16 * smt + 4 * q + r) * 128 + 16 * snt + c] = S[x][r]; } } }
        } else if (cc + 1 < nc) la_write_sb<SSD>(lds, S, w, lane);
        WG_BAR();
        PE(SSD ? 4 : 14);
    }
}

struct LruSP { bf16x8 br[2], bi[2]; float b_r, b_i, lam, hin; };
template <bool PASS_C> DI void lru_load_sp(const Ctx& F, int layer, int h, int chunk, int nt, LruSP& p) {
    const int lane = F.lane, q = lane >> 4, c = lane & 15, col = 64 * h + 16 * nt + c;
    const bf16_t* wr_t = wsb(F, WS_LRUW) + (size_t)((layer * 2 + 0) * 8 + h) * 4096; const bf16_t* wi_t = wsb(F, WS_LRUW) + (size_t)((layer * 2 + 1) * 8 + h) * 4096;
#pragma unroll
    for (int ks = 0; ks < 2; ++ks) { const int o = (16 * nt + c) * 64 + 32 * ks + 8 * q; p.br[ks] = *(const bf16x8*)(wr_t + o); p.bi[ks] = *(const bf16x8*)(wi_t + o); }
    p.b_r = F.in[I_LBR][layer * 512 + col]; p.b_i = F.in[I_LBI][layer * 512 + col]; p.lam = F.in[I_LAM][layer * 512 + col]; p.hin = 0.f;
    if (PASS_C) p.hin = chunk >= 256 ? F.in[I_SLH][(size_t)(layer * 8 + (chunk - 256)) * 512 + col] : wsf(F, WS_LRUS)[(size_t)(2 * NCH + chunk) * 512 + col];
}
template <bool PASS_C> DI void lru_chunk(const Ctx& F0, int layer, int chunk, bool dry = false) {
    Ctx F = F0; OPAQUE_CTX(F);
    const int h = F.wave, lane = F.lane, q = lane >> 4, c = lane & 15, row0 = 64 * chunk; const bool first = chunk_first(chunk);
    LAS unsigned char* T = F.lds + h * 18432; LAS unsigned char* OT = T + 9216; constexpr int TP = 144;
    bf16_t* proj = wsb(F, WS_R);
    const int cc = lane & 7, rg = lane >> 3;
    PB(PASS_C ? 21 : 31);
    LruSP cur; lru_load_sp<PASS_C>(F, layer, h, chunk, 0, cur);
    {
        const int ch = 64 * h + 8 * cc; u32x4 xr[11];
#pragma unroll
        for (int i = 0; i < 11; ++i) { const int tt = 8 * rg - 3 + i;
            if (tt >= 0 || !first) xr[i] = *(const u32x4*)(proj + (size_t)(row0 + tt) * DINP + PC_AX + ch);
            else if (chunk >= 256) { const float* sp = F.in[I_SLC] + ((size_t)(layer * 8 + (chunk - 256)) * 3 + (tt + 3)) * 512 + ch; const f32x4 a = *(const f32x4*)sp, b = *(const f32x4*)(sp + 4);
                u32x4 o; o.x = pk2(a.x, a.y); o.y = pk2(a.z, a.w); o.z = pk2(b.x, b.y); o.w = pk2(b.z, b.w); xr[i] = o; }
            else xr[i] = (u32x4){0u, 0u, 0u, 0u};
        }
        const float* cwp = F.in[I_LCW] + (size_t)layer * 4 * 512 + ch; const float* cbp = F.in[I_LCB] + layer * 512 + ch;
        float wv[4][8], bv[8];
#pragma unroll
        for (int j = 0; j < 4; ++j) { const f32x4 a = *(const f32x4*)(cwp + j * 512), b = *(const f32x4*)(cwp + j * 512 + 4); wv[j][0] = a.x; wv[j][1] = a.y; wv[j][2] = a.z; wv[j][3] = a.w; wv[j][4] = b.x; wv[j][5] = b.y; wv[j][6] = b.z; wv[j][7] = b.w; }
        { const f32x4 a = *(const f32x4*)cbp, b = *(const f32x4*)(cbp + 4); bv[0] = a.x; bv[1] = a.y; bv[2] = a.z; bv[3] = a.w; bv[4] = b.x; bv[5] = b.y; bv[6] = b.z; bv[7] = b.w; }
        float x0[8], x1[8], x2[8], x3[8]; unpack8(xr[0], x0); unpack8(xr[1], x1); unpack8(xr[2], x2);
#pragma unroll
        for (int r = 0; r < 8; ++r) { float o[8]; unpack8(xr[r + 3], x3);
#pragma unroll
            for (int e = 0; e < 8; ++e) { o[e] = bv[e] + wv[0][e] * x0[e] + wv[1][e] * x1[e] + wv[2][e] * x2[e] + wv[3][e] * x3[e]; x0[e] = x1[e]; x1[e] = x2[e]; x2[e] = x3[e]; }
            *(LAS u32x4*)(T + (8 * rg + r) * TP + cc * 16) = pack8(o); }
    }
    LDS_WAIT();
    PE(PASS_C ? 21 : 31); PB(PASS_C ? 22 : 32);
#pragma unroll 1
    for (int nt = 0; nt < 4; ++nt) {
        LruSP nx = cur; if (nt < 3) lru_load_sp<PASS_C>(F, layer, h, chunk, nt + 1, nx);
        const int col = 64 * h + 16 * nt + c;
        const float c8 = -8.f * softplus_f(-cur.lam);
        float hc = cur.hin, pc = 1.f;
#pragma unroll
        for (int mt = 0; mt < 4; ++mt) {
            const bf16x8 a0 = frag_row(T, TP, 16 * mt, 0, lane), a1 = frag_row(T, TP, 16 * mt, 32, lane);
            f32x4 ar = {0.f, 0.f, 0.f, 0.f}, ai = {0.f, 0.f, 0.f, 0.f};
            ar = MFMA16(a0, cur.br[0], ar); ar = MFMA16(a1, cur.br[1], ar); ai = MFMA16(a0, cur.bi[0], ai); ai = MFMA16(a1, cur.bi[1], ai);
            float a[4], uu[4];
#pragma unroll
            for (int r = 0; r < 4; ++r) { const int t = 16 * mt + 4 * q + r; const float rg_ = sigm(ar[r] + cur.b_r), ig = sigm(ai[r] + cur.b_i), la = c8 * rg_;
                a[r] = __expf(la); uu[r] = __builtin_amdgcn_sqrtf(fmaxf(1.f - a[r] * a[r], 0.f)) * ig * ld_bf16(T, TP, t, 16 * nt + c); }
            const float P = (a[0] * a[1]) * (a[2] * a[3]); const float Hl = ((uu[0] * a[1] + uu[1]) * a[2] + uu[2]) * a[3] + uu[3];
            float hrun = hc, my_in = 0.f;
#pragma unroll
            for (int qq = 0; qq < 4; ++qq) { const float Pq = __shfl(P, c + 16 * qq), Hq = __shfl(Hl, c + 16 * qq); if (qq == q) my_in = hrun; hrun = Pq * hrun + Hq; pc *= Pq; }
            hc = hrun;
            if (PASS_C) { float hh = my_in;
#pragma unroll
                for (int r = 0; r < 4; ++r) { hh = a[r] * hh + uu[r]; st_bf16(OT, TP, 16 * mt + 4 * q + r, 16 * nt + c, hh); } }
        }
        if (!PASS_C) { if (q == 0) { wsf(F, WS_LRUS)[(size_t)chunk * 512 + col] = pc; wsf(F, WS_LRUS)[(size_t)(NCH + chunk) * 512 + col] = hc; } }
        else if (chunk_last(chunk) && q == 0 && !dry) st_out(F, O_PLH, O_SLH, layer, chunk_seq(chunk), 512)[col] = hc;
        cur = nx;
    }
    PE(PASS_C ? 22 : 32); PB(PASS_C ? 23 : 33);
    if (PASS_C) {
        LDS_WAIT();
        u32x4* gp = (u32x4*)(proj + (size_t)(row0 + rg) * DINP + PC_AG + 64 * h + 8 * cc); u32x4 gnx = *gp;
#pragma unroll 1
        for (int i = 0; i < 8; ++i) { const int t = rg + 8 * i; const u32x4 gc = gnx; u32x4* gq = gp + (size_t)i * (8 * DINP * 2 / 16);
            if (i < 7) gnx = *(gq + (8 * DINP * 2 / 16));
            float hv[8], gv[8]; unpack8(*(const LAS u32x4*)(OT + t * TP + cc * 16), hv); unpack8(gc, gv);
#pragma unroll
            for (int e = 0; e < 8; ++e) hv[e] *= gelu_t(gv[e]);
            if (!dry) *gq = pack8(hv); }
        if (chunk_last(chunk) && !dry) { float* so = st_out(F, O_PLC, O_SLC, layer, chunk_seq(chunk), 3 * 512);
#pragma unroll
            for (int i = 0; i < 3; ++i) so[i * 512 + 64 * h + lane] = bf2f(proj[(size_t)(row0 + 61 + i) * DINP + PC_AX + 64 * h + lane]); }
    }
    LDS_WAIT();
    PE(PASS_C ? 23 : 33);
}

DI void phase_mixer_a(const Ctx& F, int layer) {
    for (int it = blockIdx.x; it < 1034; it += F.G) {
        if (it < 256) gla_pass_a(F, layer, it >> 2, it & 3);
        else if (it < 768) ssd_pass_a(F, layer, (it - 256) >> 3, (it - 256) & 7);
        else if (it < 1024) lru_chunk<false>(F, layer, it - 768);
        else { const int seq = it - 1024, lastrow = seq < 2 ? 8192 * (seq + 1) - 1 : MP + 64 * (seq - 1) - 1;
            float* so = st_out(F, O_PSC, O_SSC, layer, seq, 3 * 1024); const bf16_t* proj = wsb(F, WS_R);
            for (int e = F.tid; e < 3 * 1024; e += 512) so[e] = bf2f(proj[(size_t)(lastrow - 2 + (e >> 10)) * DINP + PC_XBC + (e & 1023)]); }
        __syncthreads();
    }
}
DI void phase_mixer_b(const Ctx& F, int layer, bool dry) {
    float* ds = wsf(F, WS_DS); const float* dec = wsf(F, WS_DEC);
    for (int e = blockIdx.x * 512 + F.tid; e < 2 * 12 * 8192; e += F.G * 512) {
        const int idx = e & 8191, hh = (e >> 13) % 12, b = e / (12 * 8192);
        const int ln = idx & 63, r = (idx >> 6) & 3, Tt = idx >> 8; const int a = 16 * (Tt >> 3) + 4 * (ln >> 4) + r;
        float v[32];
#pragma unroll
        for (int p = 0; p < 32; ++p) v[p] = ds[((size_t)(32 * b + p) * 12 + hh) * 8192 + idx];
        float S = 0.f;
#pragma unroll
        for (int p = 0; p < 32; ++p) { const int panel = 32 * b + p; const float dc = hh < 4 ? dec[(panel * 4 + hh) * 64 + a] : dec[64 * 4 * 64 + panel * 8 + (hh - 4)];
            if (!dry) ds[((size_t)panel * 12 + hh) * 8192 + idx] = S; S = dc * S + v[p]; }
    }
    {
        const int gw = blockIdx.x * NWAVES + F.wave; float* ls = wsf(F, WS_LRUS);
        if (gw < 1024) { const int b = gw >> 9, ch = gw & 511, l = F.lane; const int c0 = 128 * b + 2 * l;
            const float A0 = ls[(size_t)c0 * 512 + ch], H0 = ls[(size_t)(NCH + c0) * 512 + ch], A1 = ls[(size_t)(c0 + 1) * 512 + ch], H1 = ls[(size_t)(NCH + c0 + 1) * 512 + ch];
            float A = A1 * A0, H = A1 * H0 + H1;
#pragma unroll
            for (int o = 1; o < 64; o <<= 1) { const float Ap = __shfl_up(A, o), Hp = __shfl_up(H, o); if (l >= o) { H = A * Hp + H; A = A * Ap; } }
            float E = __shfl_up(H, 1); if (l == 0) E = 0.f;
            ls[(size_t)(2 * NCH + c0) * 512 + ch] = E; ls[(size_t)(2 * NCH + c0 + 1) * 512 + ch] = A0 * E + H0; }
    }
}
#ifndef MIX_MASK
#define MIX_MASK 7
#endif
#ifndef DRY_MIX
#define DRY_MIX 7
#endif
DI void phase_mixer_c(const Ctx& F, int layer, bool dry) {
    const int mm = dry ? DRY_MIX : MIX_MASK;
    for (int it = blockIdx.x; it < 1128; it += F.G) {
        if (it < 512) { if (mm & 1) la_pass_c<true>(F, layer, 4 * (it >> 3), 4, it & 7, dry); }
        else if (it < 768) { if (mm & 2) la_pass_c<false>(F, layer, 4 * ((it - 512) >> 2), 4, (it - 512) & 3, dry); }
        else if (it < 1032) { if (mm & 4) lru_chunk<true>(F, layer, it - 768, dry); }
        else if (it < 1096) { if (mm & 1) la_pass_c<true>(F, layer, 256 + ((it - 1032) >> 3), 1, (it - 1032) & 7, dry); }
        else { if (mm & 2) la_pass_c<false>(F, layer, 256 + ((it - 1096) >> 2), 1, (it - 1096) & 3, dry); }
        __syncthreads();
    }
}
DI void phase_ssd_norm(const Ctx& F, int layer, bool dry) {
    const int gw = F.vcu * NWAVES + F.wave, NGW = F.G * NWAVES; bf16_t* proj = wsb(F, WS_R); const float* pss = wsf(F, WS_PSS);
    float gn[8]; { const float* gp = F.in[I_SNORM] + layer * 512 + 8 * F.lane; const f32x4 a = *(const f32x4*)gp, b = *(const f32x4*)(gp + 4); gn[0] = a.x; gn[1] = a.y; gn[2] = a.z; gn[3] = a.w; gn[4] = b.x; gn[5] = b.y; gn[6] = b.z; gn[7] = b.w; }
    for (int m = gw; m < M; m += NGW) {
        const f32x4* p = (const f32x4*)(pss + (size_t)m * 16); const f32x4 a = p[0], b = p[1], c = p[2], d = p[3];
        const float s = ((a.x + a.y) + (a.z + a.w)) + ((b.x + b.y) + (b.z + b.w)) + ((c.x + c.y) + (c.z + c.w)) + ((d.x + d.y) + (d.z + d.w));
        const float rstd = rsqrtf(s * (1.f / 512.f) + EPS);
        u32x4* yp = (u32x4*)(proj + (size_t)m * DINP + PC_CZ + 8 * F.lane); float v[8]; unpack8(*yp, v);
#pragma unroll
        for (int e = 0; e < 8; ++e) v[e] *= rstd * gn[e];
        *yp = pack8(v);
    }
}
DI void phase_final(const Ctx& F) {
    const int gw = F.vcu * NWAVES + F.wave, NGW = F.G * NWAVES; const float* rss = wsf(F, WS_RSSN) + (size_t)XB_PAD * 16; const float* gf = F.in[I_NFIN]; const bf16_t* xs = wsb(F, WS_XBN);
    for (int m = gw; m < M; m += NGW) { const float rs = row_rstd(rss, m); f32x4* y4 = (f32x4*)(F.out + (size_t)m * D) + F.lane; const u32x2* x2 = (const u32x2*)(xs + (size_t)m * D) + F.lane;
#pragma unroll
        for (int j = 0; j < 4; ++j) { const f32x4 g = *((const f32x4*)gf + F.lane + 64 * j); const u32x2 xw = x2[64 * j];
            f32x4 y; y[0] = __uint_as_float(xw.x << 16) * rs * g[0]; y[1] = __uint_as_float(xw.x & 0xffff0000u) * rs * g[1]; y[2] = __uint_as_float(xw.y << 16) * rs * g[2]; y[3] = __uint_as_float(xw.y & 0xffff0000u) * rs * g[3];
            y4[64 * j] = y; } }
}

constexpr int PH_PER_LAYER = 9, N_PHASES = 1 + DEPTH * PH_PER_LAYER + 1;
__global__ void __launch_bounds__(NWAVES * 64, 2) mk_fwd(Args args) {
    extern __shared__ __attribute__((aligned(16))) unsigned char lds_raw[];
    Ctx F; F.lds = (LAS unsigned char*)lds_raw; F.in = args.in; F.out = args.out; F.ws = args.ws;
    F.wave = __builtin_amdgcn_readfirstlane((int)threadIdx.x >> 6); F.lane = 0; F.tid = 0;
#define T0() (F.wave == 0 && lane_id() == 0)
    F.G = gridDim.x; { const int bx = blockIdx.x; F.vcu = (F.G % 8 == 0) ? (bx % 8) * (F.G / 8) + bx / 8 : bx; }
    volatile LAS unsigned* MISC = (volatile LAS unsigned*)(F.lds + MISC_OFF);
    if (F.wave == 0) MISC[lane_id()] = 0u;
    __syncthreads();
    XcdBarrier bar; bar.bar = (unsigned*)(args.ws + WS_CTL); bar.x = 0; bar.st = nullptr;
    if (args.use_bar) bar = xcd_barrier_post((unsigned*)(args.ws + WS_CTL), MISC + 8, T0());
    const int lo = args.ph_lo, hi = args.ph_hi;
#ifndef PH_MASK
#define PH_MASK 0xFFFFu
#endif
#define IN(k) (lo <= (k) && (k) < hi)
#define ON(b) ((PH_MASK >> (b)) & 1u)
#define SEAM(k) do { if (IN(k) && IN((k) + 1)) xcd_barrier(bar, T0()); } while (0)
#ifndef REP_MASK
#define REP_MASK 0
#endif
#define REPS(b) ((REP_MASK >> (b)) & 1)
#define XBAR() do { if (args.use_bar) xcd_barrier(bar, T0()); } while (0)
#define GP bf16_t* XB = wsb(C, WS_XB) + (size_t)XB_PAD * D; float* RSS = wsf(C, WS_RSS) + (size_t)XB_PAD * 16; bf16_t* XBN = (bf16_t*)C.out; bf16_t* XBNO = layer + 1 < DEPTH ? (bf16_t*)C.out : wsb(C, WS_XBN); float* RSSN = wsf(C, WS_RSSN) + (size_t)XB_PAD * 16; \
    (void)XB; (void)RSS; (void)XBN; (void)XBNO; (void)RSSN
#define PHC Ctx C = F; C.lane = lane_id(); C.tid = C.wave * 64 + C.lane; OPAQUE_CTX(C); { size_t zz_ = 0; asm volatile("" : "+s"(zz_)); C.ws = F.ws + zz_; C.out = (float*)((char*)F.out + zz_); }
    PB(100);
    for (int rr_ = 0; rr_ <= REPS(0); ++rr_) { if (IN(0) && ON(0)) { PHC; convert_set(C, 0, 1 | 2 | 4 | 8 | 16 | 32 | 64 | 128, C.vcu, C.G); p0_rows(C); } if (rr_ < REPS(0)) XBAR(); }
    PE(100); PB(120); SEAM(0); PE(120);
    for (int layer = 0; layer < DEPTH; ++layer) {
        const int pb = 1 + layer * PH_PER_LAYER;
        PB(101);
        for (int rr_ = 0; rr_ <= REPS(1); ++rr_) { if (rr_) XBAR();
        if (IN(pb + 0) && ON(1)) { PHC; GP;
            pg8::Gemm g{XBN, wsb(C, WS_WIN), D, D, D}; pg8::StaticOrder S; S.init(M / 256, DINP / 256, C.G, (int)blockIdx.x, 0);
            EpiProj E{wsb(C, WS_R), RSSN}; pg8::gemm_phase<EpiProj, pg8::StaticOrder>(C.lds, g, S, E, C.wave);
            if (layer >= 1 && rr_ == 0 && C.G == 256 && (int)blockIdx.x >= 98) { __syncthreads(); convert_set(C, layer, 2 | 4 | 8 | 16 | 32 | 64, (int)blockIdx.x - 98, C.G - 98); }
            else if (layer >= 1 && rr_ == 0 && C.G != 256) { __syncthreads(); convert_set(C, layer, 2 | 4 | 8 | 16 | 32 | 64, C.vcu, C.G); }
        } }
        PE(101); PB(120); PB(121); SEAM(pb + 0); PE(121); PE(120); PB(102);
        for (int rr_ = 0; rr_ <= REPS(2); ++rr_) { if (rr_) XBAR(); if (IN(pb + 1) && ON(2)) { PHC; phase_mixer_a(C, layer); } }
        PE(102); PB(120); PB(123); SEAM(pb + 1); PE(123); PE(120); PB(103);
        for (int rr_ = 0; rr_ <= REPS(3); ++rr_) { if (rr_) XBAR();
        if (IN(pb + 2) && ON(3)) { PHC; phase_mixer_b(C, layer, rr_ < REPS(3));
            if (layer + 1 < DEPTH) convert_set(C, layer + 1, 1, C.vcu, C.G); } }
        PE(103); PB(120); PB(122); SEAM(pb + 2); PE(122); PE(120); PB(104);
        for (int rr_ = 0; rr_ <= REPS(4); ++rr_) { if (rr_) XBAR(); if (IN(pb + 3) && ON(4)) { PHC; phase_mixer_c(C, layer, rr_ < REPS(4)); } }
        PE(104); PB(120); PB(124); SEAM(pb + 3); PE(124); PE(120); PB(105);
        for (int rr_ = 0; rr_ <= REPS(5); ++rr_) { if (rr_) XBAR(); if (IN(pb + 4) && ON(5)) { PHC; phase_ssd_norm(C, layer, rr_ < REPS(5)); } }
        PE(105); PB(120); SEAM(pb + 4); PE(120); PB(106);
        for (int rr_ = 0; rr_ <= REPS(6); ++rr_) { if (rr_) XBAR(); const bool dry_ = rr_ < REPS(6);
        if (IN(pb + 5) && ON(6)) { PHC; GP;
            pg8::Gemm g{wsb(C, WS_R) + PC_Y, wsb(C, WS_WOUT), DINP, DMIX, DMIX}; pg8::StaticOrder S; S.init(MP / 256, D / 256, C.G, (int)blockIdx.x, 0);
            EpiRes E{XBN, XB, RSS, dry_};
            pg8::gemm_phase<EpiRes, pg8::StaticOrder>(C.lds, g, S, E, C.wave);
            { constexpr int SK = 6, KS = DMIX / SK; const int c = (int)blockIdx.x, j = c / SK, sl = c % SK;
              pg8::Gemm g2{wsb(C, WS_R) + PC_Y + sl * KS, wsb(C, WS_WOUT) + sl * KS, DINP, DMIX, KS}; OneUnit S2{64 + (j >> 2), j & 3, c < 8 * SK};
              EpiPart E2{C.out + (size_t)M * D / 2 + (size_t)(c < 8 * SK ? c : 0) * 65536}; pg8::gemm_phase<EpiPart, OneUnit>(C.lds, g2, S2, E2, C.wave); }
        } }
        XBAR();
        if (IN(pb + 5) && ON(6)) { PHC; GP; reduce_tail<0>(C, C.out + (size_t)M * D / 2, 6, XBN, XB, RSS, RSS, nullptr); }
        PE(106); PB(120); SEAM(pb + 5); PE(120); PB(107);
        for (int rr_ = 0; rr_ <= REPS(7); ++rr_) { if (rr_) XBAR();
        if (IN(pb + 6) && ON(7)) { PHC; GP;
            pg8::Gemm g{XB, wsb(C, WS_WGU), D, D, D}; pg8::StaticOrder S; S.init(67, 2 * DFF / 256, C.G, (int)blockIdx.x, 1);
            EpiFfn E{wsb(C, WS_R), RSS, C.in[I_FCW] + (size_t)layer * 3 * DFF, C.in[I_FCB] + layer * DFF, C.in[I_SFC] + (size_t)layer * 8 * 2 * DFF,
                     C.out + O_PFC + (size_t)layer * 2 * 2 * DFF, C.out + O_SFC + (size_t)layer * 8 * 2 * DFF};
            pg8::gemm_phase<EpiFfn, pg8::StaticOrder>(C.lds, g, S, E, C.wave);
            if (rr_ == 0) { const int sh = C.G == 256 ? 72 : 0;
                if ((int)blockIdx.x >= sh) { pg8::Gemm g2{wsb(C, WS_PB), wsb(C, WS_WPP), DPLE, DPLE, DPLE}; pg8::StaticOrder S2; S2.init(M / 256, D / 256, C.G - sh, (int)blockIdx.x - sh, 0);
                    EpiPP E2{wsb(C, WS_PPO)}; pg8::gemm_phase<EpiPP, pg8::StaticOrder>(C.lds, g2, S2, E2, C.wave); } }
        } }
        PE(107); PB(120); SEAM(pb + 6); PE(120); PB(108);
        for (int rr_ = 0; rr_ <= REPS(8); ++rr_) { if (rr_) XBAR(); const bool dry_ = rr_ < REPS(8);
        if (IN(pb + 7) && ON(8)) { PHC; GP;
            pg8::Gemm g{wsb(C, WS_R), wsb(C, WS_WD), DFF, DFF, DFF}; pg8::StaticOrder S; S.init(MP / 256, D / 256, C.G, (int)blockIdx.x, 0);
            EpiRes E{XB, XB, RSS, dry_}; pg8::gemm_phase<EpiRes, pg8::StaticOrder>(C.lds, g, S, E, C.wave);
            { constexpr int SK = 12, KS = DFF / SK; const int c = (int)blockIdx.x, j = c / SK, sl = c % SK;
              pg8::Gemm g2{wsb(C, WS_R) + sl * KS, wsb(C, WS_WD) + sl * KS, DFF, DFF, KS}; OneUnit S2{64 + (j >> 2), j & 3, c < 8 * SK};
              EpiPart E2{C.out + (size_t)M * D / 2 + (size_t)(c < 8 * SK ? c : 0) * 65536}; pg8::gemm_phase<EpiPart, OneUnit>(C.lds, g2, S2, E2, C.wave); }
        } }
        XBAR();
        if (IN(pb + 7) && ON(8)) { PHC; GP; reduce_tail<0>(C, C.out + (size_t)M * D / 2, 12, XB, XB, RSS, RSS, nullptr); }
        PE(108); PB(120); SEAM(pb + 7); PE(120); PB(109);
        for (int rr_ = 0; rr_ <= REPS(9); ++rr_) { if (rr_) XBAR(); const bool dry_ = rr_ < REPS(9);
        if (IN(pb + 8) && ON(9)) { PHC; GP;
            pg8::Gemm g{XB, wsb(C, WS_WPG), D, D, D}; pg8::StaticOrder S; S.init(MP / 256, D / 256, C.G, (int)blockIdx.x, 0);
            EpiPle E{XB, XBNO, RSS, RSSN, wsb(C, WS_PPO), dry_}; pg8::gemm_phase<EpiPle, pg8::StaticOrder>(C.lds, g, S, E, C.wave);
            { constexpr int SK = 4, KS = D / SK; const int c = (int)blockIdx.x, j = c / SK, sl = c % SK;
              pg8::Gemm g2{XB + sl * KS, wsb(C, WS_WPG) + sl * KS, D, D, KS}; OneUnit S2{64 + (j >> 2), j & 3, c < 8 * SK};
              EpiPart E2{C.out + (size_t)M * D / 2 + (size_t)(c < 8 * SK ? c : 0) * 65536}; pg8::gemm_phase<EpiPart, OneUnit>(C.lds, g2, S2, E2, C.wave); }
        } }
        XBAR();
        if (IN(pb + 8) && ON(9)) { PHC; GP; reduce_tail<1>(C, C.out + (size_t)M * D / 2, 4, XB, XBNO, RSS, RSSN, wsb(C, WS_PPO)); }
        PE(109); PB(120); SEAM(pb + 8); PE(120); PB(110);
    }
    PB(111);
    if (IN(N_PHASES - 1) && ON(10)) { PHC; phase_final(C); }
    PE(111);
    if (PROBE_ID != 0 && (int)blockIdx.x == PROBE_WG) { __syncthreads(); if (F.wave == 0) { const unsigned tot = MISC[32] * PROBE_MULT; const unsigned t0 = (unsigned)__builtin_amdgcn_s_memrealtime();
        while ((unsigned)__builtin_amdgcn_s_memrealtime() - t0 < tot) __builtin_amdgcn_s_sleep(8); } }
#undef IN
#undef ON
#undef SEAM
}

extern "C" void kernel_launch(void* const* d_in, const int* in_sizes, int n_in, void* d_out, int out_size, void* d_ws, size_t ws_size, hipStream_t stream) {
    static int grid = 0;
    if (grid == 0) {
        if (n_in != N_IN || (size_t)out_size != O_END || ws_size < WS_END) { fprintf(stderr, "kernel_launch: unexpected shapes: n_in %d out %d ws %zu (need %d, %zu, %zu)\n", n_in, out_size, ws_size, (int)N_IN, (size_t)O_END, (size_t)WS_END); grid = -1; return; }
        int dev = 0, cus = 0, per_cu = 0;
        if (hipGetDevice(&dev) != hipSuccess || hipDeviceGetAttribute(&cus, hipDeviceAttributeMultiprocessorCount, dev) != hipSuccess) { grid = -1; return; }
        if (hipFuncSetAttribute((const void*)mk_fwd, hipFuncAttributeMaxDynamicSharedMemorySize, LDS_BYTES) != hipSuccess) { fprintf(stderr, "kernel_launch: hipFuncSetAttribute failed\n"); grid = -1; return; }
        if (hipOccupancyMaxActiveBlocksPerMultiprocessor(&per_cu, (const void*)mk_fwd, NWAVES * 64, LDS_BYTES) != hipSuccess || per_cu < 1) { fprintf(stderr, "kernel_launch: occupancy query says %d\n", per_cu); per_cu = 1; }
        (void)hipGetLastError();
        grid = cus;
    }
    if (grid < 0) return;
    (void)hipMemsetAsync((char*)d_ws + WS_CTL, 0, CTL_ZERO_BYTES, stream);
    Args a{};
    for (int i = 0; i < N_IN; ++i) a.in[i] = (const float*)d_in[i];
    a.out = (float*)d_out; a.ws = (unsigned char*)d_ws;
#if MK_PER_PHASE
    for (int p = 0; p < N_PHASES; ++p) { a.ph_lo = p; a.ph_hi = p + 1; a.use_bar = 0; hipLaunchKernelGGL(mk_fwd, dim3(grid), dim3(NWAVES * 64), LDS_BYTES, stream, a); }
#else
    a.ph_lo = 0; a.ph_hi = N_PHASES; a.use_bar = 1;
    void* kargs[] = {&a};
    hipError_t e = hipLaunchCooperativeKernel((const void*)mk_fwd, dim3(grid), dim3(NWAVES * 64), kargs, LDS_BYTES, stream);
    if (e != hipSuccess) fprintf(stderr, "kernel_launch: cooperative launch failed: %s\n", hipGetErrorString(e));
#endif
}
```
